# Optimizing an MI355X kernel written in HIP

```python
import math
import jax, jax.numpy as jnp
from jax import lax
import numpy as np

D_MODEL = 1024
BATCH = 32
SEQ = 2048
DEPTH = 2

PLE_DIM = 256
N_EVEN = (DEPTH + 1) // 2
N_ODD = DEPTH // 2
D_CONV_A = D_MODEL // 2
CONV_A_WIDTH = 3
GDN_HEADS = 4
GDN_DK = D_MODEL // 8
GDN_DV = D_MODEL // 8
GDN_CONV_WIDTH = 4
GDN_CHUNK = 64
DIFF_HEADS = 4
DIFF_DH = D_MODEL // 16
DIFF_QBLK = 128
NUM_BUCKETS = 32
MAX_DISTANCE = 128
D_CONF = D_MODEL // 2
CONF_WIDTH = 31
D_FF = 11 * D_MODEL // 4
N_EXPERTS = 8
TOP_K = 2
D_FF_EXPERT = 7 * D_MODEL // 2
MOE_BLOCK = 256
EPS = 1e-6

EV_WIDTHS = (D_CONV_A, D_CONV_A, D_CONV_A,
             GDN_HEADS * GDN_DK, GDN_HEADS * GDN_DK, GDN_HEADS * GDN_DV,
             GDN_HEADS * GDN_DV, GDN_HEADS, GDN_HEADS)
EV_IN = 3 * D_CONV_A + 2 * GDN_HEADS * GDN_DK + 2 * GDN_HEADS * GDN_DV + 2 * GDN_HEADS
EV_OUT = D_CONV_A + GDN_HEADS * GDN_DV
OD_WIDTHS = (DIFF_HEADS * 2 * DIFF_DH, DIFF_HEADS * 2 * DIFF_DH, DIFF_HEADS * 2 * DIFF_DH, 2 * D_CONF)
OD_IN = 3 * DIFF_HEADS * 2 * DIFF_DH + 2 * D_CONF
OD_OUT = DIFF_HEADS * 2 * DIFF_DH + D_CONF

kernel_name = 'hybrid_conv_gdn_diffattn_conformer_moe'


def rmsnorm(x, g):
    xf = x.astype(jnp.float32)
    y = xf * lax.rsqrt(jnp.mean(xf * xf, axis=-1, keepdims=True) + EPS) * g.astype(jnp.float32)
    return y.astype(x.dtype)


def layernorm(x, g, b):
    xf = x.astype(jnp.float32)
    mu = jnp.mean(xf, axis=-1, keepdims=True)
    var = jnp.mean(jnp.square(xf - mu), axis=-1, keepdims=True)
    y = (xf - mu) * lax.rsqrt(var + EPS) * g.astype(jnp.float32) + b.astype(jnp.float32)
    return y.astype(x.dtype)


def l2norm(x):
    xf = x.astype(jnp.float32)
    return xf * lax.rsqrt(jnp.sum(xf * xf, axis=-1, keepdims=True) + EPS)


def split_cols(u, widths):
    offs = [int(o) for o in np.cumsum(widths)[:-1]]
    return jnp.split(u, offs, axis=-1)


def causal_dwconv(x, w):
    K, C = w.shape
    return lax.conv_general_dilated(x, w[:, None, :].astype(x.dtype), window_strides=(1,),
                                    padding=[(K - 1, 0)], dimension_numbers=('NWC', 'WIO', 'NWC'),
                                    feature_group_count=C)


def gated_delta_chunked(q, k, v, log_a, beta):
    Bb, Ss, H, dk = q.shape
    dv = v.shape[-1]
    C = GDN_CHUNK
    N = Ss // C
    f32 = jnp.float32
    def chunks(t):
        return t.astype(f32).reshape(Bb, N, C, H, -1).transpose(0, 3, 1, 2, 4)
    qc = chunks(q) * (dk ** -0.5)
    kc = chunks(k)
    vc = chunks(v)
    g = log_a.astype(f32).reshape(Bb, N, C, H).transpose(0, 3, 1, 2)
    bt = beta.astype(f32).reshape(Bb, N, C, H).transpose(0, 3, 1, 2)
    gc = jnp.cumsum(g, axis=-1)
    tril = jnp.tril(jnp.ones((C, C), bool))
    strict = jnp.tril(jnp.ones((C, C), bool), -1)
    diff = gc[..., :, None] - gc[..., None, :]
    decay = jnp.where(tril, jnp.exp(jnp.where(tril, diff, 0.0)), 0.0)
    kb = kc * bt[..., None]
    vb = vc * bt[..., None]
    A = jnp.where(strict, jnp.einsum('bhncd,bhnjd->bhncj', kb, kc) * decay, 0.0)
    M = A + jnp.eye(C, dtype=f32)
    u = lax.linalg.triangular_solve(M, vb, left_side=True, lower=True, unit_diagonal=True)
    w = lax.linalg.triangular_solve(M, kb * jnp.exp(gc)[..., None], left_side=True, lower=True,
                                    unit_diagonal=True)
    qk = jnp.einsum('bhncd,bhnjd->bhncj', qc, kc) * decay

    def step(S, xs):
        q_c, k_c, u_c, w_c, g_c, qk_c = xs
        v_new = u_c - jnp.einsum('bhcd,bhde->bhce', w_c, S)
        o = (jnp.einsum('bhcd,bhde->bhce', q_c * jnp.exp(g_c)[..., None], S)
             + jnp.einsum('bhcj,bhje->bhce', qk_c, v_new))
        g_last = g_c[..., -1]
        S = (S * jnp.exp(g_last)[..., None, None]
             + jnp.einsum('bhcd,bhce->bhde', k_c * jnp.exp(g_last[..., None] - g_c)[..., None], v_new))
        return S, o

    xs = (jnp.moveaxis(qc, 2, 0), jnp.moveaxis(kc, 2, 0), jnp.moveaxis(u, 2, 0),
          jnp.moveaxis(w, 2, 0), jnp.moveaxis(gc, 2, 0), jnp.moveaxis(qk, 2, 0))
    S0 = jnp.zeros((Bb, H, dk, dv), f32)
    _, o = lax.scan(step, S0, xs)
    return o.transpose(1, 0, 3, 2, 4).reshape(Bb, Ss, H, dv).astype(v.dtype)


def rel_bucket(rel):
    n = jnp.maximum(rel, 0)
    max_exact = NUM_BUCKETS // 2
    nf = jnp.maximum(n, 1).astype(jnp.float32)
    large = max_exact + (jnp.log(nf / max_exact) / math.log(MAX_DISTANCE / max_exact)
                         * (NUM_BUCKETS - max_exact)).astype(jnp.int32)
    large = jnp.minimum(large, NUM_BUCKETS - 1)
    return jnp.where(n < max_exact, n, large)


def diff_attention(q, k, v, lam, rel_table):
    Bb, Ss, H, _, dh = q.shape
    nq = Ss // DIFF_QBLK
    scale = dh ** -0.5
    qb = q.reshape(Bb, nq, DIFF_QBLK, H, 2, dh).transpose(1, 0, 2, 3, 4, 5)
    k_pos = jnp.arange(Ss, dtype=jnp.int32)

    def block(args):
        qi, iblk = args
        q_pos = iblk * DIFF_QBLK + jnp.arange(DIFF_QBLK, dtype=jnp.int32)
        rel = q_pos[:, None] - k_pos[None, :]
        bias = rel_table.astype(jnp.float32)[rel_bucket(rel)].transpose(2, 0, 1)
        s = jnp.einsum('bqhmd,bkhmd->bmhqk', qi, k).astype(jnp.float32) * scale + bias
        s = jnp.where(rel >= 0, s, -jnp.inf)
        pr = jax.nn.softmax(s, axis=-1)
        a = pr[:, 0] - lam * pr[:, 1]
        return jnp.einsum('bhqk,bkhe->bqhe', a.astype(v.dtype), v)

    o = lax.map(block, (qb, jnp.arange(nq, dtype=jnp.int32)))
    return o.transpose(1, 0, 2, 3, 4).reshape(Bb, Ss, H, 2 * dh)


def even_mixer(hn, w_in, conv_a, gdn_conv, A_log, dt_bias, gdn_norm_g, w_out):
    Bb, Ss, _ = hn.shape
    u = hn @ w_in
    bg, cg, xin, qf, kf, vf, og, af, bf = split_cols(u, EV_WIDTHS)
    ya = bg * causal_dwconv(cg * xin, conv_a)
    qkv = jax.nn.silu(causal_dwconv(jnp.concatenate([qf, kf, vf], axis=-1), gdn_conv))
    qf, kf, vf = split_cols(qkv, (GDN_HEADS * GDN_DK, GDN_HEADS * GDN_DK, GDN_HEADS * GDN_DV))
    q = l2norm(qf.reshape(Bb, Ss, GDN_HEADS, GDN_DK))
    k = l2norm(kf.reshape(Bb, Ss, GDN_HEADS, GDN_DK))
    v = vf.reshape(Bb, Ss, GDN_HEADS, GDN_DV)
    log_a = -jnp.exp(A_log.astype(jnp.float32)) * jax.nn.softplus(af.astype(jnp.float32) + dt_bias.astype(jnp.float32))
    beta = jax.nn.sigmoid(bf.astype(jnp.float32))
    o = gated_delta_chunked(q, k, v, log_a, beta)
    o = rmsnorm(o, gdn_norm_g) * jax.nn.silu(og.reshape(Bb, Ss, GDN_HEADS, GDN_DV))
    y = jnp.concatenate([ya, o.reshape(Bb, Ss, GDN_HEADS * GDN_DV)], axis=-1)
    return y @ w_out


def odd_mixer(hn, w_in, lam_params, diff_norm_g, conf_dw_w, conf_dw_b, conf_ln_g, conf_ln_b,
              w_out, rel_table, lambda_init):
    Bb, Ss, _ = hn.shape
    u = hn @ w_in
    qf, kf, vf, cf = split_cols(u, OD_WIDTHS)
    lp = lam_params.astype(jnp.float32)
    lam = jnp.exp(jnp.sum(lp[0] * lp[1])) - jnp.exp(jnp.sum(lp[2] * lp[3])) + lambda_init
    q = qf.reshape(Bb, Ss, DIFF_HEADS, 2, DIFF_DH)
    k = kf.reshape(Bb, Ss, DIFF_HEADS, 2, DIFF_DH)
    v = vf.reshape(Bb, Ss, DIFF_HEADS, 2 * DIFF_DH)
    o = diff_attention(q, k, v, lam, rel_table)
    o = rmsnorm(o, diff_norm_g) * (1.0 - lambda_init)
    ga, gb = jnp.split(cf, 2, axis=-1)
    c = ga * jax.nn.sigmoid(gb)
    c = causal_dwconv(c, conf_dw_w) + conf_dw_b.astype(c.dtype)
    c = jax.nn.silu(layernorm(c, conf_ln_g, conf_ln_b))
    y = jnp.concatenate([o.reshape(Bb, Ss, DIFF_HEADS * 2 * DIFF_DH), c], axis=-1)
    return y @ w_out


def swiglu(hn, w_gate_up, w_down):
    g, u = jnp.split(hn @ w_gate_up, 2, axis=-1)
    return (jax.nn.silu(g) * u) @ w_down


def moe_swiglu(hn, w_router, w_gate_up, w_down):
    Bb, Ss, D = hn.shape
    T = Bb * Ss
    xt = hn.reshape(T, D)
    logits = (xt @ w_router).astype(jnp.float32)
    top_val, top_idx = lax.top_k(logits, TOP_K)
    gates = jax.nn.softmax(top_val, axis=-1)
    e_flat = top_idx.reshape(-1).astype(jnp.int32)
    tok_flat = jnp.repeat(jnp.arange(T, dtype=jnp.int32), TOP_K)
    g_flat = gates.reshape(-1)
    order = jnp.argsort(e_flat)
    e_s, tok_s, g_s = e_flat[order], tok_flat[order], g_flat[order]
    counts = jnp.zeros((N_EXPERTS,), jnp.int32).at[e_flat].add(1)
    padded = (counts + MOE_BLOCK - 1) // MOE_BLOCK * MOE_BLOCK
    start = jnp.cumsum(counts) - counts
    pend = jnp.cumsum(padded)
    pstart = pend - padded
    dest = pstart[e_s] + (jnp.arange(T * TOP_K, dtype=jnp.int32) - start[e_s])
    P = T * TOP_K + N_EXPERTS * MOE_BLOCK
    NB = P // MOE_BLOCK
    row_tok = jnp.full((P,), T, jnp.int32).at[dest].set(tok_s)
    xpad = jnp.concatenate([xt, jnp.zeros((1, D), xt.dtype)], axis=0)
    rows = xpad[row_tok].reshape(NB, MOE_BLOCK, D)
    blk_e = jnp.minimum(jnp.searchsorted(pend, jnp.arange(NB, dtype=jnp.int32) * MOE_BLOCK, side='right'),
                        N_EXPERTS - 1)

    def expert_block(args):
        xb, e = args
        g, u = jnp.split(xb @ w_gate_up[e], 2, axis=-1)
        return (jax.nn.silu(g) * u) @ w_down[e]

    y = lax.map(expert_block, (rows, blk_e)).reshape(P, D)
    contrib = y[dest] * g_s[:, None].astype(y.dtype)
    out = jnp.zeros((T, D), y.dtype).at[tok_s].add(contrib)
    return out.reshape(Bb, Ss, D)


def per_layer_embed(h, p_i, g_norm, w_proj, w_gate):
    gate = jax.nn.sigmoid((rmsnorm(h, g_norm) @ w_gate).astype(jnp.float32)).astype(h.dtype)
    return (p_i.astype(h.dtype) @ w_proj) * gate


def setup_inputs(seed: int = 0) -> dict:
    key = jax.random.key(seed)
    ks = jax.random.split(key, 40)
    f32 = jnp.float32
    def nrm(k, shape, scale):
        return jax.random.normal(k, shape, f32) * scale
    def gain(k, shape):
        return 1.0 + 0.02 * jax.random.normal(k, shape, f32)
    D = D_MODEL
    A = jax.random.uniform(ks[9], (N_EVEN, GDN_HEADS), f32, 1.0, 16.0)
    dt = jnp.exp(jax.random.uniform(ks[10], (N_EVEN, GDN_HEADS), f32, math.log(1e-3), math.log(1e-1)))
    return {
        'x': nrm(ks[0], (BATCH, SEQ, D), 1.0),
        'p': nrm(ks[1], (DEPTH, BATCH, SEQ, PLE_DIM), 1.0),
        'norm_mix_g': gain(ks[2], (DEPTH, D)),
        'norm_ffn_g': gain(ks[3], (DEPTH, D)),
        'norm_ple_g': gain(ks[4], (DEPTH, D)),
        'final_norm_g': gain(ks[5], (D,)),
        'ev_w_in': nrm(ks[6], (N_EVEN, D, EV_IN), D ** -0.5),
        'ev_conv_a': nrm(ks[7], (N_EVEN, CONV_A_WIDTH, D_CONV_A), CONV_A_WIDTH ** -0.5),
        'ev_gdn_conv': nrm(ks[8], (N_EVEN, GDN_CONV_WIDTH, 2 * GDN_HEADS * GDN_DK + GDN_HEADS * GDN_DV), GDN_CONV_WIDTH ** -0.5),
        'ev_gdn_A_log': jnp.log(A),
        'ev_gdn_dt_bias': dt + jnp.log(-jnp.expm1(-dt)),
        'ev_gdn_norm_g': gain(ks[11], (N_EVEN, GDN_DV)),
        'ev_w_out': nrm(ks[12], (N_EVEN, EV_OUT, D), EV_OUT ** -0.5),
        'od_w_in': nrm(ks[13], (N_ODD, D, OD_IN), D ** -0.5),
        'od_lambda': nrm(ks[14], (N_ODD, 4, DIFF_DH), 0.1),
        'od_diff_norm_g': gain(ks[15], (N_ODD, 2 * DIFF_DH)),
        'od_conf_dw_w': nrm(ks[16], (N_ODD, CONF_WIDTH, D_CONF), CONF_WIDTH ** -0.5),
        'od_conf_dw_b': nrm(ks[17], (N_ODD, D_CONF), 0.02),
        'od_conf_ln_g': gain(ks[18], (N_ODD, D_CONF)),
        'od_conf_ln_b': nrm(ks[19], (N_ODD, D_CONF), 0.02),
        'od_w_out': nrm(ks[20], (N_ODD, OD_OUT, D), OD_OUT ** -0.5),
        'rel_bias': nrm(ks[21], (NUM_BUCKETS, DIFF_HEADS), 0.1),
        'ffn_w_gate_up': nrm(ks[22], (N_EVEN, D, 2 * D_FF), D ** -0.5),
        'ffn_w_down': nrm(ks[23], (N_EVEN, D_FF, D), D_FF ** -0.5),
        'moe_router': nrm(ks[24], (N_ODD, D, N_EXPERTS), D ** -0.5),
        'moe_w_gate_up': nrm(ks[25], (N_ODD, N_EXPERTS, D, 2 * D_FF_EXPERT), D ** -0.5),
        'moe_w_down': nrm(ks[26], (N_ODD, N_EXPERTS, D_FF_EXPERT, D), D_FF_EXPERT ** -0.5),
        'ple_w_proj': nrm(ks[27], (DEPTH, PLE_DIM, D), PLE_DIM ** -0.5),
        'ple_w_gate': nrm(ks[28], (DEPTH, D, D), D ** -0.5),
    }


def reference(x, p, norm_mix_g, norm_ffn_g, norm_ple_g, final_norm_g,
              ev_w_in, ev_conv_a, ev_gdn_conv, ev_gdn_A_log, ev_gdn_dt_bias, ev_gdn_norm_g, ev_w_out,
              od_w_in, od_lambda, od_diff_norm_g, od_conf_dw_w, od_conf_dw_b, od_conf_ln_g, od_conf_ln_b,
              od_w_out, rel_bias, ffn_w_gate_up, ffn_w_down, moe_router, moe_w_gate_up, moe_w_down,
              ple_w_proj, ple_w_gate):
    h = x
    for i in range(DEPTH):
        j = i // 2
        if i % 2 == 0:
            h = h + even_mixer(rmsnorm(h, norm_mix_g[i]), ev_w_in[j], ev_conv_a[j], ev_gdn_conv[j],
                               ev_gdn_A_log[j], ev_gdn_dt_bias[j], ev_gdn_norm_g[j], ev_w_out[j])
            h = h + swiglu(rmsnorm(h, norm_ffn_g[i]), ffn_w_gate_up[j], ffn_w_down[j])
        else:
            lambda_init = 0.8 - 0.6 * math.exp(-0.3 * i)
            h = h + odd_mixer(rmsnorm(h, norm_mix_g[i]), od_w_in[j], od_lambda[j], od_diff_norm_g[j],
                              od_conf_dw_w[j], od_conf_dw_b[j], od_conf_ln_g[j], od_conf_ln_b[j],
                              od_w_out[j], rel_bias, lambda_init)
            h = h + moe_swiglu(rmsnorm(h, norm_ffn_g[i]), moe_router[j], moe_w_gate_up[j], moe_w_down[j])
        h = h + per_layer_embed(h, p[i], norm_ple_g[i], ple_w_proj[i], ple_w_gate[i])
    return rmsnorm(h, final_norm_g)
```

```cpp
#include <hip/hip_runtime.h>
#include <stdint.h>
#include <stdio.h>

#define DI __device__ __forceinline__
#define LAS __attribute__((address_space(3)))
#define GAS __attribute__((address_space(1)))
typedef unsigned short bf16;
typedef short bf16x8 __attribute__((ext_vector_type(8)));
typedef short s16x4 __attribute__((ext_vector_type(4)));
typedef short v4i16_t __attribute__((ext_vector_type(4)));
typedef float f32x4 __attribute__((ext_vector_type(4)));
typedef float f32x16 __attribute__((ext_vector_type(16)));
typedef float f32x2_t __attribute__((ext_vector_type(2)));
typedef __bf16 bf16x2_t __attribute__((ext_vector_type(2)));
typedef unsigned u32x4 __attribute__((ext_vector_type(4)));
typedef unsigned u32x2 __attribute__((ext_vector_type(2)));
typedef GAS unsigned gu32;

constexpr int T = 65536, D = 1024, SEQ = 2048, NBATCH = 32;
constexpr int EV_IN = 3592, EV_N = 3584, EVU = 3072;
constexpr int OD_N = 2560;
constexpr int DFF = 2816, DFE = 3584, NE = 8, CAP = 65536;
constexpr int MOE_NBP = 174, MOE_NPART = 3;
constexpr float EPS = 1e-6f;
constexpr float LOG2E = 1.4426950408889634f;
constexpr float LAMBDA_INIT = 0.35550906f;

constexpr size_t MiB = 1u << 20;
constexpr size_t WS_CTL = 0, CTL_BYTES = 1 * MiB;
constexpr size_t WS_GA = 1 * MiB, WS_BETA = 2 * MiB, WS_ROWTS = 3 * MiB, WS_ROWGATE = 5 * MiB, WS_EG = 7 * MiB;
constexpr size_t WS_W = 16 * MiB;
constexpr size_t W_EVIN = WS_W;
constexpr size_t W_EVOUT = W_EVIN + (size_t)EV_N * D * 2;
constexpr size_t W_FFGU = W_EVOUT + (size_t)D * D * 2;
constexpr size_t W_FFD = W_FFGU + (size_t)2 * DFF * D * 2;
constexpr size_t W_ODIN = W_FFD + (size_t)D * DFF * 2;
constexpr size_t W_ODOUT = W_ODIN + (size_t)OD_N * D * 2;
constexpr size_t W_MGU = W_ODOUT + (size_t)D * D * 2;
constexpr size_t W_MD = W_MGU + (size_t)NE * 2 * DFE * D * 2;
constexpr size_t W_PPROJ = W_MD + (size_t)NE * D * DFE * 2;
constexpr size_t W_PGATE = W_PPROJ + (size_t)2 * D * 256 * 2;
constexpr size_t W_END = W_PGATE + (size_t)2 * D * D * 2;
constexpr size_t WS_HN = 222 * MiB;
constexpr size_t WS_G = 222 * MiB;
constexpr size_t WS_GX = 352 * MiB;
constexpr size_t WS_U = 512 * MiB;
constexpr size_t WS_Y = 896 * MiB;
constexpr size_t WS_YMOE = 768 * MiB;
constexpr size_t WS_END = 1024 * MiB;
static_assert(W_END <= WS_HN, "weights fit");
static_assert(WS_G + (size_t)4096 * 73728 <= WS_U, "gdn intermediates fit");
static_assert(WS_GX + (size_t)MOE_NBP * 256 * DFE * 2 <= WS_YMOE, "moe act fits");
constexpr size_t G_ITEM = 73728;
constexpr size_t G_W = 0, G_UT = 16384, G_QG = 32768, G_KD = 49152, G_QK = 65536;

constexpr int CW_CNT = 64;
constexpr int CW_BAR = 4096;

constexpr int LDS_BYTES = 160 * 1024;
constexpr int LDS_MISC = 131072 + 24576;
DI float bf2f(unsigned short b) { return __uint_as_float(((unsigned)b) << 16); }
DI float bflo(unsigned u) { return __uint_as_float(u << 16); }
DI float bfhi(unsigned u) { return __uint_as_float(u & 0xffff0000u); }
DI unsigned pk2(float lo, float hi) { f32x2_t v = {lo, hi}; bf16x2_t b = __builtin_convertvector(v, bf16x2_t); return __builtin_bit_cast(unsigned, b); }
DI float dppf(float v, const int ctrl_sel) {
    int r;
    switch (ctrl_sel) {
        case 0: r = __builtin_amdgcn_update_dpp(0, __builtin_bit_cast(int, v), 0xB1, 0xF, 0xF, true); break;
        case 1: r = __builtin_amdgcn_update_dpp(0, __builtin_bit_cast(int, v), 0x4E, 0xF, 0xF, true); break;
        case 2: r = __builtin_amdgcn_update_dpp(0, __builtin_bit_cast(int, v), 0x141, 0xF, 0xF, true); break;
        default: r = __builtin_amdgcn_update_dpp(0, __builtin_bit_cast(int, v), 0x140, 0xF, 0xF, true); break;
    }
    return __builtin_bit_cast(float, r);
}
DI float row16_sum(float v) { v += dppf(v, 0); v += dppf(v, 1); v += dppf(v, 2); v += dppf(v, 3); return v; }
DI float rlane(float v, int l) { return __builtin_bit_cast(float, __builtin_amdgcn_readlane(__builtin_bit_cast(int, v), l)); }
DI float wave_sum(float v) { v = row16_sum(v); return (rlane(v, 0) + rlane(v, 16)) + (rlane(v, 32) + rlane(v, 48)); }
DI float silu_f(float x) { return x / (1.f + __expf(-x)); }
DI float sigmoid_f(float x) { return 1.f / (1.f + __expf(-x)); }
DI int crow(int reg, int hh) { return (reg & 3) + 8 * (reg >> 2) + 4 * hh; }
DI bf16x8 pack_step(const f32x16& x, int s) {
    u32x4 p;
    p[0] = pk2(x[8 * s + 0], x[8 * s + 1]); p[1] = pk2(x[8 * s + 2], x[8 * s + 3]); p[2] = pk2(x[8 * s + 4], x[8 * s + 5]); p[3] = pk2(x[8 * s + 6], x[8 * s + 7]);
    return __builtin_bit_cast(bf16x8, p);
}
DI s16x4 vtr(const LAS unsigned char* p) { return __builtin_bit_cast(s16x4, __builtin_amdgcn_ds_read_tr16_b64_v4i16((LAS v4i16_t*)p)); }
DI bf16x8 cat8(s16x4 lo, s16x4 hi) { return __builtin_shufflevector(lo, hi, 0, 1, 2, 3, 4, 5, 6, 7); }
#define MFMA32(a, b, c) __builtin_amdgcn_mfma_f32_32x32x16_bf16((a), (b), (c), 0, 0, 0)
DI f32x16 zero16() { f32x16 z; for (int i = 0; i < 16; ++i) z[i] = 0.f; return z; }
#define WG_BAR() __syncthreads()

#define XB_TMO      128
#define XB_XCNT(j)  (256  + 64 * (j))
#define XB_XSUB(j)  (1280 + 64 * (j))
#define XB_XGEN(j)  (2304 + 64 * (j))
#define XB_TOP      3328
#define XB_TOPGEN   3392
#define XCD_BAR_WORDS 3456
#define XB_SPIN_CAP (1u << 22)
DI unsigned xb_ld(unsigned* p)              { return __hip_atomic_load(p, __ATOMIC_RELAXED, __HIP_MEMORY_SCOPE_AGENT); }
DI unsigned xb_add(unsigned* p, unsigned v) { return __hip_atomic_fetch_add(p, v, __ATOMIC_RELAXED, __HIP_MEMORY_SCOPE_AGENT); }
DI unsigned xb_xcc_id() { return (unsigned)__builtin_amdgcn_s_getreg((3 << 11) | 20) & 0xFu; }
#define XB_SPIN(cond, bar) do { unsigned _sp = 0; while (cond) { __builtin_amdgcn_s_sleep(1); \
    if ((++_sp & 255u) == 0u) { if (xb_ld(&(bar)[XB_TMO])) break; if (_sp > XB_SPIN_CAP) { atomicAdd(&(bar)[XB_TMO], 1u); break; } } } } while (0)
struct XcdBarrier { unsigned* bar; unsigned x; volatile LAS unsigned* st; };
DI XcdBarrier xcd_barrier_post(unsigned* bar, volatile LAS unsigned* st) {
    XcdBarrier b; b.bar = bar; b.x = xb_xcc_id(); b.st = st;
    if (threadIdx.x == 0) (void)xb_add(&bar[XB_XCNT(b.x)], 1u);
    return b;
}
DI void xcd_barrier_complete(unsigned* bar, unsigned x, unsigned& nloc, unsigned& nx) {
    const unsigned G = gridDim.x * gridDim.y * gridDim.z;
    unsigned sum, cnt, mine, sp = 0u;
    for (;;) {
        sum = 0u; cnt = 0u; mine = 0u;
#pragma unroll
        for (unsigned j = 0; j < 16; ++j) { const unsigned c = xb_ld(&bar[XB_XCNT(j)]); sum += c; cnt += (c > 0u) ? 1u : 0u; mine = (j == x) ? c : mine; }
        if (sum == G) break;
        __builtin_amdgcn_s_sleep(1);
        if ((++sp & 255u) == 0u) { if (xb_ld(&bar[XB_TMO])) break; if (sp > XB_SPIN_CAP) { atomicAdd(&bar[XB_TMO], 1u); break; } }
    }
    nloc = mine > 0u ? mine : 1u; nx = cnt > 0u ? cnt : 1u;
}
DI void xcd_barrier(const XcdBarrier& b) {
    asm volatile("s_waitcnt vmcnt(0)" ::: "memory");
    __syncthreads();
    if (threadIdx.x == 0) {
        unsigned* bar = b.bar;
        __builtin_amdgcn_s_waitcnt(0);
        unsigned nloc = b.st[0], nx = b.st[1];
        if (nloc == 0u) { xcd_barrier_complete(bar, b.x, nloc, nx); b.st[0] = nloc; b.st[1] = nx; }
        const unsigned old = xb_add(&bar[XB_XSUB(b.x)], 1u);
        const unsigned gen = old / nloc;
        if (old + 1u == (gen + 1u) * nloc) {
            __builtin_amdgcn_fence(__ATOMIC_RELEASE, "agent");
            asm volatile("s_waitcnt vmcnt(0)" ::: "memory");
            const unsigned og = xb_add(&bar[XB_TOP], 1u);
            const unsigned tg = og / nx;
            if (og + 1u == (tg + 1u) * nx) xb_add(&bar[XB_TOPGEN], 1u);
            else XB_SPIN(xb_ld(&bar[XB_TOPGEN]) == tg, bar);
            __builtin_amdgcn_fence(__ATOMIC_ACQUIRE, "agent");
            xb_add(&bar[XB_XGEN(b.x)], 1u);
            asm volatile("s_waitcnt vmcnt(0)" ::: "memory");
        } else {
            XB_SPIN(xb_ld(&bar[XB_XGEN(b.x)]) == gen, bar);
            __builtin_amdgcn_fence(__ATOMIC_ACQUIRE, "agent");
            asm volatile("s_waitcnt vmcnt(0)" ::: "memory");
        }
    }
    __syncthreads();
}

struct Args { const float* in[29]; float* out; unsigned char* ws; int ph_lo, ph_hi; };
struct Frame {
    LAS unsigned char* lds;
    unsigned char* ws;
    int tid, lane, wave, G, vcu;
};

namespace pg8 {
constexpr int BM = 256, BK = 64, HALF = 128, HTB = HALF * BK * 2, STAGE_BYTES = 8 * HTB, NXCD = 8, WGM = 8;
__host__ __device__ __forceinline__ int lds_byte(int r, int c) { const int st = (r >> 4) * 2 + (c >> 5), rr = r & 15, cc = c & 31, ob = rr * 64 + cc * 2; return st * 1024 + (ob ^ (((ob >> 9) & 1) << 5)); }
__host__ __device__ __forceinline__ void stage_rc(int b, int& R, int& C) { const int st = b / 1024, sb = b % 1024, swz = sb ^ (((sb >> 9) & 1) << 5); R = (st >> 1) * 16 + swz / 64; C = (st & 1) * 32 + (swz % 64) / 2; }
__host__ __device__ __forceinline__ int perm32(int rho) { const int n = rho >> 4, i = rho & 15; return 8 * (i >> 2) + 4 * n + (i & 3); }

struct Unit { int pm, pn, e, lb, rows; };

DI bool static_unit(int i, int G, int c, int nM, int nN, int& pm, int& pn) {
    const int nwg = nM * nN; const long L = (long)i * G + c; if (L >= nwg) return false;
    int wgid = (int)L; { const int q = nwg / NXCD, r = nwg % NXCD, xcd = wgid % NXCD, off = wgid / NXCD; wgid = (xcd < r ? xcd * (q + 1) : r * (q + 1) + (xcd - r) * q) + off; }
    const int nig = WGM * nN, gid = wgid / nig, fm = gid * WGM, gsz = (nM - fm) < WGM ? (nM - fm) : WGM;
    pm = fm + ((wgid % nig) % gsz); pn = (wgid % nig) / gsz; return true;
}
struct SchedDense {
    static constexpr bool GATHER = false;
    const char* A; const char* Bt; int K, nM, nN, G, c;
    DI void init(const void* A_, const void* Bt_, int M, int N, int K_, int G_, int c_) { A = (const char*)A_; Bt = (const char*)Bt_; K = K_; nM = M / BM; nN = N / BM; G = G_; c = c_; }
    DI bool next(int i, Unit& u) const { u.e = 0; u.lb = 0; u.rows = 256; return static_unit(i, G, c, nM, nN, u.pm, u.pn); }
    DI const char* a_base(const Unit& u) const { return A + (size_t)u.pm * BM * K * 2; }
    DI const char* b_base(const Unit& u) const { return Bt + (size_t)u.pn * BM * K * 2; }
    DI void ts_load(const Unit&, const int (&)[2], int (&)[2][2]) const {}
    DI void a_offs(const Unit&, const int (&R)[2], const int (&C)[2], const int (&)[2][2], unsigned (&o)[2][2]) const {
#pragma unroll
        for (int h = 0; h < 2; ++h)
#pragma unroll
            for (int i = 0; i < 2; ++i) o[h][i] = (unsigned)((h * HALF + R[i]) * K + C[i]) * 2u;
    }
};
struct SchedMoe {
    const char* A; const char* Bt; int K, nM, nN, G, c, blk0; size_t bstride; const int* row_ts; const LAS int* tab; bool gather;
    DI bool next(int i, Unit& u) const {
        int pm, pn; if (!static_unit(i, G, c, nM, nN, pm, pn)) return false;
        const int gb = blk0 + pm; int e = 0;
#pragma unroll
        for (int j = 1; j < 8; ++j) e += (gb >= tab[8 + j]) ? 1 : 0;
        e = __builtin_amdgcn_readfirstlane(e);
        const int lb = gb - __builtin_amdgcn_readfirstlane(tab[8 + e]); const int rem = __builtin_amdgcn_readfirstlane(tab[e]) - lb * 256;
        u.pm = pm; u.pn = pn; u.e = e; u.lb = lb; u.rows = rem < 256 ? rem : 256; return true;
    }
    DI const char* b_base(const Unit& u) const { return Bt + (size_t)u.e * bstride + (size_t)u.pn * BM * K * 2; }
};
struct SchedMoeGU : SchedMoe {
    static constexpr bool GATHER = true;
    DI const char* a_base(const Unit&) const { return A; }
    DI void ts_load(const Unit& u, const int (&R)[2], int (&ts)[2][2]) const {
#pragma unroll
        for (int h = 0; h < 2; ++h)
#pragma unroll
            for (int i = 0; i < 2; ++i) { const int lr = h * HALF + R[i]; ts[h][i] = (lr < u.rows) ? row_ts[(size_t)u.e * CAP + u.lb * 256 + lr] : (T << 1); }
    }
    DI void a_offs(const Unit&, const int (&)[2], const int (&C)[2], const int (&ts)[2][2], unsigned (&o)[2][2]) const {
#pragma unroll
        for (int h = 0; h < 2; ++h)
#pragma unroll
            for (int i = 0; i < 2; ++i) o[h][i] = ((unsigned)(ts[h][i] >> 1) * (unsigned)K + (unsigned)C[i]) * 2u;
    }
};
struct SchedMoeDown : SchedMoe {
    static constexpr bool GATHER = false;
    DI const char* a_base(const Unit& u) const { return A + (size_t)u.pm * BM * K * 2; }
    DI void ts_load(const Unit&, const int (&)[2], int (&)[2][2]) const {}
    DI void a_offs(const Unit&, const int (&R)[2], const int (&C)[2], const int (&)[2][2], unsigned (&o)[2][2]) const {
#pragma unroll
        for (int h = 0; h < 2; ++h)
#pragma unroll
            for (int i = 0; i < 2; ++i) o[h][i] = (unsigned)((h * HALF + R[i]) * K + C[i]) * 2u;
    }
};

typedef f32x4 Acc[2][2][4][2];
DI u32x4 pack8(const f32x4& v0, const f32x4& v1) { u32x4 w; w.x = pk2(v0[0], v0[1]); w.y = pk2(v0[2], v0[3]); w.z = pk2(v1[0], v1[1]); w.w = pk2(v1[2], v1[3]); return w; }

struct EpiStoreBf16 {
    static constexpr bool PERM = true;
    bf16* O; int ldc;
    DI void operator()(const Acc& acc, const Unit& u, int wr, int wc, int fr, int fq) const {
        const int row0 = u.pm * BM + wr * 64 + fr, col0 = u.pn * BM + wc * 32 + 8 * fq;
#pragma unroll
        for (int ai = 0; ai < 2; ++ai)
#pragma unroll
            for (int m = 0; m < 4; ++m) { bf16* rowp = O + (size_t)(row0 + ai * HALF + m * 16) * ldc + col0;
#pragma unroll
                for (int bj = 0; bj < 2; ++bj) *(u32x4*)(rowp + bj * HALF) = pack8(acc[ai][bj][m][0], acc[ai][bj][m][1]); }
    }
};
struct EpiEvIn {
    static constexpr bool PERM = true;
    bf16* O;
    DI void operator()(const Acc& acc, const Unit& u, int wr, int wc, int fr, int fq) const {
        const int row0 = u.pm * BM + wr * 64 + fr;
        if (u.pn >= 2 && u.pn < 6) {
            const int col0 = 512 + (u.pn - 2) * HALF + wc * 32 + 8 * fq;
#pragma unroll
            for (int ai = 0; ai < 2; ++ai)
#pragma unroll
                for (int m = 0; m < 4; ++m) { bf16* rowp = O + (size_t)(row0 + ai * HALF + m * 16) * EVU + col0;
                    *(u32x4*)rowp = pack8(acc[ai][0][m][0] * acc[ai][1][m][0], acc[ai][0][m][1] * acc[ai][1][m][1]); }
        } else {
            const int col0 = u.pn * BM - (u.pn >= 6 ? 512 : 0) + wc * 32 + 8 * fq;
#pragma unroll
            for (int ai = 0; ai < 2; ++ai)
#pragma unroll
                for (int m = 0; m < 4; ++m) { bf16* rowp = O + (size_t)(row0 + ai * HALF + m * 16) * EVU + col0;
#pragma unroll
                    for (int bj = 0; bj < 2; ++bj) *(u32x4*)(rowp + bj * HALF) = pack8(acc[ai][bj][m][0], acc[ai][bj][m][1]); }
        }
    }
};
struct EpiSwiGLU {
    static constexpr bool PERM = true;
    bf16* O; int ldc;
    DI void operator()(const Acc& acc, const Unit& u, int wr, int wc, int fr, int fq) const {
        const int row0 = u.pm * BM + wr * 64 + fr, col0 = u.pn * HALF + wc * 32 + 8 * fq;
#pragma unroll
        for (int ai = 0; ai < 2; ++ai)
#pragma unroll
            for (int m = 0; m < 4; ++m) { bf16* rowp = O + (size_t)(row0 + ai * HALF + m * 16) * ldc + col0;
                f32x4 v0, v1;
#pragma unroll
                for (int j = 0; j < 4; ++j) { v0[j] = silu_f(acc[ai][0][m][0][j]) * acc[ai][1][m][0][j]; v1[j] = silu_f(acc[ai][0][m][1][j]) * acc[ai][1][m][1][j]; }
                *(u32x4*)rowp = pack8(v0, v1); }
    }
};
struct EpiResid {
    static constexpr bool PERM = false;
    const float* base; float* out;
    DI void operator()(const Acc& acc, const Unit& u, int wr, int wc, int fr, int fq) const {
        const int row0 = u.pm * BM + wr * 64 + fr, col0 = u.pn * BM + wc * 32 + 4 * fq;
#pragma unroll
        for (int ai = 0; ai < 2; ++ai)
#pragma unroll
            for (int m = 0; m < 4; ++m) { const size_t off = (size_t)(row0 + ai * HALF + m * 16) * D + col0;
#pragma unroll
                for (int bj = 0; bj < 2; ++bj)
#pragma unroll
                    for (int n = 0; n < 2; ++n) { const f32x4 b = *(const f32x4*)(base + off + bj * HALF + n * 16); *(f32x4*)(out + off + bj * HALF + n * 16) = b + acc[ai][bj][m][n]; } }
    }
};
struct EpiPleGate {
    static constexpr bool PERM = false;
    float* h; const bf16* tmp;
    DI void operator()(const Acc& acc, const Unit& u, int wr, int wc, int fr, int fq) const {
        const int row0 = u.pm * BM + wr * 64 + fr, col0 = u.pn * BM + wc * 32 + 4 * fq;
#pragma unroll
        for (int ai = 0; ai < 2; ++ai)
#pragma unroll
            for (int m = 0; m < 4; ++m) { const size_t off = (size_t)(row0 + ai * HALF + m * 16) * D + col0;
#pragma unroll
                for (int bj = 0; bj < 2; ++bj)
#pragma unroll
                    for (int n = 0; n < 2; ++n) { const size_t o = off + bj * HALF + n * 16; const f32x4 b = *(const f32x4*)(h + o); const u32x2 t = *(const u32x2*)(tmp + o); const f32x4 a = acc[ai][bj][m][n];
                        f32x4 r; r[0] = b[0] + bflo(t.x) * sigmoid_f(a[0]); r[1] = b[1] + bfhi(t.x) * sigmoid_f(a[1]); r[2] = b[2] + bflo(t.y) * sigmoid_f(a[2]); r[3] = b[3] + bfhi(t.y) * sigmoid_f(a[3]);
                        *(f32x4*)(h + o) = r; } }
    }
};
struct EpiMoeDown {
    static constexpr bool PERM = true;
    bf16* Y; const int* row_ts; const float* row_gate;
    DI void operator()(const Acc& acc, const Unit& u, int wr, int wc, int fr, int fq) const {
        const int col0 = u.pn * BM + wc * 32 + 8 * fq; const size_t rbase = (size_t)u.e * CAP + u.lb * 256;
#pragma unroll
        for (int ai = 0; ai < 2; ++ai)
#pragma unroll
            for (int m = 0; m < 4; ++m) { const int lr = ai * HALF + wr * 64 + m * 16 + fr;
                if (lr < u.rows) { const int ts = row_ts[rbase + lr]; const float g = row_gate[rbase + lr]; bf16* rowp = Y + (size_t)ts * D + col0;
#pragma unroll
                    for (int bj = 0; bj < 2; ++bj) *(u32x4*)(rowp + bj * HALF) = pack8(acc[ai][bj][m][0] * g, acc[ai][bj][m][1] * g); } }
    }
};

template <class Epi, class Sched>
DI void gemm_phase(LAS unsigned char* lds, const Sched& S, const Epi& E) {
    constexpr bool GATHER = Sched::GATHER;
    const int tid = threadIdx.x, wid = __builtin_amdgcn_readfirstlane(tid >> 6), lane = tid & 63, wr = wid >> 2, wc = wid & 3, fr = lane & 15, fq = lane >> 4;
    const int K = S.K, nt = K / BK;
    int Rr[2], Cc[2]; unsigned voffB[2];
#pragma unroll
    for (int i = 0; i < 2; ++i) { int R, C; stage_rc(tid * 16 + i * 8192, R, C); Rr[i] = R; Cc[i] = C; const int Rb = Epi::PERM ? ((R & ~31) + perm32(R & 31)) : R; voffB[i] = (unsigned)(Rb * K + C) * 2u; }
    const size_t kstep = (size_t)(BK * 2);
    const size_t hstep = (size_t)HALF * K * 2;
    const unsigned ldsw = (unsigned)wid * 1024u;
    const int aoff = lds_byte(wr * 64 + fr, fq * 8), boff = lds_byte(wc * 32 + fr, fq * 8);
#define PG8_SA(b, h) (((b) * 2 + (h)) * HTB)
#define PG8_SB(b, h) ((4 + (b) * 2 + (h)) * HTB)
#define PG8_STAGE(bufoff, gbase, voff) do { _Pragma("unroll") for (int _i = 0; _i < 2; ++_i) \
        __builtin_amdgcn_global_load_lds((const unsigned*)((const char*)(gbase) + (voff)[_i]), (LAS unsigned*)(lds + (bufoff) + ldsw + _i * 8192), 16, 0, 0); } while (0)
#define PG8_LDA(dst, b, h) do { _Pragma("unroll") for (int m = 0; m < 4; ++m) _Pragma("unroll") for (int k = 0; k < 2; ++k) dst[m][k] = *(const LAS bf16x8*)(lds + PG8_SA(b, h) + aoff + m * 2048 + k * 1024); } while (0)
#define PG8_LDB(dst, b, h) do { _Pragma("unroll") for (int n = 0; n < 2; ++n) _Pragma("unroll") for (int k = 0; k < 2; ++k) dst[n][k] = *(const LAS bf16x8*)(lds + PG8_SB(b, h) + boff + n * 2048 + k * 1024); } while (0)
#define PG8_MMA(ai, bj, At, Bt) do { __builtin_amdgcn_s_setprio(1); _Pragma("unroll") for (int m = 0; m < 4; ++m) _Pragma("unroll") for (int n = 0; n < 2; ++n) _Pragma("unroll") for (int k = 0; k < 2; ++k) \
        acc[ai][bj][m][n] = __builtin_amdgcn_mfma_f32_16x16x32_bf16(Bt[n][k], At[m][k], acc[ai][bj][m][n], 0, 0, 0); __builtin_amdgcn_s_setprio(0); } while (0)
#define PG8_WAIT_V(n) asm volatile("s_waitcnt vmcnt(" #n ")" ::: "memory")
#define PG8_WAIT_L(n) asm volatile("s_waitcnt lgkmcnt(" #n ")" ::: "memory")
#define PG8_BAR __builtin_amdgcn_s_barrier()
#define PG8_SCHED __builtin_amdgcn_sched_barrier(0)
    Unit cur, nxt, nn; int ui = 0;
    if (!S.next(0, cur)) return;
    Acc acc;
#pragma unroll
    for (int a = 0; a < 2; ++a)
#pragma unroll
        for (int b = 0; b < 2; ++b)
#pragma unroll
            for (int m = 0; m < 4; ++m)
#pragma unroll
                for (int n = 0; n < 2; ++n) acc[a][b][m][n] = (f32x4){0.f, 0.f, 0.f, 0.f};
    bf16x8 At[4][2], B0[2][2], B1[2][2];
    unsigned vA[2][2], nvA[2][2]; int pts[2][2] = {{0, 0}, {0, 0}};
    { int ts0[2][2] = {{0, 0}, {0, 0}}; S.ts_load(cur, Rr, ts0); S.a_offs(cur, Rr, Cc, ts0, vA); }
    bool has_next = S.next(1, nxt);
    if (GATHER && has_next) S.ts_load(nxt, Rr, pts);
    const char* cA = S.a_base(cur); const char* cB = S.b_base(cur);
    PG8_STAGE(PG8_SB(0, 0), cB, voffB); PG8_STAGE(PG8_SB(0, 1), cB + hstep, voffB); PG8_STAGE(PG8_SA(0, 0), cA, vA[0]); PG8_STAGE(PG8_SA(0, 1), cA, vA[1]);
    if (wr == 1) PG8_BAR;
    PG8_WAIT_V(2); PG8_BAR;
    PG8_STAGE(PG8_SB(1, 0), cB + kstep, voffB); PG8_STAGE(PG8_SA(1, 0), cA + kstep, vA[0]); PG8_STAGE(PG8_SB(1, 1), cB + hstep + kstep, voffB);
    PG8_WAIT_V(6); PG8_BAR;
    for (;;) {
        const char* nA = has_next ? S.a_base(nxt) : cA; const char* nB = has_next ? S.b_base(nxt) : cB;
        if (has_next) S.a_offs(nxt, Rr, Cc, pts, nvA);
        else {
#pragma unroll
            for (int h = 0; h < 2; ++h)
#pragma unroll
                for (int i = 0; i < 2; ++i) nvA[h][i] = vA[h][i];
        }
        const bool has_nn = has_next && S.next(ui + 2, nn);
        if (GATHER && has_nn) S.ts_load(nn, Rr, pts);
        for (int t = 0; t < nt; t += 2) {
            const bool last = (t == nt - 2);
            const char* a1 = cA + (size_t)(t + 1) * kstep;
            const char* a2 = last ? nA : cA + (size_t)(t + 2) * kstep; const char* b2 = last ? nB : cB + (size_t)(t + 2) * kstep;
            const char* a3 = a2 + kstep; const char* b3 = b2 + kstep;
            unsigned w0[2], w1[2];
            if (GATHER) { w0[0] = last ? nvA[0][0] : vA[0][0]; w0[1] = last ? nvA[0][1] : vA[0][1]; w1[0] = last ? nvA[1][0] : vA[1][0]; w1[1] = last ? nvA[1][1] : vA[1][1]; }
            else { w0[0] = vA[0][0]; w0[1] = vA[0][1]; w1[0] = vA[1][0]; w1[1] = vA[1][1]; }
            PG8_LDB(B0, 0, 0); PG8_LDB(B1, 0, 1); PG8_SCHED; PG8_LDA(At, 0, 0); PG8_STAGE(PG8_SA(1, 1), a1, vA[1]);
            PG8_WAIT_V(8); PG8_WAIT_L(0); PG8_BAR; PG8_MMA(0, 0, At, B0); PG8_MMA(0, 1, At, B1); PG8_BAR; PG8_SCHED;
            PG8_LDA(At, 0, 1); PG8_STAGE(PG8_SB(0, 0), b2, voffB); PG8_STAGE(PG8_SB(0, 1), b2 + hstep, voffB); PG8_STAGE(PG8_SA(0, 0), a2, w0);
            PG8_WAIT_V(8); PG8_WAIT_L(0); PG8_BAR; PG8_MMA(1, 0, At, B0); PG8_MMA(1, 1, At, B1); PG8_BAR; PG8_SCHED;
            PG8_LDB(B0, 1, 0); PG8_LDB(B1, 1, 1); PG8_SCHED; PG8_LDA(At, 1, 0); PG8_STAGE(PG8_SA(0, 1), a2, w1);
            PG8_WAIT_V(8); PG8_WAIT_L(0); PG8_BAR; PG8_MMA(0, 0, At, B0); PG8_MMA(0, 1, At, B1); PG8_BAR; PG8_SCHED;
            PG8_LDA(At, 1, 1); PG8_STAGE(PG8_SB(1, 0), b3, voffB); PG8_STAGE(PG8_SB(1, 1), b3 + hstep, voffB); PG8_STAGE(PG8_SA(1, 0), a3, w0);
            PG8_WAIT_V(8); PG8_WAIT_L(0); PG8_BAR; PG8_MMA(1, 0, At, B0); PG8_MMA(1, 1, At, B1); PG8_BAR; PG8_SCHED;
        }
        if (wr == 0) PG8_BAR;
        E(acc, cur, wr, wc, fr, fq);
        if (!has_next) break;
#pragma unroll
        for (int a = 0; a < 2; ++a)
#pragma unroll
            for (int b = 0; b < 2; ++b)
#pragma unroll
                for (int m = 0; m < 4; ++m)
#pragma unroll
                    for (int n = 0; n < 2; ++n) acc[a][b][m][n] = (f32x4){0.f, 0.f, 0.f, 0.f};
        cur = nxt; cA = nA; cB = nB; ++ui;
#pragma unroll
        for (int h = 0; h < 2; ++h)
#pragma unroll
            for (int i = 0; i < 2; ++i) vA[h][i] = nvA[h][i];
        nxt = nn; has_next = has_nn;
        if (wr == 1) PG8_BAR;
    }
    PG8_WAIT_V(0);
    PG8_BAR;
#undef PG8_SA
#undef PG8_SB
#undef PG8_STAGE
#undef PG8_LDA
#undef PG8_LDB
#undef PG8_MMA
#undef PG8_WAIT_V
#undef PG8_WAIT_L
#undef PG8_BAR
#undef PG8_SCHED
}
}

struct ConvJob { const float* W; bf16* WT; int K, ldn, col0, ncols, drow0, mode, nbatch; size_t sstride, dstride; };
DI void transpose_item(const ConvJob& J, int item, LAS float* scr, int lane) {
    const int per = (J.K / 64) * (J.ncols / 32); const int bi = item / per; int r = item - bi * per;
    const int nblk = J.ncols / 32, kb = r / nblk, nb = r % nblk, k0 = 64 * kb, j0 = 32 * nb;
    const float* W = J.W + (size_t)bi * J.sstride; bf16* WT = J.WT + (size_t)bi * J.dstride;
#pragma unroll 8
    for (int i = 0; i < 32; ++i) { const int kk = 2 * i + (lane >> 5); scr[kk * 33 + (lane & 31)] = W[(size_t)(k0 + kk) * J.ldn + J.col0 + j0 + (lane & 31)]; }
    asm volatile("s_waitcnt lgkmcnt(0)" ::: "memory");
    const int c = lane & 7;
    const int drow = J.drow0 + (J.mode ? ((j0 >> 7) * 256 + (j0 & 127)) : j0);
#pragma unroll
    for (int j = 0; j < 4; ++j) { const int n = (lane >> 3) + 8 * j; const LAS float* s = scr + (8 * c) * 33 + n;
        u32x4 o; o.x = pk2(s[0 * 33], s[1 * 33]); o.y = pk2(s[2 * 33], s[3 * 33]); o.z = pk2(s[4 * 33], s[5 * 33]); o.w = pk2(s[6 * 33], s[7 * 33]);
        *(u32x4*)(WT + (size_t)(drow + n) * J.K + k0 + 8 * c) = o; }
    asm volatile("s_waitcnt lgkmcnt(0)" ::: "memory");
}
constexpr int N_JOBS = 15;
DI ConvJob get_job(const Args& a, int j) {
    unsigned char* ws = a.ws; ConvJob J; J.nbatch = 1; J.sstride = 0; J.dstride = 0; J.mode = 0;
    switch (j) {
        case 0: J.W = a.in[6]; J.WT = (bf16*)(ws + W_EVIN); J.K = D; J.ldn = EV_IN; J.col0 = 0; J.ncols = 512; J.drow0 = 0; break;
        case 1: J.W = a.in[6]; J.WT = (bf16*)(ws + W_EVIN); J.K = D; J.ldn = EV_IN; J.col0 = 512; J.ncols = 512; J.drow0 = 512; J.mode = 1; break;
        case 2: J.W = a.in[6]; J.WT = (bf16*)(ws + W_EVIN); J.K = D; J.ldn = EV_IN; J.col0 = 1024; J.ncols = 512; J.drow0 = 640; J.mode = 1; break;
        case 3: J.W = a.in[6]; J.WT = (bf16*)(ws + W_EVIN); J.K = D; J.ldn = EV_IN; J.col0 = 1536; J.ncols = 2048; J.drow0 = 1536; break;
        case 4: J.W = a.in[12]; J.WT = (bf16*)(ws + W_EVOUT); J.K = D; J.ldn = D; J.col0 = 0; J.ncols = D; J.drow0 = 0; break;
        case 5: J.W = a.in[22]; J.WT = (bf16*)(ws + W_FFGU); J.K = D; J.ldn = 2 * DFF; J.col0 = 0; J.ncols = DFF; J.drow0 = 0; J.mode = 1; break;
        case 6: J.W = a.in[22]; J.WT = (bf16*)(ws + W_FFGU); J.K = D; J.ldn = 2 * DFF; J.col0 = DFF; J.ncols = DFF; J.drow0 = 128; J.mode = 1; break;
        case 7: J.W = a.in[23]; J.WT = (bf16*)(ws + W_FFD); J.K = DFF; J.ldn = D; J.col0 = 0; J.ncols = D; J.drow0 = 0; break;
        case 8: J.W = a.in[13]; J.WT = (bf16*)(ws + W_ODIN); J.K = D; J.ldn = OD_N; J.col0 = 0; J.ncols = OD_N; J.drow0 = 0; break;
        case 9: J.W = a.in[20]; J.WT = (bf16*)(ws + W_ODOUT); J.K = D; J.ldn = D; J.col0 = 0; J.ncols = D; J.drow0 = 0; break;
        case 10: J.W = a.in[25]; J.WT = (bf16*)(ws + W_MGU); J.K = D; J.ldn = 2 * DFE; J.col0 = 0; J.ncols = DFE; J.drow0 = 0; J.mode = 1; J.nbatch = NE; J.sstride = (size_t)D * 2 * DFE; J.dstride = (size_t)2 * DFE * D; break;
        case 11: J.W = a.in[25]; J.WT = (bf16*)(ws + W_MGU); J.K = D; J.ldn = 2 * DFE; J.col0 = DFE; J.ncols = DFE; J.drow0 = 128; J.mode = 1; J.nbatch = NE; J.sstride = (size_t)D * 2 * DFE; J.dstride = (size_t)2 * DFE * D; break;
        case 12: J.W = a.in[26]; J.WT = (bf16*)(ws + W_MD); J.K = DFE; J.ldn = D; J.col0 = 0; J.ncols = D; J.drow0 = 0; J.nbatch = NE; J.sstride = (size_t)DFE * D; J.dstride = (size_t)D * DFE; break;
        case 13: J.W = a.in[27]; J.WT = (bf16*)(ws + W_PPROJ); J.K = 256; J.ldn = D; J.col0 = 0; J.ncols = D; J.drow0 = 0; J.nbatch = 2; J.sstride = (size_t)256 * D; J.dstride = (size_t)D * 256; break;
        default: J.W = a.in[28]; J.WT = (bf16*)(ws + W_PGATE); J.K = D; J.ldn = D; J.col0 = 0; J.ncols = D; J.drow0 = 0; J.nbatch = 2; J.sstride = (size_t)D * D; J.dstride = (size_t)D * D; break;
    }
    return J;
}
DI void convert_weights(const Frame& F, const Args& a) {
    LAS float* scr = (LAS float*)(F.lds + F.wave * 16384);
    const int gw = F.vcu * 8 + F.wave, NGW = F.G * 8;
    for (int j = 0; j < N_JOBS; ++j) {
        const ConvJob J = get_job(a, j);
        const int nitems = J.nbatch * (J.K / 64) * (J.ncols / 32);
        for (int it = gw; it < nitems; it += NGW) transpose_item(J, it, scr, F.lane);
    }
}

DI void load_row(const float* p, int lane, f32x4 (&v)[4]) {
    const f32x4* xr = (const f32x4*)p + lane;
#pragma unroll
    for (int j = 0; j < 4; ++j) v[j] = xr[64 * j];
}
DI float sumsq16(const f32x4 (&v)[4]) { float s = 0.f;
#pragma unroll
    for (int j = 0; j < 4; ++j) s += (v[j].x * v[j].x + v[j].y * v[j].y) + (v[j].z * v[j].z + v[j].w * v[j].w);
    return s; }
DI void store_bf16_row(bf16* orow, int lane, const f32x4 (&v)[4]) {
    u32x2* o8 = (u32x2*)orow + lane;
#pragma unroll
    for (int j = 0; j < 4; ++j) { u32x2 w; w.x = pk2(v[j].x, v[j].y); w.y = pk2(v[j].z, v[j].w); o8[64 * j] = w; }
}
DI void norm_plain(const Frame& F, const float* src, const float* g, bf16* dst) {
    f32x4 gv[4]; load_row(g, F.lane, gv);
    const int gw = F.vcu * 8 + F.wave, NGW = F.G * 8;
    for (int m = gw; m < T; m += NGW) {
        f32x4 v[4]; load_row(src + (size_t)m * D, F.lane, v);
        const float rstd = rsqrtf(wave_sum(sumsq16(v)) * (1.f / D) + EPS);
#pragma unroll
        for (int j = 0; j < 4; ++j) v[j] = v[j] * rstd * gv[j];
        store_bf16_row(dst + (size_t)m * D, F.lane, v);
    }
}
DI void norm_mix0(const Frame& F, const Args& a) {
    const float* x = a.in[0]; const float* g = a.in[2]; const float* win = a.in[6];
    bf16* dst = (bf16*)(F.ws + WS_HN); float* GA = (float*)(F.ws + WS_GA); float* BT = (float*)(F.ws + WS_BETA);
    f32x4 gv[4]; load_row(g, F.lane, gv);
    float w8[16][8];
#pragma unroll
    for (int j = 0; j < 4; ++j)
#pragma unroll
        for (int e = 0; e < 4; ++e) { const int k = 256 * j + 4 * F.lane + e; const f32x4 lo = *(const f32x4*)(win + (size_t)k * EV_IN + EV_N), hi = *(const f32x4*)(win + (size_t)k * EV_IN + EV_N + 4);
#pragma unroll
            for (int c = 0; c < 4; ++c) { w8[4 * j + e][c] = lo[c]; w8[4 * j + e][4 + c] = hi[c]; } }
    const int h4 = F.lane & 3;
    const float negA = -__expf(a.in[9][h4]), dtb = a.in[10][h4];
    const int gw = F.vcu * 8 + F.wave, NGW = F.G * 8;
    for (int m = gw; m < T; m += NGW) {
        f32x4 v[4]; load_row(x + (size_t)m * D, F.lane, v);
        const float rstd = rsqrtf(wave_sum(sumsq16(v)) * (1.f / D) + EPS);
#pragma unroll
        for (int j = 0; j < 4; ++j) v[j] = v[j] * rstd * gv[j];
        store_bf16_row(dst + (size_t)m * D, F.lane, v);
        float dsum[8];
#pragma unroll
        for (int c = 0; c < 8; ++c) { float s = 0.f;
#pragma unroll
            for (int j = 0; j < 4; ++j)
#pragma unroll
                for (int e = 0; e < 4; ++e) s += v[j][e] * w8[4 * j + e][c];
            dsum[c] = wave_sum(s); }
        float af = dsum[0], bfv = dsum[4];
        if (h4 == 1) { af = dsum[1]; bfv = dsum[5]; } else if (h4 == 2) { af = dsum[2]; bfv = dsum[6]; } else if (h4 == 3) { af = dsum[3]; bfv = dsum[7]; }
        const float z = af + dtb; const float sp = (z > 20.f) ? z : log1pf(__expf(z));
        if (F.lane < 4) { GA[(size_t)m * 4 + h4] = negA * sp; BT[(size_t)m * 4 + h4] = sigmoid_f(bfv); }
    }
}
DI void convert_p(const Frame& F, const float* p, bf16* dst) {
    const size_t n8 = (size_t)T * 256 / 8;
    for (size_t i = (size_t)F.vcu * 512 + F.tid; i < n8; i += (size_t)F.G * 512) {
        const f32x4 a = *(const f32x4*)(p + i * 8), b = *(const f32x4*)(p + i * 8 + 4);
        *(u32x4*)(dst + i * 8) = pg8::pack8(a, b);
    }
}
DI void norm_router(const Frame& F, const Args& a) {
    const float* h = a.out; const float* g = a.in[3] + D; const float* wr_ = a.in[24];
    bf16* dst = (bf16*)(F.ws + WS_HN); int* row_ts = (int*)(F.ws + WS_ROWTS); float* row_gate = (float*)(F.ws + WS_ROWGATE); unsigned* ctl = (unsigned*)(F.ws + WS_CTL);
    f32x4 gv[4]; load_row(g, F.lane, gv);
    float w8[16][8];
#pragma unroll
    for (int j = 0; j < 4; ++j)
#pragma unroll
        for (int e = 0; e < 4; ++e) { const int k = 256 * j + 4 * F.lane + e; const f32x4 lo = *(const f32x4*)(wr_ + (size_t)k * 8), hi = *(const f32x4*)(wr_ + (size_t)k * 8 + 4);
#pragma unroll
            for (int c = 0; c < 4; ++c) { w8[4 * j + e][c] = lo[c]; w8[4 * j + e][4 + c] = hi[c]; } }
    const int gw = F.vcu * 8 + F.wave, NGW = F.G * 8;
    if (gw == 0) { u32x2* z = (u32x2*)(dst + (size_t)T * D) + F.lane;
#pragma unroll
        for (int j = 0; j < 4; ++j) z[64 * j] = (u32x2){0u, 0u}; }
    for (int grp = gw; grp < T / 32; grp += NGW) {
        int e0 = 0, e1 = 1; float g0 = 0.f, g1 = 0.f;
        for (int rr = 0; rr < 32; ++rr) {
            const int m = grp * 32 + rr;
            f32x4 v[4]; load_row(h + (size_t)m * D, F.lane, v);
            const float rstd = rsqrtf(wave_sum(sumsq16(v)) * (1.f / D) + EPS);
#pragma unroll
            for (int j = 0; j < 4; ++j) v[j] = v[j] * rstd * gv[j];
            store_bf16_row(dst + (size_t)m * D, F.lane, v);
            float lg[8];
#pragma unroll
            for (int c = 0; c < 8; ++c) { float s = 0.f;
#pragma unroll
                for (int j = 0; j < 4; ++j)
#pragma unroll
                    for (int e = 0; e < 4; ++e) s += v[j][e] * w8[4 * j + e][c];
                lg[c] = wave_sum(s); }
            int b0 = 0; float v0 = lg[0];
#pragma unroll
            for (int c = 1; c < 8; ++c) if (lg[c] > v0) { v0 = lg[c]; b0 = c; }
            int b1 = -1; float v1 = -INFINITY;
#pragma unroll
            for (int c = 0; c < 8; ++c) if (c != b0 && lg[c] > v1) { v1 = lg[c]; b1 = c; }
            const float ga = 1.f / (1.f + __expf(v1 - v0));
            if (F.lane == rr) { e0 = b0; e1 = b1; g0 = ga; g1 = 1.f - ga; }
        }
        const bool act = F.lane < 32;
#pragma unroll
        for (int e = 0; e < 8; ++e) {
            const unsigned long long m0 = __ballot(act && e0 == e), m1 = __ballot(act && e1 == e);
            const int n0 = __popcll(m0), n1 = __popcll(m1);
            if (n0 + n1 == 0) continue;
            unsigned base = 0;
            if (F.lane == 0) base = __hip_atomic_fetch_add(ctl + CW_CNT + 64 * e, (unsigned)(n0 + n1), __ATOMIC_RELAXED, __HIP_MEMORY_SCOPE_AGENT);
            base = (unsigned)__builtin_amdgcn_readfirstlane((int)base);
            const unsigned long long below = (1ull << F.lane) - 1ull;
            const int tok = grp * 32 + F.lane;
            if (act && e0 == e) { const unsigned off = base + (unsigned)__popcll(m0 & below); row_ts[(size_t)e * CAP + off] = tok * 2; row_gate[(size_t)e * CAP + off] = g0; }
            if (act && e1 == e) { const unsigned off = base + (unsigned)n0 + (unsigned)__popcll(m1 & below); row_ts[(size_t)e * CAP + off] = tok * 2 + 1; row_gate[(size_t)e * CAP + off] = g1; }
        }
    }
}
DI void combine_norm(const Frame& F, const Args& a) {
    float* h = a.out; const float* g = a.in[4] + D; const bf16* ym = (const bf16*)(F.ws + WS_YMOE); bf16* dst = (bf16*)(F.ws + WS_HN);
    f32x4 gv[4]; load_row(g, F.lane, gv);
    const int gw = F.vcu * 8 + F.wave, NGW = F.G * 8;
    for (int m = gw; m < T; m += NGW) {
        f32x4 v[4]; load_row(h + (size_t)m * D, F.lane, v);
        const u32x2* y0 = (const u32x2*)(ym + (size_t)m * 2 * D) + F.lane; const u32x2* y1 = (const u32x2*)(ym + (size_t)m * 2 * D + D) + F.lane;
#pragma unroll
        for (int j = 0; j < 4; ++j) { const u32x2 p = y0[64 * j], q = y1[64 * j];
            v[j].x += bflo(p.x) + bflo(q.x); v[j].y += bfhi(p.x) + bfhi(q.x); v[j].z += bflo(p.y) + bflo(q.y); v[j].w += bfhi(p.y) + bfhi(q.y); }
        f32x4* hw = (f32x4*)(h + (size_t)m * D) + F.lane;
#pragma unroll
        for (int j = 0; j < 4; ++j) hw[64 * j] = v[j];
        const float rstd = rsqrtf(wave_sum(sumsq16(v)) * (1.f / D) + EPS);
#pragma unroll
        for (int j = 0; j < 4; ++j) v[j] = v[j] * rstd * gv[j];
        store_bf16_row(dst + (size_t)m * D, F.lane, v);
    }
}
DI void final_norm(const Frame& F, const Args& a) {
    float* h = a.out; const float* g = a.in[5];
    f32x4 gv[4]; load_row(g, F.lane, gv);
    const int gw = F.vcu * 8 + F.wave, NGW = F.G * 8;
    for (int m = gw; m < T; m += NGW) {
        f32x4 v[4]; load_row(h + (size_t)m * D, F.lane, v);
        const float rstd = rsqrtf(wave_sum(sumsq16(v)) * (1.f / D) + EPS);
        f32x4* hw = (f32x4*)(h + (size_t)m * D) + F.lane;
#pragma unroll
        for (int j = 0; j < 4; ++j) hw[64 * j] = v[j] * rstd * gv[j];
    }
}

DI void mixer_a(const Frame& F, const Args& a, int worker, int nworkers) {
    const bf16* U = (const bf16*)(F.ws + WS_U); bf16* Y = (bf16*)(F.ws + WS_Y); const float* cw = a.in[7];
    const size_t nitems = (size_t)T * 64;
    for (size_t it = (size_t)worker * 512 + F.tid; it < nitems; it += (size_t)nworkers * 512) {
        const int t = (int)(it >> 6), c8 = (int)(it & 63) * 8, s = t & (SEQ - 1);
        const u32x4 bg = *(const u32x4*)(U + (size_t)t * EVU + c8);
        const u32x4 z2 = *(const u32x4*)(U + (size_t)t * EVU + 512 + c8);
        u32x4 z1 = (u32x4){0u, 0u, 0u, 0u}, z0 = (u32x4){0u, 0u, 0u, 0u};
        if (s >= 1) z1 = *(const u32x4*)(U + (size_t)(t - 1) * EVU + 512 + c8);
        if (s >= 2) z0 = *(const u32x4*)(U + (size_t)(t - 2) * EVU + 512 + c8);
        float o[8];
#pragma unroll
        for (int q = 0; q < 4; ++q) {
            const int c = c8 + 2 * q;
            const float a0 = cw[c] * bflo(z0[q]) + cw[512 + c] * bflo(z1[q]) + cw[1024 + c] * bflo(z2[q]);
            const float a1 = cw[c + 1] * bfhi(z0[q]) + cw[512 + c + 1] * bfhi(z1[q]) + cw[1024 + c + 1] * bfhi(z2[q]);
            o[2 * q] = bflo(bg[q]) * a0; o[2 * q + 1] = bfhi(bg[q]) * a1;
        }
        u32x4 w; w.x = pk2(o[0], o[1]); w.y = pk2(o[2], o[3]); w.z = pk2(o[4], o[5]); w.w = pk2(o[6], o[7]);
        *(u32x4*)(Y + (size_t)t * D + c8) = w;
    }
}

constexpr int GA_GCS = 0, GA_BTS = 256, GA_KN = 1024, GA_KB = GA_KN + 17408, GA_QN = GA_KB + 17408, GA_VBT = GA_QN + 17408, GA_KGT = GA_VBT + 18432,
              GA_AM = GA_KGT + 18432, GA_TB = GA_AM + 17408, GA_QKS = GA_TB + 9216, GA_END = GA_QKS + 9216;
static_assert(GA_END <= 131072, "gdn-a lds");
DI void gdn_a(const Frame& F, const Args& a) {
    LAS unsigned char* L = F.lds;
    LAS float* gcs = (LAS float*)(L + GA_GCS); LAS float* bts = (LAS float*)(L + GA_BTS);
    LAS float* Am = (LAS float*)(L + GA_AM);
    const bf16* U = (const bf16*)(F.ws + WS_U); const float* GA = (const float*)(F.ws + WS_GA); const float* BT = (const float*)(F.ws + WS_BETA);
    float* EG = (float*)(F.ws + WS_EG); const float* cw = a.in[8];
    const int lane = F.lane, w = F.wave, r = lane & 31, hh = lane >> 5;
    for (int item = F.vcu; item < 4096; item += F.G) {
        const int bh = item >> 5, n = item & 31, b = bh >> 2, h = bh & 3, t0 = b * SEQ + n * 64;
        unsigned char* Gp = F.ws + WS_G + (size_t)item * G_ITEM;
        if (w == 0) {
            float gc = GA[(size_t)(t0 + lane) * 4 + h];
#pragma unroll
            for (int o = 1; o < 64; o <<= 1) { const float up = __shfl_up(gc, o); if (lane >= o) gc += up; }
            gcs[lane] = gc; bts[lane] = BT[(size_t)(t0 + lane) * 4 + h];
            if (lane == 63) EG[item] = __expf(gc);
        }
        WG_BAR();
        const float glast = gcs[63];
#pragma unroll 1
        for (int it = 0; it < 6; ++it) {
            const int part = it >> 1, tok = (it & 1) * 32 + (F.tid >> 4), c8 = (F.tid & 15) * 8;
            const int ch = part * 512 + h * 128 + c8;
            const int sq = n * 64 + tok;
            float acc[8];
#pragma unroll
            for (int e = 0; e < 8; ++e) acc[e] = 0.f;
#pragma unroll
            for (int j = 0; j < 4; ++j) {
                if (sq - 3 + j >= 0) {
                    const u32x4 xv = *(const u32x4*)(U + (size_t)(t0 + tok - 3 + j) * EVU + 1024 + ch);
                    const f32x4 w0 = *(const f32x4*)(cw + j * 1536 + ch), w1 = *(const f32x4*)(cw + j * 1536 + ch + 4);
                    acc[0] += w0[0] * bflo(xv[0]); acc[1] += w0[1] * bfhi(xv[0]); acc[2] += w0[2] * bflo(xv[1]); acc[3] += w0[3] * bfhi(xv[1]);
                    acc[4] += w1[0] * bflo(xv[2]); acc[5] += w1[1] * bfhi(xv[2]); acc[6] += w1[2] * bflo(xv[3]); acc[7] += w1[3] * bfhi(xv[3]);
                }
            }
            float ss = 0.f;
#pragma unroll
            for (int e = 0; e < 8; ++e) { acc[e] = silu_f(acc[e]); ss += acc[e] * acc[e]; }
            ss = row16_sum(ss);
            const float beta = bts[tok], gc = gcs[tok];
            if (part == 0) {
                const float sc = rsqrtf(ss + EPS) * 0.08838834764831845f, eg = __expf(gc);
                u32x4 o; o.x = pk2(acc[0] * sc, acc[1] * sc); o.y = pk2(acc[2] * sc, acc[3] * sc); o.z = pk2(acc[4] * sc, acc[5] * sc); o.w = pk2(acc[6] * sc, acc[7] * sc);
                *(LAS u32x4*)(L + GA_QN + tok * 272 + c8 * 2) = o;
                const float s2 = sc * eg;
                u32x4 g; g.x = pk2(acc[0] * s2, acc[1] * s2); g.y = pk2(acc[2] * s2, acc[3] * s2); g.z = pk2(acc[4] * s2, acc[5] * s2); g.w = pk2(acc[6] * s2, acc[7] * s2);
                *(u32x4*)(Gp + G_QG + tok * 256 + c8 * 2) = g;
            } else if (part == 1) {
                const float sc = rsqrtf(ss + EPS), sb = sc * beta, sg = sb * __expf(gc), sd = sc * __expf(glast - gc);
                u32x4 o; o.x = pk2(acc[0] * sc, acc[1] * sc); o.y = pk2(acc[2] * sc, acc[3] * sc); o.z = pk2(acc[4] * sc, acc[5] * sc); o.w = pk2(acc[6] * sc, acc[7] * sc);
                *(LAS u32x4*)(L + GA_KN + tok * 272 + c8 * 2) = o;
                u32x4 p; p.x = pk2(acc[0] * sb, acc[1] * sb); p.y = pk2(acc[2] * sb, acc[3] * sb); p.z = pk2(acc[4] * sb, acc[5] * sb); p.w = pk2(acc[6] * sb, acc[7] * sb);
                *(LAS u32x4*)(L + GA_KB + tok * 272 + c8 * 2) = p;
                u32x4 d; d.x = pk2(acc[0] * sd, acc[1] * sd); d.y = pk2(acc[2] * sd, acc[3] * sd); d.z = pk2(acc[4] * sd, acc[5] * sd); d.w = pk2(acc[6] * sd, acc[7] * sd);
                *(u32x4*)(Gp + G_KD + tok * 256 + c8 * 2) = d;
#pragma unroll
                for (int e = 0; e < 8; ++e) *(LAS bf16*)(L + GA_KGT + (c8 + e) * 144 + tok * 2) = (bf16)(pk2(acc[e] * sg, 0.f) & 0xffffu);
            } else {
#pragma unroll
                for (int e = 0; e < 8; ++e) *(LAS bf16*)(L + GA_VBT + (c8 + e) * 144 + tok * 2) = (bf16)(pk2(acc[e] * beta, 0.f) & 0xffffu);
            }
        }
        WG_BAR();
        {
            const int mat = w >> 2, ti = (w >> 1) & 1, tj = w & 1;
            f32x16 x = zero16();
            if (ti >= tj) {
                const LAS unsigned char* ap = L + (mat ? GA_QN : GA_KB) + (32 * ti + r) * 272 + hh * 16;
                const LAS unsigned char* bp = L + GA_KN + (32 * tj + r) * 272 + hh * 16;
#pragma unroll
                for (int s = 0; s < 8; ++s) x = MFMA32(*(const LAS bf16x8*)(ap + 32 * s), *(const LAS bf16x8*)(bp + 32 * s), x);
            }
            const int j = 32 * tj + r; const float gj = gcs[j];
#pragma unroll
            for (int reg = 0; reg < 16; ++reg) {
                const int i = 32 * ti + crow(reg, hh);
                const float dec = __expf(gcs[i] - gj);
                if (mat == 0) Am[i * 68 + j] = (i > j) ? x[reg] * dec : 0.f;
                else *(LAS bf16*)(L + GA_QKS + i * 144 + j * 2) = (bf16)(pk2((i >= j) ? x[reg] * dec : 0.f, 0.f) & 0xffffu);
            }
        }
        WG_BAR();
        if (w == 0) {
            const int blk = hh, col = r;
            float Tr[32];
            const LAS float* Ab = Am + (blk * 32) * 68 + blk * 32;
#pragma unroll
            for (int i = 0; i < 32; ++i) {
                float acc = (i == col) ? 1.f : 0.f;
#pragma unroll
                for (int j = 0; j < i; ++j) acc -= Ab[i * 68 + j] * Tr[j];
                Tr[i] = acc;
            }
#pragma unroll
            for (int i = 0; i < 32; ++i) *(LAS bf16*)(L + GA_TB + (blk * 32 + i) * 144 + (blk * 32 + col) * 2) = (bf16)(pk2(Tr[i], 0.f) & 0xffffu);
#pragma unroll
            for (int i = 0; i < 16; ++i) *(LAS bf16*)(L + GA_TB + (2 * i + blk) * 144 + (32 + col) * 2) = (bf16)0;
            f32x16 P = zero16();
#pragma unroll
            for (int s = 0; s < 2; ++s) {
                const LAS float* arow = Am + (32 + r) * 68 + 16 * s + 8 * hh;
                const f32x4 a0 = *(const LAS f32x4*)arow, a1 = *(const LAS f32x4*)(arow + 4);
                const bf16x8 af = __builtin_bit_cast(bf16x8, pg8::pack8(a0, a1));
                float tv[8];
#pragma unroll
                for (int jj = 0; jj < 8; ++jj) { const float lo = Tr[16 * s + jj]; const float hi = __shfl(Tr[16 * s + 8 + jj], r); tv[jj] = hh ? hi : lo; }
                u32x4 tb; tb.x = pk2(tv[0], tv[1]); tb.y = pk2(tv[2], tv[3]); tb.z = pk2(tv[4], tv[5]); tb.w = pk2(tv[6], tv[7]);
                P = MFMA32(af, __builtin_bit_cast(bf16x8, tb), P);
            }
            f32x16 R = zero16();
#pragma unroll
            for (int s = 0; s < 2; ++s) {
                const LAS unsigned char* tp = L + GA_TB + (32 + r) * 144 + (32 + 16 * s + 4 * hh) * 2;
                const s16x4 lo = *(const LAS s16x4*)tp, hi = *(const LAS s16x4*)(tp + 16);
                R = MFMA32(cat8(lo, hi), pack_step(P, s), R);
            }
#pragma unroll
            for (int reg = 0; reg < 16; ++reg) *(LAS bf16*)(L + GA_TB + (32 + crow(reg, hh)) * 144 + r * 2) = (bf16)(pk2(-R[reg], 0.f) & 0xffffu);
        } else {
            for (int p = F.tid - 64; p < 512; p += 448) { const int row = p >> 3, c = p & 7; *(u32x4*)(Gp + G_QK + row * 128 + c * 16) = *(const LAS u32x4*)(L + GA_QKS + row * 144 + c * 16); }
        }
        WG_BAR();
        if (w < 4) {
#pragma unroll
            for (int q = 0; q < 2; ++q) {
                const int idx = w * 2 + q, ib = idx >> 2, db = idx & 3;
                f32x16 x = zero16();
                const LAS unsigned char* ap = L + GA_TB + (32 * ib + r) * 144 + hh * 16;
                const LAS unsigned char* bp = L + GA_VBT + (32 * db + r) * 144 + hh * 16;
#pragma unroll
                for (int s = 0; s < 4; ++s) if (ib || s < 2) x = MFMA32(*(const LAS bf16x8*)(ap + 32 * s), *(const LAS bf16x8*)(bp + 32 * s), x);
#pragma unroll
                for (int g = 0; g < 4; ++g) { u32x2 o; o.x = pk2(x[4 * g], x[4 * g + 1]); o.y = pk2(x[4 * g + 2], x[4 * g + 3]);
                    *(u32x2*)(Gp + G_UT + ((32 * db + r) * 64 + 32 * ib + 8 * g + 4 * hh) * 2) = o; }
            }
        } else {
#pragma unroll
            for (int q = 0; q < 2; ++q) {
                const int idx = (w - 4) * 2 + q, dkb = idx >> 1, ib = idx & 1;
                f32x16 x = zero16();
                const LAS unsigned char* ap = L + GA_KGT + (32 * dkb + r) * 144 + hh * 16;
                const LAS unsigned char* bp = L + GA_TB + (32 * ib + r) * 144 + hh * 16;
#pragma unroll
                for (int s = 0; s < 4; ++s) if (ib || s < 2) x = MFMA32(*(const LAS bf16x8*)(ap + 32 * s), *(const LAS bf16x8*)(bp + 32 * s), x);
#pragma unroll
                for (int g = 0; g < 4; ++g) { u32x2 o; o.x = pk2(x[4 * g], x[4 * g + 1]); o.y = pk2(x[4 * g + 2], x[4 * g + 3]);
                    *(u32x2*)(Gp + G_W + ((32 * ib + r) * 128 + 32 * dkb + 8 * g + 4 * hh) * 2) = o; }
            }
        }
        WG_BAR();
    }
}

constexpr int GB_ST = 0, GB_W = 34816, GB_QG = GB_W + 17408, GB_KD = GB_QG + 17408, GB_QK = GB_KD + 20480, GB_O = GB_QK + 9216, GB_END = GB_O + 33792;
static_assert(GB_END <= 140000, "gdn-b lds");
DI void gdn_b(const Frame& F, const Args& a, int worker, int nworkers) {
    LAS unsigned char* L = F.lds;
    const bf16* U = (const bf16*)(F.ws + WS_U); bf16* Y = (bf16*)(F.ws + WS_Y); const float* EG = (const float*)(F.ws + WS_EG); const float* gn = a.in[11];
    const int lane = F.lane, w = F.wave, r = lane & 31, hh = lane >> 5, dvb = w & 3, hf = w >> 2;
    const int q4 = (lane & 15) >> 2, p4 = lane & 3, g1 = (lane >> 4) & 1;
    LAS float* Ol = (LAS float*)(L + GB_O);
    const float gn0 = gn[lane], gn1 = gn[64 + lane];
    for (int bh = worker; bh < 128; bh += nworkers) {
        const int b = bh >> 2, h = bh & 3;
        f32x16 Sacc[2] = {zero16(), zero16()};
        for (int p = F.tid; p < 34816 / 16; p += 512) *(LAS u32x4*)(L + GB_ST + p * 16) = (u32x4){0u, 0u, 0u, 0u};
        for (int n = 0; n < 32; ++n) {
            const int item = bh * 32 + n, t0 = b * SEQ + n * 64;
            const unsigned char* Gp = F.ws + WS_G + (size_t)item * G_ITEM;
#pragma unroll
            for (int k = 0; k < 7; ++k) {
                const int p = F.tid + 512 * k;
                if (p < 1024) { const int row = p >> 4, c = p & 15; *(LAS u32x4*)(L + GB_W + row * 272 + c * 16) = *(const u32x4*)(Gp + G_W + p * 16); }
                else if (p < 2048) { const int q = p - 1024, row = q >> 4, c = q & 15; *(LAS u32x4*)(L + GB_QG + row * 272 + c * 16) = *(const u32x4*)(Gp + G_QG + q * 16); }
                else if (p < 3072) { const int q = p - 2048, row = q >> 4, c = q & 15; *(LAS u32x4*)(L + GB_KD + row * 320 + c * 16) = *(const u32x4*)(Gp + G_KD + q * 16); }
                else { const int q = p - 3072, row = q >> 3, c = q & 7; *(LAS u32x4*)(L + GB_QK + row * 144 + c * 16) = *(const u32x4*)(Gp + G_QK + q * 16); }
            }
            u32x2 ui[2][4];
#pragma unroll
            for (int tb = 0; tb < 2; ++tb)
#pragma unroll
                for (int g = 0; g < 4; ++g) ui[tb][g] = *(const u32x2*)(Gp + G_UT + ((32 * dvb + r) * 64 + 32 * tb + 8 * g + 4 * hh) * 2);
            const float eg = EG[item];
            WG_BAR();
            bf16x8 Sf[8];
#pragma unroll
            for (int s = 0; s < 8; ++s) Sf[s] = *(const LAS bf16x8*)(L + GB_ST + (32 * dvb + r) * 272 + (16 * s + 8 * hh) * 2);
            bf16x8 pv[2][2];
#pragma unroll
            for (int tb = 0; tb < 2; ++tb) {
                f32x16 x = zero16();
                const LAS unsigned char* wp = L + GB_W + (32 * tb + r) * 272 + hh * 16;
#pragma unroll
                for (int s = 0; s < 8; ++s) x = MFMA32(*(const LAS bf16x8*)(wp + 32 * s), Sf[s], x);
#pragma unroll
                for (int g = 0; g < 4; ++g) { x[4 * g] = bflo(ui[tb][g].x) - x[4 * g]; x[4 * g + 1] = bfhi(ui[tb][g].x) - x[4 * g + 1]; x[4 * g + 2] = bflo(ui[tb][g].y) - x[4 * g + 2]; x[4 * g + 3] = bfhi(ui[tb][g].y) - x[4 * g + 3]; }
                pv[tb][0] = pack_step(x, 0); pv[tb][1] = pack_step(x, 1);
            }
            {
                f32x16 o = zero16();
                const LAS unsigned char* qp = L + GB_QG + (32 * hf + r) * 272 + hh * 16;
#pragma unroll
                for (int s = 0; s < 8; ++s) o = MFMA32(*(const LAS bf16x8*)(qp + 32 * s), Sf[s], o);
#pragma unroll
                for (int tb = 0; tb < 2; ++tb) {
                    if (tb <= hf) {
#pragma unroll
                        for (int s = 0; s < 2; ++s) {
                            const LAS unsigned char* kp = L + GB_QK + (32 * hf + r) * 144 + (32 * tb + 16 * s + 4 * hh) * 2;
                            o = MFMA32(cat8(*(const LAS s16x4*)kp, *(const LAS s16x4*)(kp + 16)), pv[tb][s], o);
                        }
                    }
                }
#pragma unroll
                for (int reg = 0; reg < 16; ++reg) Ol[(32 * hf + crow(reg, hh)) * 132 + 32 * dvb + r] = o[reg];
            }
#pragma unroll
            for (int d2 = 0; d2 < 2; ++d2) {
                const int db = 2 * hf + d2;
                f32x16 x = Sacc[d2] * eg;
#pragma unroll
                for (int tb = 0; tb < 2; ++tb)
#pragma unroll
                    for (int s = 0; s < 2; ++s) {
                        const LAS unsigned char* kp = L + GB_KD + (32 * tb + 16 * s + 4 * hh + q4) * 320 + (32 * db + 16 * g1 + 4 * p4) * 2;
                        x = MFMA32(cat8(vtr(kp), vtr(kp + 8 * 320)), pv[tb][s], x);
                    }
                Sacc[d2] = x;
            }
            WG_BAR();
#pragma unroll
            for (int d2 = 0; d2 < 2; ++d2) {
                const int db = 2 * hf + d2;
#pragma unroll
                for (int g = 0; g < 4; ++g) { u32x2 o; o.x = pk2(Sacc[d2][4 * g], Sacc[d2][4 * g + 1]); o.y = pk2(Sacc[d2][4 * g + 2], Sacc[d2][4 * g + 3]);
                    *(LAS u32x2*)(L + GB_ST + (32 * dvb + r) * 272 + (32 * db + 8 * g + 4 * hh) * 2) = o; }
            }
#pragma unroll
            for (int k = 0; k < 8; ++k) {
                const int tt = w * 8 + k, t = t0 + tt;
                const float v0 = Ol[tt * 132 + lane], v1 = Ol[tt * 132 + 64 + lane];
                const float rstd = rsqrtf(wave_sum(v0 * v0 + v1 * v1) * (1.f / 128.f) + EPS);
                const float og0 = bf2f(U[(size_t)t * EVU + 2560 + h * 128 + lane]), og1 = bf2f(U[(size_t)t * EVU + 2560 + h * 128 + 64 + lane]);
                Y[(size_t)t * D + 512 + h * 128 + lane] = (bf16)(pk2(v0 * rstd * gn0 * silu_f(og0), 0.f) & 0xffffu);
                Y[(size_t)t * D + 512 + h * 128 + 64 + lane] = (bf16)(pk2(v1 * rstd * gn1 * silu_f(og1), 0.f) & 0xffffu);
            }
        }
        WG_BAR();
    }
}

constexpr int AT_STAGE = 38912, AT_K = 0, AT_V = 18432, AT_BIAS = 2 * AT_STAGE, AT_END = AT_BIAS + 512;
DI void attn_stage_load(const bf16* U1, int trow, int h, int tid, u32x4 (&st)[4]) {
#pragma unroll
    for (int p = 0; p < 4; ++p) { const int idx = tid + 512 * p, row = idx >> 5, c = idx & 31;
        st[p] = *(const u32x4*)(U1 + (size_t)(trow + row) * OD_N + (c < 16 ? 512 + h * 128 + c * 8 : 1024 + h * 128 + (c - 16) * 8)); }
}
DI void attn_stage_store(LAS unsigned char* sb, int tid, const u32x4 (&st)[4]) {
#pragma unroll
    for (int p = 0; p < 4; ++p) { const int idx = tid + 512 * p, row = idx >> 5, c = idx & 31;
        if (c < 16) { const int e = c * 8, mp = e >> 6, wi = e & 63; *(LAS u32x4*)(sb + AT_K + mp * 9216 + row * 144 + wi * 2) = st[p]; }
        else *(LAS u32x4*)(sb + AT_V + row * 320 + (c - 16) * 16) = st[p]; }
}
DI void attn_phase(const Frame& F, const Args& a) {
    LAS unsigned char* L = F.lds;
    const bf16* U1 = (const bf16*)(F.ws + WS_U); bf16* Y = (bf16*)(F.ws + WS_Y);
    const float* lamp = a.in[14]; const float* dng = a.in[15]; const float* relb = a.in[21];
    const int lane = F.lane, w = F.wave, r = lane & 31, hh = lane >> 5, mp = w >> 2, qs = w & 3;
    const int q4 = (lane & 15) >> 2, p4 = lane & 3, g1 = (lane >> 4) & 1;
    const float lam = __expf(wave_sum(lamp[lane] * lamp[64 + lane])) - __expf(wave_sum(lamp[128 + lane] * lamp[192 + lane])) + LAMBDA_INIT;
    const float c1 = 0.125f * LOG2E;
    LAS float* btab = (LAS float*)(L + AT_BIAS);
    LAS float* exch = (LAS float*)L;
    for (int item = F.vcu; item < 256; item += F.G) {
        const int bh = item >> 1, par = item & 1, b = bh >> 2, h = bh & 3, trow0 = b * SEQ;
        WG_BAR();
        if (F.tid < 128) { const int n = F.tid; int bucket = n;
            if (n >= 16) { const int lg = 16 + (int)(__logf((float)n / 16.f) / 2.0794415416798357f * 16.f); bucket = lg < 31 ? lg : 31; }
            btab[n] = relb[bucket * 4 + h] * LOG2E; }
        const float bias_far = relb[31 * 4 + h] * LOG2E;
        for (int ui = 0; ui < 8; ++ui) {
            const int qblk = 2 * ui + ((ui ^ par) & 1);
            const int q0 = qblk * 128 + qs * 32, qpos = q0 + r, ntiles = 2 * (qblk + 1);
            bf16x8 qf[4];
            { const bf16* qp = U1 + (size_t)(trow0 + qpos) * OD_N + h * 128 + mp * 64 + 8 * hh;
#pragma unroll
              for (int s = 0; s < 4; ++s) qf[s] = *(const bf16x8*)(qp + 16 * s); }
            f32x16 O[4] = {zero16(), zero16(), zero16(), zero16()};
            float mrun = -INFINITY, lrun = 0.f;
            u32x4 st[4];
            attn_stage_load(U1, trow0, h, F.tid, st);
            attn_stage_store(L, F.tid, st);
            WG_BAR();
            for (int kt = 0; kt < ntiles; ++kt) {
                const bool more = kt + 1 < ntiles;
                if (more) attn_stage_load(U1, trow0 + (kt + 1) * 64, h, F.tid, st);
                const int key0 = kt * 64;
                if (key0 <= q0 + 31) {
                    const LAS unsigned char* sb = L + (kt & 1) * AT_STAGE;
                    const LAS unsigned char* kb = sb + AT_K + mp * 9216 + r * 144 + hh * 16;
                    f32x16 x0 = zero16(), x1 = zero16();
#pragma unroll
                    for (int s = 0; s < 4; ++s) { x0 = MFMA32(*(const LAS bf16x8*)(kb + 32 * s), qf[s], x0); x1 = MFMA32(*(const LAS bf16x8*)(kb + 32 * 144 + 32 * s), qf[s], x1); }
                    if (q0 - (key0 + 63) >= 128) {
#pragma unroll
                        for (int reg = 0; reg < 16; ++reg) { x0[reg] = x0[reg] * c1 + bias_far; x1[reg] = x1[reg] * c1 + bias_far; }
                    } else {
#pragma unroll
                        for (int reg = 0; reg < 16; ++reg) {
                            const int d0 = qpos - (key0 + crow(reg, hh)), d1 = d0 - 32;
                            const float b0 = btab[d0 < 0 ? 0 : (d0 > 127 ? 127 : d0)], b1 = btab[d1 < 0 ? 0 : (d1 > 127 ? 127 : d1)];
                            x0[reg] = (d0 >= 0) ? x0[reg] * c1 + b0 : -INFINITY; x1[reg] = (d1 >= 0) ? x1[reg] * c1 + b1 : -INFINITY;
                        }
                    }
                    float mx = x0[0];
#pragma unroll
                    for (int reg = 1; reg < 16; ++reg) mx = fmaxf(mx, x0[reg]);
#pragma unroll
                    for (int reg = 0; reg < 16; ++reg) mx = fmaxf(mx, x1[reg]);
                    mx = fmaxf(mx, __shfl_xor(mx, 32));
                    const float mnew = fmaxf(mrun, mx), alpha = exp2f(mrun - mnew); mrun = mnew;
                    float rs = 0.f;
#pragma unroll
                    for (int reg = 0; reg < 16; ++reg) { x0[reg] = exp2f(x0[reg] - mnew); x1[reg] = exp2f(x1[reg] - mnew); rs += x0[reg] + x1[reg]; }
                    lrun = lrun * alpha + rs;
#pragma unroll
                    for (int db = 0; db < 4; ++db) O[db] = O[db] * alpha;
                    bf16x8 pf[2][2]; pf[0][0] = pack_step(x0, 0); pf[0][1] = pack_step(x0, 1); pf[1][0] = pack_step(x1, 0); pf[1][1] = pack_step(x1, 1);
                    const LAS unsigned char* vb = sb + AT_V + (4 * hh + q4) * 320 + (16 * g1 + 4 * p4) * 2;
#pragma unroll
                    for (int db = 0; db < 4; ++db)
#pragma unroll
                        for (int kh = 0; kh < 2; ++kh)
#pragma unroll
                            for (int s = 0; s < 2; ++s) {
                                const LAS unsigned char* vp = vb + (32 * kh + 16 * s) * 320 + 64 * db;
                                O[db] = MFMA32(cat8(vtr(vp), vtr(vp + 8 * 320)), pf[kh][s], O[db]);
                            }
                }
                if (more) attn_stage_store(L + ((kt + 1) & 1) * AT_STAGE, F.tid, st);
                WG_BAR();
            }
            const float ltot = lrun + __shfl_xor(lrun, 32);
            const float inv = 1.f / ltot;
            if (mp == 1) {
                const float sc = inv * lam;
#pragma unroll
                for (int db = 0; db < 4; ++db)
#pragma unroll
                    for (int reg = 0; reg < 16; ++reg) exch[(qs * 64 + db * 16 + reg) * 64 + lane] = O[db][reg] * sc;
            }
            WG_BAR();
            if (mp == 0) {
                float ss = 0.f;
#pragma unroll
                for (int db = 0; db < 4; ++db)
#pragma unroll
                    for (int reg = 0; reg < 16; ++reg) { const float o = O[db][reg] * inv - exch[(qs * 64 + db * 16 + reg) * 64 + lane]; O[db][reg] = o; ss += o * o; }
                ss += __shfl_xor(ss, 32);
                const float rstd = rsqrtf(ss * (1.f / 128.f) + EPS) * (1.f - LAMBDA_INIT);
                bf16* yp = Y + (size_t)(trow0 + qpos) * D + h * 128;
#pragma unroll
                for (int db = 0; db < 4; ++db)
#pragma unroll
                    for (int g = 0; g < 4; ++g) { const int d = 32 * db + 8 * g + 4 * hh; const f32x4 gv = *(const f32x4*)(dng + d);
                        u32x2 o; o.x = pk2(O[db][4 * g] * rstd * gv[0], O[db][4 * g + 1] * rstd * gv[1]); o.y = pk2(O[db][4 * g + 2] * rstd * gv[2], O[db][4 * g + 3] * rstd * gv[3]);
                        *(u32x2*)(yp + d) = o; }
            }
            WG_BAR();
        }
    }
}

constexpr int CF_GLU = 0, CF_RED = 96256, CF_STAT = CF_RED + 4096, CF_END = CF_STAT + 512;
DI void conformer_phase(const Frame& F, const Args& a) {
    LAS unsigned char* L = F.lds;
    const bf16* U1 = (const bf16*)(F.ws + WS_U); bf16* Y = (bf16*)(F.ws + WS_Y);
    const float* cw = a.in[16]; const float* cb = a.in[17]; const float* lg = a.in[18]; const float* lb = a.in[19];
    const int c = F.tid;
    float wv[31];
#pragma unroll
    for (int j = 0; j < 31; ++j) wv[j] = cw[j * 512 + c];
    const float bias = cb[c], lng = lg[c], lnb = lb[c];
    LAS float* red = (LAS float*)(L + CF_RED); LAS float* stat = (LAS float*)(L + CF_STAT);
    for (int tile = F.vcu; tile < T / 64; tile += F.G) {
        const int t0 = tile * 64, s0 = t0 & (SEQ - 1);
        WG_BAR();
        for (int it = F.tid; it < 94 * 64; it += 512) {
            const int row = it >> 6, c8 = (it & 63) * 8;
            u32x4 o = (u32x4){0u, 0u, 0u, 0u};
            if (s0 + row - 30 >= 0) {
                const bf16* up = U1 + (size_t)(t0 + row - 30) * OD_N + 1536 + c8;
                const u32x4 ga = *(const u32x4*)up, gb = *(const u32x4*)(up + 512);
#pragma unroll
                for (int q = 0; q < 4; ++q) o[q] = pk2(bflo(ga[q]) * sigmoid_f(bflo(gb[q])), bfhi(ga[q]) * sigmoid_f(bfhi(gb[q])));
            }
            *(LAS u32x4*)(L + CF_GLU + row * 1024 + c8 * 2) = o;
        }
        WG_BAR();
        float out[64];
#pragma unroll
        for (int tt = 0; tt < 64; ++tt) {
            float acc = bias;
#pragma unroll
            for (int j = 0; j < 31; ++j) acc += wv[j] * bf2f(*(const LAS bf16*)(L + CF_GLU + (tt + j) * 1024 + c * 2));
            out[tt] = acc;
            const float s1 = wave_sum(acc), s2 = wave_sum(acc * acc);
            if (F.lane == 0) { red[(tt * 8 + F.wave) * 2] = s1; red[(tt * 8 + F.wave) * 2 + 1] = s2; }
        }
        WG_BAR();
        if (F.tid < 64) { float s1 = 0.f, s2 = 0.f;
#pragma unroll
            for (int q = 0; q < 8; ++q) { s1 += red[(F.tid * 8 + q) * 2]; s2 += red[(F.tid * 8 + q) * 2 + 1]; }
            const float mean = s1 * (1.f / 512.f); const float var = fmaxf(s2 * (1.f / 512.f) - mean * mean, 0.f);
            stat[F.tid * 2] = mean; stat[F.tid * 2 + 1] = rsqrtf(var + EPS); }
        WG_BAR();
#pragma unroll
        for (int tt = 0; tt < 64; ++tt) {
            const float v = (out[tt] - stat[tt * 2]) * stat[tt * 2 + 1] * lng + lnb;
            Y[(size_t)(t0 + tt) * D + 512 + c] = (bf16)(pk2(silu_f(v), 0.f) & 0xffffu);
        }
    }
}

constexpr int NPH = 26;
__global__ void __launch_bounds__(512, 2) fwd_kernel(Args args) {
    extern __shared__ __attribute__((aligned(16))) unsigned char lds_raw[];
    Frame F;
    F.lds = (LAS unsigned char*)lds_raw; F.ws = args.ws;
    F.tid = threadIdx.x; F.lane = F.tid & 63; F.wave = __builtin_amdgcn_readfirstlane(F.tid >> 6);
    F.G = gridDim.x; { const int bx = blockIdx.x; F.vcu = (F.G % 8 == 0) ? (bx % 8) * (F.G / 8) + bx / 8 : bx; }
    volatile LAS unsigned* MISC = (volatile LAS unsigned*)(F.lds + LDS_MISC);
    if (F.tid < 64) MISC[F.tid] = 0u;
    __syncthreads();
    unsigned* ctl = (unsigned*)(F.ws + WS_CTL);
    const bool multi = (args.ph_hi - args.ph_lo) > 1;
    XcdBarrier bar; bar.bar = ctl + CW_BAR; bar.x = 0; bar.st = MISC + 8;
    if (multi) bar = xcd_barrier_post(ctl + CW_BAR, MISC + 8);
    const int lo = args.ph_lo, hi = args.ph_hi;
#define IN(k) (lo <= (k) && (k) < hi)
#define SEAM(k) do { if (IN(k) && IN((k) + 1)) xcd_barrier(bar); } while (0)
    unsigned char* ws = F.ws;
    bf16* HN = (bf16*)(ws + WS_HN); bf16* UB = (bf16*)(ws + WS_U); bf16* YB = (bf16*)(ws + WS_Y);
    const int bx = (int)blockIdx.x;

    if (IN(0)) { convert_weights(F, args); norm_mix0(F, args); } SEAM(0);
    if (IN(1)) { pg8::SchedDense S; S.init(HN, ws + W_EVIN, T, EV_N, D, F.G, bx); pg8::EpiEvIn E{UB}; pg8::gemm_phase(F.lds, S, E); } SEAM(1);
    if (IN(2)) { gdn_a(F, args); } SEAM(2);
    if (IN(3)) { if (F.G >= 2) { if ((bx & 1) == 0) gdn_b(F, args, bx >> 1, (F.G + 1) >> 1); else mixer_a(F, args, bx >> 1, F.G >> 1); } else { gdn_b(F, args, 0, 1); mixer_a(F, args, 0, 1); } } SEAM(3);
    if (IN(4)) { pg8::SchedDense S; S.init(YB, ws + W_EVOUT, T, D, D, F.G, bx); pg8::EpiResid E{args.in[0], args.out}; pg8::gemm_phase(F.lds, S, E); } SEAM(4);
    if (IN(5)) { norm_plain(F, args.out, args.in[3], HN); } SEAM(5);
    if (IN(6)) { pg8::SchedDense S; S.init(HN, ws + W_FFGU, T, 2 * DFF, D, F.G, bx); pg8::EpiSwiGLU E{UB, DFF}; pg8::gemm_phase(F.lds, S, E); } SEAM(6);
    if (IN(7)) { pg8::SchedDense S; S.init(UB, ws + W_FFD, T, D, DFF, F.G, bx); pg8::EpiResid E{args.out, args.out}; pg8::gemm_phase(F.lds, S, E); } SEAM(7);
    if (IN(8)) { norm_plain(F, args.out, args.in[4], HN); convert_p(F, args.in[1], (bf16*)(ws + WS_GX)); } SEAM(8);
    if (IN(9)) { pg8::SchedDense S; S.init(ws + WS_GX, ws + W_PPROJ, T, D, 256, F.G, bx); pg8::EpiStoreBf16 E{UB, D}; pg8::gemm_phase(F.lds, S, E); } SEAM(9);
    if (IN(10)) { pg8::SchedDense S; S.init(HN, ws + W_PGATE, T, D, D, F.G, bx); pg8::EpiPleGate E{args.out, UB}; pg8::gemm_phase(F.lds, S, E); } SEAM(10);
    if (IN(11)) { norm_plain(F, args.out, args.in[2] + D, HN); } SEAM(11);
    if (IN(12)) { pg8::SchedDense S; S.init(HN, ws + W_ODIN, T, OD_N, D, F.G, bx); pg8::EpiStoreBf16 E{UB, OD_N}; pg8::gemm_phase(F.lds, S, E); } SEAM(12);
    if (IN(13)) { attn_phase(F, args); conformer_phase(F, args); } SEAM(13);
    if (IN(14)) { pg8::SchedDense S; S.init(YB, ws + W_ODOUT, T, D, D, F.G, bx); pg8::EpiResid E{args.out, args.out}; pg8::gemm_phase(F.lds, S, E); } SEAM(14);
    if (IN(15)) { norm_router(F, args); } SEAM(15);
#define MOE_PART(part, phg, phd) \
    if (IN(phg) || IN(phd)) { \
        LAS int* tab = (LAS int*)(F.lds + LDS_MISC + 256); \
        if (F.tid == 0) { int pb = 0; for (int e = 0; e < 8; ++e) { const int c = (int)__hip_atomic_load(ctl + CW_CNT + 64 * e, __ATOMIC_RELAXED, __HIP_MEMORY_SCOPE_AGENT); tab[e] = c; tab[8 + e] = pb; pb += (c + 255) >> 8; } tab[16] = pb; } \
        __syncthreads(); \
        const int nbt = tab[16]; int nMp = nbt - (part) * MOE_NBP; nMp = nMp < 0 ? 0 : (nMp > MOE_NBP ? MOE_NBP : nMp); \
        if (IN(phg)) { pg8::SchedMoeGU S; S.A = (const char*)HN; S.Bt = (const char*)(ws + W_MGU); S.K = D; S.nM = nMp; S.nN = 2 * DFE / 256; S.G = F.G; S.c = bx; S.blk0 = (part) * MOE_NBP; S.bstride = (size_t)2 * DFE * D * 2; \
            S.row_ts = (const int*)(ws + WS_ROWTS); S.tab = tab; S.gather = true; pg8::EpiSwiGLU E{(bf16*)(ws + WS_GX), DFE}; pg8::gemm_phase(F.lds, S, E); } \
        SEAM(phg); \
        if (IN(phd)) { pg8::SchedMoeDown S; S.A = (const char*)(ws + WS_GX); S.Bt = (const char*)(ws + W_MD); S.K = DFE; S.nM = nMp; S.nN = D / 256; S.G = F.G; S.c = bx; S.blk0 = (part) * MOE_NBP; S.bstride = (size_t)D * DFE * 2; \
            S.row_ts = (const int*)(ws + WS_ROWTS); S.tab = tab; S.gather = false; pg8::EpiMoeDown E{(bf16*)(ws + WS_YMOE), (const int*)(ws + WS_ROWTS), (const float*)(ws + WS_ROWGATE)}; pg8::gemm_phase(F.lds, S, E); } \
        SEAM(phd); \
    }
    MOE_PART(0, 16, 17)
    MOE_PART(1, 18, 19)
    MOE_PART(2, 20, 21)
    if (IN(22)) { combine_norm(F, args); convert_p(F, args.in[1] + (size_t)T * 256, (bf16*)(ws + WS_GX)); } SEAM(22);
    if (IN(23)) { pg8::SchedDense S; S.init(ws + WS_GX, ws + W_PPROJ + (size_t)D * 256 * 2, T, D, 256, F.G, bx); pg8::EpiStoreBf16 E{UB, D}; pg8::gemm_phase(F.lds, S, E); } SEAM(23);
    if (IN(24)) { pg8::SchedDense S; S.init(HN, ws + W_PGATE + (size_t)D * D * 2, T, D, D, F.G, bx); pg8::EpiPleGate E{args.out, UB}; pg8::gemm_phase(F.lds, S, E); } SEAM(24);
    if (IN(25)) { final_norm(F, args); }
#undef IN
#undef SEAM
}

#ifndef MK_MULTI_LAUNCH
#define MK_MULTI_LAUNCH 1
#endif
extern "C" void kernel_launch(void* const* d_in, const int* in_sizes, int n_in, void* d_out, int out_size, void* d_ws, size_t ws_size, hipStream_t stream) {
    static int grid = 0;
    if (grid == 0) {
        if (n_in != 29 || out_size != T * D || ws_size < WS_END) { fprintf(stderr, "kernel_launch: unexpected shapes (n_in %d out %d ws %zu)\n", n_in, out_size, ws_size); grid = -1; return; }
        int dev = 0, cus = 0, per_cu = 0;
        if (hipGetDevice(&dev) != hipSuccess || hipDeviceGetAttribute(&cus, hipDeviceAttributeMultiprocessorCount, dev) != hipSuccess) { grid = -1; return; }
        if (hipFuncSetAttribute((const void*)fwd_kernel, hipFuncAttributeMaxDynamicSharedMemorySize, LDS_BYTES) != hipSuccess) { fprintf(stderr, "kernel_launch: LDS attribute failed\n"); grid = -1; return; }
        if (hipOccupancyMaxActiveBlocksPerMultiprocessor(&per_cu, (const void*)fwd_kernel, 512, LDS_BYTES) != hipSuccess || per_cu < 1) { fprintf(stderr, "kernel_launch: occupancy query says %d\n", per_cu); }
        (void)hipGetLastError();
        grid = cus;
    }
    if (grid < 0) return;
    (void)hipMemsetAsync((char*)d_ws + WS_CTL, 0, CTL_BYTES, stream);
    Args a{};
    for (int i = 0; i < 29; ++i) a.in[i] = (const float*)d_in[i];
    a.out = (float*)d_out; a.ws = (unsigned char*)d_ws;
#if MK_MULTI_LAUNCH
    for (int ph = 0; ph < NPH; ++ph) { a.ph_lo = ph; a.ph_hi = ph + 1; hipLaunchKernelGGL(fwd_kernel, dim3(grid), dim3(512), LDS_BYTES, stream, a); }
#else
    a.ph_lo = 0; a.ph_hi = NPH;
    hipLaunchKernelGGL(fwd_kernel, dim3(grid), dim3(512), LDS_BYTES, stream, a);
#endif
}
```

```cpp
#include <hip/hip_runtime.h>
#include <stdint.h>
#include <stdio.h>

#define DI __device__ __forceinline__
#define LAS __attribute__((address_space(3)))
#define GAS __attribute__((address_space(1)))
typedef unsigned short bf16;
typedef short bf16x8 __attribute__((ext_vector_type(8)));
typedef short s16x4 __attribute__((ext_vector_type(4)));
typedef short v4i16_t __attribute__((ext_vector_type(4)));
typedef float f32x4 __attribute__((ext_vector_type(4)));
typedef float f32x16 __attribute__((ext_vector_type(16)));
typedef float f32x2_t __attribute__((ext_vector_type(2)));
typedef __bf16 bf16x2_t __attribute__((ext_vector_type(2)));
typedef unsigned u32x4 __attribute__((ext_vector_type(4)));
typedef unsigned u32x2 __attribute__((ext_vector_type(2)));
typedef GAS unsigned gu32;

constexpr int T = 65536, D = 1024, SEQ = 2048, NBATCH = 32;
constexpr int EV_IN = 3592, EV_N = 3584, EVU = 3072;
constexpr int OD_N = 2560;
constexpr int DFF = 2816, DFE = 3584, NE = 8, CAP = 65536;
constexpr int MOE_NBP = 174, MOE_NPART = 3;
constexpr float EPS = 1e-6f;
constexpr float LOG2E = 1.4426950408889634f;
constexpr float LAMBDA_INIT = 0.35550906f;

constexpr size_t MiB = 1u << 20;
constexpr size_t WS_CTL = 0, CTL_BYTES = 1 * MiB;
constexpr size_t WS_GA = 1 * MiB, WS_BETA = 2 * MiB, WS_ROWTS = 3 * MiB, WS_ROWGATE = 5 * MiB, WS_EG = 7 * MiB;
constexpr size_t WS_W = 16 * MiB;
constexpr size_t W_EVIN = WS_W;
constexpr size_t W_EVOUT = W_EVIN + (size_t)EV_N * D * 2;
constexpr size_t W_FFGU = W_EVOUT + (size_t)D * D * 2;
constexpr size_t W_FFD = W_FFGU + (size_t)2 * DFF * D * 2;
constexpr size_t W_ODIN = W_FFD + (size_t)D * DFF * 2;
constexpr size_t W_ODOUT = W_ODIN + (size_t)OD_N * D * 2;
constexpr size_t W_MGU = W_ODOUT + (size_t)D * D * 2;
constexpr size_t W_MD = W_MGU + (size_t)NE * 2 * DFE * D * 2;
constexpr size_t W_PPROJ = W_MD + (size_t)NE * D * DFE * 2;
constexpr size_t W_PGATE = W_PPROJ + (size_t)2 * D * 256 * 2;
constexpr size_t W_END = W_PGATE + (size_t)2 * D * D * 2;
constexpr size_t WS_HN = 222 * MiB;
constexpr size_t WS_G = 222 * MiB;
constexpr size_t WS_GX = 352 * MiB;
constexpr size_t WS_U = 512 * MiB;
constexpr size_t WS_Y = 896 * MiB;
constexpr size_t WS_YMOE = 768 * MiB;
constexpr size_t WS_END = 1024 * MiB;
static_assert(W_END <= WS_HN, "weights fit");
static_assert(WS_G + (size_t)4096 * 73728 <= WS_U, "gdn intermediates fit");
static_assert(WS_GX + (size_t)MOE_NBP * 256 * DFE * 2 <= WS_YMOE, "moe act fits");
constexpr size_t G_ITEM = 73728;
constexpr size_t G_W = 0, G_UT = 16384, G_QG = 32768, G_KD = 49152, G_QK = 65536;

constexpr int CW_CNT = 64;
constexpr int CW_BAR = 4096;

constexpr int LDS_BYTES = 160 * 1024;
constexpr int LDS_MISC = 131072 + 24576;
DI float bf2f(unsigned short b) { return __uint_as_float(((unsigned)b) << 16); }
DI float bflo(unsigned u) { return __uint_as_float(u << 16); }
DI float bfhi(unsigned u) { return __uint_as_float(u & 0xffff0000u); }
DI unsigned pk2(float lo, float hi) { f32x2_t v = {lo, hi}; bf16x2_t b = __builtin_convertvector(v, bf16x2_t); return __builtin_bit_cast(unsigned, b); }
DI float dppf(float v, const int ctrl_sel) {
    int r;
    switch (ctrl_sel) {
        case 0: r = __builtin_amdgcn_update_dpp(0, __builtin_bit_cast(int, v), 0xB1, 0xF, 0xF, true); break;
        case 1: r = __builtin_amdgcn_update_dpp(0, __builtin_bit_cast(int, v), 0x4E, 0xF, 0xF, true); break;
        case 2: r = __builtin_amdgcn_update_dpp(0, __builtin_bit_cast(int, v), 0x141, 0xF, 0xF, true); break;
        default: r = __builtin_amdgcn_update_dpp(0, __builtin_bit_cast(int, v), 0x140, 0xF, 0xF, true); break;
    }
    return __builtin_bit_cast(float, r);
}
DI float row16_sum(float v) { v += dppf(v, 0); v += dppf(v, 1); v += dppf(v, 2); v += dppf(v, 3); return v; }
DI float rlane(float v, int l) { return __builtin_bit_cast(float, __builtin_amdgcn_readlane(__builtin_bit_cast(int, v), l)); }
DI float wave_sum(float v) { v = row16_sum(v); return (rlane(v, 0) + rlane(v, 16)) + (rlane(v, 32) + rlane(v, 48)); }
DI float silu_f(float x) { return x / (1.f + __expf(-x)); }
DI float sigmoid_f(float x) { return 1.f / (1.f + __expf(-x)); }
DI int crow(int reg, int hh) { return (reg & 3) + 8 * (reg >> 2) + 4 * hh; }
DI bf16x8 pack_step(const f32x16& x, int s) {
    u32x4 p;
    p[0] = pk2(x[8 * s + 0], x[8 * s + 1]); p[1] = pk2(x[8 * s + 2], x[8 * s + 3]); p[2] = pk2(x[8 * s + 4], x[8 * s + 5]); p[3] = pk2(x[8 * s + 6], x[8 * s + 7]);
    return __builtin_bit_cast(bf16x8, p);
}
DI s16x4 vtr(const LAS unsigned char* p) { return __builtin_bit_cast(s16x4, __builtin_amdgcn_ds_read_tr16_b64_v4i16((LAS v4i16_t*)p)); }
DI bf16x8 cat8(s16x4 lo, s16x4 hi) { return __builtin_shufflevector(lo, hi, 0, 1, 2, 3, 4, 5, 6, 7); }
#define MFMA32(a, b, c) __builtin_amdgcn_mfma_f32_32x32x16_bf16((a), (b), (c), 0, 0, 0)
DI f32x16 zero16() { f32x16 z; for (int i = 0; i < 16; ++i) z[i] = 0.f; return z; }
#define WG_BAR() __syncthreads()

#define XB_TMO      128
#define XB_XCNT(j)  (256  + 64 * (j))
#define XB_XSUB(j)  (1280 + 64 * (j))
#define XB_XGEN(j)  (2304 + 64 * (j))
#define XB_TOP      3328
#define XB_TOPGEN   3392
#define XCD_BAR_WORDS 3456
#define XB_SPIN_CAP (1u << 22)
DI unsigned xb_ld(unsigned* p)              { return __hip_atomic_load(p, __ATOMIC_RELAXED, __HIP_MEMORY_SCOPE_AGENT); }
DI unsigned xb_add(unsigned* p, unsigned v) { return __hip_atomic_fetch_add(p, v, __ATOMIC_RELAXED, __HIP_MEMORY_SCOPE_AGENT); }
DI unsigned xb_xcc_id() { return (unsigned)__builtin_amdgcn_s_getreg((3 << 11) | 20) & 0xFu; }
#define XB_SPIN(cond, bar) do { unsigned _sp = 0; while (cond) { __builtin_amdgcn_s_sleep(1); \
    if ((++_sp & 255u) == 0u) { if (xb_ld(&(bar)[XB_TMO])) break; if (_sp > XB_SPIN_CAP) { atomicAdd(&(bar)[XB_TMO], 1u); break; } } } } while (0)
struct XcdBarrier { unsigned* bar; unsigned x; volatile LAS unsigned* st; };
DI XcdBarrier xcd_barrier_post(unsigned* bar, volatile LAS unsigned* st) {
    XcdBarrier b; b.bar = bar; b.x = xb_xcc_id(); b.st = st;
    if (threadIdx.x == 0) (void)xb_add(&bar[XB_XCNT(b.x)], 1u);
    return b;
}
DI void xcd_barrier_complete(unsigned* bar, unsigned x, unsigned& nloc, unsigned& nx) {
    const unsigned G = gridDim.x * gridDim.y * gridDim.z;
    unsigned sum, cnt, mine, sp = 0u;
    for (;;) {
        sum = 0u; cnt = 0u; mine = 0u;
#pragma unroll
        for (unsigned j = 0; j < 16; ++j) { const unsigned c = xb_ld(&bar[XB_XCNT(j)]); sum += c; cnt += (c > 0u) ? 1u : 0u; mine = (j == x) ? c : mine; }
        if (sum == G) break;
        __builtin_amdgcn_s_sleep(1);
        if ((++sp & 255u) == 0u) { if (xb_ld(&bar[XB_TMO])) break; if (sp > XB_SPIN_CAP) { atomicAdd(&bar[XB_TMO], 1u); break; } }
    }
    nloc = mine > 0u ? mine : 1u; nx = cnt > 0u ? cnt : 1u;
}
DI void xcd_barrier(const XcdBarrier& b) {
    asm volatile("s_waitcnt vmcnt(0)" ::: "memory");
    __syncthreads();
    if (threadIdx.x == 0) {
        unsigned* bar = b.bar;
        __builtin_amdgcn_s_waitcnt(0);
        unsigned nloc = b.st[0], nx = b.st[1];
        if (nloc == 0u) { xcd_barrier_complete(bar, b.x, nloc, nx); b.st[0] = nloc; b.st[1] = nx; }
        const unsigned old = xb_add(&bar[XB_XSUB(b.x)], 1u);
        const unsigned gen = old / nloc;
        if (old + 1u == (gen + 1u) * nloc) {
            __builtin_amdgcn_fence(__ATOMIC_RELEASE, "agent");
            asm volatile("s_waitcnt vmcnt(0)" ::: "memory");
            const unsigned og = xb_add(&bar[XB_TOP], 1u);
            const unsigned tg = og / nx;
            if (og + 1u == (tg + 1u) * nx) xb_add(&bar[XB_TOPGEN], 1u);
            else XB_SPIN(xb_ld(&bar[XB_TOPGEN]) == tg, bar);
            __builtin_amdgcn_fence(__ATOMIC_ACQUIRE, "agent");
            xb_add(&bar[XB_XGEN(b.x)], 1u);
            asm volatile("s_waitcnt vmcnt(0)" ::: "memory");
        } else {
            XB_SPIN(xb_ld(&bar[XB_XGEN(b.x)]) == gen, bar);
            __builtin_amdgcn_fence(__ATOMIC_ACQUIRE, "agent");
            asm volatile("s_waitcnt vmcnt(0)" ::: "memory");
        }
    }
    __syncthreads();
}

struct Args { const float* in[29]; float* out; unsigned char* ws; int ph_lo, ph_hi; };
struct Frame {
    LAS unsigned char* lds;
    unsigned char* ws;
    int tid, lane, wave, G, vcu;
};

namespace pg8 {
constexpr int BM = 256, BK = 64, HALF = 128, HTB = HALF * BK * 2, STAGE_BYTES = 8 * HTB, NXCD = 8, WGM = 8;
__host__ __device__ __forceinline__ int lds_byte(int r, int c) { const int st = (r >> 4) * 2 + (c >> 5), rr = r & 15, cc = c & 31, ob = rr * 64 + cc * 2; return st * 1024 + (ob ^ (((ob >> 9) & 1) << 5)); }
__host__ __device__ __forceinline__ void stage_rc(int b, int& R, int& C) { const int st = b / 1024, sb = b % 1024, swz = sb ^ (((sb >> 9) & 1) << 5); R = (st >> 1) * 16 + swz / 64; C = (st & 1) * 32 + (swz % 64) / 2; }
__host__ __device__ __forceinline__ int perm32(int rho) { const int n = rho >> 4, i = rho & 15; return 8 * (i >> 2) + 4 * n + (i & 3); }

struct Unit { int pm, pn, e, lb, rows; };

DI bool static_unit(int i, int G, int c, int nM, int nN, int& pm, int& pn) {
    const int nwg = nM * nN; const long L = (long)i * G + c; if (L >= nwg) return false;
    int wgid = (int)L; { const int q = nwg / NXCD, r = nwg % NXCD, xcd = wgid % NXCD, off = wgid / NXCD; wgid = (xcd < r ? xcd * (q + 1) : r * (q + 1) + (xcd - r) * q) + off; }
    const int nig = WGM * nN, gid = wgid / nig, fm = gid * WGM, gsz = (nM - fm) < WGM ? (nM - fm) : WGM;
    pm = fm + ((wgid % nig) % gsz); pn = (wgid % nig) / gsz; return true;
}
struct SchedDense {
    static constexpr bool GATHER = false;
    const char* A; const char* Bt; int K, nM, nN, G, c;
    DI void init(const void* A_, const void* Bt_, int M, int N, int K_, int G_, int c_) { A = (const char*)A_; Bt = (const char*)Bt_; K = K_; nM = M / BM; nN = N / BM; G = G_; c = c_; }
    DI bool next(int i, Unit& u) const { u.e = 0; u.lb = 0; u.rows = 256; return static_unit(i, G, c, nM, nN, u.pm, u.pn); }
    DI const char* a_base(const Unit& u) const { return A + (size_t)u.pm * BM * K * 2; }
    DI const char* b_base(const Unit& u) const { return Bt + (size_t)u.pn * BM * K * 2; }
    DI void ts_load(const Unit&, const int (&)[2], int (&)[2][2]) const {}
    DI void a_offs(const Unit&, const int (&R)[2], const int (&C)[2], const int (&)[2][2], unsigned (&o)[2][2]) const {
#pragma unroll
        for (int h = 0; h < 2; ++h)
#pragma unroll
            for (int i = 0; i < 2; ++i) o[h][i] = (unsigned)((h * HALF + R[i]) * K + C[i]) * 2u;
    }
};
struct SchedMoe {
    const char* A; const char* Bt; int K, nM, nN, G, c, blk0; size_t bstride; const int* row_ts; const LAS int* tab; bool gather;
    DI bool next(int i, Unit& u) const {
        int pm, pn; if (!static_unit(i, G, c, nM, nN, pm, pn)) return false;
        const int gb = blk0 + pm; int e = 0;
#pragma unroll
        for (int j = 1; j < 8; ++j) e += (gb >= tab[8 + j]) ? 1 : 0;
        e = __builtin_amdgcn_readfirstlane(e);
        const int lb = gb - __builtin_amdgcn_readfirstlane(tab[8 + e]); const int rem = __builtin_amdgcn_readfirstlane(tab[e]) - lb * 256;
        u.pm = pm; u.pn = pn; u.e = e; u.lb = lb; u.rows = rem < 256 ? rem : 256; return true;
    }
    DI const char* b_base(const Unit& u) const { return Bt + (size_t)u.e * bstride + (size_t)u.pn * BM * K * 2; }
};
struct SchedMoeGU : SchedMoe {
    static constexpr bool GATHER = true;
    DI const char* a_base(const Unit&) const { return A; }
    DI void ts_load(const Unit& u, const int (&R)[2], int (&ts)[2][2]) const {
#pragma unroll
        for (int h = 0; h < 2; ++h)
#pragma unroll
            for (int i = 0; i < 2; ++i) { const int lr = h * HALF + R[i]; ts[h][i] = (lr < u.rows) ? row_ts[(size_t)u.e * CAP + u.lb * 256 + lr] : (T << 1); }
    }
    DI void a_offs(const Unit&, const int (&)[2], const int (&C)[2], const int (&ts)[2][2], unsigned (&o)[2][2]) const {
#pragma unroll
        for (int h = 0; h < 2; ++h)
#pragma unroll
            for (int i = 0; i < 2; ++i) o[h][i] = ((unsigned)(ts[h][i] >> 1) * (unsigned)K + (unsigned)C[i]) * 2u;
    }
};
struct SchedMoeDown : SchedMoe {
    static constexpr bool GATHER = false;
    DI const char* a_base(const Unit& u) const { return A + (size_t)u.pm * BM * K * 2; }
    DI void ts_load(const Unit&, const int (&)[2], int (&)[2][2]) const {}
    DI void a_offs(const Unit&, const int (&R)[2], const int (&C)[2], const int (&)[2][2], unsigned (&o)[2][2]) const {
#pragma unroll
        for (int h = 0; h < 2; ++h)
#pragma unroll
            for (int i = 0; i < 2; ++i) o[h][i] = (unsigned)((h * HALF + R[i]) * K + C[i]) * 2u;
    }
};

typedef f32x4 Acc[2][2][4][2];
DI u32x4 pack8(const f32x4& v0, const f32x4& v1) { u32x4 w; w.x = pk2(v0[0], v0[1]); w.y = pk2(v0[2], v0[3]); w.z = pk2(v1[0], v1[1]); w.w = pk2(v1[2], v1[3]); return w; }

struct EpiStoreBf16 {
    static constexpr bool PERM = true;
    bf16* O; int ldc;
    DI void operator()(const Acc& acc, const Unit& u, int wr, int wc, int fr, int fq) const {
        const int row0 = u.pm * BM + wr * 64 + fr, col0 = u.pn * BM + wc * 32 + 8 * fq;
#pragma unroll
        for (int ai = 0; ai < 2; ++ai)
#pragma unroll
            for (int m = 0; m < 4; ++m) { bf16* rowp = O + (size_t)(row0 + ai * HALF + m * 16) * ldc + col0;
#pragma unroll
                for (int bj = 0; bj < 2; ++bj) *(u32x4*)(rowp + bj * HALF) = pack8(acc[ai][bj][m][0], acc[ai][bj][m][1]); }
    }
};
struct EpiEvIn {
    static constexpr bool PERM = true;
    bf16* O;
    DI void operator()(const Acc& acc, const Unit& u, int wr, int wc, int fr, int fq) const {
        const int row0 = u.pm * BM + wr * 64 + fr;
        if (u.pn >= 2 && u.pn < 6) {
            const int col0 = 512 + (u.pn - 2) * HALF + wc * 32 + 8 * fq;
#pragma unroll
            for (int ai = 0; ai < 2; ++ai)
#pragma unroll
                for (int m = 0; m < 4; ++m) { bf16* rowp = O + (size_t)(row0 + ai * HALF + m * 16) * EVU + col0;
                    *(u32x4*)rowp = pack8(acc[ai][0][m][0] * acc[ai][1][m][0], acc[ai][0][m][1] * acc[ai][1][m][1]); }
        } else {
            const int col0 = u.pn * BM - (u.pn >= 6 ? 512 : 0) + wc * 32 + 8 * fq;
#pragma unroll
            for (int ai = 0; ai < 2; ++ai)
#pragma unroll
                for (int m = 0; m < 4; ++m) { bf16* rowp = O + (size_t)(row0 + ai * HALF + m * 16) * EVU + col0;
#pragma unroll
                    for (int bj = 0; bj < 2; ++bj) *(u32x4*)(rowp + bj * HALF) = pack8(acc[ai][bj][m][0], acc[ai][bj][m][1]); }
        }
    }
};
struct EpiSwiGLU {
    static constexpr bool PERM = true;
    bf16* O; int ldc;
    DI void operator()(const Acc& acc, const Unit& u, int wr, int wc, int fr, int fq) const {
        const int row0 = u.pm * BM + wr * 64 + fr, col0 = u.pn * HALF + wc * 32 + 8 * fq;
#pragma unroll
        for (int ai = 0; ai < 2; ++ai)
#pragma unroll
            for (int m = 0; m < 4; ++m) { bf16* rowp = O + (size_t)(row0 + ai * HALF + m * 16) * ldc + col0;
                f32x4 v0, v1;
#pragma unroll
                for (int j = 0; j < 4; ++j) { v0[j] = silu_f(acc[ai][0][m][0][j]) * acc[ai][1][m][0][j]; v1[j] = silu_f(acc[ai][0][m][1][j]) * acc[ai][1][m][1][j]; }
                *(u32x4*)rowp = pack8(v0, v1); }
    }
};
struct EpiResid {
    static constexpr bool PERM = false;
    const float* base; float* out;
    DI void operator()(const Acc& acc, const Unit& u, int wr, int wc, int fr, int fq) const {
        const int row0 = u.pm * BM + wr * 64 + fr, col0 = u.pn * BM + wc * 32 + 4 * fq;
#pragma unroll
        for (int ai = 0; ai < 2; ++ai)
#pragma unroll
            for (int m = 0; m < 4; ++m) { const size_t off = (size_t)(row0 + ai * HALF + m * 16) * D + col0;
#pragma unroll
                for (int bj = 0; bj < 2; ++bj)
#pragma unroll
                    for (int n = 0; n < 2; ++n) { const f32x4 b = *(const f32x4*)(base + off + bj * HALF + n * 16); *(f32x4*)(out + off + bj * HALF + n * 16) = b + acc[ai][bj][m][n]; } }
    }
};
struct EpiPleGate {
    static constexpr bool PERM = false;
    float* h; const bf16* tmp;
    DI void operator()(const Acc& acc, const Unit& u, int wr, int wc, int fr, int fq) const {
        const int row0 = u.pm * BM + wr * 64 + fr, col0 = u.pn * BM + wc * 32 + 4 * fq;
#pragma unroll
        for (int ai = 0; ai < 2; ++ai)
#pragma unroll
            for (int m = 0; m < 4; ++m) { const size_t off = (size_t)(row0 + ai * HALF + m * 16) * D + col0;
#pragma unroll
                for (int bj = 0; bj < 2; ++bj)
#pragma unroll
                    for (int n = 0; n < 2; ++n) { const size_t o = off + bj * HALF + n * 16; const f32x4 b = *(const f32x4*)(h + o); const u32x2 t = *(const u32x2*)(tmp + o); const f32x4 a = acc[ai][bj][m][n];
                        f32x4 r; r[0] = b[0] + bflo(t.x) * sigmoid_f(a[0]); r[1] = b[1] + bfhi(t.x) * sigmoid_f(a[1]); r[2] = b[2] + bflo(t.y) * sigmoid_f(a[2]); r[3] = b[3] + bfhi(t.y) * sigmoid_f(a[3]);
                        *(f32x4*)(h + o) = r; } }
    }
};
struct EpiMoeDown {
    static constexpr bool PERM = true;
    bf16* Y; const int* row_ts; const float* row_gate;
    DI void operator()(const Acc& acc, const Unit& u, int wr, int wc, int fr, int fq) const {
        const int col0 = u.pn * BM + wc * 32 + 8 * fq; const size_t rbase = (size_t)u.e * CAP + u.lb * 256;
#pragma unroll
        for (int ai = 0; ai < 2; ++ai)
#pragma unroll
            for (int m = 0; m < 4; ++m) { const int lr = ai * HALF + wr * 64 + m * 16 + fr;
                if (lr < u.rows) { const int ts = row_ts[rbase + lr]; const float g = row_gate[rbase + lr]; bf16* rowp = Y + (size_t)ts * D + col0;
#pragma unroll
                    for (int bj = 0; bj < 2; ++bj) *(u32x4*)(rowp + bj * HALF) = pack8(acc[ai][bj][m][0] * g, acc[ai][bj][m][1] * g); } }
    }
};

template <class Epi, class Sched>
DI void gemm_phase(LAS unsigned char* lds, const Sched& S, const Epi& E) {
    constexpr bool GATHER = Sched::GATHER;
    const int tid = threadIdx.x, wid = __builtin_amdgcn_readfirstlane(tid >> 6), lane = tid & 63, wr = wid >> 2, wc = wid & 3, fr = lane & 15, fq = lane >> 4;
    const int K = S.K, nt = K / BK;
    int Rr[2], Cc[2]; unsigned voffB[2];
#pragma unroll
    for (int i = 0; i < 2; ++i) { int R, C; stage_rc(tid * 16 + i * 8192, R, C); Rr[i] = R; Cc[i] = C; const int Rb = Epi::PERM ? ((R & ~31) + perm32(R & 31)) : R; voffB[i] = (unsigned)(Rb * K + C) * 2u; }
    const size_t kstep = (size_t)(BK * 2);
    const size_t hstep = (size_t)HALF * K * 2;
    const unsigned ldsw = (unsigned)wid * 1024u;
    const int aoff = lds_byte(wr * 64 + fr, fq * 8), boff = lds_byte(wc * 32 + fr, fq * 8);
#define PG8_SA(b, h) (((b) * 2 + (h)) * HTB)
#define PG8_SB(b, h) ((4 + (b) * 2 + (h)) * HTB)
#define PG8_STAGE(bufoff, gbase, voff) do { _Pragma("unroll") for (int _i = 0; _i < 2; ++_i) \
        __builtin_amdgcn_global_load_lds((const unsigned*)((const char*)(gbase) + (voff)[_i]), (LAS unsigned*)(lds + (bufoff) + ldsw + _i * 8192), 16, 0, 0); } while (0)
#define PG8_LDA(dst, b, h) do { _Pragma("unroll") for (int m = 0; m < 4; ++m) _Pragma("unroll") for (int k = 0; k < 2; ++k) dst[m][k] = *(const LAS bf16x8*)(lds + PG8_SA(b, h) + aoff + m * 2048 + k * 1024); } while (0)
#define PG8_LDB(dst, b, h) do { _Pragma("unroll") for (int n = 0; n < 2; ++n) _Pragma("unroll") for (int k = 0; k < 2; ++k) dst[n][k] = *(const LAS bf16x8*)(lds + PG8_SB(b, h) + boff + n * 2048 + k * 1024); } while (0)
#define PG8_MMA(ai, bj, At, Bt) do { __builtin_amdgcn_s_setprio(1); _Pragma("unroll") for (int m = 0; m < 4; ++m) _Pragma("unroll") for (int n = 0; n < 2; ++n) _Pragma("unroll") for (int k = 0; k < 2; ++k) \
        acc[ai][bj][m][n] = __builtin_amdgcn_mfma_f32_16x16x32_bf16(Bt[n][k], At[m][k], acc[ai][bj][m][n], 0, 0, 0); __builtin_amdgcn_s_setprio(0); } while (0)
#define PG8_WAIT_V(n) asm volatile("s_waitcnt vmcnt(" #n ")" ::: "memory")
#define PG8_WAIT_L(n) asm volatile("s_waitcnt lgkmcnt(" #n ")" ::: "memory")
#define PG8_BAR __builtin_amdgcn_s_barrier()
#define PG8_SCHED __builtin_amdgcn_sched_barrier(0)
    Unit cur, nxt, nn; int ui = 0;
    if (!S.next(0, cur)) return;
    Acc acc;
#pragma unroll
    for (int a = 0; a < 2; ++a)
#pragma unroll
        for (int b = 0; b < 2; ++b)
#pragma unroll
            for (int m = 0; m < 4; ++m)
#pragma unroll
                for (int n = 0; n < 2; ++n) acc[a][b][m][n] = (f32x4){0.f, 0.f, 0.f, 0.f};
    bf16x8 At[4][2], B0[2][2], B1[2][2];
    unsigned vA[2][2], nvA[2][2]; int pts[2][2] = {{0, 0}, {0, 0}};
    { int ts0[2][2] = {{0, 0}, {0, 0}}; S.ts_load(cur, Rr, ts0); S.a_offs(cur, Rr, Cc, ts0, vA); }
    bool has_next = S.next(1, nxt);
    if (GATHER && has_next) S.ts_load(nxt, Rr, pts);
    const char* cA = S.a_base(cur); const char* cB = S.b_base(cur);
    PG8_STAGE(PG8_SB(0, 0), cB, voffB); PG8_STAGE(PG8_SB(0, 1), cB + hstep, voffB); PG8_STAGE(PG8_SA(0, 0), cA, vA[0]); PG8_STAGE(PG8_SA(0, 1), cA, vA[1]);
    if (wr == 1) PG8_BAR;
    PG8_WAIT_V(2); PG8_BAR;
    PG8_STAGE(PG8_SB(1, 0), cB + kstep, voffB); PG8_STAGE(PG8_SA(1, 0), cA + kstep, vA[0]); PG8_STAGE(PG8_SB(1, 1), cB + hstep + kstep, voffB);
    PG8_WAIT_V(6); PG8_BAR;
    for (;;) {
        const char* nA = has_next ? S.a_base(nxt) : cA; const char* nB = has_next ? S.b_base(nxt) : cB;
        if (has_next) S.a_offs(nxt, Rr, Cc, pts, nvA);
        else {
#pragma unroll
            for (int h = 0; h < 2; ++h)
#pragma unroll
                for (int i = 0; i < 2; ++i) nvA[h][i] = vA[h][i];
        }
        const bool has_nn = has_next && S.next(ui + 2, nn);
        if (GATHER && has_nn) S.ts_load(nn, Rr, pts);
        for (int t = 0; t < nt; t += 2) {
            const bool last = (t == nt - 2);
            const char* a1 = cA + (size_t)(t + 1) * kstep;
            const char* a2 = last ? nA : cA + (size_t)(t + 2) * kstep; const char* b2 = last ? nB : cB + (size_t)(t + 2) * kstep;
            const char* a3 = a2 + kstep; const char* b3 = b2 + kstep;
            unsigned w0[2], w1[2];
            if (GATHER) { w0[0] = last ? nvA[0][0] : vA[0][0]; w0[1] = last ? nvA[0][1] : vA[0][1]; w1[0] = last ? nvA[1][0] : vA[1][0]; w1[1] = last ? nvA[1][1] : vA[1][1]; }
            else { w0[0] = vA[0][0]; w0[1] = vA[0][1]; w1[0] = vA[1][0]; w1[1] = vA[1][1]; }
            PG8_LDB(B0, 0, 0); PG8_LDB(B1, 0, 1); PG8_SCHED; PG8_LDA(At, 0, 0); PG8_STAGE(PG8_SA(1, 1), a1, vA[1]);
            PG8_WAIT_V(8); PG8_WAIT_L(0); PG8_BAR; PG8_MMA(0, 0, At, B0); PG8_MMA(0, 1, At, B1); PG8_BAR; PG8_SCHED;
            PG8_LDA(At, 0, 1); PG8_STAGE(PG8_SB(0, 0), b2, voffB); PG8_STAGE(PG8_SB(0, 1), b2 + hstep, voffB); PG8_STAGE(PG8_SA(0, 0), a2, w0);
            PG8_WAIT_V(8); PG8_WAIT_L(0); PG8_BAR; PG8_MMA(1, 0, At, B0); PG8_MMA(1, 1, At, B1); PG8_BAR; PG8_SCHED;
            PG8_LDB(B0, 1, 0); PG8_LDB(B1, 1, 1); PG8_SCHED; PG8_LDA(At, 1, 0); PG8_STAGE(PG8_SA(0, 1), a2, w1);
            PG8_WAIT_V(8); PG8_WAIT_L(0); PG8_BAR; PG8_MMA(0, 0, At, B0); PG8_MMA(0, 1, At, B1); PG8_BAR; PG8_SCHED;
            PG8_LDA(At, 1, 1); PG8_STAGE(PG8_SB(1, 0), b3, voffB); PG8_STAGE(PG8_SB(1, 1), b3 + hstep, voffB); PG8_STAGE(PG8_SA(1, 0), a3, w0);
            PG8_WAIT_V(8); PG8_WAIT_L(0); PG8_BAR; PG8_MMA(1, 0, At, B0); PG8_MMA(1, 1, At, B1); PG8_BAR; PG8_SCHED;
        }
        if (wr == 0) PG8_BAR;
        E(acc, cur, wr, wc, fr, fq);
        if (!has_next) break;
#pragma unroll
        for (int a = 0; a < 2; ++a)
#pragma unroll
            for (int b = 0; b < 2; ++b)
#pragma unroll
                for (int m = 0; m < 4; ++m)
#pragma unroll
                    for (int n = 0; n < 2; ++n) acc[a][b][m][n] = (f32x4){0.f, 0.f, 0.f, 0.f};
        cur = nxt; cA = nA; cB = nB; ++ui;
#pragma unroll
        for (int h = 0; h < 2; ++h)
#pragma unroll
            for (int i = 0; i < 2; ++i) vA[h][i] = nvA[h][i];
        nxt = nn; has_next = has_nn;
        if (wr == 1) PG8_BAR;
    }
    PG8_WAIT_V(0);
    PG8_BAR;
#undef PG8_SA
#undef PG8_SB
#undef PG8_STAGE
#undef PG8_LDA
#undef PG8_LDB
#undef PG8_MMA
#undef PG8_WAIT_V
#undef PG8_WAIT_L
#undef PG8_BAR
#undef PG8_SCHED
}
}

struct ConvJob { const float* W; bf16* WT; int K, ldn, col0, ncols, drow0, mode, nbatch; size_t sstride, dstride; };
DI void transpose_item(const ConvJob& J, int item, LAS float* scr, int lane) {
    const int per = (J.K / 64) * (J.ncols / 32); const int bi = item / per; int r = item - bi * per;
    const int nblk = J.ncols / 32, kb = r / nblk, nb = r % nblk, k0 = 64 * kb, j0 = 32 * nb;
    const float* W = J.W + (size_t)bi * J.sstride; bf16* WT = J.WT + (size_t)bi * J.dstride;
#pragma unroll 8
    for (int i = 0; i < 32; ++i) { const int kk = 2 * i + (lane >> 5); scr[kk * 33 + (lane & 31)] = W[(size_t)(k0 + kk) * J.ldn + J.col0 + j0 + (lane & 31)]; }
    asm volatile("s_waitcnt lgkmcnt(0)" ::: "memory");
    const int c = lane & 7;
    const int drow = J.drow0 + (J.mode ? ((j0 >> 7) * 256 + (j0 & 127)) : j0);
#pragma unroll
    for (int j = 0; j < 4; ++j) { const int n = (lane >> 3) + 8 * j; const LAS float* s = scr + (8 * c) * 33 + n;
        u32x4 o; o.x = pk2(s[0 * 33], s[1 * 33]); o.y = pk2(s[2 * 33], s[3 * 33]); o.z = pk2(s[4 * 33], s[5 * 33]); o.w = pk2(s[6 * 33], s[7 * 33]);
        *(u32x4*)(WT + (size_t)(drow + n) * J.K + k0 + 8 * c) = o; }
    asm volatile("s_waitcnt lgkmcnt(0)" ::: "memory");
}
constexpr int N_JOBS = 15;
DI ConvJob get_job(const Args& a, int j) {
    unsigned char* ws = a.ws; ConvJob J; J.nbatch = 1; J.sstride = 0; J.dstride = 0; J.mode = 0;
    switch (j) {
        case 0: J.W = a.in[6]; J.WT = (bf16*)(ws + W_EVIN); J.K = D; J.ldn = EV_IN; J.col0 = 0; J.ncols = 512; J.drow0 = 0; break;
        case 1: J.W = a.in[6]; J.WT = (bf16*)(ws + W_EVIN); J.K = D; J.ldn = EV_IN; J.col0 = 512; J.ncols = 512; J.drow0 = 512; J.mode = 1; break;
        case 2: J.W = a.in[6]; J.WT = (bf16*)(ws + W_EVIN); J.K = D; J.ldn = EV_IN; J.col0 = 1024; J.ncols = 512; J.drow0 = 640; J.mode = 1; break;
        case 3: J.W = a.in[6]; J.WT = (bf16*)(ws + W_EVIN); J.K = D; J.ldn = EV_IN; J.col0 = 1536; J.ncols = 2048; J.drow0 = 1536; break;
        case 4: J.W = a.in[12]; J.WT = (bf16*)(ws + W_EVOUT); J.K = D; J.ldn = D; J.col0 = 0; J.ncols = D; J.drow0 = 0; break;
        case 5: J.W = a.in[22]; J.WT = (bf16*)(ws + W_FFGU); J.K = D; J.ldn = 2 * DFF; J.col0 = 0; J.ncols = DFF; J.drow0 = 0; J.mode = 1; break;
        case 6: J.W = a.in[22]; J.WT = (bf16*)(ws + W_FFGU); J.K = D; J.ldn = 2 * DFF; J.col0 = DFF; J.ncols = DFF; J.drow0 = 128; J.mode = 1; break;
        case 7: J.W = a.in[23]; J.WT = (bf16*)(ws + W_FFD); J.K = DFF; J.ldn = D; J.col0 = 0; J.ncols = D; J.drow0 = 0; break;
        case 8: J.W = a.in[13]; J.WT = (bf16*)(ws + W_ODIN); J.K = D; J.ldn = OD_N; J.col0 = 0; J.ncols = OD_N; J.drow0 = 0; break;
        case 9: J.W = a.in[20]; J.WT = (bf16*)(ws + W_ODOUT); J.K = D; J.ldn = D; J.col0 = 0; J.ncols = D; J.drow0 = 0; break;
        case 10: J.W = a.in[25]; J.WT = (bf16*)(ws + W_MGU); J.K = D; J.ldn = 2 * DFE; J.col0 = 0; J.ncols = DFE; J.drow0 = 0; J.mode = 1; J.nbatch = NE; J.sstride = (size_t)D * 2 * DFE; J.dstride = (size_t)2 * DFE * D; break;
        case 11: J.W = a.in[25]; J.WT = (bf16*)(ws + W_MGU); J.K = D; J.ldn = 2 * DFE; J.col0 = DFE; J.ncols = DFE; J.drow0 = 128; J.mode = 1; J.nbatch = NE; J.sstride = (size_t)D * 2 * DFE; J.dstride = (size_t)2 * DFE * D; break;
        case 12: J.W = a.in[26]; J.WT = (bf16*)(ws + W_MD); J.K = DFE; J.ldn = D; J.col0 = 0; J.ncols = D; J.drow0 = 0; J.nbatch = NE; J.sstride = (size_t)DFE * D; J.dstride = (size_t)D * DFE; break;
        case 13: J.W = a.in[27]; J.WT = (bf16*)(ws + W_PPROJ); J.K = 256; J.ldn = D; J.col0 = 0; J.ncols = D; J.drow0 = 0; J.nbatch = 2; J.sstride = (size_t)256 * D; J.dstride = (size_t)D * 256; break;
        default: J.W = a.in[28]; J.WT = (bf16*)(ws + W_PGATE); J.K = D; J.ldn = D; J.col0 = 0; J.ncols = D; J.drow0 = 0; J.nbatch = 2; J.sstride = (size_t)D * D; J.dstride = (size_t)D * D; break;
    }
    return J;
}
DI void convert_weights(const Frame& F, const Args& a) {
    LAS float* scr = (LAS float*)(F.lds + F.wave * 16384);
    const int gw = F.vcu * 8 + F.wave, NGW = F.G * 8;
    for (int j = 0; j < N_JOBS; ++j) {
        const ConvJob J = get_job(a, j);
        const int nitems = J.nbatch * (J.K / 64) * (J.ncols / 32);
        for (int it = gw; it < nitems; it += NGW) transpose_item(J, it, scr, F.lane);
    }
}

DI void load_row(const float* p, int lane, f32x4 (&v)[4]) {
    const f32x4* xr = (const f32x4*)p + lane;
#pragma unroll
    for (int j = 0; j < 4; ++j) v[j] = xr[64 * j];
}
DI float sumsq16(const f32x4 (&v)[4]) { float s = 0.f;
#pragma unroll
    for (int j = 0; j < 4; ++j) s += (v[j].x * v[j].x + v[j].y * v[j].y) + (v[j].z * v[j].z + v[j].w * v[j].w);
    return s; }
DI void store_bf16_row(bf16* orow, int lane, const f32x4 (&v)[4]) {
    u32x2* o8 = (u32x2*)orow + lane;
#pragma unroll
    for (int j = 0; j < 4; ++j) { u32x2 w; w.x = pk2(v[j].x, v[j].y); w.y = pk2(v[j].z, v[j].w); o8[64 * j] = w; }
}
DI void norm_plain(const Frame& F, const float* src, const float* g, bf16* dst) {
    f32x4 gv[4]; load_row(g, F.lane, gv);
    const int gw = F.vcu * 8 + F.wave, NGW = F.G * 8;
    for (int m = gw; m < T; m += NGW) {
        f32x4 v[4]; load_row(src + (size_t)m * D, F.lane, v);
        const float rstd = rsqrtf(wave_sum(sumsq16(v)) * (1.f / D) + EPS);
#pragma unroll
        for (int j = 0; j < 4; ++j) v[j] = v[j] * rstd * gv[j];
        store_bf16_row(dst + (size_t)m * D, F.lane, v);
    }
}
DI void norm_mix0(const Frame& F, const Args& a) {
    const float* x = a.in[0]; const float* g = a.in[2]; const float* win = a.in[6];
    bf16* dst = (bf16*)(F.ws + WS_HN); float* GA = (float*)(F.ws + WS_GA); float* BT = (float*)(F.ws + WS_BETA);
    f32x4 gv[4]; load_row(g, F.lane, gv);
    float w8[16][8];
#pragma unroll
    for (int j = 0; j < 4; ++j)
#pragma unroll
        for (int e = 0; e < 4; ++e) { const int k = 256 * j + 4 * F.lane + e; const f32x4 lo = *(const f32x4*)(win + (size_t)k * EV_IN + EV_N), hi = *(const f32x4*)(win + (size_t)k * EV_IN + EV_N + 4);
#pragma unroll
            for (int c = 0; c < 4; ++c) { w8[4 * j + e][c] = lo[c]; w8[4 * j + e][4 + c] = hi[c]; } }
    const int h4 = F.lane & 3;
    const float negA = -__expf(a.in[9][h4]), dtb = a.in[10][h4];
    const int gw = F.vcu * 8 + F.wave, NGW = F.G * 8;
    for (int m = gw; m < T; m += NGW) {
        f32x4 v[4]; load_row(x + (size_t)m * D, F.lane, v);
        const float rstd = rsqrtf(wave_sum(sumsq16(v)) * (1.f / D) + EPS);
#pragma unroll
        for (int j = 0; j < 4; ++j) v[j] = v[j] * rstd * gv[j];
        store_bf16_row(dst + (size_t)m * D, F.lane, v);
        float dsum[8];
#pragma unroll
        for (int c = 0; c < 8; ++c) { float s = 0.f;
#pragma unroll
            for (int j = 0; j < 4; ++j)
#pragma unroll
                for (int e = 0; e < 4; ++e) s += v[j][e] * w8[4 * j + e][c];
            dsum[c] = wave_sum(s); }
        float af = dsum[0], bfv = dsum[4];
        if (h4 == 1) { af = dsum[1]; bfv = dsum[5]; } else if (h4 == 2) { af = dsum[2]; bfv = dsum[6]; } else if (h4 == 3) { af = dsum[3]; bfv = dsum[7]; }
        const float z = af + dtb; const float sp = (z > 20.f) ? z : log1pf(__expf(z));
        if (F.lane < 4) { GA[(size_t)m * 4 + h4] = negA * sp; BT[(size_t)m * 4 + h4] = sigmoid_f(bfv); }
    }
}
DI void convert_p(const Frame& F, const float* p, bf16* dst) {
    const size_t n8 = (size_t)T * 256 / 8;
    for (size_t i = (size_t)F.vcu * 512 + F.tid; i < n8; i += (size_t)F.G * 512) {
        const f32x4 a = *(const f32x4*)(p + i * 8), b = *(const f32x4*)(p + i * 8 + 4);
        *(u32x4*)(dst + i * 8) = pg8::pack8(a, b);
    }
}
DI void norm_router(const Frame& F, const Args& a) {
    const float* h = a.out; const float* g = a.in[3] + D; const float* wr_ = a.in[24];
    bf16* dst = (bf16*)(F.ws + WS_HN); int* row_ts = (int*)(F.ws + WS_ROWTS); float* row_gate = (float*)(F.ws + WS_ROWGATE); unsigned* ctl = (unsigned*)(F.ws + WS_CTL);
    f32x4 gv[4]; load_row(g, F.lane, gv);
    float w8[16][8];
#pragma unroll
    for (int j = 0; j < 4; ++j)
#pragma unroll
        for (int e = 0; e < 4; ++e) { const int k = 256 * j + 4 * F.lane + e; const f32x4 lo = *(const f32x4*)(wr_ + (size_t)k * 8), hi = *(const f32x4*)(wr_ + (size_t)k * 8 + 4);
#pragma unroll
            for (int c = 0; c < 4; ++c) { w8[4 * j + e][c] = lo[c]; w8[4 * j + e][4 + c] = hi[c]; } }
    const int gw = F.vcu * 8 + F.wave, NGW = F.G * 8;
    if (gw == 0) { u32x2* z = (u32x2*)(dst + (size_t)T * D) + F.lane;
#pragma unroll
        for (int j = 0; j < 4; ++j) z[64 * j] = (u32x2){0u, 0u}; }
    for (int grp = gw; grp < T / 32; grp += NGW) {
        int e0 = 0, e1 = 1; float g0 = 0.f, g1 = 0.f;
        for (int rr = 0; rr < 32; ++rr) {
            const int m = grp * 32 + rr;
            f32x4 v[4]; load_row(h + (size_t)m * D, F.lane, v);
            const float rstd = rsqrtf(wave_sum(sumsq16(v)) * (1.f / D) + EPS);
#pragma unroll
            for (int j = 0; j < 4; ++j) v[j] = v[j] * rstd * gv[j];
            store_bf16_row(dst + (size_t)m * D, F.lane, v);
            float lg[8];
#pragma unroll
            for (int c = 0; c < 8; ++c) { float s = 0.f;
#pragma unroll
                for (int j = 0; j < 4; ++j)
#pragma unroll
                    for (int e = 0; e < 4; ++e) s += v[j][e] * w8[4 * j + e][c];
                lg[c] = wave_sum(s); }
            int b0 = 0; float v0 = lg[0];
#pragma unroll
            for (int c = 1; c < 8; ++c) if (lg[c] > v0) { v0 = lg[c]; b0 = c; }
            int b1 = -1; float v1 = -INFINITY;
#pragma unroll
            for (int c = 0; c < 8; ++c) if (c != b0 && lg[c] > v1) { v1 = lg[c]; b1 = c; }
            const float ga = 1.f / (1.f + __expf(v1 - v0));
            if (F.lane == rr) { e0 = b0; e1 = b1; g0 = ga; g1 = 1.f - ga; }
        }
        const bool act = F.lane < 32;
#pragma unroll
        for (int e = 0; e < 8; ++e) {
            const unsigned long long m0 = __ballot(act && e0 == e), m1 = __ballot(act && e1 == e);
            const int n0 = __popcll(m0), n1 = __popcll(m1);
            if (n0 + n1 == 0) continue;
            unsigned base = 0;
            if (F.lane == 0) base = __hip_atomic_fetch_add(ctl + CW_CNT + 64 * e, (unsigned)(n0 + n1), __ATOMIC_RELAXED, __HIP_MEMORY_SCOPE_AGENT);
            base = (unsigned)__builtin_amdgcn_readfirstlane((int)base);
            const unsigned long long below = (1ull << F.lane) - 1ull;
            const int tok = grp * 32 + F.lane;
            if (act && e0 == e) { const unsigned off = base + (unsigned)__popcll(m0 & below); row_ts[(size_t)e * CAP + off] = tok * 2; row_gate[(size_t)e * CAP + off] = g0; }
            if (act && e1 == e) { const unsigned off = base + (unsigned)n0 + (unsigned)__popcll(m1 & below); row_ts[(size_t)e * CAP + off] = tok * 2 + 1; row_gate[(size_t)e * CAP + off] = g1; }
        }
    }
}
DI void combine_norm(const Frame& F, const Args& a) {
    float* h = a.out; const float* g = a.in[4] + D; const bf16* ym = (const bf16*)(F.ws + WS_YMOE); bf16* dst = (bf16*)(F.ws + WS_HN);
    f32x4 gv[4]; load_row(g, F.lane, gv);
    const int gw = F.vcu * 8 + F.wave, NGW = F.G * 8;
    for (int m = gw; m < T; m += NGW) {
        f32x4 v[4]; load_row(h + (size_t)m * D, F.lane, v);
        const u32x2* y0 = (const u32x2*)(ym + (size_t)m * 2 * D) + F.lane; const u32x2* y1 = (const u32x2*)(ym + (size_t)m * 2 * D + D) + F.lane;
#pragma unroll
        for (int j = 0; j < 4; ++j) { const u32x2 p = y0[64 * j], q = y1[64 * j];
            v[j].x += bflo(p.x) + bflo(q.x); v[j].y += bfhi(p.x) + bfhi(q.x); v[j].z += bflo(p.y) + bflo(q.y); v[j].w += bfhi(p.y) + bfhi(q.y); }
        f32x4* hw = (f32x4*)(h + (size_t)m * D) + F.lane;
#pragma unroll
        for (int j = 0; j < 4; ++j) hw[64 * j] = v[j];
        const float rstd = rsqrtf(wave_sum(sumsq16(v)) * (1.f / D) + EPS);
#pragma unroll
        for (int j = 0; j < 4; ++j) v[j] = v[j] * rstd * gv[j];
        store_bf16_row(dst + (size_t)m * D, F.lane, v);
    }
}
DI void final_norm(const Frame& F, const Args& a) {
    float* h = a.out; const float* g = a.in[5];
    f32x4 gv[4]; load_row(g, F.lane, gv);
    const int gw = F.vcu * 8 + F.wave, NGW = F.G * 8;
    for (int m = gw; m < T; m += NGW) {
        f32x4 v[4]; load_row(h + (size_t)m * D, F.lane, v);
        const float rstd = rsqrtf(wave_sum(sumsq16(v)) * (1.f / D) + EPS);
        f32x4* hw = (f32x4*)(h + (size_t)m * D) + F.lane;
#pragma unroll
        for (int j = 0; j < 4; ++j) hw[64 * j] = v[j] * rstd * gv[j];
    }
}

DI void mixer_a(const Frame& F, const Args& a, int worker, int nworkers) {
    const bf16* U = (const bf16*)(F.ws + WS_U); bf16* Y = (bf16*)(F.ws + WS_Y); const float* cw = a.in[7];
    const size_t nitems = (size_t)T * 64;
    for (size_t it = (size_t)worker * 512 + F.tid; it < nitems; it += (size_t)nworkers * 512) {
        const int t = (int)(it >> 6), c8 = (int)(it & 63) * 8, s = t & (SEQ - 1);
        const u32x4 bg = *(const u32x4*)(U + (size_t)t * EVU + c8);
        const u32x4 z2 = *(const u32x4*)(U + (size_t)t * EVU + 512 + c8);
        u32x4 z1 = (u32x4){0u, 0u, 0u, 0u}, z0 = (u32x4){0u, 0u, 0u, 0u};
        if (s >= 1) z1 = *(const u32x4*)(U + (size_t)(t - 1) * EVU + 512 + c8);
        if (s >= 2) z0 = *(const u32x4*)(U + (size_t)(t - 2) * EVU + 512 + c8);
        float o[8];
#pragma unroll
        for (int q = 0; q < 4; ++q) {
            const int c = c8 + 2 * q;
            const float a0 = cw[c] * bflo(z0[q]) + cw[512 + c] * bflo(z1[q]) + cw[1024 + c] * bflo(z2[q]);
            const float a1 = cw[c + 1] * bfhi(z0[q]) + cw[512 + c + 1] * bfhi(z1[q]) + cw[1024 + c + 1] * bfhi(z2[q]);
            o[2 * q] = bflo(bg[q]) * a0; o[2 * q + 1] = bfhi(bg[q]) * a1;
        }
        u32x4 w; w.x = pk2(o[0], o[1]); w.y = pk2(o[2], o[3]); w.z = pk2(o[4], o[5]); w.w = pk2(o[6], o[7]);
        *(u32x4*)(Y + (size_t)t * D + c8) = w;
    }
}

constexpr int GA_GCS = 0, GA_BTS = 256, GA_KN = 1024, GA_KB = GA_KN + 17408, GA_QN = GA_KB + 17408, GA_VBT = GA_QN + 17408, GA_KGT = GA_VBT + 18432,
              GA_AM = GA_KGT + 18432, GA_TB = GA_AM + 17408, GA_QKS = GA_TB + 9216, GA_END = GA_QKS + 9216;
static_assert(GA_END <= 131072, "gdn-a lds");
DI void gdn_a(const Frame& F, const Args& a) {
    LAS unsigned char* L = F.lds;
    LAS float* gcs = (LAS float*)(L + GA_GCS); LAS float* bts = (LAS float*)(L + GA_BTS);
    LAS float* Am = (LAS float*)(L + GA_AM);
    const bf16* U = (const bf16*)(F.ws + WS_U); const float* GA = (const float*)(F.ws + WS_GA); const float* BT = (const float*)(F.ws + WS_BETA);
    float* EG = (float*)(F.ws + WS_EG); const float* cw = a.in[8];
    const int lane = F.lane, w = F.wave, r = lane & 31, hh = lane >> 5;
    for (int item = F.vcu; item < 4096; item += F.G) {
        const int bh = item >> 5, n = item & 31, b = bh >> 2, h = bh & 3, t0 = b * SEQ + n * 64;
        unsigned char* Gp = F.ws + WS_G + (size_t)item * G_ITEM;
        if (w == 0) {
            float gc = GA[(size_t)(t0 + lane) * 4 + h];
#pragma unroll
            for (int o = 1; o < 64; o <<= 1) { const float up = __shfl_up(gc, o); if (lane >= o) gc += up; }
            gcs[lane] = gc; bts[lane] = BT[(size_t)(t0 + lane) * 4 + h];
            if (lane == 63) EG[item] = __expf(gc);
        }
        WG_BAR();
        const float glast = gcs[63];
#pragma unroll 1
        for (int it = 0; it < 6; ++it) {
            const int part = it >> 1, tok = (it & 1) * 32 + (F.tid >> 4), c8 = (F.tid & 15) * 8;
            const int ch = part * 512 + h * 128 + c8;
            const int sq = n * 64 + tok;
            float acc[8];
#pragma unroll
            for (int e = 0; e < 8; ++e) acc[e] = 0.f;
#pragma unroll
            for (int j = 0; j < 4; ++j) {
                if (sq - 3 + j >= 0) {
                    const u32x4 xv = *(const u32x4*)(U + (size_t)(t0 + tok - 3 + j) * EVU + 1024 + ch);
                    const f32x4 w0 = *(const f32x4*)(cw + j * 1536 + ch), w1 = *(const f32x4*)(cw + j * 1536 + ch + 4);
                    acc[0] += w0[0] * bflo(xv[0]); acc[1] += w0[1] * bfhi(xv[0]); acc[2] += w0[2] * bflo(xv[1]); acc[3] += w0[3] * bfhi(xv[1]);
                    acc[4] += w1[0] * bflo(xv[2]); acc[5] += w1[1] * bfhi(xv[2]); acc[6] += w1[2] * bflo(xv[3]); acc[7] += w1[3] * bfhi(xv[3]);
                }
            }
            float ss = 0.f;
#pragma unroll
            for (int e = 0; e < 8; ++e) { acc[e] = silu_f(acc[e]); ss += acc[e] * acc[e]; }
            ss = row16_sum(ss);
            const float beta = bts[tok], gc = gcs[tok];
            if (part == 0) {
                const float sc = rsqrtf(ss + EPS) * 0.08838834764831845f, eg = __expf(gc);
                u32x4 o; o.x = pk2(acc[0] * sc, acc[1] * sc); o.y = pk2(acc[2] * sc, acc[3] * sc); o.z = pk2(acc[4] * sc, acc[5] * sc); o.w = pk2(acc[6] * sc, acc[7] * sc);
                *(LAS u32x4*)(L + GA_QN + tok * 272 + c8 * 2) = o;
                const float s2 = sc * eg;
                u32x4 g; g.x = pk2(acc[0] * s2, acc[1] * s2); g.y = pk2(acc[2] * s2, acc[3] * s2); g.z = pk2(acc[4] * s2, acc[5] * s2); g.w = pk2(acc[6] * s2, acc[7] * s2);
                *(u32x4*)(Gp + G_QG + tok * 256 + c8 * 2) = g;
            } else if (part == 1) {
                const float sc = rsqrtf(ss + EPS), sb = sc * beta, sg = sb * __expf(gc), sd = sc * __expf(glast - gc);
                u32x4 o; o.x = pk2(acc[0] * sc, acc[1] * sc); o.y = pk2(acc[2] * sc, acc[3] * sc); o.z = pk2(acc[4] * sc, acc[5] * sc); o.w = pk2(acc[6] * sc, acc[7] * sc);
                *(LAS u32x4*)(L + GA_KN + tok * 272 + c8 * 2) = o;
                u32x4 p; p.x = pk2(acc[0] * sb, acc[1] * sb); p.y = pk2(acc[2] * sb, acc[3] * sb); p.z = pk2(acc[4] * sb, acc[5] * sb); p.w = pk2(acc[6] * sb, acc[7] * sb);
                *(LAS u32x4*)(L + GA_KB + tok * 272 + c8 * 2) = p;
                u32x4 d; d.x = pk2(acc[0] * sd, acc[1] * sd); d.y = pk2(acc[2] * sd, acc[3] * sd); d.z = pk2(acc[4] * sd, acc[5] * sd); d.w = pk2(acc[6] * sd, acc[7] * sd);
                *(u32x4*)(Gp + G_KD + tok * 256 + c8 * 2) = d;
#pragma unroll
                for (int e = 0; e < 8; ++e) *(LAS bf16*)(L + GA_KGT + (c8 + e) * 144 + tok * 2) = (bf16)(pk2(acc[e] * sg, 0.f) & 0xffffu);
            } else {
#pragma unroll
                for (int e = 0; e < 8; ++e) *(LAS bf16*)(L + GA_VBT + (c8 + e) * 144 + tok * 2) = (bf16)(pk2(acc[e] * beta, 0.f) & 0xffffu);
            }
        }
        WG_BAR();
        {
            const int mat = w >> 2, ti = (w >> 1) & 1, tj = w & 1;
            f32x16 x = zero16();
            if (ti >= tj) {
                const LAS unsigned char* ap = L + (mat ? GA_QN : GA_KB) + (32 * ti + r) * 272 + hh * 16;
                const LAS unsigned char* bp = L + GA_KN + (32 * tj + r) * 272 + hh * 16;
#pragma unroll
                for (int s = 0; s < 8; ++s) x = MFMA32(*(const LAS bf16x8*)(ap + 32 * s), *(const LAS bf16x8*)(bp + 32 * s), x);
            }
            const int j = 32 * tj + r; const float gj = gcs[j];
#pragma unroll
            for (int reg = 0; reg < 16; ++reg) {
                const int i = 32 * ti + crow(reg, hh);
                const float dec = __expf(gcs[i] - gj);
                if (mat == 0) Am[i * 68 + j] = (i > j) ? x[reg] * dec : 0.f;
                else *(LAS bf16*)(L + GA_QKS + i * 144 + j * 2) = (bf16)(pk2((i >= j) ? x[reg] * dec : 0.f, 0.f) & 0xffffu);
            }
        }
        WG_BAR();
        if (w == 0) {
            const int blk = hh, col = r;
            float Tr[32];
            const LAS float* Ab = Am + (blk * 32) * 68 + blk * 32;
#pragma unroll
            for (int i = 0; i < 32; ++i) {
                float acc = (i == col) ? 1.f : 0.f;
#pragma unroll
                for (int j = 0; j < i; ++j) acc -= Ab[i * 68 + j] * Tr[j];
                Tr[i] = acc;
            }
#pragma unroll
            for (int i = 0; i < 32; ++i) *(LAS bf16*)(L + GA_TB + (blk * 32 + i) * 144 + (blk * 32 + col) * 2) = (bf16)(pk2(Tr[i], 0.f) & 0xffffu);
#pragma unroll
            for (int i = 0; i < 16; ++i) *(LAS bf16*)(L + GA_TB + (2 * i + blk) * 144 + (32 + col) * 2) = (bf16)0;
            f32x16 P = zero16();
#pragma unroll
            for (int s = 0; s < 2; ++s) {
                const LAS float* arow = Am + (32 + r) * 68 + 16 * s + 8 * hh;
                const f32x4 a0 = *(const LAS f32x4*)arow, a1 = *(const LAS f32x4*)(arow + 4);
                const bf16x8 af = __builtin_bit_cast(bf16x8, pg8::pack8(a0, a1));
                float tv[8];
#pragma unroll
                for (int jj = 0; jj < 8; ++jj) { const float lo = Tr[16 * s + jj]; const float hi = __shfl(Tr[16 * s + 8 + jj], r); tv[jj] = hh ? hi : lo; }
                u32x4 tb; tb.x = pk2(tv[0], tv[1]); tb.y = pk2(tv[2], tv[3]); tb.z = pk2(tv[4], tv[5]); tb.w = pk2(tv[6], tv[7]);
                P = MFMA32(af, __builtin_bit_cast(bf16x8, tb), P);
            }
            f32x16 R = zero16();
#pragma unroll
            for (int s = 0; s < 2; ++s) {
                const LAS unsigned char* tp = L + GA_TB + (32 + r) * 144 + (32 + 16 * s + 4 * hh) * 2;
                const s16x4 lo = *(const LAS s16x4*)tp, hi = *(const LAS s16x4*)(tp + 16);
                R = MFMA32(cat8(lo, hi), pack_step(P, s), R);
            }
#pragma unroll
            for (int reg = 0; reg < 16; ++reg) *(LAS bf16*)(L + GA_TB + (32 + crow(reg, hh)) * 144 + r * 2) = (bf16)(pk2(-R[reg], 0.f) & 0xffffu);
        } else {
            for (int p = F.tid - 64; p < 512; p += 448) { const int row = p >> 3, c = p & 7; *(u32x4*)(Gp + G_QK + row * 128 + c * 16) = *(const LAS u32x4*)(L + GA_QKS + row * 144 + c * 16); }
        }
        WG_BAR();
        if (w < 4) {
#pragma unroll
            for (int q = 0; q < 2; ++q) {
                const int idx = w * 2 + q, ib = idx >> 2, db = idx & 3;
                f32x16 x = zero16();
                const LAS unsigned char* ap = L + GA_TB + (32 * ib + r) * 144 + hh * 16;
                const LAS unsigned char* bp = L + GA_VBT + (32 * db + r) * 144 + hh * 16;
#pragma unroll
                for (int s = 0; s < 4; ++s) if (ib || s < 2) x = MFMA32(*(const LAS bf16x8*)(ap + 32 * s), *(const LAS bf16x8*)(bp + 32 * s), x);
#pragma unroll
                for (int g = 0; g < 4; ++g) { u32x2 o; o.x = pk2(x[4 * g], x[4 * g + 1]); o.y = pk2(x[4 * g + 2], x[4 * g + 3]);
                    *(u32x2*)(Gp + G_UT + ((32 * db + r) * 64 + 32 * ib + 8 * g + 4 * hh) * 2) = o; }
            }
        } else {
#pragma unroll
            for (int q = 0; q < 2; ++q) {
                const int idx = (w - 4) * 2 + q, dkb = idx >> 1, ib = idx & 1;
                f32x16 x = zero16();
                const LAS unsigned char* ap = L + GA_KGT + (32 * dkb + r) * 144 + hh * 16;
                const LAS unsigned char* bp = L + GA_TB + (32 * ib + r) * 144 + hh * 16;
#pragma unroll
                for (int s = 0; s < 4; ++s) if (ib || s < 2) x = MFMA32(*(const LAS bf16x8*)(ap + 32 * s), *(const LAS bf16x8*)(bp + 32 * s), x);
#pragma unroll
                for (int g = 0; g < 4; ++g) { u32x2 o; o.x = pk2(x[4 * g], x[4 * g + 1]); o.y = pk2(x[4 * g + 2], x[4 * g + 3]);
                    *(u32x2*)(Gp + G_W + ((32 * ib + r) * 128 + 32 * dkb + 8 * g + 4 * hh) * 2) = o; }
            }
        }
        WG_BAR();
    }
}

constexpr int GB_ST = 0, GB_W = 34816, GB_QG = GB_W + 17408, GB_KD = GB_QG + 17408, GB_QK = GB_KD + 20480, GB_O = GB_QK + 9216, GB_END = GB_O + 33792;
static_assert(GB_END <= 140000, "gdn-b lds");
DI void gdn_b(const Frame& F, const Args& a, int worker, int nworkers) {
    LAS unsigned char* L = F.lds;
    const bf16* U = (const bf16*)(F.ws + WS_U); bf16* Y = (bf16*)(F.ws + WS_Y); const float* EG = (const float*)(F.ws + WS_EG); const float* gn = a.in[11];
    const int lane = F.lane, w = F.wave, r = lane & 31, hh = lane >> 5, dvb = w & 3, hf = w >> 2;
    const int q4 = (lane & 15) >> 2, p4 = lane & 3, g1 = (lane >> 4) & 1;
    LAS float* Ol = (LAS float*)(L + GB_O);
    const float gn0 = gn[lane], gn1 = gn[64 + lane];
    for (int bh = worker; bh < 128; bh += nworkers) {
        const int b = bh >> 2, h = bh & 3;
        f32x16 Sacc[2] = {zero16(), zero16()};
        for (int p = F.tid; p < 34816 / 16; p += 512) *(LAS u32x4*)(L + GB_ST + p * 16) = (u32x4){0u, 0u, 0u, 0u};
        for (int n = 0; n < 32; ++n) {
            const int item = bh * 32 + n, t0 = b * SEQ + n * 64;
            const unsigned char* Gp = F.ws + WS_G + (size_t)item * G_ITEM;
#pragma unroll
            for (int k = 0; k < 7; ++k) {
                const int p = F.tid + 512 * k;
                if (p < 1024) { const int row = p >> 4, c = p & 15; *(LAS u32x4*)(L + GB_W + row * 272 + c * 16) = *(const u32x4*)(Gp + G_W + p * 16); }
                else if (p < 2048) { const int q = p - 1024, row = q >> 4, c = q & 15; *(LAS u32x4*)(L + GB_QG + row * 272 + c * 16) = *(const u32x4*)(Gp + G_QG + q * 16); }
                else if (p < 3072) { const int q = p - 2048, row = q >> 4, c = q & 15; *(LAS u32x4*)(L + GB_KD + row * 320 + c * 16) = *(const u32x4*)(Gp + G_KD + q * 16); }
                else { const int q = p - 3072, row = q >> 3, c = q & 7; *(LAS u32x4*)(L + GB_QK + row * 144 + c * 16) = *(const u32x4*)(Gp + G_QK + q * 16); }
            }
            u32x2 ui[2][4];
#pragma unroll
            for (int tb = 0; tb < 2; ++tb)
#pragma unroll
                for (int g = 0; g < 4; ++g) ui[tb][g] = *(const u32x2*)(Gp + G_UT + ((32 * dvb + r) * 64 + 32 * tb + 8 * g + 4 * hh) * 2);
            const float eg = EG[item];
            WG_BAR();
            bf16x8 Sf[8];
#pragma unroll
            for (int s = 0; s < 8; ++s) Sf[s] = *(const LAS bf16x8*)(L + GB_ST + (32 * dvb + r) * 272 + (16 * s + 8 * hh) * 2);
            bf16x8 pv[2][2];
#pragma unroll
            for (int tb = 0; tb < 2; ++tb) {
                f32x16 x = zero16();
                const LAS unsigned char* wp = L + GB_W + (32 * tb + r) * 272 + hh * 16;
#pragma unroll
                for (int s = 0; s < 8; ++s) x = MFMA32(*(const LAS bf16x8*)(wp + 32 * s), Sf[s], x);
#pragma unroll
                for (int g = 0; g < 4; ++g) { x[4 * g] = bflo(ui[tb][g].x) - x[4 * g]; x[4 * g + 1] = bfhi(ui[tb][g].x) - x[4 * g + 1]; x[4 * g + 2] = bflo(ui[tb][g].y) - x[4 * g + 2]; x[4 * g + 3] = bfhi(ui[tb][g].y) - x[4 * g + 3]; }
                pv[tb][0] = pack_step(x, 0); pv[tb][1] = pack_step(x, 1);
            }
            {
                f32x16 o = zero16();
                const LAS unsigned char* qp = L + GB_QG + (32 * hf + r) * 272 + hh * 16;
#pragma unroll
                for (int s = 0; s < 8; ++s) o = MFMA32(*(const LAS bf16x8*)(qp + 32 * s), Sf[s], o);
#pragma unroll
                for (int tb = 0; tb < 2; ++tb) {
                    if (tb <= hf) {
#pragma unroll
                        for (int s = 0; s < 2; ++s) {
                            const LAS unsigned char* kp = L + GB_QK + (32 * hf + r) * 144 + (32 * tb + 16 * s + 4 * hh) * 2;
                            o = MFMA32(cat8(*(const LAS s16x4*)kp, *(const LAS s16x4*)(kp + 16)), pv[tb][s], o);
                        }
                    }
                }
#pragma unroll
                for (int reg = 0; reg < 16; ++reg) Ol[(32 * hf + crow(reg, hh)) * 132 + 32 * dvb + r] = o[reg];
            }
#pragma unroll
            for (int d2 = 0; d2 < 2; ++d2) {
                const int db = 2 * hf + d2;
                f32x16 x = Sacc[d2] * eg;
#pragma unroll
                for (int tb = 0; tb < 2; ++tb)
#pragma unroll
                    for (int s = 0; s < 2; ++s) {
                        const LAS unsigned char* kp = L + GB_KD + (32 * tb + 16 * s + 4 * hh + q4) * 320 + (32 * db + 16 * g1 + 4 * p4) * 2;
                        x = MFMA32(cat8(vtr(kp), vtr(kp + 8 * 320)), pv[tb][s], x);
                    }
                Sacc[d2] = x;
            }
            WG_BAR();
#pragma unroll
            for (int d2 = 0; d2 < 2; ++d2) {
                const int db = 2 * hf + d2;
#pragma unroll
                for (int g = 0; g < 4; ++g) { u32x2 o; o.x = pk2(Sacc[d2][4 * g], Sacc[d2][4 * g + 1]); o.y = pk2(Sacc[d2][4 * g + 2], Sacc[d2][4 * g + 3]);
                    *(LAS u32x2*)(L + GB_ST + (32 * dvb + r) * 272 + (32 * db + 8 * g + 4 * hh) * 2) = o; }
            }
#pragma unroll
            for (int k = 0; k < 8; ++k) {
                const int tt = w * 8 + k, t = t0 + tt;
                const float v0 = Ol[tt * 132 + lane], v1 = Ol[tt * 132 + 64 + lane];
                const float rstd = rsqrtf(wave_sum(v0 * v0 + v1 * v1) * (1.f / 128.f) + EPS);
                const float og0 = bf2f(U[(size_t)t * EVU + 2560 + h * 128 + lane]), og1 = bf2f(U[(size_t)t * EVU + 2560 + h * 128 + 64 + lane]);
                Y[(size_t)t * D + 512 + h * 128 + lane] = (bf16)(pk2(v0 * rstd * gn0 * silu_f(og0), 0.f) & 0xffffu);
                Y[(size_t)t * D + 512 + h * 128 + 64 + lane] = (bf16)(pk2(v1 * rstd * gn1 * silu_f(og1), 0.f) & 0xffffu);
            }
        }
        WG_BAR();
    }
}

constexpr int AT_STAGE = 38912, AT_K = 0, AT_V = 18432, AT_BIAS = 2 * AT_STAGE, AT_END = AT_BIAS + 512;
DI void attn_stage_load(const bf16* U1, int trow, int h, int tid, u32x4 (&st)[4]) {
#pragma unroll
    for (int p = 0; p < 4; ++p) { const int idx = tid + 512 * p, row = idx >> 5, c = idx & 31;
        st[p] = *(const u32x4*)(U1 + (size_t)(trow + row) * OD_N + (c < 16 ? 512 + h * 128 + c * 8 : 1024 + h * 128 + (c - 16) * 8)); }
}
DI void attn_stage_store(LAS unsigned char* sb, int tid, const u32x4 (&st)[4]) {
#pragma unroll
    for (int p = 0; p < 4; ++p) { const int idx = tid + 512 * p, row = idx >> 5, c = idx & 31;
        if (c < 16) { const int e = c * 8, mp = e >> 6, wi = e & 63; *(LAS u32x4*)(sb + AT_K + mp * 9216 + row * 144 + wi * 2) = st[p]; }
        else *(LAS u32x4*)(sb + AT_V + row * 320 + (c - 16) * 16) = st[p]; }
}
DI void attn_phase(const Frame& F, const Args& a) {
    LAS unsigned char* L = F.lds;
    const bf16* U1 = (const bf16*)(F.ws + WS_U); bf16* Y = (bf16*)(F.ws + WS_Y);
    const float* lamp = a.in[14]; const float* dng = a.in[15]; const float* relb = a.in[21];
    const int lane = F.lane, w = F.wave, r = lane & 31, hh = lane >> 5, mp = w >> 2, qs = w & 3;
    const int q4 = (lane & 15) >> 2, p4 = lane & 3, g1 = (lane >> 4) & 1;
    const float lam = __expf(wave_sum(lamp[lane] * lamp[64 + lane])) - __expf(wave_sum(lamp[128 + lane] * lamp[192 + lane])) + LAMBDA_INIT;
    const float c1 = 0.125f * LOG2E;
    LAS float* btab = (LAS float*)(L + AT_BIAS);
    LAS float* exch = (LAS float*)L;
    for (int item = F.vcu; item < 256; item += F.G) {
        const int bh = item >> 1, par = item & 1, b = bh >> 2, h = bh & 3, trow0 = b * SEQ;
        WG_BAR();
        if (F.tid < 128) { const int n = F.tid; int bucket = n;
            if (n >= 16) { const int lg = 16 + (int)(__logf((float)n / 16.f) / 2.0794415416798357f * 16.f); bucket = lg < 31 ? lg : 31; }
            btab[n] = relb[bucket * 4 + h] * LOG2E; }
        const float bias_far = relb[31 * 4 + h] * LOG2E;
        for (int ui = 0; ui < 8; ++ui) {
            const int qblk = 2 * ui + ((ui ^ par) & 1);
            const int q0 = qblk * 128 + qs * 32, qpos = q0 + r, ntiles = 2 * (qblk + 1);
            bf16x8 qf[4];
            { const bf16* qp = U1 + (size_t)(trow0 + qpos) * OD_N + h * 128 + mp * 64 + 8 * hh;
#pragma unroll
              for (int s = 0; s < 4; ++s) qf[s] = *(const bf16x8*)(qp + 16 * s); }
            f32x16 O[4] = {zero16(), zero16(), zero16(), zero16()};
            float mrun = -INFINITY, lrun = 0.f;
            u32x4 st[4];
            attn_stage_load(U1, trow0, h, F.tid, st);
            attn_stage_store(L, F.tid, st);
            WG_BAR();
            for (int kt = 0; kt < ntiles; ++kt) {
                const bool more = kt + 1 < ntiles;
                if (more) attn_stage_load(U1, trow0 + (kt + 1) * 64, h, F.tid, st);
                const int key0 = kt * 64;
                if (key0 <= q0 + 31) {
                    const LAS unsigned char* sb = L + (kt & 1) * AT_STAGE;
                    const LAS unsigned char* kb = sb + AT_K + mp * 9216 + r * 144 + hh * 16;
                    f32x16 x0 = zero16(), x1 = zero16();
#pragma unroll
                    for (int s = 0; s < 4; ++s) { x0 = MFMA32(*(const LAS bf16x8*)(kb + 32 * s), qf[s], x0); x1 = MFMA32(*(const LAS bf16x8*)(kb + 32 * 144 + 32 * s), qf[s], x1); }
                    if (q0 - (key0 + 63) >= 128) {
#pragma unroll
                        for (int reg = 0; reg < 16; ++reg) { x0[reg] = x0[reg] * c1 + bias_far; x1[reg] = x1[reg] * c1 + bias_far; }
                    } else {
#pragma unroll
                        for (int reg = 0; reg < 16; ++reg) {
                            const int d0 = qpos - (key0 + crow(reg, hh)), d1 = d0 - 32;
                            const float b0 = btab[d0 < 0 ? 0 : (d0 > 127 ? 127 : d0)], b1 = btab[d1 < 0 ? 0 : (d1 > 127 ? 127 : d1)];
                            x0[reg] = (d0 >= 0) ? x0[reg] * c1 + b0 : -INFINITY; x1[reg] = (d1 >= 0) ? x1[reg] * c1 + b1 : -INFINITY;
                        }
                    }
                    float mx = x0[0];
#pragma unroll
                    for (int reg = 1; reg < 16; ++reg) mx = fmaxf(mx, x0[reg]);
#pragma unroll
                    for (int reg = 0; reg < 16; ++reg) mx = fmaxf(mx, x1[reg]);
                    mx = fmaxf(mx, __shfl_xor(mx, 32));
                    const float mnew = fmaxf(mrun, mx), alpha = exp2f(mrun - mnew); mrun = mnew;
                    float rs = 0.f;
#pragma unroll
                    for (int reg = 0; reg < 16; ++reg) { x0[reg] = exp2f(x0[reg] - mnew); x1[reg] = exp2f(x1[reg] - mnew); rs += x0[reg] + x1[reg]; }
                    lrun = lrun * alpha + rs;
#pragma unroll
                    for (int db = 0; db < 4; ++db) O[db] = O[db] * alpha;
                    bf16x8 pf[2][2]; pf[0][0] = pack_step(x0, 0); pf[0][1] = pack_step(x0, 1); pf[1][0] = pack_step(x1, 0); pf[1][1] = pack_step(x1, 1);
                    const LAS unsigned char* vb = sb + AT_V + (4 * hh + q4) * 320 + (16 * g1 + 4 * p4) * 2;
#pragma unroll
                    for (int db = 0; db < 4; ++db)
#pragma unroll
                        for (int kh = 0; kh < 2; ++kh)
#pragma unroll
                            for (int s = 0; s < 2; ++s) {
                                const LAS unsigned char* vp = vb + (32 * kh + 16 * s) * 320 + 64 * db;
                                O[db] = MFMA32(cat8(vtr(vp), vtr(vp + 8 * 320)), pf[kh][s], O[db]);
                            }
                }
                if (more) attn_stage_store(L + ((kt + 1) & 1) * AT_STAGE, F.tid, st);
                WG_BAR();
            }
            const float ltot = lrun + __shfl_xor(lrun, 32);
            const float inv = 1.f / ltot;
            if (mp == 1) {
                const float sc = inv * lam;
#pragma unroll
                for (int db = 0; db < 4; ++db)
#pragma unroll
                    for (int reg = 0; reg < 16; ++reg) exch[(qs * 64 + db * 16 + reg) * 64 + lane] = O[db][reg] * sc;
            }
            WG_BAR();
            if (mp == 0) {
                float ss = 0.f;
#pragma unroll
                for (int db = 0; db < 4; ++db)
#pragma unroll
                    for (int reg = 0; reg < 16; ++reg) { const float o = O[db][reg] * inv - exch[(qs * 64 + db * 16 + reg) * 64 + lane]; O[db][reg] = o; ss += o * o; }
                ss += __shfl_xor(ss, 32);
                const float rstd = rsqrtf(ss * (1.f / 128.f) + EPS) * (1.f - LAMBDA_INIT);
                bf16* yp = Y + (size_t)(trow0 + qpos) * D + h * 128;
#pragma unroll
                for (int db = 0; db < 4; ++db)
#pragma unroll
                    for (int g = 0; g < 4; ++g) { const int d = 32 * db + 8 * g + 4 * hh; const f32x4 gv = *(const f32x4*)(dng + d);
                        u32x2 o; o.x = pk2(O[db][4 * g] * rstd * gv[0], O[db][4 * g + 1] * rstd * gv[1]); o.y = pk2(O[db][4 * g + 2] * rstd * gv[2], O[db][4 * g + 3] * rstd * gv[3]);
                        *(u32x2*)(yp + d) = o; }
            }
            WG_BAR();
        }
    }
}

constexpr int CF_GLU = 0, CF_RED = 96256, CF_STAT = CF_RED + 4096, CF_END = CF_STAT + 512;
DI void conformer_phase(const Frame& F, const Args& a) {
    LAS unsigned char* L = F.lds;
    const bf16* U1 = (const bf16*)(F.ws + WS_U); bf16* Y = (bf16*)(F.ws + WS_Y);
    const float* cw = a.in[16]; const float* cb = a.in[17]; const float* lg = a.in[18]; const float* lb = a.in[19];
    const int c = F.tid;
    float wv[31];
#pragma unroll
    for (int j = 0; j < 31; ++j) wv[j] = cw[j * 512 + c];
    const float bias = cb[c], lng = lg[c], lnb = lb[c];
    LAS float* red = (LAS float*)(L + CF_RED); LAS float* stat = (LAS float*)(L + CF_STAT);
    for (int tile = F.vcu; tile < T / 64; tile += F.G) {
        const int t0 = tile * 64, s0 = t0 & (SEQ - 1);
        WG_BAR();
        for (int it = F.tid; it < 94 * 64; it += 512) {
            const int row = it >> 6, c8 = (it & 63) * 8;
            u32x4 o = (u32x4){0u, 0u, 0u, 0u};
            if (s0 + row - 30 >= 0) {
                const bf16* up = U1 + (size_t)(t0 + row - 30) * OD_N + 1536 + c8;
                const u32x4 ga = *(const u32x4*)up, gb = *(const u32x4*)(up + 512);
#pragma unroll
                for (int q = 0; q < 4; ++q) o[q] = pk2(bflo(ga[q]) * sigmoid_f(bflo(gb[q])), bfhi(ga[q]) * sigmoid_f(bfhi(gb[q])));
            }
            *(LAS u32x4*)(L + CF_GLU + row * 1024 + c8 * 2) = o;
        }
        WG_BAR();
        float out[64];
#pragma unroll
        for (int tt = 0; tt < 64; ++tt) {
            float acc = bias;
#pragma unroll
            for (int j = 0; j < 31; ++j) acc += wv[j] * bf2f(*(const LAS bf16*)(L + CF_GLU + (tt + j) * 1024 + c * 2));
            out[tt] = acc;
            const float s1 = wave_sum(acc), s2 = wave_sum(acc * acc);
            if (F.lane == 0) { red[(tt * 8 + F.wave) * 2] = s1; red[(tt * 8 + F.wave) * 2 + 1] = s2; }
        }
        WG_BAR();
        if (F.tid < 64) { float s1 = 0.f, s2 = 0.f;
#pragma unroll
            for (int q = 0; q < 8; ++q) { s1 += red[(F.tid * 8 + q) * 2]; s2 += red[(F.tid * 8 + q) * 2 + 1]; }
            const float mean = s1 * (1.f / 512.f); const float var = fmaxf(s2 * (1.f / 512.f) - mean * mean, 0.f);
            stat[F.tid * 2] = mean; stat[F.tid * 2 + 1] = rsqrtf(var + EPS); }
        WG_BAR();
#pragma unroll
        for (int tt = 0; tt < 64; ++tt) {
            const float v = (out[tt] - stat[tt * 2]) * stat[tt * 2 + 1] * lng + lnb;
            Y[(size_t)(t0 + tt) * D + 512 + c] = (bf16)(pk2(silu_f(v), 0.f) & 0xffffu);
        }
    }
}

constexpr int NPH = 26;
__global__ void __launch_bounds__(512, 2) fwd_kernel(Args args) {
    extern __shared__ __attribute__((aligned(16))) unsigned char lds_raw[];
    Frame F;
    F.lds = (LAS unsigned char*)lds_raw; F.ws = args.ws;
    F.tid = threadIdx.x; F.lane = F.tid & 63; F.wave = __builtin_amdgcn_readfirstlane(F.tid >> 6);
    F.G = gridDim.x; { const int bx = blockIdx.x; F.vcu = (F.G % 8 == 0) ? (bx % 8) * (F.G / 8) + bx / 8 : bx; }
    volatile LAS unsigned* MISC = (volatile LAS unsigned*)(F.lds + LDS_MISC);
    if (F.tid < 64) MISC[F.tid] = 0u;
    __syncthreads();
    unsigned* ctl = (unsigned*)(F.ws + WS_CTL);
    const bool multi = (args.ph_hi - args.ph_lo) > 1;
    XcdBarrier bar; bar.bar = ctl + CW_BAR; bar.x = 0; bar.st = MISC + 8;
    if (multi) bar = xcd_barrier_post(ctl + CW_BAR, MISC + 8);
    const int lo = args.ph_lo, hi = args.ph_hi;
#define IN(k) (lo <= (k) && (k) < hi)
#define SEAM(k) do { if (IN(k) && IN((k) + 1)) xcd_barrier(bar); } while (0)
    unsigned char* ws = F.ws;
    bf16* HN = (bf16*)(ws + WS_HN); bf16* UB = (bf16*)(ws + WS_U); bf16* YB = (bf16*)(ws + WS_Y);
    const int bx = (int)blockIdx.x;

    if (IN(0)) { convert_weights(F, args); norm_mix0(F, args); } SEAM(0);
    if (IN(1)) { pg8::SchedDense S; S.init(HN, ws + W_EVIN, T, EV_N, D, F.G, bx); pg8::EpiEvIn E{UB}; pg8::gemm_phase(F.lds, S, E); } SEAM(1);
    if (IN(2)) { gdn_a(F, args); } SEAM(2);
    if (IN(3)) { if (F.G >= 2) { if ((bx & 1) == 0) gdn_b(F, args, bx >> 1, (F.G + 1) >> 1); else mixer_a(F, args, bx >> 1, F.G >> 1); } else { gdn_b(F, args, 0, 1); mixer_a(F, args, 0, 1); } } SEAM(3);
    if (IN(4)) { pg8::SchedDense S; S.init(YB, ws + W_EVOUT, T, D, D, F.G, bx); pg8::EpiResid E{args.in[0], args.out}; pg8::gemm_phase(F.lds, S, E); } SEAM(4);
    if (IN(5)) { norm_plain(F, args.out, args.in[3], HN); } SEAM(5);
    if (IN(6)) { pg8::SchedDense S; S.init(HN, ws + W_FFGU, T, 2 * DFF, D, F.G, bx); pg8::EpiSwiGLU E{UB, DFF}; pg8::gemm_phase(F.lds, S, E); } SEAM(6);
    if (IN(7)) { pg8::SchedDense S; S.init(UB, ws + W_FFD, T, D, DFF, F.G, bx); pg8::EpiResid E{args.out, args.out}; pg8::gemm_phase(F.lds, S, E); } SEAM(7);
    if (IN(8)) { norm_plain(F, args.out, args.in[4], HN); convert_p(F, args.in[1], (bf16*)(ws + WS_GX)); } SEAM(8);
    if (IN(9)) { pg8::SchedDense S; S.init(ws + WS_GX, ws + W_PPROJ, T, D, 256, F.G, bx); pg8::EpiStoreBf16 E{UB, D}; pg8::gemm_phase(F.lds, S, E); } SEAM(9);
    if (IN(10)) { pg8::SchedDense S; S.init(HN, ws + W_PGATE, T, D, D, F.G, bx); pg8::EpiPleGate E{args.out, UB}; pg8::gemm_phase(F.lds, S, E); } SEAM(10);
    if (IN(11)) { norm_plain(F, args.out, args.in[2] + D, HN); } SEAM(11);
    if (IN(12)) { pg8::SchedDense S; S.init(HN, ws + W_ODIN, T, OD_N, D, F.G, bx); pg8::EpiStoreBf16 E{UB, OD_N}; pg8::gemm_phase(F.lds, S, E); } SEAM(12);
    if (IN(13)) { attn_phase(F, args); conformer_phase(F, args); } SEAM(13);
    if (IN(14)) { pg8::SchedDense S; S.init(YB, ws + W_ODOUT, T, D, D, F.G, bx); pg8::EpiResid E{args.out, args.out}; pg8::gemm_phase(F.lds, S, E); } SEAM(14);
    if (IN(15)) { norm_router(F, args); } SEAM(15);
#define MOE_PART(part, phg, phd) \
    if (IN(phg) || IN(phd)) { \
        LAS int* tab = (LAS int*)(F.lds + LDS_MISC + 256); \
        if (F.tid == 0) { int pb = 0; for (int e = 0; e < 8; ++e) { const int c = (int)__hip_atomic_load(ctl + CW_CNT + 64 * e, __ATOMIC_RELAXED, __HIP_MEMORY_SCOPE_AGENT); tab[e] = c; tab[8 + e] = pb; pb += (c + 255) >> 8; } tab[16] = pb; } \
        __syncthreads(); \
        const int nbt = tab[16]; int nMp = nbt - (part) * MOE_NBP; nMp = nMp < 0 ? 0 : (nMp > MOE_NBP ? MOE_NBP : nMp); \
        if (IN(phg)) { pg8::SchedMoeGU S; S.A = (const char*)HN; S.Bt = (const char*)(ws + W_MGU); S.K = D; S.nM = nMp; S.nN = 2 * DFE / 256; S.G = F.G; S.c = bx; S.blk0 = (part) * MOE_NBP; S.bstride = (size_t)2 * DFE * D * 2; \
            S.row_ts = (const int*)(ws + WS_ROWTS); S.tab = tab; S.gather = true; pg8::EpiSwiGLU E{(bf16*)(ws + WS_GX), DFE}; pg8::gemm_phase(F.lds, S, E); } \
        SEAM(phg); \
        if (IN(phd)) { pg8::SchedMoeDown S; S.A = (const char*)(ws + WS_GX); S.Bt = (const char*)(ws + W_MD); S.K = DFE; S.nM = nMp; S.nN = D / 256; S.G = F.G; S.c = bx; S.blk0 = (part) * MOE_NBP; S.bstride = (size_t)D * DFE * 2; \
            S.row_ts = (const int*)(ws + WS_ROWTS); S.tab = tab; S.gather = false; pg8::EpiMoeDown E{(bf16*)(ws + WS_YMOE), (const int*)(ws + WS_ROWTS), (const float*)(ws + WS_ROWGATE)}; pg8::gemm_phase(F.lds, S, E); } \
        SEAM(phd); \
    }
    MOE_PART(0, 16, 17)
    MOE_PART(1, 18, 19)
    MOE_PART(2, 20, 21)
    if (IN(22)) { combine_norm(F, args); convert_p(F, args.in[1] + (size_t)T * 256, (bf16*)(ws + WS_GX)); } SEAM(22);
    if (IN(23)) { pg8::SchedDense S; S.init(ws + WS_GX, ws + W_PPROJ + (size_t)D * 256 * 2, T, D, 256, F.G, bx); pg8::EpiStoreBf16 E{UB, D}; pg8::gemm_phase(F.lds, S, E); } SEAM(23);
    if (IN(24)) { pg8::SchedDense S; S.init(HN, ws + W_PGATE + (size_t)D * D * 2, T, D, D, F.G, bx); pg8::EpiPleGate E{args.out, UB}; pg8::gemm_phase(F.lds, S, E); } SEAM(24);
    if (IN(25)) { final_norm(F, args); }
#undef IN
#undef SEAM
}

#ifndef MK_MULTI_LAUNCH
#define MK_MULTI_LAUNCH 0
#endif
extern "C" void kernel_launch(void* const* d_in, const int* in_sizes, int n_in, void* d_out, int out_size, void* d_ws, size_t ws_size, hipStream_t stream) {
    static int grid = 0;
    if (grid == 0) {
        if (n_in != 29 || out_size != T * D || ws_size < WS_END) { fprintf(stderr, "kernel_launch: unexpected shapes (n_in %d out %d ws %zu)\n", n_in, out_size, ws_size); grid = -1; return; }
        int dev = 0, cus = 0, per_cu = 0;
        if (hipGetDevice(&dev) != hipSuccess || hipDeviceGetAttribute(&cus, hipDeviceAttributeMultiprocessorCount, dev) != hipSuccess) { grid = -1; return; }
        if (hipFuncSetAttribute((const void*)fwd_kernel, hipFuncAttributeMaxDynamicSharedMemorySize, LDS_BYTES) != hipSuccess) { fprintf(stderr, "kernel_launch: LDS attribute failed\n"); grid = -1; return; }
        if (hipOccupancyMaxActiveBlocksPerMultiprocessor(&per_cu, (const void*)fwd_kernel, 512, LDS_BYTES) != hipSuccess || per_cu < 1) { fprintf(stderr, "kernel_launch: occupancy query says %d\n", per_cu); }
        (void)hipGetLastError();
        grid = cus;
    }
    if (grid < 0) return;
    (void)hipMemsetAsync((char*)d_ws + WS_CTL, 0, CTL_BYTES, stream);
    Args a{};
    for (int i = 0; i < 29; ++i) a.in[i] = (const float*)d_in[i];
    a.out = (float*)d_out; a.ws = (unsigned char*)d_ws;
#if MK_MULTI_LAUNCH
    for (int ph = 0; ph < NPH; ++ph) { a.ph_lo = ph; a.ph_hi = ph + 1; hipLaunchKernelGGL(fwd_kernel, dim3(grid), dim3(512), LDS_BYTES, stream, a); }
#else
    a.ph_lo = 0; a.ph_hi = NPH;
    hipLaunchKernelGGL(fwd_kernel, dim3(grid), dim3(512), LDS_BYTES, stream, a);
#endif
}
```

```cpp
#include <hip/hip_runtime.h>
#include <stdint.h>
#include <stdio.h>

#define DI __device__ __forceinline__
#define LAS __attribute__((address_space(3)))
#define GAS __attribute__((address_space(1)))
typedef unsigned short bf16;
typedef short bf16x8 __attribute__((ext_vector_type(8)));
typedef short s16x4 __attribute__((ext_vector_type(4)));
typedef short v4i16_t __attribute__((ext_vector_type(4)));
typedef float f32x4 __attribute__((ext_vector_type(4)));
typedef float f32x16 __attribute__((ext_vector_type(16)));
typedef float f32x2_t __attribute__((ext_vector_type(2)));
typedef __bf16 bf16x2_t __attribute__((ext_vector_type(2)));
typedef unsigned u32x4 __attribute__((ext_vector_type(4)));
typedef unsigned u32x2 __attribute__((ext_vector_type(2)));
typedef GAS unsigned gu32;

constexpr int T = 65536, D = 1024, SEQ = 2048, NBATCH = 32;
constexpr int EV_IN = 3592, EV_N = 3584, EVU = 3072;
constexpr int OD_N = 2560;
constexpr int DFF = 2816, DFE = 3584, NE = 8, CAP = 65536;
constexpr int MOE_NBP = 174, MOE_NPART = 3;
constexpr float EPS = 1e-6f;
constexpr float LOG2E = 1.4426950408889634f;
constexpr float LAMBDA_INIT = 0.35550906f;

constexpr size_t MiB = 1u << 20;
constexpr size_t WS_CTL = 0, CTL_BYTES = 1 * MiB;
constexpr size_t WS_GA = 1 * MiB, WS_BETA = 2 * MiB, WS_ROWTS = 3 * MiB, WS_ROWGATE = 5 * MiB, WS_EG = 7 * MiB;
constexpr size_t WS_W = 16 * MiB;
constexpr size_t W_EVIN = WS_W;
constexpr size_t W_EVOUT = W_EVIN + (size_t)EV_N * D * 2;
constexpr size_t W_FFGU = W_EVOUT + (size_t)D * D * 2;
constexpr size_t W_FFD = W_FFGU + (size_t)2 * DFF * D * 2;
constexpr size_t W_ODIN = W_FFD + (size_t)D * DFF * 2;
constexpr size_t W_ODOUT = W_ODIN + (size_t)OD_N * D * 2;
constexpr size_t W_MGU = W_ODOUT + (size_t)D * D * 2;
constexpr size_t W_MD = W_MGU + (size_t)NE * 2 * DFE * D * 2;
constexpr size_t W_PPROJ = W_MD + (size_t)NE * D * DFE * 2;
constexpr size_t W_PGATE = W_PPROJ + (size_t)2 * D * 256 * 2;
constexpr size_t W_END = W_PGATE + (size_t)2 * D * D * 2;
constexpr size_t WS_HN = 222 * MiB;
constexpr size_t WS_G = 222 * MiB;
constexpr size_t WS_GX = 352 * MiB;
constexpr size_t WS_U = 512 * MiB;
constexpr size_t WS_Y = 896 * MiB;
constexpr size_t WS_YMOE = 768 * MiB;
constexpr size_t WS_END = 1024 * MiB;
static_assert(W_END <= WS_HN, "weights fit");
static_assert(WS_G + (size_t)4096 * 73728 <= WS_U, "gdn intermediates fit");
static_assert(WS_GX + (size_t)MOE_NBP * 256 * DFE * 2 <= WS_YMOE, "moe act fits");
constexpr size_t G_ITEM = 73728;
constexpr size_t G_W = 0, G_UT = 16384, G_QG = 32768, G_KD = 49152, G_QK = 65536;

constexpr int CW_CNT = 64;
constexpr int CW_BAR = 4096;

constexpr int LDS_BYTES = 160 * 1024;
constexpr int LDS_MISC = 131072 + 24576;
DI float bf2f(unsigned short b) { return __uint_as_float(((unsigned)b) << 16); }
DI float bflo(unsigned u) { return __uint_as_float(u << 16); }
DI float bfhi(unsigned u) { return __uint_as_float(u & 0xffff0000u); }
DI unsigned pk2(float lo, float hi) { f32x2_t v = {lo, hi}; bf16x2_t b = __builtin_convertvector(v, bf16x2_t); return __builtin_bit_cast(unsigned, b); }
DI float dppf(float v, const int ctrl_sel) {
    int r;
    switch (ctrl_sel) {
        case 0: r = __builtin_amdgcn_update_dpp(0, __builtin_bit_cast(int, v), 0xB1, 0xF, 0xF, true); break;
        case 1: r = __builtin_amdgcn_update_dpp(0, __builtin_bit_cast(int, v), 0x4E, 0xF, 0xF, true); break;
        case 2: r = __builtin_amdgcn_update_dpp(0, __builtin_bit_cast(int, v), 0x141, 0xF, 0xF, true); break;
        default: r = __builtin_amdgcn_update_dpp(0, __builtin_bit_cast(int, v), 0x140, 0xF, 0xF, true); break;
    }
    return __builtin_bit_cast(float, r);
}
DI float row16_sum(float v) { v += dppf(v, 0); v += dppf(v, 1); v += dppf(v, 2); v += dppf(v, 3); return v; }
DI float rlane(float v, int l) { return __builtin_bit_cast(float, __builtin_amdgcn_readlane(__builtin_bit_cast(int, v), l)); }
DI float wave_sum(float v) { v = row16_sum(v); return (rlane(v, 0) + rlane(v, 16)) + (rlane(v, 32) + rlane(v, 48)); }
DI float silu_f(float x) { return x / (1.f + __expf(-x)); }
DI float sigmoid_f(float x) { return 1.f / (1.f + __expf(-x)); }
DI int crow(int reg, int hh) { return (reg & 3) + 8 * (reg >> 2) + 4 * hh; }
DI bf16x8 pack_step(const f32x16& x, int s) {
    u32x4 p;
    p[0] = pk2(x[8 * s + 0], x[8 * s + 1]); p[1] = pk2(x[8 * s + 2], x[8 * s + 3]); p[2] = pk2(x[8 * s + 4], x[8 * s + 5]); p[3] = pk2(x[8 * s + 6], x[8 * s + 7]);
    return __builtin_bit_cast(bf16x8, p);
}
DI s16x4 vtr(const LAS unsigned char* p) { return __builtin_bit_cast(s16x4, __builtin_amdgcn_ds_read_tr16_b64_v4i16((LAS v4i16_t*)p)); }
DI bf16x8 cat8(s16x4 lo, s16x4 hi) { return __builtin_shufflevector(lo, hi, 0, 1, 2, 3, 4, 5, 6, 7); }
#define MFMA32(a, b, c) __builtin_amdgcn_mfma_f32_32x32x16_bf16((a), (b), (c), 0, 0, 0)
DI f32x16 zero16() { f32x16 z; for (int i = 0; i < 16; ++i) z[i] = 0.f; return z; }
#define WG_BAR() __syncthreads()

#define XB_TMO      128
#define XB_XCNT(j)  (256  + 64 * (j))
#define XB_XSUB(j)  (1280 + 64 * (j))
#define XB_XGEN(j)  (2304 + 64 * (j))
#define XB_TOP      3328
#define XB_TOPGEN   3392
#define XCD_BAR_WORDS 3456
#define XB_SPIN_CAP (1u << 22)
DI unsigned xb_ld(unsigned* p)              { return __hip_atomic_load(p, __ATOMIC_RELAXED, __HIP_MEMORY_SCOPE_AGENT); }
DI unsigned xb_add(unsigned* p, unsigned v) { return __hip_atomic_fetch_add(p, v, __ATOMIC_RELAXED, __HIP_MEMORY_SCOPE_AGENT); }
DI unsigned xb_xcc_id() { return (unsigned)__builtin_amdgcn_s_getreg((3 << 11) | 20) & 0xFu; }
#define XB_SPIN(cond, bar) do { unsigned _sp = 0; while (cond) { __builtin_amdgcn_s_sleep(1); \
    if ((++_sp & 255u) == 0u) { if (xb_ld(&(bar)[XB_TMO])) break; if (_sp > XB_SPIN_CAP) { atomicAdd(&(bar)[XB_TMO], 1u); break; } } } } while (0)
struct XcdBarrier { unsigned* bar; unsigned x; volatile LAS unsigned* st; };
DI XcdBarrier xcd_barrier_post(unsigned* bar, volatile LAS unsigned* st) {
    XcdBarrier b; b.bar = bar; b.x = xb_xcc_id(); b.st = st;
    if (threadIdx.x == 0) (void)xb_add(&bar[XB_XCNT(b.x)], 1u);
    return b;
}
DI void xcd_barrier_complete(unsigned* bar, unsigned x, unsigned& nloc, unsigned& nx) {
    const unsigned G = gridDim.x * gridDim.y * gridDim.z;
    unsigned sum, cnt, mine, sp = 0u;
    for (;;) {
        sum = 0u; cnt = 0u; mine = 0u;
#pragma unroll
        for (unsigned j = 0; j < 16; ++j) { const unsigned c = xb_ld(&bar[XB_XCNT(j)]); sum += c; cnt += (c > 0u) ? 1u : 0u; mine = (j == x) ? c : mine; }
        if (sum == G) break;
        __builtin_amdgcn_s_sleep(1);
        if ((++sp & 255u) == 0u) { if (xb_ld(&bar[XB_TMO])) break; if (sp > XB_SPIN_CAP) { atomicAdd(&bar[XB_TMO], 1u); break; } }
    }
    nloc = mine > 0u ? mine : 1u; nx = cnt > 0u ? cnt : 1u;
}
DI void xcd_barrier(const XcdBarrier& b) {
    asm volatile("s_waitcnt vmcnt(0)" ::: "memory");
    __syncthreads();
    if (threadIdx.x == 0) {
        unsigned* bar = b.bar;
        __builtin_amdgcn_s_waitcnt(0);
        unsigned nloc = b.st[0], nx = b.st[1];
        if (nloc == 0u) { xcd_barrier_complete(bar, b.x, nloc, nx); b.st[0] = nloc; b.st[1] = nx; }
        const unsigned old = xb_add(&bar[XB_XSUB(b.x)], 1u);
        const unsigned gen = old / nloc;
        if (old + 1u == (gen + 1u) * nloc) {
            __builtin_amdgcn_fence(__ATOMIC_RELEASE, "agent");
            asm volatile("s_waitcnt vmcnt(0)" ::: "memory");
            const unsigned og = xb_add(&bar[XB_TOP], 1u);
            const unsigned tg = og / nx;
            if (og + 1u == (tg + 1u) * nx) xb_add(&bar[XB_TOPGEN], 1u);
            else XB_SPIN(xb_ld(&bar[XB_TOPGEN]) == tg, bar);
            __builtin_amdgcn_fence(__ATOMIC_ACQUIRE, "agent");
            xb_add(&bar[XB_XGEN(b.x)], 1u);
            asm volatile("s_waitcnt vmcnt(0)" ::: "memory");
        } else {
            XB_SPIN(xb_ld(&bar[XB_XGEN(b.x)]) == gen, bar);
            __builtin_amdgcn_fence(__ATOMIC_ACQUIRE, "agent");
            asm volatile("s_waitcnt vmcnt(0)" ::: "memory");
        }
    }
    __syncthreads();
}

struct Args { const float* in[29]; float* out; unsigned char* ws; int ph_lo, ph_hi; };
struct Frame {
    LAS unsigned char* lds;
    unsigned char* ws;
    int tid, lane, wave, G, vcu;
};

namespace pg8 {
constexpr int BM = 256, BK = 64, HALF = 128, HTB = HALF * BK * 2, STAGE_BYTES = 8 * HTB, NXCD = 8, WGM = 8;
__host__ __device__ __forceinline__ int lds_byte(int r, int c) { const int st = (r >> 4) * 2 + (c >> 5), rr = r & 15, cc = c & 31, ob = rr * 64 + cc * 2; return st * 1024 + (ob ^ (((ob >> 9) & 1) << 5)); }
__host__ __device__ __forceinline__ void stage_rc(int b, int& R, int& C) { const int st = b / 1024, sb = b % 1024, swz = sb ^ (((sb >> 9) & 1) << 5); R = (st >> 1) * 16 + swz / 64; C = (st & 1) * 32 + (swz % 64) / 2; }
__host__ __device__ __forceinline__ int perm32(int rho) { const int n = rho >> 4, i = rho & 15; return 8 * (i >> 2) + 4 * n + (i & 3); }

struct Unit { int pm, pn, e, lb, rows; };

DI bool static_unit(int i, int G, int c, int nM, int nN, int& pm, int& pn) {
    const int nwg = nM * nN; const long L = (long)i * G + c; if (L >= nwg) return false;
    int wgid = (int)L; { const int q = nwg / NXCD, r = nwg % NXCD, xcd = wgid % NXCD, off = wgid / NXCD; wgid = (xcd < r ? xcd * (q + 1) : r * (q + 1) + (xcd - r) * q) + off; }
    const int nig = WGM * nN, gid = wgid / nig, fm = gid * WGM, gsz = (nM - fm) < WGM ? (nM - fm) : WGM;
    pm = fm + ((wgid % nig) % gsz); pn = (wgid % nig) / gsz; return true;
}
struct SchedDense {
    static constexpr bool GATHER = false;
    const char* A; const char* Bt; int K, nM, nN, G, c;
    DI void init(const void* A_, const void* Bt_, int M, int N, int K_, int G_, int c_) { A = (const char*)A_; Bt = (const char*)Bt_; K = K_; nM = M / BM; nN = N / BM; G = G_; c = c_; }
    DI bool next(int i, Unit& u) const { u.e = 0; u.lb = 0; u.rows = 256; return static_unit(i, G, c, nM, nN, u.pm, u.pn); }
    DI const char* a_base(const Unit& u) const { return A + (size_t)u.pm * BM * K * 2; }
    DI const char* b_base(const Unit& u) const { return Bt + (size_t)u.pn * BM * K * 2; }
    DI void ts_load(const Unit&, const int (&)[2], int (&)[2][2]) const {}
    DI void a_offs(const Unit&, const int (&R)[2], const int (&C)[2], const int (&)[2][2], unsigned (&o)[2][2]) const {
#pragma unroll
        for (int h = 0; h < 2; ++h)
#pragma unroll
            for (int i = 0; i < 2; ++i) o[h][i] = (unsigned)((h * HALF + R[i]) * K + C[i]) * 2u;
    }
};
struct SchedMoe {
    const char* A; const char* Bt; int K, nM, nN, G, c, blk0; size_t bstride; const int* row_ts; const LAS int* tab; bool gather;
    DI bool next(int i, Unit& u) const {
        int pm, pn; if (!static_unit(i, G, c, nM, nN, pm, pn)) return false;
        const int gb = blk0 + pm; int e = 0;
#pragma unroll
        for (int j = 1; j < 8; ++j) e += (gb >= tab[8 + j]) ? 1 : 0;
        e = __builtin_amdgcn_readfirstlane(e);
        const int lb = gb - __builtin_amdgcn_readfirstlane(tab[8 + e]); const int rem = __builtin_amdgcn_readfirstlane(tab[e]) - lb * 256;
        u.pm = pm; u.pn = pn; u.e = e; u.lb = lb; u.rows = rem < 256 ? rem : 256; return true;
    }
    DI const char* b_base(const Unit& u) const { return Bt + (size_t)u.e * bstride + (size_t)u.pn * BM * K * 2; }
};
struct SchedMoeGU : SchedMoe {
    static constexpr bool GATHER = true;
    DI const char* a_base(const Unit&) const { return A; }
    DI void ts_load(const Unit& u, const int (&R)[2], int (&ts)[2][2]) const {
#pragma unroll
        for (int h = 0; h < 2; ++h)
#pragma unroll
            for (int i = 0; i < 2; ++i) { const int lr = h * HALF + R[i]; ts[h][i] = (lr < u.rows) ? row_ts[(size_t)u.e * CAP + u.lb * 256 + lr] : (T << 1); }
    }
    DI void a_offs(const Unit&, const int (&)[2], const int (&C)[2], const int (&ts)[2][2], unsigned (&o)[2][2]) const {
#pragma unroll
        for (int h = 0; h < 2; ++h)
#pragma unroll
            for (int i = 0; i < 2; ++i) o[h][i] = ((unsigned)(ts[h][i] >> 1) * (unsigned)K + (unsigned)C[i]) * 2u;
    }
};
struct SchedMoeDown : SchedMoe {
    static constexpr bool GATHER = false;
    DI const char* a_base(const Unit& u) const { return A + (size_t)u.pm * BM * K * 2; }
    DI void ts_load(const Unit&, const int (&)[2], int (&)[2][2]) const {}
    DI void a_offs(const Unit&, const int (&R)[2], const int (&C)[2], const int (&)[2][2], unsigned (&o)[2][2]) const {
#pragma unroll
        for (int h = 0; h < 2; ++h)
#pragma unroll
            for (int i = 0; i < 2; ++i) o[h][i] = (unsigned)((h * HALF + R[i]) * K + C[i]) * 2u;
    }
};

typedef f32x4 Acc[2][2][4][2];
DI u32x4 pack8(const f32x4& v0, const f32x4& v1) { u32x4 w; w.x = pk2(v0[0], v0[1]); w.y = pk2(v0[2], v0[3]); w.z = pk2(v1[0], v1[1]); w.w = pk2(v1[2], v1[3]); return w; }

struct EpiStoreBf16 {
    static constexpr bool PERM = true;
    bf16* O; int ldc;
    DI void operator()(const Acc& acc, const Unit& u, int wr, int wc, int fr, int fq) const {
        const int row0 = u.pm * BM + wr * 64 + fr, col0 = u.pn * BM + wc * 32 + 8 * fq;
#pragma unroll
        for (int ai = 0; ai < 2; ++ai)
#pragma unroll
            for (int m = 0; m < 4; ++m) { bf16* rowp = O + (size_t)(row0 + ai * HALF + m * 16) * ldc + col0;
#pragma unroll
                for (int bj = 0; bj < 2; ++bj) *(u32x4*)(rowp + bj * HALF) = pack8(acc[ai][bj][m][0], acc[ai][bj][m][1]); }
    }
};
struct EpiEvIn {
    static constexpr bool PERM = true;
    bf16* O;
    DI void operator()(const Acc& acc, const Unit& u, int wr, int wc, int fr, int fq) const {
        const int row0 = u.pm * BM + wr * 64 + fr;
        if (u.pn >= 2 && u.pn < 6) {
            const int col0 = 512 + (u.pn - 2) * HALF + wc * 32 + 8 * fq;
#pragma unroll
            for (int ai = 0; ai < 2; ++ai)
#pragma unroll
                for (int m = 0; m < 4; ++m) { bf16* rowp = O + (size_t)(row0 + ai * HALF + m * 16) * EVU + col0;
                    *(u32x4*)rowp = pack8(acc[ai][0][m][0] * acc[ai][1][m][0], acc[ai][0][m][1] * acc[ai][1][m][1]); }
        } else {
            const int col0 = u.pn * BM - (u.pn >= 6 ? 512 : 0) + wc * 32 + 8 * fq;
#pragma unroll
            for (int ai = 0; ai < 2; ++ai)
#pragma unroll
                for (int m = 0; m < 4; ++m) { bf16* rowp = O + (size_t)(row0 + ai * HALF + m * 16) * EVU + col0;
#pragma unroll
                    for (int bj = 0; bj < 2; ++bj) *(u32x4*)(rowp + bj * HALF) = pack8(acc[ai][bj][m][0], acc[ai][bj][m][1]); }
        }
    }
};
struct EpiSwiGLU {
    static constexpr bool PERM = true;
    bf16* O; int ldc;
    DI void operator()(const Acc& acc, const Unit& u, int wr, int wc, int fr, int fq) const {
        const int row0 = u.pm * BM + wr * 64 + fr, col0 = u.pn * HALF + wc * 32 + 8 * fq;
#pragma unroll
        for (int ai = 0; ai < 2; ++ai)
#pragma unroll
            for (int m = 0; m < 4; ++m) { bf16* rowp = O + (size_t)(row0 + ai * HALF + m * 16) * ldc + col0;
                f32x4 v0, v1;
#pragma unroll
                for (int j = 0; j < 4; ++j) { v0[j] = silu_f(acc[ai][0][m][0][j]) * acc[ai][1][m][0][j]; v1[j] = silu_f(acc[ai][0][m][1][j]) * acc[ai][1][m][1][j]; }
                *(u32x4*)rowp = pack8(v0, v1); }
    }
};
struct EpiResid {
    static constexpr bool PERM = false;
    const float* base; float* out;
    DI void operator()(const Acc& acc, const Unit& u, int wr, int wc, int fr, int fq) const {
        const int row0 = u.pm * BM + wr * 64 + fr, col0 = u.pn * BM + wc * 32 + 4 * fq;
#pragma unroll
        for (int ai = 0; ai < 2; ++ai)
#pragma unroll
            for (int m = 0; m < 4; ++m) { const size_t off = (size_t)(row0 + ai * HALF + m * 16) * D + col0;
#pragma unroll
                for (int bj = 0; bj < 2; ++bj)
#pragma unroll
                    for (int n = 0; n < 2; ++n) { const f32x4 b = *(const f32x4*)(base + off + bj * HALF + n * 16); *(f32x4*)(out + off + bj * HALF + n * 16) = b + acc[ai][bj][m][n]; } }
    }
};
struct EpiPleGate {
    static constexpr bool PERM = false;
    float* h; const bf16* tmp;
    DI void operator()(const Acc& acc, const Unit& u, int wr, int wc, int fr, int fq) const {
        const int row0 = u.pm * BM + wr * 64 + fr, col0 = u.pn * BM + wc * 32 + 4 * fq;
#pragma unroll
        for (int ai = 0; ai < 2; ++ai)
#pragma unroll
            for (int m = 0; m < 4; ++m) { const size_t off = (size_t)(row0 + ai * HALF + m * 16) * D + col0;
#pragma unroll
                for (int bj = 0; bj < 2; ++bj)
#pragma unroll
                    for (int n = 0; n < 2; ++n) { const size_t o = off + bj * HALF + n * 16; const f32x4 b = *(const f32x4*)(h + o); const u32x2 t = *(const u32x2*)(tmp + o); const f32x4 a = acc[ai][bj][m][n];
                        f32x4 r; r[0] = b[0] + bflo(t.x) * sigmoid_f(a[0]); r[1] = b[1] + bfhi(t.x) * sigmoid_f(a[1]); r[2] = b[2] + bflo(t.y) * sigmoid_f(a[2]); r[3] = b[3] + bfhi(t.y) * sigmoid_f(a[3]);
                        *(f32x4*)(h + o) = r; } }
    }
};
struct EpiMoeDown {
    static constexpr bool PERM = true;
    bf16* Y; const int* row_ts; const float* row_gate;
    DI void operator()(const Acc& acc, const Unit& u, int wr, int wc, int fr, int fq) const {
        const int col0 = u.pn * BM + wc * 32 + 8 * fq; const size_t rbase = (size_t)u.e * CAP + u.lb * 256;
#pragma unroll
        for (int ai = 0; ai < 2; ++ai)
#pragma unroll
            for (int m = 0; m < 4; ++m) { const int lr = ai * HALF + wr * 64 + m * 16 + fr;
                if (lr < u.rows) { const int ts = row_ts[rbase + lr]; const float g = row_gate[rbase + lr]; bf16* rowp = Y + (size_t)ts * D + col0;
#pragma unroll
                    for (int bj = 0; bj < 2; ++bj) *(u32x4*)(rowp + bj * HALF) = pack8(acc[ai][bj][m][0] * g, acc[ai][bj][m][1] * g); } }
    }
};

template <class Epi, class Sched>
DI void gemm_phase(LAS unsigned char* lds, const Sched& S, const Epi& E) {
    constexpr bool GATHER = Sched::GATHER;
    const int tid = threadIdx.x, wid = __builtin_amdgcn_readfirstlane(tid >> 6), lane = tid & 63, wr = wid >> 2, wc = wid & 3, fr = lane & 15, fq = lane >> 4;
    const int K = S.K, nt = K / BK;
    int Rr[2], Cc[2]; unsigned voffB[2];
#pragma unroll
    for (int i = 0; i < 2; ++i) { int R, C; stage_rc(tid * 16 + i * 8192, R, C); Rr[i] = R; Cc[i] = C; const int Rb = Epi::PERM ? ((R & ~31) + perm32(R & 31)) : R; voffB[i] = (unsigned)(Rb * K + C) * 2u; }
    const size_t kstep = (size_t)(BK * 2);
    const size_t hstep = (size_t)HALF * K * 2;
    const unsigned ldsw = (unsigned)wid * 1024u;
    const int aoff = lds_byte(wr * 64 + fr, fq * 8), boff = lds_byte(wc * 32 + fr, fq * 8);
#define PG8_SA(b, h) (((b) * 2 + (h)) * HTB)
#define PG8_SB(b, h) ((4 + (b) * 2 + (h)) * HTB)
#define PG8_STAGE(bufoff, gbase, voff) do { _Pragma("unroll") for (int _i = 0; _i < 2; ++_i) \
        __builtin_amdgcn_global_load_lds((const unsigned*)((const char*)(gbase) + (voff)[_i]), (LAS unsigned*)(lds + (bufoff) + ldsw + _i * 8192), 16, 0, 0); } while (0)
#define PG8_LDA(dst, b, h) do { _Pragma("unroll") for (int m = 0; m < 4; ++m) _Pragma("unroll") for (int k = 0; k < 2; ++k) dst[m][k] = *(const LAS bf16x8*)(lds + PG8_SA(b, h) + aoff + m * 2048 + k * 1024); } while (0)
#define PG8_LDB(dst, b, h) do { _Pragma("unroll") for (int n = 0; n < 2; ++n) _Pragma("unroll") for (int k = 0; k < 2; ++k) dst[n][k] = *(const LAS bf16x8*)(lds + PG8_SB(b, h) + boff + n * 2048 + k * 1024); } while (0)
#define PG8_MMA(ai, bj, At, Bt) do { __builtin_amdgcn_s_setprio(1); _Pragma("unroll") for (int m = 0; m < 4; ++m) _Pragma("unroll") for (int n = 0; n < 2; ++n) _Pragma("unroll") for (int k = 0; k < 2; ++k) \
        acc[ai][bj][m][n] = __builtin_amdgcn_mfma_f32_16x16x32_bf16(Bt[n][k], At[m][k], acc[ai][bj][m][n], 0, 0, 0); __builtin_amdgcn_s_setprio(0); } while (0)
#define PG8_WAIT_V(n) asm volatile("s_waitcnt vmcnt(" #n ")" ::: "memory")
#define PG8_WAIT_L(n) asm volatile("s_waitcnt lgkmcnt(" #n ")" ::: "memory")
#define PG8_BAR __builtin_amdgcn_s_barrier()
#define PG8_SCHED __builtin_amdgcn_sched_barrier(0)
    Unit cur, nxt, nn; int ui = 0;
    if (!S.next(0, cur)) return;
    Acc acc;
#pragma unroll
    for (int a = 0; a < 2; ++a)
#pragma unroll
        for (int b = 0; b < 2; ++b)
#pragma unroll
            for (int m = 0; m < 4; ++m)
#pragma unroll
                for (int n = 0; n < 2; ++n) acc[a][b][m][n] = (f32x4){0.f, 0.f, 0.f, 0.f};
    bf16x8 At[4][2], B0[2][2], B1[2][2];
    unsigned vA[2][2], nvA[2][2]; int pts[2][2] = {{0, 0}, {0, 0}};
    { int ts0[2][2] = {{0, 0}, {0, 0}}; S.ts_load(cur, Rr, ts0); S.a_offs(cur, Rr, Cc, ts0, vA); }
    bool has_next = S.next(1, nxt);
    if (GATHER && has_next) S.ts_load(nxt, Rr, pts);
    const char* cA = S.a_base(cur); const char* cB = S.b_base(cur);
    PG8_STAGE(PG8_SB(0, 0), cB, voffB); PG8_STAGE(PG8_SB(0, 1), cB + hstep, voffB); PG8_STAGE(PG8_SA(0, 0), cA, vA[0]); PG8_STAGE(PG8_SA(0, 1), cA, vA[1]);
    if (wr == 1) PG8_BAR;
    PG8_WAIT_V(2); PG8_BAR;
    PG8_STAGE(PG8_SB(1, 0), cB + kstep, voffB); PG8_STAGE(PG8_SA(1, 0), cA + kstep, vA[0]); PG8_STAGE(PG8_SB(1, 1), cB + hstep + kstep, voffB);
    PG8_WAIT_V(6); PG8_BAR;
    for (;;) {
        const char* nA = has_next ? S.a_base(nxt) : cA; const char* nB = has_next ? S.b_base(nxt) : cB;
        if (has_next) S.a_offs(nxt, Rr, Cc, pts, nvA);
        else {
#pragma unroll
            for (int h = 0; h < 2; ++h)
#pragma unroll
                for (int i = 0; i < 2; ++i) nvA[h][i] = vA[h][i];
        }
        const bool has_nn = has_next && S.next(ui + 2, nn);
        if (GATHER && has_nn) S.ts_load(nn, Rr, pts);
        for (int t = 0; t < nt; t += 2) {
            const bool last = (t == nt - 2);
            const char* a1 = cA + (size_t)(t + 1) * kstep;
            const char* a2 = last ? nA : cA + (size_t)(t + 2) * kstep; const char* b2 = last ? nB : cB + (size_t)(t + 2) * kstep;
            const char* a3 = a2 + kstep; const char* b3 = b2 + kstep;
            unsigned w0[2], w1[2];
            if (GATHER) { w0[0] = last ? nvA[0][0] : vA[0][0]; w0[1] = last ? nvA[0][1] : vA[0][1]; w1[0] = last ? nvA[1][0] : vA[1][0]; w1[1] = last ? nvA[1][1] : vA[1][1]; }
            else { w0[0] = vA[0][0]; w0[1] = vA[0][1]; w1[0] = vA[1][0]; w1[1] = vA[1][1]; }
            PG8_LDB(B0, 0, 0); PG8_LDB(B1, 0, 1); PG8_SCHED; PG8_LDA(At, 0, 0); PG8_STAGE(PG8_SA(1, 1), a1, vA[1]);
            PG8_WAIT_V(8); PG8_WAIT_L(0); PG8_BAR; PG8_MMA(0, 0, At, B0); PG8_MMA(0, 1, At, B1); PG8_BAR; PG8_SCHED;
            PG8_LDA(At, 0, 1); PG8_STAGE(PG8_SB(0, 0), b2, voffB); PG8_STAGE(PG8_SB(0, 1), b2 + hstep, voffB); PG8_STAGE(PG8_SA(0, 0), a2, w0);
            PG8_WAIT_V(8); PG8_WAIT_L(0); PG8_BAR; PG8_MMA(1, 0, At, B0); PG8_MMA(1, 1, At, B1); PG8_BAR; PG8_SCHED;
            PG8_LDB(B0, 1, 0); PG8_LDB(B1, 1, 1); PG8_SCHED; PG8_LDA(At, 1, 0); PG8_STAGE(PG8_SA(0, 1), a2, w1);
            PG8_WAIT_V(8); PG8_WAIT_L(0); PG8_BAR; PG8_MMA(0, 0, At, B0); PG8_MMA(0, 1, At, B1); PG8_BAR; PG8_SCHED;
            PG8_LDA(At, 1, 1); PG8_STAGE(PG8_SB(1, 0), b3, voffB); PG8_STAGE(PG8_SB(1, 1), b3 + hstep, voffB); PG8_STAGE(PG8_SA(1, 0), a3, w0);
            PG8_WAIT_V(8); PG8_WAIT_L(0); PG8_BAR; PG8_MMA(1, 0, At, B0); PG8_MMA(1, 1, At, B1); PG8_BAR; PG8_SCHED;
        }
        if (wr == 0) PG8_BAR;
        E(acc, cur, wr, wc, fr, fq);
        if (!has_next) break;
#pragma unroll
        for (int a = 0; a < 2; ++a)
#pragma unroll
            for (int b = 0; b < 2; ++b)
#pragma unroll
                for (int m = 0; m < 4; ++m)
#pragma unroll
                    for (int n = 0; n < 2; ++n) acc[a][b][m][n] = (f32x4){0.f, 0.f, 0.f, 0.f};
        cur = nxt; cA = nA; cB = nB; ++ui;
#pragma unroll
        for (int h = 0; h < 2; ++h)
#pragma unroll
            for (int i = 0; i < 2; ++i) vA[h][i] = nvA[h][i];
        nxt = nn; has_next = has_nn;
        if (wr == 1) PG8_BAR;
    }
    PG8_WAIT_V(0);
    PG8_BAR;
#undef PG8_SA
#undef PG8_SB
#undef PG8_STAGE
#undef PG8_LDA
#undef PG8_LDB
#undef PG8_MMA
#undef PG8_WAIT_V
#undef PG8_WAIT_L
#undef PG8_BAR
#undef PG8_SCHED
}
}

struct ConvJob { const float* W; bf16* WT; int K, ldn, col0, ncols, drow0, mode, nbatch; size_t sstride, dstride; };
DI void transpose_item(const ConvJob& J, int item, LAS float* scr, int lane) {
    const int per = (J.K / 64) * (J.ncols / 32); const int bi = item / per; int r = item - bi * per;
    const int nblk = J.ncols / 32, kb = r / nblk, nb = r % nblk, k0 = 64 * kb, j0 = 32 * nb;
    const float* W = J.W + (size_t)bi * J.sstride; bf16* WT = J.WT + (size_t)bi * J.dstride;
    float tv[32];
#pragma unroll
    for (int i = 0; i < 32; ++i) { const int kk = 2 * i + (lane >> 5); tv[i] = __builtin_nontemporal_load(W + (size_t)(k0 + kk) * J.ldn + J.col0 + j0 + (lane & 31)); }
#pragma unroll
    for (int i = 0; i < 32; ++i) { const int kk = 2 * i + (lane >> 5); scr[kk * 33 + (lane & 31)] = tv[i]; }
    asm volatile("s_waitcnt lgkmcnt(0)" ::: "memory");
    const int c = lane & 7;
    const int drow = J.drow0 + (J.mode ? ((j0 >> 7) * 256 + (j0 & 127)) : j0);
#pragma unroll
    for (int j = 0; j < 4; ++j) { const int n = (lane >> 3) + 8 * j; const LAS float* s = scr + (8 * c) * 33 + n;
        u32x4 o; o.x = pk2(s[0 * 33], s[1 * 33]); o.y = pk2(s[2 * 33], s[3 * 33]); o.z = pk2(s[4 * 33], s[5 * 33]); o.w = pk2(s[6 * 33], s[7 * 33]);
        *(u32x4*)(WT + (size_t)(drow + n) * J.K + k0 + 8 * c) = o; }
    asm volatile("s_waitcnt lgkmcnt(0)" ::: "memory");
}
constexpr int N_JOBS = 15;
DI ConvJob get_job(const Args& a, int j) {
    unsigned char* ws = a.ws; ConvJob J; J.nbatch = 1; J.sstride = 0; J.dstride = 0; J.mode = 0;
    switch (j) {
        case 0: J.W = a.in[6]; J.WT = (bf16*)(ws + W_EVIN); J.K = D; J.ldn = EV_IN; J.col0 = 0; J.ncols = 512; J.drow0 = 0; break;
        case 1: J.W = a.in[6]; J.WT = (bf16*)(ws + W_EVIN); J.K = D; J.ldn = EV_IN; J.col0 = 512; J.ncols = 512; J.drow0 = 512; J.mode = 1; break;
        case 2: J.W = a.in[6]; J.WT = (bf16*)(ws + W_EVIN); J.K = D; J.ldn = EV_IN; J.col0 = 1024; J.ncols = 512; J.drow0 = 640; J.mode = 1; break;
        case 3: J.W = a.in[6]; J.WT = (bf16*)(ws + W_EVIN); J.K = D; J.ldn = EV_IN; J.col0 = 1536; J.ncols = 2048; J.drow0 = 1536; break;
        case 4: J.W = a.in[12]; J.WT = (bf16*)(ws + W_EVOUT); J.K = D; J.ldn = D; J.col0 = 0; J.ncols = D; J.drow0 = 0; break;
        case 5: J.W = a.in[22]; J.WT = (bf16*)(ws + W_FFGU); J.K = D; J.ldn = 2 * DFF; J.col0 = 0; J.ncols = DFF; J.drow0 = 0; J.mode = 1; break;
        case 6: J.W = a.in[22]; J.WT = (bf16*)(ws + W_FFGU); J.K = D; J.ldn = 2 * DFF; J.col0 = DFF; J.ncols = DFF; J.drow0 = 128; J.mode = 1; break;
        case 7: J.W = a.in[23]; J.WT = (bf16*)(ws + W_FFD); J.K = DFF; J.ldn = D; J.col0 = 0; J.ncols = D; J.drow0 = 0; break;
        case 8: J.W = a.in[13]; J.WT = (bf16*)(ws + W_ODIN); J.K = D; J.ldn = OD_N; J.col0 = 0; J.ncols = OD_N; J.drow0 = 0; break;
        case 9: J.W = a.in[20]; J.WT = (bf16*)(ws + W_ODOUT); J.K = D; J.ldn = D; J.col0 = 0; J.ncols = D; J.drow0 = 0; break;
        case 10: J.W = a.in[25]; J.WT = (bf16*)(ws + W_MGU); J.K = D; J.ldn = 2 * DFE; J.col0 = 0; J.ncols = DFE; J.drow0 = 0; J.mode = 1; J.nbatch = NE; J.sstride = (size_t)D * 2 * DFE; J.dstride = (size_t)2 * DFE * D; break;
        case 11: J.W = a.in[25]; J.WT = (bf16*)(ws + W_MGU); J.K = D; J.ldn = 2 * DFE; J.col0 = DFE; J.ncols = DFE; J.drow0 = 128; J.mode = 1; J.nbatch = NE; J.sstride = (size_t)D * 2 * DFE; J.dstride = (size_t)2 * DFE * D; break;
        case 12: J.W = a.in[26]; J.WT = (bf16*)(ws + W_MD); J.K = DFE; J.ldn = D; J.col0 = 0; J.ncols = D; J.drow0 = 0; J.nbatch = NE; J.sstride = (size_t)DFE * D; J.dstride = (size_t)D * DFE; break;
        case 13: J.W = a.in[27]; J.WT = (bf16*)(ws + W_PPROJ); J.K = 256; J.ldn = D; J.col0 = 0; J.ncols = D; J.drow0 = 0; J.nbatch = 2; J.sstride = (size_t)256 * D; J.dstride = (size_t)D * 256; break;
        default: J.W = a.in[28]; J.WT = (bf16*)(ws + W_PGATE); J.K = D; J.ldn = D; J.col0 = 0; J.ncols = D; J.drow0 = 0; J.nbatch = 2; J.sstride = (size_t)D * D; J.dstride = (size_t)D * D; break;
    }
    return J;
}
DI void convert_weights(const Frame& F, const Args& a) {
    LAS float* scr = (LAS float*)(F.lds + F.wave * 16384);
    const int gw = F.vcu * 8 + F.wave, NGW = F.G * 8;
    for (int j = 0; j < N_JOBS; ++j) {
        const ConvJob J = get_job(a, j);
        const int nitems = J.nbatch * (J.K / 64) * (J.ncols / 32);
        for (int it = gw; it < nitems; it += NGW) transpose_item(J, it, scr, F.lane);
    }
}

DI void load_row(const float* p, int lane, f32x4 (&v)[4]) {
    const f32x4* xr = (const f32x4*)p + lane;
#pragma unroll
    for (int j = 0; j < 4; ++j) v[j] = xr[64 * j];
}
DI float sumsq16(const f32x4 (&v)[4]) { float s = 0.f;
#pragma unroll
    for (int j = 0; j < 4; ++j) s += (v[j].x * v[j].x + v[j].y * v[j].y) + (v[j].z * v[j].z + v[j].w * v[j].w);
    return s; }
DI void store_bf16_row(bf16* orow, int lane, const f32x4 (&v)[4]) {
    u32x2* o8 = (u32x2*)orow + lane;
#pragma unroll
    for (int j = 0; j < 4; ++j) { u32x2 w; w.x = pk2(v[j].x, v[j].y); w.y = pk2(v[j].z, v[j].w); o8[64 * j] = w; }
}
DI void norm_plain(const Frame& F, const float* src, const float* g, bf16* dst) {
    f32x4 gv[4]; load_row(g, F.lane, gv);
    const int gw = F.vcu * 8 + F.wave, NGW = F.G * 8;
    for (int m = gw; m < T; m += NGW) {
        f32x4 v[4]; load_row(src + (size_t)m * D, F.lane, v);
        const float rstd = rsqrtf(wave_sum(sumsq16(v)) * (1.f / D) + EPS);
#pragma unroll
        for (int j = 0; j < 4; ++j) v[j] = v[j] * rstd * gv[j];
        store_bf16_row(dst + (size_t)m * D, F.lane, v);
    }
}
DI void norm_mix0(const Frame& F, const Args& a) {
    const float* x = a.in[0]; const float* g = a.in[2]; const float* win = a.in[6];
    bf16* dst = (bf16*)(F.ws + WS_HN); float* GA = (float*)(F.ws + WS_GA); float* BT = (float*)(F.ws + WS_BETA);
    f32x4 gv[4]; load_row(g, F.lane, gv);
    float w8[16][8];
#pragma unroll
    for (int j = 0; j < 4; ++j)
#pragma unroll
        for (int e = 0; e < 4; ++e) { const int k = 256 * j + 4 * F.lane + e; const f32x4 lo = *(const f32x4*)(win + (size_t)k * EV_IN + EV_N), hi = *(const f32x4*)(win + (size_t)k * EV_IN + EV_N + 4);
#pragma unroll
            for (int c = 0; c < 4; ++c) { w8[4 * j + e][c] = lo[c]; w8[4 * j + e][4 + c] = hi[c]; } }
    const int h4 = F.lane & 3;
    const float negA = -__expf(a.in[9][h4]), dtb = a.in[10][h4];
    const int gw = F.vcu * 8 + F.wave, NGW = F.G * 8;
    for (int m = gw; m < T; m += NGW) {
        f32x4 v[4]; load_row(x + (size_t)m * D, F.lane, v);
        const float rstd = rsqrtf(wave_sum(sumsq16(v)) * (1.f / D) + EPS);
#pragma unroll
        for (int j = 0; j < 4; ++j) v[j] = v[j] * rstd * gv[j];
        store_bf16_row(dst + (size_t)m * D, F.lane, v);
        float dsum[8];
#pragma unroll
        for (int c = 0; c < 8; ++c) { float s = 0.f;
#pragma unroll
            for (int j = 0; j < 4; ++j)
#pragma unroll
                for (int e = 0; e < 4; ++e) s += v[j][e] * w8[4 * j + e][c];
            dsum[c] = wave_sum(s); }
        float af = dsum[0], bfv = dsum[4];
        if (h4 == 1) { af = dsum[1]; bfv = dsum[5]; } else if (h4 == 2) { af = dsum[2]; bfv = dsum[6]; } else if (h4 == 3) { af = dsum[3]; bfv = dsum[7]; }
        const float z = af + dtb; const float sp = (z > 20.f) ? z : log1pf(__expf(z));
        if (F.lane < 4) { GA[(size_t)m * 4 + h4] = negA * sp; BT[(size_t)m * 4 + h4] = sigmoid_f(bfv); }
    }
}
DI void convert_p(const Frame& F, const float* p, bf16* dst) {
    const size_t n8 = (size_t)T * 256 / 8;
    for (size_t i = (size_t)F.vcu * 512 + F.tid; i < n8; i += (size_t)F.G * 512) {
        const f32x4 a = *(const f32x4*)(p + i * 8), b = *(const f32x4*)(p + i * 8 + 4);
        *(u32x4*)(dst + i * 8) = pg8::pack8(a, b);
    }
}
DI void norm_router(const Frame& F, const Args& a) {
    const float* h = a.out; const float* g = a.in[3] + D; const float* wr_ = a.in[24];
    bf16* dst = (bf16*)(F.ws + WS_HN); int* row_ts = (int*)(F.ws + WS_ROWTS); float* row_gate = (float*)(F.ws + WS_ROWGATE); unsigned* ctl = (unsigned*)(F.ws + WS_CTL);
    f32x4 gv[4]; load_row(g, F.lane, gv);
    float w8[16][8];
#pragma unroll
    for (int j = 0; j < 4; ++j)
#pragma unroll
        for (int e = 0; e < 4; ++e) { const int k = 256 * j + 4 * F.lane + e; const f32x4 lo = *(const f32x4*)(wr_ + (size_t)k * 8), hi = *(const f32x4*)(wr_ + (size_t)k * 8 + 4);
#pragma unroll
            for (int c = 0; c < 4; ++c) { w8[4 * j + e][c] = lo[c]; w8[4 * j + e][4 + c] = hi[c]; } }
    const int gw = F.vcu * 8 + F.wave, NGW = F.G * 8;
    if (gw == 0) { u32x2* z = (u32x2*)(dst + (size_t)T * D) + F.lane;
#pragma unroll
        for (int j = 0; j < 4; ++j) z[64 * j] = (u32x2){0u, 0u}; }
    for (int grp = gw; grp < T / 32; grp += NGW) {
        int e0 = 0, e1 = 1; float g0 = 0.f, g1 = 0.f;
        for (int rr = 0; rr < 32; ++rr) {
            const int m = grp * 32 + rr;
            f32x4 v[4]; load_row(h + (size_t)m * D, F.lane, v);
            const float rstd = rsqrtf(wave_sum(sumsq16(v)) * (1.f / D) + EPS);
#pragma unroll
            for (int j = 0; j < 4; ++j) v[j] = v[j] * rstd * gv[j];
            store_bf16_row(dst + (size_t)m * D, F.lane, v);
            float lg[8];
#pragma unroll
            for (int c = 0; c < 8; ++c) { float s = 0.f;
#pragma unroll
                for (int j = 0; j < 4; ++j)
#pragma unroll
                    for (int e = 0; e < 4; ++e) s += v[j][e] * w8[4 * j + e][c];
                lg[c] = wave_sum(s); }
            int b0 = 0; float v0 = lg[0];
#pragma unroll
            for (int c = 1; c < 8; ++c) if (lg[c] > v0) { v0 = lg[c]; b0 = c; }
            int b1 = -1; float v1 = -INFINITY;
#pragma unroll
            for (int c = 0; c < 8; ++c) if (c != b0 && lg[c] > v1) { v1 = lg[c]; b1 = c; }
            const float ga = 1.f / (1.f + __expf(v1 - v0));
            if (F.lane == rr) { e0 = b0; e1 = b1; g0 = ga; g1 = 1.f - ga; }
        }
        const bool act = F.lane < 32;
#pragma unroll
        for (int e = 0; e < 8; ++e) {
            const unsigned long long m0 = __ballot(act && e0 == e), m1 = __ballot(act && e1 == e);
            const int n0 = __popcll(m0), n1 = __popcll(m1);
            if (n0 + n1 == 0) continue;
            unsigned base = 0;
            if (F.lane == 0) base = __hip_atomic_fetch_add(ctl + CW_CNT + 64 * e, (unsigned)(n0 + n1), __ATOMIC_RELAXED, __HIP_MEMORY_SCOPE_AGENT);
            base = (unsigned)__builtin_amdgcn_readfirstlane((int)base);
            const unsigned long long below = (1ull << F.lane) - 1ull;
            const int tok = grp * 32 + F.lane;
            if (act && e0 == e) { const unsigned off = base + (unsigned)__popcll(m0 & below); row_ts[(size_t)e * CAP + off] = tok * 2; row_gate[(size_t)e * CAP + off] = g0; }
            if (act && e1 == e) { const unsigned off = base + (unsigned)n0 + (unsigned)__popcll(m1 & below); row_ts[(size_t)e * CAP + off] = tok * 2 + 1; row_gate[(size_t)e * CAP + off] = g1; }
        }
    }
}
DI void combine_norm(const Frame& F, const Args& a) {
    float* h = a.out; const float* g = a.in[4] + D; const bf16* ym = (const bf16*)(F.ws + WS_YMOE); bf16* dst = (bf16*)(F.ws + WS_HN);
    f32x4 gv[4]; load_row(g, F.lane, gv);
    const int gw = F.vcu * 8 + F.wave, NGW = F.G * 8;
    for (int m = gw; m < T; m += NGW) {
        f32x4 v[4]; load_row(h + (size_t)m * D, F.lane, v);
        const u32x2* y0 = (const u32x2*)(ym + (size_t)m * 2 * D) + F.lane; const u32x2* y1 = (const u32x2*)(ym + (size_t)m * 2 * D + D) + F.lane;
#pragma unroll
        for (int j = 0; j < 4; ++j) { const u32x2 p = y0[64 * j], q = y1[64 * j];
            v[j].x += bflo(p.x) + bflo(q.x); v[j].y += bfhi(p.x) + bfhi(q.x); v[j].z += bflo(p.y) + bflo(q.y); v[j].w += bfhi(p.y) + bfhi(q.y); }
        f32x4* hw = (f32x4*)(h + (size_t)m * D) + F.lane;
#pragma unroll
        for (int j = 0; j < 4; ++j) hw[64 * j] = v[j];
        const float rstd = rsqrtf(wave_sum(sumsq16(v)) * (1.f / D) + EPS);
#pragma unroll
        for (int j = 0; j < 4; ++j) v[j] = v[j] * rstd * gv[j];
        store_bf16_row(dst + (size_t)m * D, F.lane, v);
    }
}
DI void final_norm(const Frame& F, const Args& a) {
    float* h = a.out; const float* g = a.in[5];
    f32x4 gv[4]; load_row(g, F.lane, gv);
    const int gw = F.vcu * 8 + F.wave, NGW = F.G * 8;
    for (int m = gw; m < T; m += NGW) {
        f32x4 v[4]; load_row(h + (size_t)m * D, F.lane, v);
        const float rstd = rsqrtf(wave_sum(sumsq16(v)) * (1.f / D) + EPS);
        f32x4* hw = (f32x4*)(h + (size_t)m * D) + F.lane;
#pragma unroll
        for (int j = 0; j < 4; ++j) hw[64 * j] = v[j] * rstd * gv[j];
    }
}

DI void mixer_a(const Frame& F, const Args& a, int worker, int nworkers) {
    const bf16* U = (const bf16*)(F.ws + WS_U); bf16* Y = (bf16*)(F.ws + WS_Y); const float* cw = a.in[7];
    const size_t nitems = (size_t)T * 64;
    for (size_t it = (size_t)worker * 512 + F.tid; it < nitems; it += (size_t)nworkers * 512) {
        const int t = (int)(it >> 6), c8 = (int)(it & 63) * 8, s = t & (SEQ - 1);
        const u32x4 bg = *(const u32x4*)(U + (size_t)t * EVU + c8);
        const u32x4 z2 = *(const u32x4*)(U + (size_t)t * EVU + 512 + c8);
        u32x4 z1 = (u32x4){0u, 0u, 0u, 0u}, z0 = (u32x4){0u, 0u, 0u, 0u};
        if (s >= 1) z1 = *(const u32x4*)(U + (size_t)(t - 1) * EVU + 512 + c8);
        if (s >= 2) z0 = *(const u32x4*)(U + (size_t)(t - 2) * EVU + 512 + c8);
        float o[8];
#pragma unroll
        for (int q = 0; q < 4; ++q) {
            const int c = c8 + 2 * q;
            const float a0 = cw[c] * bflo(z0[q]) + cw[512 + c] * bflo(z1[q]) + cw[1024 + c] * bflo(z2[q]);
            const float a1 = cw[c + 1] * bfhi(z0[q]) + cw[512 + c + 1] * bfhi(z1[q]) + cw[1024 + c + 1] * bfhi(z2[q]);
            o[2 * q] = bflo(bg[q]) * a0; o[2 * q + 1] = bfhi(bg[q]) * a1;
        }
        u32x4 w; w.x = pk2(o[0], o[1]); w.y = pk2(o[2], o[3]); w.z = pk2(o[4], o[5]); w.w = pk2(o[6], o[7]);
        *(u32x4*)(Y + (size_t)t * D + c8) = w;
    }
}

constexpr int GA_GCS = 0, GA_BTS = 256, GA_KN = 1024, GA_KB = GA_KN + 17408, GA_QN = GA_KB + 17408, GA_VBT = GA_QN + 17408, GA_KGT = GA_VBT + 18432,
              GA_AM = GA_KGT + 18432, GA_TB = GA_AM + 17408, GA_QKS = GA_TB + 9216, GA_CW = GA_QKS + 9216, GA_END = GA_CW + 6144;
static_assert(GA_END <= 155648, "gdn-a lds");
DI void gdn_a(const Frame& F, const Args& a) {
    LAS unsigned char* L = F.lds;
    LAS float* gcs = (LAS float*)(L + GA_GCS); LAS float* bts = (LAS float*)(L + GA_BTS);
    LAS float* Am = (LAS float*)(L + GA_AM);
    const bf16* U = (const bf16*)(F.ws + WS_U); const float* GA = (const float*)(F.ws + WS_GA); const float* BT = (const float*)(F.ws + WS_BETA);
    float* EG = (float*)(F.ws + WS_EG); const float* cw = a.in[8];
    const int lane = F.lane, w = F.wave, r = lane & 31, hh = lane >> 5;
    for (int item = F.vcu; item < 4096; item += F.G) {
        const int bh = item >> 5, n = item & 31, b = bh >> 2, h = bh & 3, t0 = b * SEQ + n * 64;
        unsigned char* Gp = F.ws + WS_G + (size_t)item * G_ITEM;
        if (w == 0) {
            float gc = GA[(size_t)(t0 + lane) * 4 + h];
#pragma unroll
            for (int o = 1; o < 64; o <<= 1) { const float up = __shfl_up(gc, o); if (lane >= o) gc += up; }
            gcs[lane] = gc; bts[lane] = BT[(size_t)(t0 + lane) * 4 + h];
            if (lane == 63) EG[item] = __expf(gc);
        }
        for (int i = F.tid; i < 1536; i += 512) { const int part = i >> 9, rem = i & 511, j = rem >> 7, c = rem & 127; *(LAS float*)(L + GA_CW + i * 4) = cw[j * 1536 + part * 512 + h * 128 + c]; }
        const int g2 = (F.tid >> 4) * 2, c8 = (F.tid & 15) * 8;
        u32x4 xr[3][5];
#pragma unroll
        for (int part = 0; part < 3; ++part)
#pragma unroll
            for (int q = 0; q < 5; ++q) {
                xr[part][q] = (u32x4){0u, 0u, 0u, 0u};
                if (n * 64 + g2 - 3 + q >= 0) xr[part][q] = *(const u32x4*)(U + (size_t)(t0 + g2 - 3 + q) * EVU + 1024 + part * 512 + h * 128 + c8);
            }
        WG_BAR();
        const float glast = gcs[63];
#pragma unroll
        for (int part = 0; part < 3; ++part) {
#pragma unroll
            for (int tk = 0; tk < 2; ++tk) {
                const int tok = g2 + tk;
                float acc[8];
#pragma unroll
                for (int e = 0; e < 8; ++e) acc[e] = 0.f;
#pragma unroll
                for (int j = 0; j < 4; ++j) {
                    const u32x4 xv = xr[part][tk + j];
                    const f32x4 w0 = *(const LAS f32x4*)(L + GA_CW + ((part * 4 + j) * 128 + c8) * 4), w1 = *(const LAS f32x4*)(L + GA_CW + ((part * 4 + j) * 128 + c8 + 4) * 4);
                    acc[0] += w0[0] * bflo(xv[0]); acc[1] += w0[1] * bfhi(xv[0]); acc[2] += w0[2] * bflo(xv[1]); acc[3] += w0[3] * bfhi(xv[1]);
                    acc[4] += w1[0] * bflo(xv[2]); acc[5] += w1[1] * bfhi(xv[2]); acc[6] += w1[2] * bflo(xv[3]); acc[7] += w1[3] * bfhi(xv[3]);
                }
                float ss = 0.f;
#pragma unroll
                for (int e = 0; e < 8; ++e) { acc[e] = silu_f(acc[e]); ss += acc[e] * acc[e]; }
                ss = row16_sum(ss);
                const float beta = bts[tok], gc = gcs[tok];
                if (part == 0) {
                    const float sc = rsqrtf(ss + EPS) * 0.08838834764831845f, eg = __expf(gc);
                    u32x4 o; o.x = pk2(acc[0] * sc, acc[1] * sc); o.y = pk2(acc[2] * sc, acc[3] * sc); o.z = pk2(acc[4] * sc, acc[5] * sc); o.w = pk2(acc[6] * sc, acc[7] * sc);
                    *(LAS u32x4*)(L + GA_QN + tok * 272 + c8 * 2) = o;
                    const float s2 = sc * eg;
                    u32x4 g; g.x = pk2(acc[0] * s2, acc[1] * s2); g.y = pk2(acc[2] * s2, acc[3] * s2); g.z = pk2(acc[4] * s2, acc[5] * s2); g.w = pk2(acc[6] * s2, acc[7] * s2);
                    *(u32x4*)(Gp + G_QG + tok * 256 + c8 * 2) = g;
                } else if (part == 1) {
                    const float sc = rsqrtf(ss + EPS), sb = sc * beta, sg = sb * __expf(gc), sd = sc * __expf(glast - gc);
                    u32x4 o; o.x = pk2(acc[0] * sc, acc[1] * sc); o.y = pk2(acc[2] * sc, acc[3] * sc); o.z = pk2(acc[4] * sc, acc[5] * sc); o.w = pk2(acc[6] * sc, acc[7] * sc);
                    *(LAS u32x4*)(L + GA_KN + tok * 272 + c8 * 2) = o;
                    u32x4 p; p.x = pk2(acc[0] * sb, acc[1] * sb); p.y = pk2(acc[2] * sb, acc[3] * sb); p.z = pk2(acc[4] * sb, acc[5] * sb); p.w = pk2(acc[6] * sb, acc[7] * sb);
                    *(LAS u32x4*)(L + GA_KB + tok * 272 + c8 * 2) = p;
                    u32x4 d; d.x = pk2(acc[0] * sd, acc[1] * sd); d.y = pk2(acc[2] * sd, acc[3] * sd); d.z = pk2(acc[4] * sd, acc[5] * sd); d.w = pk2(acc[6] * sd, acc[7] * sd);
                    *(u32x4*)(Gp + G_KD + tok * 256 + c8 * 2) = d;
#pragma unroll
                    for (int e = 0; e < 8; ++e) *(LAS bf16*)(L + GA_KGT + (c8 + e) * 144 + tok * 2) = (bf16)(pk2(acc[e] * sg, 0.f) & 0xffffu);
                } else {
#pragma unroll
                    for (int e = 0; e < 8; ++e) *(LAS bf16*)(L + GA_VBT + (c8 + e) * 144 + tok * 2) = (bf16)(pk2(acc[e] * beta, 0.f) & 0xffffu);
                }
            }
        }
        WG_BAR();
        {
            const int mat = w >> 2, ti = (w >> 1) & 1, tj = w & 1;
            f32x16 x = zero16();
            if (ti >= tj) {
                const LAS unsigned char* ap = L + (mat ? GA_QN : GA_KB) + (32 * ti + r) * 272 + hh * 16;
                const LAS unsigned char* bp = L + GA_KN + (32 * tj + r) * 272 + hh * 16;
#pragma unroll
                for (int s = 0; s < 8; ++s) x = MFMA32(*(const LAS bf16x8*)(ap + 32 * s), *(const LAS bf16x8*)(bp + 32 * s), x);
            }
            const int j = 32 * tj + r; const float gj = gcs[j];
#pragma unroll
            for (int reg = 0; reg < 16; ++reg) {
                const int i = 32 * ti + crow(reg, hh);
                const float dec = __expf(gcs[i] - gj);
                if (mat == 0) Am[i * 68 + j] = (i > j) ? x[reg] * dec : 0.f;
                else *(LAS bf16*)(L + GA_QKS + i * 144 + j * 2) = (bf16)(pk2((i >= j) ? x[reg] * dec : 0.f, 0.f) & 0xffffu);
            }
        }
        WG_BAR();
        if (w == 0) {
            const int blk = hh, col = r;
            float Tr[32];
            const LAS float* Ab = Am + (blk * 32) * 68 + blk * 32;
#pragma unroll
            for (int i = 0; i < 32; ++i) {
                float acc = (i == col) ? 1.f : 0.f;
#pragma unroll
                for (int j = 0; j < i; ++j) acc -= Ab[i * 68 + j] * Tr[j];
                Tr[i] = acc;
            }
#pragma unroll
            for (int i = 0; i < 32; ++i) *(LAS bf16*)(L + GA_TB + (blk * 32 + i) * 144 + (blk * 32 + col) * 2) = (bf16)(pk2(Tr[i], 0.f) & 0xffffu);
#pragma unroll
            for (int i = 0; i < 16; ++i) *(LAS bf16*)(L + GA_TB + (2 * i + blk) * 144 + (32 + col) * 2) = (bf16)0;
            f32x16 P = zero16();
#pragma unroll
            for (int s = 0; s < 2; ++s) {
                const LAS float* arow = Am + (32 + r) * 68 + 16 * s + 8 * hh;
                const f32x4 a0 = *(const LAS f32x4*)arow, a1 = *(const LAS f32x4*)(arow + 4);
                const bf16x8 af = __builtin_bit_cast(bf16x8, pg8::pack8(a0, a1));
                float tv[8];
#pragma unroll
                for (int jj = 0; jj < 8; ++jj) { const float lo = Tr[16 * s + jj]; const float hi = __shfl(Tr[16 * s + 8 + jj], r); tv[jj] = hh ? hi : lo; }
                u32x4 tb; tb.x = pk2(tv[0], tv[1]); tb.y = pk2(tv[2], tv[3]); tb.z = pk2(tv[4], tv[5]); tb.w = pk2(tv[6], tv[7]);
                P = MFMA32(af, __builtin_bit_cast(bf16x8, tb), P);
            }
            f32x16 R = zero16();
#pragma unroll
            for (int s = 0; s < 2; ++s) {
                const LAS unsigned char* tp = L + GA_TB + (32 + r) * 144 + (32 + 16 * s + 4 * hh) * 2;
                const s16x4 lo = *(const LAS s16x4*)tp, hi = *(const LAS s16x4*)(tp + 16);
                R = MFMA32(cat8(lo, hi), pack_step(P, s), R);
            }
#pragma unroll
            for (int reg = 0; reg < 16; ++reg) *(LAS bf16*)(L + GA_TB + (32 + crow(reg, hh)) * 144 + r * 2) = (bf16)(pk2(-R[reg], 0.f) & 0xffffu);
        } else {
            for (int p = F.tid - 64; p < 512; p += 448) { const int row = p >> 3, c = p & 7; *(u32x4*)(Gp + G_QK + row * 128 + c * 16) = *(const LAS u32x4*)(L + GA_QKS + row * 144 + c * 16); }
        }
        WG_BAR();
        if (w < 4) {
#pragma unroll
            for (int q = 0; q < 2; ++q) {
                const int idx = w * 2 + q, ib = idx >> 2, db = idx & 3;
                f32x16 x = zero16();
                const LAS unsigned char* ap = L + GA_TB + (32 * ib + r) * 144 + hh * 16;
                const LAS unsigned char* bp = L + GA_VBT + (32 * db + r) * 144 + hh * 16;
#pragma unroll
                for (int s = 0; s < 4; ++s) if (ib || s < 2) x = MFMA32(*(const LAS bf16x8*)(ap + 32 * s), *(const LAS bf16x8*)(bp + 32 * s), x);
#pragma unroll
                for (int g = 0; g < 4; ++g) { u32x2 o; o.x = pk2(x[4 * g], x[4 * g + 1]); o.y = pk2(x[4 * g + 2], x[4 * g + 3]);
                    *(u32x2*)(Gp + G_UT + ((32 * db + r) * 64 + 32 * ib + 8 * g + 4 * hh) * 2) = o; }
            }
        } else {
#pragma unroll
            for (int q = 0; q < 2; ++q) {
                const int idx = (w - 4) * 2 + q, dkb = idx >> 1, ib = idx & 1;
                f32x16 x = zero16();
                const LAS unsigned char* ap = L + GA_KGT + (32 * dkb + r) * 144 + hh * 16;
                const LAS unsigned char* bp = L + GA_TB + (32 * ib + r) * 144 + hh * 16;
#pragma unroll
                for (int s = 0; s < 4; ++s) if (ib || s < 2) x = MFMA32(*(const LAS bf16x8*)(ap + 32 * s), *(const LAS bf16x8*)(bp + 32 * s), x);
#pragma unroll
                for (int g = 0; g < 4; ++g) { u32x2 o; o.x = pk2(x[4 * g], x[4 * g + 1]); o.y = pk2(x[4 * g + 2], x[4 * g + 3]);
                    *(u32x2*)(Gp + G_W + ((32 * ib + r) * 128 + 32 * dkb + 8 * g + 4 * hh) * 2) = o; }
            }
        }
        WG_BAR();
    }
}

constexpr int GB_ST = 0, GB_W = 34816, GB_QG = GB_W + 17408, GB_KD = GB_QG + 17408, GB_QK = GB_KD + 20480, GB_O = GB_QK + 9216, GB_END = GB_O + 33792;
static_assert(GB_END <= 140000, "gdn-b lds");
DI void gdn_b(const Frame& F, const Args& a, int worker, int nworkers) {
    LAS unsigned char* L = F.lds;
    const bf16* U = (const bf16*)(F.ws + WS_U); bf16* Y = (bf16*)(F.ws + WS_Y); const float* EG = (const float*)(F.ws + WS_EG); const float* gn = a.in[11];
    const int lane = F.lane, w = F.wave, r = lane & 31, hh = lane >> 5, dvb = w & 3, hf = w >> 2;
    const int q4 = (lane & 15) >> 2, p4 = lane & 3, g1 = (lane >> 4) & 1;
    const float gn0 = gn[2 * lane], gn1 = gn[2 * lane + 1];
    const unsigned src_t = (unsigned)F.tid * 16u;
    const unsigned dst_w = (unsigned)((F.tid >> 4) * 272 + (F.tid & 15) * 16);
    const unsigned dst_k = (unsigned)((F.tid >> 4) * 320 + (F.tid & 15) * 16);
    const unsigned dst_q = (unsigned)((F.tid >> 3) * 144 + (F.tid & 7) * 16);
    const unsigned ut_t = (unsigned)(((32 * dvb + r) * 64 + 4 * hh) * 2);
    for (int bh = worker; bh < 128; bh += nworkers) {
        const int b = bh >> 2, h = bh & 3;
        f32x16 Sacc[2] = {zero16(), zero16()};
        for (int p = F.tid; p < 34816 / 16; p += 512) *(LAS u32x4*)(L + GB_ST + p * 16) = (u32x4){0u, 0u, 0u, 0u};
        u32x4 nop[7]; u32x2 nui[2][4]; float neg; unsigned nog[8];
#define GB_PREFETCH(nn) do { const int _item = bh * 32 + (nn); const unsigned char* _Gp = F.ws + WS_G + (size_t)_item * G_ITEM; \
            unsigned _so = src_t, _uo = ut_t; asm volatile("" : "+v"(_so), "+v"(_uo)); \
            _Pragma("unroll") for (int k = 0; k < 7; ++k) { const unsigned char* _bk = _Gp + (8192 * k + (k >= 2 ? 16384 : 0)); nop[k] = *(const u32x4*)(_bk + _so); } \
            _Pragma("unroll") for (int tb = 0; tb < 2; ++tb) _Pragma("unroll") for (int g = 0; g < 4; ++g) { const unsigned char* _bu = _Gp + G_UT + (64 * tb + 16 * g); nui[tb][g] = *(const u32x2*)(_bu + _uo); } \
            neg = EG[_item]; \
            const bf16* _og = U + (size_t)(b * SEQ + (nn) * 64 + w * 8) * EVU + 2560 + h * 128; \
            unsigned _lo = (unsigned)lane * 4u; asm volatile("" : "+v"(_lo)); \
            _Pragma("unroll") for (int k = 0; k < 8; ++k) { const unsigned char* _bo = (const unsigned char*)(_og + (size_t)k * EVU); nog[k] = *(const unsigned*)(_bo + _lo); } } while (0)
        GB_PREFETCH(0);
        for (int n = 0; n < 32; ++n) {
            const int t0 = b * SEQ + n * 64;
            *(LAS u32x4*)(L + GB_W + dst_w) = nop[0]; *(LAS u32x4*)(L + GB_W + dst_w + 32 * 272) = nop[1];
            *(LAS u32x4*)(L + GB_QG + dst_w) = nop[2]; *(LAS u32x4*)(L + GB_QG + dst_w + 32 * 272) = nop[3];
            *(LAS u32x4*)(L + GB_KD + dst_k) = nop[4]; *(LAS u32x4*)(L + GB_KD + dst_k + 32 * 320) = nop[5];
            *(LAS u32x4*)(L + GB_QK + dst_q) = nop[6];
            u32x2 ui[2][4]; unsigned og[8];
#pragma unroll
            for (int tb = 0; tb < 2; ++tb)
#pragma unroll
                for (int g = 0; g < 4; ++g) ui[tb][g] = nui[tb][g];
#pragma unroll
            for (int k = 0; k < 8; ++k) og[k] = nog[k];
            const float eg = neg;
            WG_BAR();
            if (n + 1 < 32) GB_PREFETCH(n + 1);
            f32x16 x0 = zero16(), x1 = zero16(), o = zero16();
            {
                const LAS unsigned char* sp = L + GB_ST + (32 * dvb + r) * 272 + hh * 16;
                const LAS unsigned char* wp = L + GB_W + r * 272 + hh * 16;
                const LAS unsigned char* qp = L + GB_QG + (32 * hf + r) * 272 + hh * 16;
#pragma unroll
                for (int s = 0; s < 8; ++s) {
                    const bf16x8 sf = *(const LAS bf16x8*)(sp + 32 * s);
                    x0 = MFMA32(*(const LAS bf16x8*)(wp + 32 * s), sf, x0);
                    x1 = MFMA32(*(const LAS bf16x8*)(wp + 32 * 272 + 32 * s), sf, x1);
                    o = MFMA32(*(const LAS bf16x8*)(qp + 32 * s), sf, o);
                }
            }
            bf16x8 pv[2][2];
#pragma unroll
            for (int g = 0; g < 4; ++g) {
                x0[4 * g] = bflo(ui[0][g].x) - x0[4 * g]; x0[4 * g + 1] = bfhi(ui[0][g].x) - x0[4 * g + 1]; x0[4 * g + 2] = bflo(ui[0][g].y) - x0[4 * g + 2]; x0[4 * g + 3] = bfhi(ui[0][g].y) - x0[4 * g + 3];
                x1[4 * g] = bflo(ui[1][g].x) - x1[4 * g]; x1[4 * g + 1] = bfhi(ui[1][g].x) - x1[4 * g + 1]; x1[4 * g + 2] = bflo(ui[1][g].y) - x1[4 * g + 2]; x1[4 * g + 3] = bfhi(ui[1][g].y) - x1[4 * g + 3];
            }
            pv[0][0] = pack_step(x0, 0); pv[0][1] = pack_step(x0, 1); pv[1][0] = pack_step(x1, 0); pv[1][1] = pack_step(x1, 1);
#pragma unroll
            for (int tb = 0; tb < 2; ++tb) {
                if (tb <= hf) {
#pragma unroll
                    for (int s = 0; s < 2; ++s) {
                        const LAS unsigned char* kp = L + GB_QK + (32 * hf + r) * 144 + (32 * tb + 16 * s + 4 * hh) * 2;
                        o = MFMA32(cat8(*(const LAS s16x4*)kp, *(const LAS s16x4*)(kp + 16)), pv[tb][s], o);
                    }
                }
            }
            {
                LAS float* Ol = (LAS float*)(L + GB_O) + (32 * hf + 4 * hh) * 132 + 32 * dvb + r;
#pragma unroll
                for (int reg = 0; reg < 16; ++reg) Ol[((reg & 3) + 8 * (reg >> 2)) * 132] = o[reg];
            }
#pragma unroll
            for (int d2 = 0; d2 < 2; ++d2) {
                const int db = 2 * hf + d2;
                f32x16 x = Sacc[d2] * eg;
                const LAS unsigned char* kb = L + GB_KD + (4 * hh + q4) * 320 + (32 * db + 16 * g1 + 4 * p4) * 2;
#pragma unroll
                for (int tb = 0; tb < 2; ++tb)
#pragma unroll
                    for (int s = 0; s < 2; ++s) {
                        const LAS unsigned char* kp = kb + (32 * tb + 16 * s) * 320;
                        x = MFMA32(cat8(vtr(kp), vtr(kp + 8 * 320)), pv[tb][s], x);
                    }
                Sacc[d2] = x;
            }
            WG_BAR();
#pragma unroll
            for (int d2 = 0; d2 < 2; ++d2) {
                const int db = 2 * hf + d2;
#pragma unroll
                for (int g = 0; g < 4; ++g) { u32x2 ov; ov.x = pk2(Sacc[d2][4 * g], Sacc[d2][4 * g + 1]); ov.y = pk2(Sacc[d2][4 * g + 2], Sacc[d2][4 * g + 3]);
                    *(LAS u32x2*)(L + GB_ST + (32 * dvb + r) * 272 + (32 * db + 8 * g + 4 * hh) * 2) = ov; }
            }
            {
                const LAS float* Ol = (const LAS float*)(L + GB_O) + (w * 8) * 132 + 2 * lane;
                bf16* yp = Y + (size_t)(t0 + w * 8) * D + 512 + h * 128 + 2 * lane;
#pragma unroll
                for (int k = 0; k < 8; ++k) {
                    const f32x2_t v = *(const LAS f32x2_t*)(Ol + k * 132);
                    const float rstd = rsqrtf(wave_sum(v.x * v.x + v.y * v.y) * (1.f / 128.f) + EPS);
                    *(unsigned*)(yp + (size_t)k * D) = pk2(v.x * rstd * gn0 * silu_f(bflo(og[k])), v.y * rstd * gn1 * silu_f(bfhi(og[k])));
                }
            }
        }
        WG_BAR();
    }
#undef GB_PREFETCH
}

constexpr int AT_STAGE = 38912, AT_K = 0, AT_V = 18432, AT_BIAS = 2 * AT_STAGE, AT_END = AT_BIAS + 512;
DI void attn_stage_load(const bf16* U1, int trow, int h, int tid, u32x4 (&st)[4]) {
#pragma unroll
    for (int p = 0; p < 4; ++p) { const int idx = tid + 512 * p, row = idx >> 5, c = idx & 31;
        st[p] = *(const u32x4*)(U1 + (size_t)(trow + row) * OD_N + (c < 16 ? 512 + h * 128 + c * 8 : 1024 + h * 128 + (c - 16) * 8)); }
}
DI void attn_stage_store(LAS unsigned char* sb, int tid, const u32x4 (&st)[4]) {
#pragma unroll
    for (int p = 0; p < 4; ++p) { const int idx = tid + 512 * p, row = idx >> 5, c = idx & 31;
        if (c < 16) { const int e = c * 8, mp = e >> 6, wi = e & 63; *(LAS u32x4*)(sb + AT_K + mp * 9216 + row * 144 + wi * 2) = st[p]; }
        else *(LAS u32x4*)(sb + AT_V + row * 320 + (c - 16) * 16) = st[p]; }
}
DI void attn_phase(const Frame& F, const Args& a) {
    LAS unsigned char* L = F.lds;
    const bf16* U1 = (const bf16*)(F.ws + WS_U); bf16* Y = (bf16*)(F.ws + WS_Y);
    const float* lamp = a.in[14]; const float* dng = a.in[15]; const float* relb = a.in[21];
    const int lane = F.lane, w = F.wave, r = lane & 31, hh = lane >> 5, mp = w >> 2, qs = w & 3;
    const int q4 = (lane & 15) >> 2, p4 = lane & 3, g1 = (lane >> 4) & 1;
    const float lam = __expf(wave_sum(lamp[lane] * lamp[64 + lane])) - __expf(wave_sum(lamp[128 + lane] * lamp[192 + lane])) + LAMBDA_INIT;
    const float c1 = 0.125f * LOG2E;
    LAS float* btab = (LAS float*)(L + AT_BIAS);
    LAS float* exch = (LAS float*)L;
    for (int item = F.vcu; item < 256; item += F.G) {
        const int bh = item >> 1, par = item & 1, b = bh >> 2, h = bh & 3, trow0 = b * SEQ;
        WG_BAR();
        if (F.tid < 128) { const int n = F.tid; int bucket = n;
            if (n >= 16) { const int lg = 16 + (int)(__logf((float)n / 16.f) / 2.0794415416798357f * 16.f); bucket = lg < 31 ? lg : 31; }
            btab[n] = relb[bucket * 4 + h] * LOG2E; }
        const float bias_far = relb[31 * 4 + h] * LOG2E;
        for (int ui = 0; ui < 8; ++ui) {
            const int qblk = 2 * ui + ((ui ^ par) & 1);
            const int q0 = qblk * 128 + qs * 32, qpos = q0 + r, ntiles = 2 * (qblk + 1);
            bf16x8 qf[4];
            { const bf16* qp = U1 + (size_t)(trow0 + qpos) * OD_N + h * 128 + mp * 64 + 8 * hh;
#pragma unroll
              for (int s = 0; s < 4; ++s) qf[s] = *(const bf16x8*)(qp + 16 * s); }
            f32x16 O[4] = {zero16(), zero16(), zero16(), zero16()};
            float mrun = -INFINITY, lrun = 0.f;
            u32x4 st[4];
            attn_stage_load(U1, trow0, h, F.tid, st);
            attn_stage_store(L, F.tid, st);
            WG_BAR();
            for (int kt = 0; kt < ntiles; ++kt) {
                const bool more = kt + 1 < ntiles;
                if (more) attn_stage_load(U1, trow0 + (kt + 1) * 64, h, F.tid, st);
                const int key0 = kt * 64;
                if (key0 <= q0 + 31) {
                    const LAS unsigned char* sb = L + (kt & 1) * AT_STAGE;
                    const LAS unsigned char* kb = sb + AT_K + mp * 9216 + r * 144 + hh * 16;
                    f32x16 x0 = zero16(), x1 = zero16();
#pragma unroll
                    for (int s = 0; s < 4; ++s) { x0 = MFMA32(*(const LAS bf16x8*)(kb + 32 * s), qf[s], x0); x1 = MFMA32(*(const LAS bf16x8*)(kb + 32 * 144 + 32 * s), qf[s], x1); }
                    if (q0 - (key0 + 63) >= 128) {
#pragma unroll
                        for (int reg = 0; reg < 16; ++reg) { x0[reg] = x0[reg] * c1 + bias_far; x1[reg] = x1[reg] * c1 + bias_far; }
                    } else {
#pragma unroll
                        for (int reg = 0; reg < 16; ++reg) {
                            const int d0 = qpos - (key0 + crow(reg, hh)), d1 = d0 - 32;
                            const float b0 = btab[d0 < 0 ? 0 : (d0 > 127 ? 127 : d0)], b1 = btab[d1 < 0 ? 0 : (d1 > 127 ? 127 : d1)];
                            x0[reg] = (d0 >= 0) ? x0[reg] * c1 + b0 : -INFINITY; x1[reg] = (d1 >= 0) ? x1[reg] * c1 + b1 : -INFINITY;
                        }
                    }
                    float mx = x0[0];
#pragma unroll
                    for (int reg = 1; reg < 16; ++reg) mx = fmaxf(mx, x0[reg]);
#pragma unroll
                    for (int reg = 0; reg < 16; ++reg) mx = fmaxf(mx, x1[reg]);
                    mx = fmaxf(mx, __shfl_xor(mx, 32));
                    if (__any(mx - mrun > 6.f)) {
                        const float mnew = fmaxf(mrun, mx), alpha = __builtin_amdgcn_exp2f(mrun - mnew); mrun = mnew;
                        lrun *= alpha;
#pragma unroll
                        for (int db = 0; db < 4; ++db) O[db] = O[db] * alpha;
                    }
                    float rs = 0.f;
#pragma unroll
                    for (int reg = 0; reg < 16; ++reg) { x0[reg] = __builtin_amdgcn_exp2f(x0[reg] - mrun); x1[reg] = __builtin_amdgcn_exp2f(x1[reg] - mrun); rs += x0[reg] + x1[reg]; }
                    lrun += rs;
                    bf16x8 pf[2][2]; pf[0][0] = pack_step(x0, 0); pf[0][1] = pack_step(x0, 1); pf[1][0] = pack_step(x1, 0); pf[1][1] = pack_step(x1, 1);
                    const LAS unsigned char* vb = sb + AT_V + (4 * hh + q4) * 320 + (16 * g1 + 4 * p4) * 2;
#pragma unroll
                    for (int db = 0; db < 4; ++db)
#pragma unroll
                        for (int kh = 0; kh < 2; ++kh)
#pragma unroll
                            for (int s = 0; s < 2; ++s) {
                                const LAS unsigned char* vp = vb + (32 * kh + 16 * s) * 320 + 64 * db;
                                O[db] = MFMA32(cat8(vtr(vp), vtr(vp + 8 * 320)), pf[kh][s], O[db]);
                            }
                }
                if (more) attn_stage_store(L + ((kt + 1) & 1) * AT_STAGE, F.tid, st);
                WG_BAR();
            }
            const float ltot = lrun + __shfl_xor(lrun, 32);
            const float inv = 1.f / ltot;
            if (mp == 1) {
                const float sc = inv * lam;
#pragma unroll
                for (int db = 0; db < 4; ++db)
#pragma unroll
                    for (int reg = 0; reg < 16; ++reg) exch[(qs * 64 + db * 16 + reg) * 64 + lane] = O[db][reg] * sc;
            }
            WG_BAR();
            if (mp == 0) {
                float ss = 0.f;
#pragma unroll
                for (int db = 0; db < 4; ++db)
#pragma unroll
                    for (int reg = 0; reg < 16; ++reg) { const float o = O[db][reg] * inv - exch[(qs * 64 + db * 16 + reg) * 64 + lane]; O[db][reg] = o; ss += o * o; }
                ss += __shfl_xor(ss, 32);
                const float rstd = rsqrtf(ss * (1.f / 128.f) + EPS) * (1.f - LAMBDA_INIT);
                bf16* yp = Y + (size_t)(trow0 + qpos) * D + h * 128;
#pragma unroll
                for (int db = 0; db < 4; ++db)
#pragma unroll
                    for (int g = 0; g < 4; ++g) { const int d = 32 * db + 8 * g + 4 * hh; const f32x4 gv = *(const f32x4*)(dng + d);
                        u32x2 o; o.x = pk2(O[db][4 * g] * rstd * gv[0], O[db][4 * g + 1] * rstd * gv[1]); o.y = pk2(O[db][4 * g + 2] * rstd * gv[2], O[db][4 * g + 3] * rstd * gv[3]);
                        *(u32x2*)(yp + d) = o; }
            }
            WG_BAR();
        }
    }
}

constexpr int CF_GLU = 0, CF_RED = 96256, CF_STAT = CF_RED + 4096, CF_END = CF_STAT + 512;
DI void conformer_phase(const Frame& F, const Args& a) {
    LAS unsigned char* L = F.lds;
    const bf16* U1 = (const bf16*)(F.ws + WS_U); bf16* Y = (bf16*)(F.ws + WS_Y);
    const float* cw = a.in[16]; const float* cb = a.in[17]; const float* lg = a.in[18]; const float* lb = a.in[19];
    const int c = F.tid;
    float wv[31];
#pragma unroll
    for (int j = 0; j < 31; ++j) wv[j] = cw[j * 512 + c];
    const float bias = cb[c], lng = lg[c], lnb = lb[c];
    LAS float* red = (LAS float*)(L + CF_RED); LAS float* stat = (LAS float*)(L + CF_STAT);
    for (int tile = F.vcu; tile < T / 64; tile += F.G) {
        const int t0 = tile * 64, s0 = t0 & (SEQ - 1);
        WG_BAR();
        for (int it = F.tid; it < 94 * 64; it += 512) {
            const int row = it >> 6, c8 = (it & 63) * 8;
            u32x4 o = (u32x4){0u, 0u, 0u, 0u};
            if (s0 + row - 30 >= 0) {
                const bf16* up = U1 + (size_t)(t0 + row - 30) * OD_N + 1536 + c8;
                const u32x4 ga = *(const u32x4*)up, gb = *(const u32x4*)(up + 512);
#pragma unroll
                for (int q = 0; q < 4; ++q) o[q] = pk2(bflo(ga[q]) * sigmoid_f(bflo(gb[q])), bfhi(ga[q]) * sigmoid_f(bfhi(gb[q])));
            }
            *(LAS u32x4*)(L + CF_GLU + row * 1024 + c8 * 2) = o;
        }
        WG_BAR();
        float out[64];
#pragma unroll
        for (int tt = 0; tt < 64; ++tt) {
            float acc = bias;
#pragma unroll
            for (int j = 0; j < 31; ++j) acc += wv[j] * bf2f(*(const LAS bf16*)(L + CF_GLU + (tt + j) * 1024 + c * 2));
            out[tt] = acc;
            const float s1 = wave_sum(acc), s2 = wave_sum(acc * acc);
            if (F.lane == 0) { red[(tt * 8 + F.wave) * 2] = s1; red[(tt * 8 + F.wave) * 2 + 1] = s2; }
        }
        WG_BAR();
        if (F.tid < 64) { float s1 = 0.f, s2 = 0.f;
#pragma unroll
            for (int q = 0; q < 8; ++q) { s1 += red[(F.tid * 8 + q) * 2]; s2 += red[(F.tid * 8 + q) * 2 + 1]; }
            const float mean = s1 * (1.f / 512.f); const float var = fmaxf(s2 * (1.f / 512.f) - mean * mean, 0.f);
            stat[F.tid * 2] = mean; stat[F.tid * 2 + 1] = rsqrtf(var + EPS); }
        WG_BAR();
#pragma unroll
        for (int tt = 0; tt < 64; ++tt) {
            const float v = (out[tt] - stat[tt * 2]) * stat[tt * 2 + 1] * lng + lnb;
            Y[(size_t)(t0 + tt) * D + 512 + c] = (bf16)(pk2(silu_f(v), 0.f) & 0xffffu);
        }
    }
}

constexpr int NPH = 26;
__global__ void __launch_bounds__(512, 2) fwd_kernel(Args args) {
    extern __shared__ __attribute__((aligned(16))) unsigned char lds_raw[];
    Frame F;
    F.lds = (LAS unsigned char*)lds_raw; F.ws = args.ws;
    F.tid = threadIdx.x; F.lane = F.tid & 63; F.wave = __builtin_amdgcn_readfirstlane(F.tid >> 6);
    F.G = gridDim.x; { const int bx = blockIdx.x; F.vcu = (F.G % 8 == 0) ? (bx % 8) * (F.G / 8) + bx / 8 : bx; }
    volatile LAS unsigned* MISC = (volatile LAS unsigned*)(F.lds + LDS_MISC);
    if (F.tid < 64) MISC[F.tid] = 0u;
    __syncthreads();
    unsigned* ctl = (unsigned*)(F.ws + WS_CTL);
    const bool multi = (args.ph_hi - args.ph_lo) > 1;
    XcdBarrier bar; bar.bar = ctl + CW_BAR; bar.x = 0; bar.st = MISC + 8;
    if (multi) bar = xcd_barrier_post(ctl + CW_BAR, MISC + 8);
    const int lo = args.ph_lo, hi = args.ph_hi;
#define IN(k) (lo <= (k) && (k) < hi)
#define SEAM(k) do { if (IN(k) && IN((k) + 1)) xcd_barrier(bar); } while (0)
    unsigned char* ws = F.ws;
    bf16* HN = (bf16*)(ws + WS_HN); bf16* UB = (bf16*)(ws + WS_U); bf16* YB = (bf16*)(ws + WS_Y);
    const int bx = (int)blockIdx.x;

    if (IN(0)) { convert_weights(F, args); norm_mix0(F, args); } SEAM(0);
    if (IN(1)) { pg8::SchedDense S; S.init(HN, ws + W_EVIN, T, EV_N, D, F.G, bx); pg8::EpiEvIn E{UB}; pg8::gemm_phase(F.lds, S, E); } SEAM(1);
    if (IN(2)) { gdn_a(F, args); } SEAM(2);
    if (IN(3)) { if ((bx & 1) == 0) gdn_b(F, args, bx >> 1, (F.G + 1) >> 1); else mixer_a(F, args, bx >> 1, F.G >> 1); } SEAM(3);
    if (IN(4)) { pg8::SchedDense S; S.init(YB, ws + W_EVOUT, T, D, D, F.G, bx); pg8::EpiResid E{args.in[0], args.out}; pg8::gemm_phase(F.lds, S, E); } SEAM(4);
    if (IN(5)) { norm_plain(F, args.out, args.in[3], HN); } SEAM(5);
    if (IN(6)) { pg8::SchedDense S; S.init(HN, ws + W_FFGU, T, 2 * DFF, D, F.G, bx); pg8::EpiSwiGLU E{UB, DFF}; pg8::gemm_phase(F.lds, S, E); } SEAM(6);
    if (IN(7)) { pg8::SchedDense S; S.init(UB, ws + W_FFD, T, D, DFF, F.G, bx); pg8::EpiResid E{args.out, args.out}; pg8::gemm_phase(F.lds, S, E); } SEAM(7);
    if (IN(8)) { norm_plain(F, args.out, args.in[4], HN); convert_p(F, args.in[1], (bf16*)(ws + WS_GX)); } SEAM(8);
    if (IN(9)) { pg8::SchedDense S; S.init(ws + WS_GX, ws + W_PPROJ, T, D, 256, F.G, bx); pg8::EpiStoreBf16 E{UB, D}; pg8::gemm_phase(F.lds, S, E); } SEAM(9);
    if (IN(10)) { pg8::SchedDense S; S.init(HN, ws + W_PGATE, T, D, D, F.G, bx); pg8::EpiPleGate E{args.out, UB}; pg8::gemm_phase(F.lds, S, E); } SEAM(10);
    if (IN(11)) { norm_plain(F, args.out, args.in[2] + D, HN); } SEAM(11);
    if (IN(12)) { pg8::SchedDense S; S.init(HN, ws + W_ODIN, T, OD_N, D, F.G, bx); pg8::EpiStoreBf16 E{UB, OD_N}; pg8::gemm_phase(F.lds, S, E); } SEAM(12);
    if (IN(13)) { attn_phase(F, args); conformer_phase(F, args); } SEAM(13);
    if (IN(14)) { pg8::SchedDense S; S.init(YB, ws + W_ODOUT, T, D, D, F.G, bx); pg8::EpiResid E{args.out, args.out}; pg8::gemm_phase(F.lds, S, E); } SEAM(14);
    if (IN(15)) { norm_router(F, args); } SEAM(15);
#define MOE_PART(part, phg, phd) \
    if (IN(phg) || IN(phd)) { \
        LAS int* tab = (LAS int*)(F.lds + LDS_MISC + 256); \
        if (F.tid == 0) { int pb = 0; for (int e = 0; e < 8; ++e) { const int c = (int)__hip_atomic_load(ctl + CW_CNT + 64 * e, __ATOMIC_RELAXED, __HIP_MEMORY_SCOPE_AGENT); tab[e] = c; tab[8 + e] = pb; pb += (c + 255) >> 8; } tab[16] = pb; } \
        __syncthreads(); \
        const int nbt = tab[16]; int nMp = nbt - (part) * MOE_NBP; nMp = nMp < 0 ? 0 : (nMp > MOE_NBP ? MOE_NBP : nMp); \
        if (IN(phg)) { pg8::SchedMoeGU S; S.A = (const char*)HN; S.Bt = (const char*)(ws + W_MGU); S.K = D; S.nM = nMp; S.nN = 2 * DFE / 256; S.G = F.G; S.c = bx; S.blk0 = (part) * MOE_NBP; S.bstride = (size_t)2 * DFE * D * 2; \
            S.row_ts = (const int*)(ws + WS_ROWTS); S.tab = tab; S.gather = true; pg8::EpiSwiGLU E{(bf16*)(ws + WS_GX), DFE}; pg8::gemm_phase(F.lds, S, E); } \
        SEAM(phg); \
        if (IN(phd)) { pg8::SchedMoeDown S; S.A = (const char*)(ws + WS_GX); S.Bt = (const char*)(ws + W_MD); S.K = DFE; S.nM = nMp; S.nN = D / 256; S.G = F.G; S.c = bx; S.blk0 = (part) * MOE_NBP; S.bstride = (size_t)D * DFE * 2; \
            S.row_ts = (const int*)(ws + WS_ROWTS); S.tab = tab; S.gather = false; pg8::EpiMoeDown E{(bf16*)(ws + WS_YMOE), (const int*)(ws + WS_ROWTS), (const float*)(ws + WS_ROWGATE)}; pg8::gemm_phase(F.lds, S, E); } \
        SEAM(phd); \
    }
    MOE_PART(0, 16, 17)
    MOE_PART(1, 18, 19)
    MOE_PART(2, 20, 21)
    if (IN(22)) { combine_norm(F, args); convert_p(F, args.in[1] + (size_t)T * 256, (bf16*)(ws + WS_GX)); } SEAM(22);
    if (IN(23)) { pg8::SchedDense S; S.init(ws + WS_GX, ws + W_PPROJ + (size_t)D * 256 * 2, T, D, 256, F.G, bx); pg8::EpiStoreBf16 E{UB, D}; pg8::gemm_phase(F.lds, S, E); } SEAM(23);
    if (IN(24)) { pg8::SchedDense S; S.init(HN, ws + W_PGATE + (size_t)D * D * 2, T, D, D, F.G, bx); pg8::EpiPleGate E{args.out, UB}; pg8::gemm_phase(F.lds, S, E); } SEAM(24);
    if (IN(25)) { final_norm(F, args); }
#undef IN
#undef SEAM
}

#ifndef MK_MULTI_LAUNCH
#define MK_MULTI_LAUNCH 0
#endif
extern "C" void kernel_launch(void* const* d_in, const int* in_sizes, int n_in, void* d_out, int out_size, void* d_ws, size_t ws_size, hipStream_t stream) {
    static int grid = 0;
    if (grid == 0) {
        if (n_in != 29 || out_size != T * D || ws_size < WS_END) { fprintf(stderr, "kernel_launch: unexpected shapes (n_in %d out %d ws %zu)\n", n_in, out_size, ws_size); grid = -1; return; }
        int dev = 0, cus = 0, per_cu = 0;
        if (hipGetDevice(&dev) != hipSuccess || hipDeviceGetAttribute(&cus, hipDeviceAttributeMultiprocessorCount, dev) != hipSuccess) { grid = -1; return; }
        if (hipFuncSetAttribute((const void*)fwd_kernel, hipFuncAttributeMaxDynamicSharedMemorySize, LDS_BYTES) != hipSuccess) { fprintf(stderr, "kernel_launch: LDS attribute failed\n"); grid = -1; return; }
        if (hipOccupancyMaxActiveBlocksPerMultiprocessor(&per_cu, (const void*)fwd_kernel, 512, LDS_BYTES) != hipSuccess || per_cu < 1) { fprintf(stderr, "kernel_launch: occupancy query says %d\n", per_cu); }
        (void)hipGetLastError();
        grid = cus;
    }
    if (grid < 0) return;
    (void)hipMemsetAsync((char*)d_ws + WS_CTL, 0, CTL_BYTES, stream);
    Args a{};
    for (int i = 0; i < 29; ++i) a.in[i] = (const float*)d_in[i];
    a.out = (float*)d_out; a.ws = (unsigned char*)d_ws;
#if MK_MULTI_LAUNCH
    for (int ph = 0; ph < NPH; ++ph) { a.ph_lo = ph; a.ph_hi = ph + 1; hipLaunchKernelGGL(fwd_kernel, dim3(grid), dim3(512), LDS_BYTES, stream, a); }
#else
    a.ph_lo = 0; a.ph_hi = NPH;
    hipLaunchKernelGGL(fwd_kernel, dim3(grid), dim3(512), LDS_BYTES, stream, a);
#endif
}
```

```cpp
#include <hip/hip_runtime.h>
#include <stdint.h>
#include <stdio.h>

#define DI __device__ __forceinline__
#define LAS __attribute__((address_space(3)))
#define GAS __attribute__((address_space(1)))
typedef unsigned short bf16;
typedef short bf16x8 __attribute__((ext_vector_type(8)));
typedef short s16x4 __attribute__((ext_vector_type(4)));
typedef short v4i16_t __attribute__((ext_vector_type(4)));
typedef float f32x4 __attribute__((ext_vector_type(4)));
typedef float f32x16 __attribute__((ext_vector_type(16)));
typedef float f32x2_t __attribute__((ext_vector_type(2)));
typedef __bf16 bf16x2_t __attribute__((ext_vector_type(2)));
typedef unsigned u32x4 __attribute__((ext_vector_type(4)));
typedef unsigned u32x2 __attribute__((ext_vector_type(2)));
typedef int i32x4 __attribute__((ext_vector_type(4)));
typedef GAS unsigned gu32;

constexpr int T = 65536, D = 1024, SEQ = 2048, NBATCH = 32;
constexpr int EV_IN = 3592, EV_N = 3584, EVU = 3072;
constexpr int OD_N = 2560;
constexpr int DFF = 2816, DFE = 3584, NE = 8, CAP = 65536;
constexpr int MOE_NBP = 174, MOE_NPART = 3;
constexpr float EPS = 1e-6f;
constexpr float LOG2E = 1.4426950408889634f;
constexpr float LAMBDA_INIT = 0.35550906f;

constexpr size_t MiB = 1u << 20;
constexpr size_t WS_CTL = 0, CTL_BYTES = 1 * MiB;
constexpr size_t WS_GA = 1 * MiB, WS_BETA = 2 * MiB, WS_ROWTS = 3 * MiB, WS_ROWGATE = 5 * MiB, WS_EG = 7 * MiB, WS_ROWSA = 8 * MiB, WS_SB = 10 * MiB;
constexpr size_t WS_W = 16 * MiB;
constexpr size_t W_EVIN = WS_W;
constexpr size_t W_EVOUT = W_EVIN + (size_t)EV_N * D * 2;
constexpr size_t W_FFGU = W_EVOUT + (size_t)D * D * 2;
constexpr size_t W_FFD = W_FFGU + (size_t)2 * DFF * D * 2;
constexpr size_t W_ODIN = W_FFD + (size_t)D * DFF * 2;
constexpr size_t W_ODOUT = W_ODIN + (size_t)OD_N * D * 2;
constexpr size_t W_MGU = W_ODOUT + (size_t)D * D * 2;
constexpr size_t W_MD = W_MGU + (size_t)NE * 2 * DFE * D;
constexpr size_t W_PPROJ = W_MD + (size_t)NE * D * DFE * 2;
constexpr size_t W_PGATE = W_PPROJ + (size_t)2 * D * 256 * 2;
constexpr size_t W_END = W_PGATE + (size_t)2 * D * D * 2;
constexpr size_t WS_HN = 222 * MiB;
constexpr size_t WS_G = 222 * MiB;
constexpr size_t WS_GX = 352 * MiB;
constexpr size_t WS_U = 512 * MiB;
constexpr size_t WS_Y = 896 * MiB;
constexpr size_t WS_YMOE = 768 * MiB;
constexpr size_t WS_END = 1024 * MiB;
static_assert(W_END <= WS_HN, "weights fit");
static_assert(WS_G + (size_t)4096 * 73728 <= WS_U, "gdn intermediates fit");
static_assert(WS_GX + (size_t)MOE_NBP * 256 * DFE * 2 <= WS_YMOE, "moe act fits");
constexpr size_t G_ITEM = 73728;
constexpr size_t G_W = 0, G_UT = 16384, G_QG = 32768, G_KD = 49152, G_QK = 65536;

constexpr int CW_CNT = 64;
constexpr int CW_BAR = 4096;
constexpr int CW_CMAX = 65536;

constexpr int LDS_BYTES = 160 * 1024;
constexpr int LDS_MISC = 131072 + 24576;
DI float bf2f(unsigned short b) { return __uint_as_float(((unsigned)b) << 16); }
DI float bflo(unsigned u) { return __uint_as_float(u << 16); }
DI float bfhi(unsigned u) { return __uint_as_float(u & 0xffff0000u); }
DI unsigned pk2(float lo, float hi) { f32x2_t v = {lo, hi}; bf16x2_t b = __builtin_convertvector(v, bf16x2_t); return __builtin_bit_cast(unsigned, b); }
DI float dppf(float v, const int ctrl_sel) {
    int r;
    switch (ctrl_sel) {
        case 0: r = __builtin_amdgcn_update_dpp(0, __builtin_bit_cast(int, v), 0xB1, 0xF, 0xF, true); break;
        case 1: r = __builtin_amdgcn_update_dpp(0, __builtin_bit_cast(int, v), 0x4E, 0xF, 0xF, true); break;
        case 2: r = __builtin_amdgcn_update_dpp(0, __builtin_bit_cast(int, v), 0x141, 0xF, 0xF, true); break;
        default: r = __builtin_amdgcn_update_dpp(0, __builtin_bit_cast(int, v), 0x140, 0xF, 0xF, true); break;
    }
    return __builtin_bit_cast(float, r);
}
DI float row16_sum(float v) { v += dppf(v, 0); v += dppf(v, 1); v += dppf(v, 2); v += dppf(v, 3); return v; }
DI float rlane(float v, int l) { return __builtin_bit_cast(float, __builtin_amdgcn_readlane(__builtin_bit_cast(int, v), l)); }
DI float wave_sum(float v) { v = row16_sum(v); return (rlane(v, 0) + rlane(v, 16)) + (rlane(v, 32) + rlane(v, 48)); }
DI float wave_max(float v) { v = fmaxf(v, dppf(v, 0)); v = fmaxf(v, dppf(v, 1)); v = fmaxf(v, dppf(v, 2)); v = fmaxf(v, dppf(v, 3)); return fmaxf(fmaxf(rlane(v, 0), rlane(v, 16)), fmaxf(rlane(v, 32), rlane(v, 48))); }
DI float silu_f(float x) { return x / (1.f + __expf(-x)); }
DI float sigmoid_f(float x) { return 1.f / (1.f + __expf(-x)); }
DI int crow(int reg, int hh) { return (reg & 3) + 8 * (reg >> 2) + 4 * hh; }
DI bf16x8 pack_step(const f32x16& x, int s) {
    u32x4 p;
    p[0] = pk2(x[8 * s + 0], x[8 * s + 1]); p[1] = pk2(x[8 * s + 2], x[8 * s + 3]); p[2] = pk2(x[8 * s + 4], x[8 * s + 5]); p[3] = pk2(x[8 * s + 6], x[8 * s + 7]);
    return __builtin_bit_cast(bf16x8, p);
}
DI s16x4 vtr(const LAS unsigned char* p) { return __builtin_bit_cast(s16x4, __builtin_amdgcn_ds_read_tr16_b64_v4i16((LAS v4i16_t*)p)); }
DI bf16x8 cat8(s16x4 lo, s16x4 hi) { return __builtin_shufflevector(lo, hi, 0, 1, 2, 3, 4, 5, 6, 7); }
#define MFMA32(a, b, c) __builtin_amdgcn_mfma_f32_32x32x16_bf16((a), (b), (c), 0, 0, 0)
DI f32x16 zero16() { f32x16 z; for (int i = 0; i < 16; ++i) z[i] = 0.f; return z; }
#define WG_BAR() __syncthreads()

#define XB_TMO      128
#define XB_XCNT(j)  (256  + 64 * (j))
#define XB_XSUB(j)  (1280 + 64 * (j))
#define XB_XGEN(j)  (2304 + 64 * (j))
#define XB_TOP      3328
#define XB_TOPGEN   3392
#define XCD_BAR_WORDS 3456
#define XB_SPIN_CAP (1u << 22)
DI unsigned xb_ld(unsigned* p)              { return __hip_atomic_load(p, __ATOMIC_RELAXED, __HIP_MEMORY_SCOPE_AGENT); }
DI unsigned xb_add(unsigned* p, unsigned v) { return __hip_atomic_fetch_add(p, v, __ATOMIC_RELAXED, __HIP_MEMORY_SCOPE_AGENT); }
DI unsigned xb_xcc_id() { return (unsigned)__builtin_amdgcn_s_getreg((3 << 11) | 20) & 0xFu; }
#define XB_SPIN(cond, bar) do { unsigned _sp = 0; while (cond) { __builtin_amdgcn_s_sleep(1); \
    if ((++_sp & 255u) == 0u) { if (xb_ld(&(bar)[XB_TMO])) break; if (_sp > XB_SPIN_CAP) { atomicAdd(&(bar)[XB_TMO], 1u); break; } } } } while (0)
struct XcdBarrier { unsigned* bar; unsigned x; volatile LAS unsigned* st; };
DI XcdBarrier xcd_barrier_post(unsigned* bar, volatile LAS unsigned* st) {
    XcdBarrier b; b.bar = bar; b.x = xb_xcc_id(); b.st = st;
    if (threadIdx.x == 0) (void)xb_add(&bar[XB_XCNT(b.x)], 1u);
    return b;
}
DI void xcd_barrier_complete(unsigned* bar, unsigned x, unsigned& nloc, unsigned& nx) {
    const unsigned G = gridDim.x * gridDim.y * gridDim.z;
    unsigned sum, cnt, mine, sp = 0u;
    for (;;) {
        sum = 0u; cnt = 0u; mine = 0u;
#pragma unroll
        for (unsigned j = 0; j < 16; ++j) { const unsigned c = xb_ld(&bar[XB_XCNT(j)]); sum += c; cnt += (c > 0u) ? 1u : 0u; mine = (j == x) ? c : mine; }
        if (sum == G) break;
        __builtin_amdgcn_s_sleep(1);
        if ((++sp & 255u) == 0u) { if (xb_ld(&bar[XB_TMO])) break; if (sp > XB_SPIN_CAP) { atomicAdd(&bar[XB_TMO], 1u); break; } }
    }
    nloc = mine > 0u ? mine : 1u; nx = cnt > 0u ? cnt : 1u;
}
DI void xcd_barrier(const XcdBarrier& b) {
    asm volatile("s_waitcnt vmcnt(0)" ::: "memory");
    __syncthreads();
    if (threadIdx.x == 0) {
        unsigned* bar = b.bar;
        __builtin_amdgcn_s_waitcnt(0);
        unsigned nloc = b.st[0], nx = b.st[1];
        if (nloc == 0u) { xcd_barrier_complete(bar, b.x, nloc, nx); b.st[0] = nloc; b.st[1] = nx; }
        const unsigned old = xb_add(&bar[XB_XSUB(b.x)], 1u);
        const unsigned gen = old / nloc;
        if (old + 1u == (gen + 1u) * nloc) {
            __builtin_amdgcn_fence(__ATOMIC_RELEASE, "agent");
            asm volatile("s_waitcnt vmcnt(0)" ::: "memory");
            const unsigned og = xb_add(&bar[XB_TOP], 1u);
            const unsigned tg = og / nx;
            if (og + 1u == (tg + 1u) * nx) xb_add(&bar[XB_TOPGEN], 1u);
            else XB_SPIN(xb_ld(&bar[XB_TOPGEN]) == tg, bar);
            __builtin_amdgcn_fence(__ATOMIC_ACQUIRE, "agent");
            xb_add(&bar[XB_XGEN(b.x)], 1u);
            asm volatile("s_waitcnt vmcnt(0)" ::: "memory");
        } else {
            XB_SPIN(xb_ld(&bar[XB_XGEN(b.x)]) == gen, bar);
            __builtin_amdgcn_fence(__ATOMIC_ACQUIRE, "agent");
            asm volatile("s_waitcnt vmcnt(0)" ::: "memory");
        }
    }
    __syncthreads();
}

struct Args { const float* in[29]; float* out; unsigned char* ws; int ph_lo, ph_hi; };
struct Frame {
    LAS unsigned char* lds;
    unsigned char* ws;
    int tid, lane, wave, G, vcu;
};

namespace pg8 {
constexpr int BM = 256, BK = 64, HALF = 128, HTB = HALF * BK * 2, STAGE_BYTES = 8 * HTB, NXCD = 8, WGM = 8;
__host__ __device__ __forceinline__ int lds_byte(int r, int c) { const int st = (r >> 4) * 2 + (c >> 5), rr = r & 15, cc = c & 31, ob = rr * 64 + cc * 2; return st * 1024 + (ob ^ (((ob >> 9) & 1) << 5)); }
__host__ __device__ __forceinline__ void stage_rc(int b, int& R, int& C) { const int st = b / 1024, sb = b % 1024, swz = sb ^ (((sb >> 9) & 1) << 5); R = (st >> 1) * 16 + swz / 64; C = (st & 1) * 32 + (swz % 64) / 2; }
__host__ __device__ __forceinline__ int perm32(int rho) { const int n = rho >> 4, i = rho & 15; return 8 * (i >> 2) + 4 * n + (i & 3); }

struct Unit { int pm, pn, e, lb, rows; };

DI bool static_unit(int i, int G, int c, int nM, int nN, int& pm, int& pn) {
    const int nwg = nM * nN; const long L = (long)i * G + c; if (L >= nwg) return false;
    int wgid = (int)L; { const int q = nwg / NXCD, r = nwg % NXCD, xcd = wgid % NXCD, off = wgid / NXCD; wgid = (xcd < r ? xcd * (q + 1) : r * (q + 1) + (xcd - r) * q) + off; }
    const int nig = WGM * nN, gid = wgid / nig, fm = gid * WGM, gsz = (nM - fm) < WGM ? (nM - fm) : WGM;
    pm = fm + ((wgid % nig) % gsz); pn = (wgid % nig) / gsz; return true;
}
struct SchedDense {
    static constexpr bool GATHER = false;
    const char* A; const char* Bt; int K, nM, nN, G, c;
    DI void init(const void* A_, const void* Bt_, int M, int N, int K_, int G_, int c_) { A = (const char*)A_; Bt = (const char*)Bt_; K = K_; nM = M / BM; nN = N / BM; G = G_; c = c_; }
    DI bool next(int i, Unit& u) const { u.e = 0; u.lb = 0; u.rows = 256; return static_unit(i, G, c, nM, nN, u.pm, u.pn); }
    DI const char* a_base(const Unit& u) const { return A + (size_t)u.pm * BM * K * 2; }
    DI const char* b_base(const Unit& u) const { return Bt + (size_t)u.pn * BM * K * 2; }
    DI void ts_load(const Unit&, const int (&)[2], int (&)[2][2]) const {}
    DI void a_offs(const Unit&, const int (&R)[2], const int (&C)[2], const int (&)[2][2], unsigned (&o)[2][2]) const {
#pragma unroll
        for (int h = 0; h < 2; ++h)
#pragma unroll
            for (int i = 0; i < 2; ++i) o[h][i] = (unsigned)((h * HALF + R[i]) * K + C[i]) * 2u;
    }
};
struct SchedMoe {
    const char* A; const char* Bt; int K, nM, nN, G, c, blk0; size_t bstride; const int* row_ts; const LAS int* tab; bool gather;
    DI bool next(int i, Unit& u) const {
        int pm, pn; if (!static_unit(i, G, c, nM, nN, pm, pn)) return false;
        const int gb = blk0 + pm; int e = 0;
#pragma unroll
        for (int j = 1; j < 8; ++j) e += (gb >= tab[8 + j]) ? 1 : 0;
        e = __builtin_amdgcn_readfirstlane(e);
        const int lb = gb - __builtin_amdgcn_readfirstlane(tab[8 + e]); const int rem = __builtin_amdgcn_readfirstlane(tab[e]) - lb * 256;
        u.pm = pm; u.pn = pn; u.e = e; u.lb = lb; u.rows = rem < 256 ? rem : 256; return true;
    }
    DI const char* b_base(const Unit& u) const { return Bt + (size_t)u.e * bstride + (size_t)u.pn * BM * K * 2; }
};
struct SchedMoeGU : SchedMoe {
    static constexpr bool GATHER = true;
    DI const char* a_base(const Unit&) const { return A; }
    DI void ts_load(const Unit& u, const int (&R)[2], int (&ts)[2][2]) const {
#pragma unroll
        for (int h = 0; h < 2; ++h)
#pragma unroll
            for (int i = 0; i < 2; ++i) { const int lr = h * HALF + R[i]; ts[h][i] = (lr < u.rows) ? row_ts[(size_t)u.e * CAP + u.lb * 256 + lr] : (T << 1); }
    }
    DI void a_offs(const Unit&, const int (&)[2], const int (&C)[2], const int (&ts)[2][2], unsigned (&o)[2][2]) const {
#pragma unroll
        for (int h = 0; h < 2; ++h)
#pragma unroll
            for (int i = 0; i < 2; ++i) o[h][i] = ((unsigned)(ts[h][i] >> 1) * (unsigned)K + (unsigned)C[i]) * 2u;
    }
};
struct SchedMoeDown : SchedMoe {
    static constexpr bool GATHER = false;
    DI const char* a_base(const Unit& u) const { return A + (size_t)u.pm * BM * K * 2; }
    DI void ts_load(const Unit&, const int (&)[2], int (&)[2][2]) const {}
    DI void a_offs(const Unit&, const int (&R)[2], const int (&C)[2], const int (&)[2][2], unsigned (&o)[2][2]) const {
#pragma unroll
        for (int h = 0; h < 2; ++h)
#pragma unroll
            for (int i = 0; i < 2; ++i) o[h][i] = (unsigned)((h * HALF + R[i]) * K + C[i]) * 2u;
    }
};

typedef f32x4 Acc[2][2][4][2];
typedef i32x4 AccI[2][2][4][2];
template <bool I8> struct AccSel { typedef f32x4 type; };
template <> struct AccSel<true> { typedef i32x4 type; };
DI u32x4 pack8(const f32x4& v0, const f32x4& v1) { u32x4 w; w.x = pk2(v0[0], v0[1]); w.y = pk2(v0[2], v0[3]); w.z = pk2(v1[0], v1[1]); w.w = pk2(v1[2], v1[3]); return w; }

struct EpiStoreBf16 {
    static constexpr bool PERM = true, I8 = false;
    bf16* O; int ldc;
    DI void operator()(const Acc& acc, const Unit& u, int wr, int wc, int fr, int fq) const {
        const int row0 = u.pm * BM + wr * 64 + fr, col0 = u.pn * BM + wc * 32 + 8 * fq;
#pragma unroll
        for (int ai = 0; ai < 2; ++ai)
#pragma unroll
            for (int m = 0; m < 4; ++m) { bf16* rowp = O + (size_t)(row0 + ai * HALF + m * 16) * ldc + col0;
#pragma unroll
                for (int bj = 0; bj < 2; ++bj) *(u32x4*)(rowp + bj * HALF) = pack8(acc[ai][bj][m][0], acc[ai][bj][m][1]); }
    }
};
struct EpiEvIn {
    static constexpr bool PERM = true, I8 = false;
    bf16* O;
    DI void operator()(const Acc& acc, const Unit& u, int wr, int wc, int fr, int fq) const {
        const int row0 = u.pm * BM + wr * 64 + fr;
        if (u.pn >= 2 && u.pn < 6) {
            const int col0 = 512 + (u.pn - 2) * HALF + wc * 32 + 8 * fq;
#pragma unroll
            for (int ai = 0; ai < 2; ++ai)
#pragma unroll
                for (int m = 0; m < 4; ++m) { bf16* rowp = O + (size_t)(row0 + ai * HALF + m * 16) * EVU + col0;
                    *(u32x4*)rowp = pack8(acc[ai][0][m][0] * acc[ai][1][m][0], acc[ai][0][m][1] * acc[ai][1][m][1]); }
        } else {
            const int col0 = u.pn * BM - (u.pn >= 6 ? 512 : 0) + wc * 32 + 8 * fq;
#pragma unroll
            for (int ai = 0; ai < 2; ++ai)
#pragma unroll
                for (int m = 0; m < 4; ++m) { bf16* rowp = O + (size_t)(row0 + ai * HALF + m * 16) * EVU + col0;
#pragma unroll
                    for (int bj = 0; bj < 2; ++bj) *(u32x4*)(rowp + bj * HALF) = pack8(acc[ai][bj][m][0], acc[ai][bj][m][1]); }
        }
    }
};
struct EpiSwiGLU {
    static constexpr bool PERM = true, I8 = false;
    bf16* O; int ldc;
    DI void operator()(const Acc& acc, const Unit& u, int wr, int wc, int fr, int fq) const {
        const int row0 = u.pm * BM + wr * 64 + fr, col0 = u.pn * HALF + wc * 32 + 8 * fq;
#pragma unroll
        for (int ai = 0; ai < 2; ++ai)
#pragma unroll
            for (int m = 0; m < 4; ++m) { bf16* rowp = O + (size_t)(row0 + ai * HALF + m * 16) * ldc + col0;
                f32x4 v0, v1;
#pragma unroll
                for (int j = 0; j < 4; ++j) { v0[j] = silu_f(acc[ai][0][m][0][j]) * acc[ai][1][m][0][j]; v1[j] = silu_f(acc[ai][0][m][1][j]) * acc[ai][1][m][1][j]; }
                *(u32x4*)rowp = pack8(v0, v1); }
    }
};
struct EpiSwiGLUI8 {
    static constexpr bool PERM = true, I8 = true;
    bf16* O; int ldc; const float* row_sa; const float* sb;
    DI void operator()(const AccI& acc, const Unit& u, int wr, int wc, int fr, int fq) const {
        const int row0 = u.pm * BM + wr * 64 + fr, col0 = u.pn * HALF + wc * 32 + 8 * fq; const size_t rbase = (size_t)u.e * CAP + u.lb * 256;
        const float* sbp = sb + (size_t)u.e * (2 * DFE) + u.pn * BM + wc * 32 + 8 * fq;
        const f32x4 sg0 = *(const f32x4*)sbp, sg1 = *(const f32x4*)(sbp + 4), su0 = *(const f32x4*)(sbp + HALF), su1 = *(const f32x4*)(sbp + HALF + 4);
#pragma unroll
        for (int ai = 0; ai < 2; ++ai)
#pragma unroll
            for (int m = 0; m < 4; ++m) { const int lr = ai * HALF + wr * 64 + m * 16 + fr; bf16* rowp = O + (size_t)(row0 + ai * HALF + m * 16) * ldc + col0;
                const float ra = (lr < u.rows) ? row_sa[rbase + lr] : 0.f;
                f32x4 v0, v1;
#pragma unroll
                for (int j = 0; j < 4; ++j) { v0[j] = silu_f((float)acc[ai][0][m][0][j] * (ra * sg0[j])) * ((float)acc[ai][1][m][0][j] * (ra * su0[j])); v1[j] = silu_f((float)acc[ai][0][m][1][j] * (ra * sg1[j])) * ((float)acc[ai][1][m][1][j] * (ra * su1[j])); }
                *(u32x4*)rowp = pack8(v0, v1); }
    }
};
struct EpiResid {
    static constexpr bool PERM = false, I8 = false;
    const float* base; float* out;
    DI void operator()(const Acc& acc, const Unit& u, int wr, int wc, int fr, int fq) const {
        const int row0 = u.pm * BM + wr * 64 + fr, col0 = u.pn * BM + wc * 32 + 4 * fq;
#pragma unroll
        for (int ai = 0; ai < 2; ++ai)
#pragma unroll
            for (int m = 0; m < 4; ++m) { const size_t off = (size_t)(row0 + ai * HALF + m * 16) * D + col0;
#pragma unroll
                for (int bj = 0; bj < 2; ++bj)
#pragma unroll
                    for (int n = 0; n < 2; ++n) { const f32x4 b = *(const f32x4*)(base + off + bj * HALF + n * 16); *(f32x4*)(out + off + bj * HALF + n * 16) = b + acc[ai][bj][m][n]; } }
    }
};
struct EpiPleGate {
    static constexpr bool PERM = false, I8 = false;
    float* h; const bf16* tmp;
    DI void operator()(const Acc& acc, const Unit& u, int wr, int wc, int fr, int fq) const {
        const int row0 = u.pm * BM + wr * 64 + fr, col0 = u.pn * BM + wc * 32 + 4 * fq;
#pragma unroll
        for (int ai = 0; ai < 2; ++ai)
#pragma unroll
            for (int m = 0; m < 4; ++m) { const size_t off = (size_t)(row0 + ai * HALF + m * 16) * D + col0;
#pragma unroll
                for (int bj = 0; bj < 2; ++bj)
#pragma unroll
                    for (int n = 0; n < 2; ++n) { const size_t o = off + bj * HALF + n * 16; const f32x4 b = *(const f32x4*)(h + o); const u32x2 t = *(const u32x2*)(tmp + o); const f32x4 a = acc[ai][bj][m][n];
                        f32x4 r; r[0] = b[0] + bflo(t.x) * sigmoid_f(a[0]); r[1] = b[1] + bfhi(t.x) * sigmoid_f(a[1]); r[2] = b[2] + bflo(t.y) * sigmoid_f(a[2]); r[3] = b[3] + bfhi(t.y) * sigmoid_f(a[3]);
                        *(f32x4*)(h + o) = r; } }
    }
};
struct EpiMoeDown {
    static constexpr bool PERM = true, I8 = false;
    bf16* Y; const int* row_ts; const float* row_gate;
    DI void operator()(const Acc& acc, const Unit& u, int wr, int wc, int fr, int fq) const {
        const int col0 = u.pn * BM + wc * 32 + 8 * fq; const size_t rbase = (size_t)u.e * CAP + u.lb * 256;
#pragma unroll
        for (int ai = 0; ai < 2; ++ai)
#pragma unroll
            for (int m = 0; m < 4; ++m) { const int lr = ai * HALF + wr * 64 + m * 16 + fr;
                if (lr < u.rows) { const int ts = row_ts[rbase + lr]; const float g = row_gate[rbase + lr]; bf16* rowp = Y + (size_t)ts * D + col0;
#pragma unroll
                    for (int bj = 0; bj < 2; ++bj) *(u32x4*)(rowp + bj * HALF) = pack8(acc[ai][bj][m][0] * g, acc[ai][bj][m][1] * g); } }
    }
};

DI f32x4 mma16(const bf16x8& a, const bf16x8& b, const f32x4& c) { return __builtin_amdgcn_mfma_f32_16x16x32_bf16(a, b, c, 0, 0, 0); }
DI i32x4 mma16(const bf16x8& a, const bf16x8& b, const i32x4& c) { return __builtin_amdgcn_mfma_i32_16x16x64_i8(__builtin_bit_cast(i32x4, a), __builtin_bit_cast(i32x4, b), c, 0, 0, 0); }
template <class Epi, class Sched>
DI void gemm_phase(LAS unsigned char* lds, const Sched& S, const Epi& E) {
    constexpr bool GATHER = Sched::GATHER; constexpr bool I8 = Epi::I8; typedef typename AccSel<I8>::type acc_t;
    const int tid = threadIdx.x, wid = __builtin_amdgcn_readfirstlane(tid >> 6), lane = tid & 63, wr = wid >> 2, wc = wid & 3, fr = lane & 15, fq = lane >> 4;
    const int K = S.K, nt = K / BK;
    int Rr[2], Cc[2]; unsigned voffB[2];
#pragma unroll
    for (int i = 0; i < 2; ++i) { int R, C; stage_rc(tid * 16 + i * 8192, R, C); Rr[i] = R; Cc[i] = C; const int Rb = Epi::PERM ? ((R & ~31) + perm32(R & 31)) : R; voffB[i] = (unsigned)(Rb * K + C) * 2u; }
    const size_t kstep = (size_t)(BK * 2);
    const size_t hstep = (size_t)HALF * K * 2;
    const unsigned ldsw = (unsigned)wid * 1024u;
    const int aoff = lds_byte(wr * 64 + fr, fq * 8), boff = lds_byte(wc * 32 + fr, fq * 8);
#define PG8_SA(b, h) (((b) * 2 + (h)) * HTB)
#define PG8_SB(b, h) ((4 + (b) * 2 + (h)) * HTB)
#define PG8_STAGE(bufoff, gbase, voff) do { _Pragma("unroll") for (int _i = 0; _i < 2; ++_i) \
        __builtin_amdgcn_global_load_lds((const unsigned*)((const char*)(gbase) + (voff)[_i]), (LAS unsigned*)(lds + (bufoff) + ldsw + _i * 8192), 16, 0, 0); } while (0)
#define PG8_LDA(dst, b, h) do { _Pragma("unroll") for (int m = 0; m < 4; ++m) _Pragma("unroll") for (int k = 0; k < 2; ++k) dst[m][k] = *(const LAS bf16x8*)(lds + PG8_SA(b, h) + aoff + m * 2048 + k * 1024); } while (0)
#define PG8_LDB(dst, b, h) do { _Pragma("unroll") for (int n = 0; n < 2; ++n) _Pragma("unroll") for (int k = 0; k < 2; ++k) dst[n][k] = *(const LAS bf16x8*)(lds + PG8_SB(b, h) + boff + n * 2048 + k * 1024); } while (0)
#define PG8_MMA(ai, bj, At, Bt) do { __builtin_amdgcn_s_setprio(1); _Pragma("unroll") for (int m = 0; m < 4; ++m) _Pragma("unroll") for (int n = 0; n < 2; ++n) _Pragma("unroll") for (int k = 0; k < 2; ++k) \
        acc[ai][bj][m][n] = mma16(Bt[n][k], At[m][k], acc[ai][bj][m][n]); __builtin_amdgcn_s_setprio(0); } while (0)
#define PG8_WAIT_V(n) asm volatile("s_waitcnt vmcnt(" #n ")" ::: "memory")
#define PG8_WAIT_L(n) asm volatile("s_waitcnt lgkmcnt(" #n ")" ::: "memory")
#define PG8_BAR __builtin_amdgcn_s_barrier()
#define PG8_SCHED __builtin_amdgcn_sched_barrier(0)
    Unit cur, nxt, nn; int ui = 0;
    if (!S.next(0, cur)) return;
    acc_t acc[2][2][4][2];
#pragma unroll
    for (int a = 0; a < 2; ++a)
#pragma unroll
        for (int b = 0; b < 2; ++b)
#pragma unroll
            for (int m = 0; m < 4; ++m)
#pragma unroll
                for (int n = 0; n < 2; ++n) acc[a][b][m][n] = (acc_t){0, 0, 0, 0};
    bf16x8 At[4][2], B0[2][2], B1[2][2];
    unsigned vA[2][2], nvA[2][2]; int pts[2][2] = {{0, 0}, {0, 0}};
    { int ts0[2][2] = {{0, 0}, {0, 0}}; S.ts_load(cur, Rr, ts0); S.a_offs(cur, Rr, Cc, ts0, vA); }
    bool has_next = S.next(1, nxt);
    if (GATHER && has_next) S.ts_load(nxt, Rr, pts);
    const char* cA = S.a_base(cur); const char* cB = S.b_base(cur);
    PG8_STAGE(PG8_SB(0, 0), cB, voffB); PG8_STAGE(PG8_SB(0, 1), cB + hstep, voffB); PG8_STAGE(PG8_SA(0, 0), cA, vA[0]); PG8_STAGE(PG8_SA(0, 1), cA, vA[1]);
    if (wr == 1) PG8_BAR;
    PG8_WAIT_V(2); PG8_BAR;
    PG8_STAGE(PG8_SB(1, 0), cB + kstep, voffB); PG8_STAGE(PG8_SA(1, 0), cA + kstep, vA[0]); PG8_STAGE(PG8_SB(1, 1), cB + hstep + kstep, voffB);
    PG8_WAIT_V(6); PG8_BAR;
    for (;;) {
        const char* nA = has_next ? S.a_base(nxt) : cA; const char* nB = has_next ? S.b_base(nxt) : cB;
        if (has_next) S.a_offs(nxt, Rr, Cc, pts, nvA);
        else {
#pragma unroll
            for (int h = 0; h < 2; ++h)
#pragma unroll
                for (int i = 0; i < 2; ++i) nvA[h][i] = vA[h][i];
        }
        const bool has_nn = has_next && S.next(ui + 2, nn);
        if (GATHER && has_nn) S.ts_load(nn, Rr, pts);
        for (int t = 0; t < nt; t += 2) {
            const bool last = (t == nt - 2);
            const char* a1 = cA + (size_t)(t + 1) * kstep;
            const char* a2 = last ? nA : cA + (size_t)(t + 2) * kstep; const char* b2 = last ? nB : cB + (size_t)(t + 2) * kstep;
            const char* a3 = a2 + kstep; const char* b3 = b2 + kstep;
            unsigned w0[2], w1[2];
            if (GATHER) { w0[0] = last ? nvA[0][0] : vA[0][0]; w0[1] = last ? nvA[0][1] : vA[0][1]; w1[0] = last ? nvA[1][0] : vA[1][0]; w1[1] = last ? nvA[1][1] : vA[1][1]; }
            else { w0[0] = vA[0][0]; w0[1] = vA[0][1]; w1[0] = vA[1][0]; w1[1] = vA[1][1]; }
            PG8_LDB(B0, 0, 0); PG8_LDB(B1, 0, 1); PG8_SCHED; PG8_LDA(At, 0, 0); PG8_STAGE(PG8_SA(1, 1), a1, vA[1]);
            PG8_WAIT_V(8); PG8_WAIT_L(0); PG8_BAR; PG8_MMA(0, 0, At, B0); PG8_MMA(0, 1, At, B1); PG8_BAR; PG8_SCHED;
            PG8_LDA(At, 0, 1); PG8_STAGE(PG8_SB(0, 0), b2, voffB); PG8_STAGE(PG8_SB(0, 1), b2 + hstep, voffB); PG8_STAGE(PG8_SA(0, 0), a2, w0);
            PG8_WAIT_V(8); PG8_WAIT_L(0); PG8_BAR; PG8_MMA(1, 0, At, B0); PG8_MMA(1, 1, At, B1); PG8_BAR; PG8_SCHED;
            PG8_LDB(B0, 1, 0); PG8_LDB(B1, 1, 1); PG8_SCHED; PG8_LDA(At, 1, 0); PG8_STAGE(PG8_SA(0, 1), a2, w1);
            PG8_WAIT_V(8); PG8_WAIT_L(0); PG8_BAR; PG8_MMA(0, 0, At, B0); PG8_MMA(0, 1, At, B1); PG8_BAR; PG8_SCHED;
            PG8_LDA(At, 1, 1); PG8_STAGE(PG8_SB(1, 0), b3, voffB); PG8_STAGE(PG8_SB(1, 1), b3 + hstep, voffB); PG8_STAGE(PG8_SA(1, 0), a3, w0);
            PG8_WAIT_V(8); PG8_WAIT_L(0); PG8_BAR; PG8_MMA(1, 0, At, B0); PG8_MMA(1, 1, At, B1); PG8_BAR; PG8_SCHED;
        }
        if (wr == 0) PG8_BAR;
        E(acc, cur, wr, wc, fr, fq);
        if (!has_next) break;
#pragma unroll
        for (int a = 0; a < 2; ++a)
#pragma unroll
            for (int b = 0; b < 2; ++b)
#pragma unroll
                for (int m = 0; m < 4; ++m)
#pragma unroll
                    for (int n = 0; n < 2; ++n) acc[a][b][m][n] = (acc_t){0, 0, 0, 0};
        cur = nxt; cA = nA; cB = nB; ++ui;
#pragma unroll
        for (int h = 0; h < 2; ++h)
#pragma unroll
            for (int i = 0; i < 2; ++i) vA[h][i] = nvA[h][i];
        nxt = nn; has_next = has_nn;
        if (wr == 1) PG8_BAR;
    }
    PG8_WAIT_V(0);
    PG8_BAR;
#undef PG8_SA
#undef PG8_SB
#undef PG8_STAGE
#undef PG8_LDA
#undef PG8_LDB
#undef PG8_MMA
#undef PG8_WAIT_V
#undef PG8_WAIT_L
#undef PG8_BAR
#undef PG8_SCHED
}
}

struct ConvJob { const float* W; bf16* WT; int K, ldn, col0, ncols, drow0, mode, nbatch; size_t sstride, dstride; };
DI void transpose_item(const ConvJob& J, int item, LAS float* scr, int lane) {
    const int per = (J.K / 64) * (J.ncols / 32); const int bi = item / per; int r = item - bi * per;
    const int nblk = J.ncols / 32, kb = r / nblk, nb = r % nblk, k0 = 64 * kb, j0 = 32 * nb;
    const float* W = J.W + (size_t)bi * J.sstride; bf16* WT = J.WT + (size_t)bi * J.dstride;
    float tv[32];
#pragma unroll
    for (int i = 0; i < 32; ++i) { const int kk = 2 * i + (lane >> 5); tv[i] = __builtin_nontemporal_load(W + (size_t)(k0 + kk) * J.ldn + J.col0 + j0 + (lane & 31)); }
#pragma unroll
    for (int i = 0; i < 32; ++i) { const int kk = 2 * i + (lane >> 5); scr[kk * 33 + (lane & 31)] = tv[i]; }
    asm volatile("s_waitcnt lgkmcnt(0)" ::: "memory");
    const int c = lane & 7;
    const int drow = J.drow0 + (J.mode ? ((j0 >> 7) * 256 + (j0 & 127)) : j0);
#pragma unroll
    for (int j = 0; j < 4; ++j) { const int n = (lane >> 3) + 8 * j; const LAS float* s = scr + (8 * c) * 33 + n;
        u32x4 o; o.x = pk2(s[0 * 33], s[1 * 33]); o.y = pk2(s[2 * 33], s[3 * 33]); o.z = pk2(s[4 * 33], s[5 * 33]); o.w = pk2(s[6 * 33], s[7 * 33]);
        *(u32x4*)(WT + (size_t)(drow + n) * J.K + k0 + 8 * c) = o; }
    asm volatile("s_waitcnt lgkmcnt(0)" ::: "memory");
}
constexpr int N_JOBS = 15;
DI ConvJob get_job(const Args& a, int j) {
    unsigned char* ws = a.ws; ConvJob J; J.nbatch = 1; J.sstride = 0; J.dstride = 0; J.mode = 0;
    switch (j) {
        case 0: J.W = a.in[6]; J.WT = (bf16*)(ws + W_EVIN); J.K = D; J.ldn = EV_IN; J.col0 = 0; J.ncols = 512; J.drow0 = 0; break;
        case 1: J.W = a.in[6]; J.WT = (bf16*)(ws + W_EVIN); J.K = D; J.ldn = EV_IN; J.col0 = 512; J.ncols = 512; J.drow0 = 512; J.mode = 1; break;
        case 2: J.W = a.in[6]; J.WT = (bf16*)(ws + W_EVIN); J.K = D; J.ldn = EV_IN; J.col0 = 1024; J.ncols = 512; J.drow0 = 640; J.mode = 1; break;
        case 3: J.W = a.in[6]; J.WT = (bf16*)(ws + W_EVIN); J.K = D; J.ldn = EV_IN; J.col0 = 1536; J.ncols = 2048; J.drow0 = 1536; break;
        case 4: J.W = a.in[12]; J.WT = (bf16*)(ws + W_EVOUT); J.K = D; J.ldn = D; J.col0 = 0; J.ncols = D; J.drow0 = 0; break;
        case 5: J.W = a.in[22]; J.WT = (bf16*)(ws + W_FFGU); J.K = D; J.ldn = 2 * DFF; J.col0 = 0; J.ncols = DFF; J.drow0 = 0; J.mode = 1; break;
        case 6: J.W = a.in[22]; J.WT = (bf16*)(ws + W_FFGU); J.K = D; J.ldn = 2 * DFF; J.col0 = DFF; J.ncols = DFF; J.drow0 = 128; J.mode = 1; break;
        case 7: J.W = a.in[23]; J.WT = (bf16*)(ws + W_FFD); J.K = DFF; J.ldn = D; J.col0 = 0; J.ncols = D; J.drow0 = 0; break;
        case 8: J.W = a.in[13]; J.WT = (bf16*)(ws + W_ODIN); J.K = D; J.ldn = OD_N; J.col0 = 0; J.ncols = OD_N; J.drow0 = 0; break;
        case 9: J.W = a.in[20]; J.WT = (bf16*)(ws + W_ODOUT); J.K = D; J.ldn = D; J.col0 = 0; J.ncols = D; J.drow0 = 0; break;
        case 10: J.W = a.in[25]; J.WT = (bf16*)(ws + W_MGU); J.K = D; J.ldn = 2 * DFE; J.col0 = 0; J.ncols = DFE; J.drow0 = 0; J.mode = 1; J.nbatch = NE; J.sstride = (size_t)D * 2 * DFE; J.dstride = (size_t)2 * DFE * D; break;
        case 11: J.W = a.in[25]; J.WT = (bf16*)(ws + W_MGU); J.K = D; J.ldn = 2 * DFE; J.col0 = DFE; J.ncols = DFE; J.drow0 = 128; J.mode = 1; J.nbatch = NE; J.sstride = (size_t)D * 2 * DFE; J.dstride = (size_t)2 * DFE * D; break;
        case 12: J.W = a.in[26]; J.WT = (bf16*)(ws + W_MD); J.K = DFE; J.ldn = D; J.col0 = 0; J.ncols = D; J.drow0 = 0; J.nbatch = NE; J.sstride = (size_t)DFE * D; J.dstride = (size_t)D * DFE; break;
        case 13: J.W = a.in[27]; J.WT = (bf16*)(ws + W_PPROJ); J.K = 256; J.ldn = D; J.col0 = 0; J.ncols = D; J.drow0 = 0; J.nbatch = 2; J.sstride = (size_t)256 * D; J.dstride = (size_t)D * 256; break;
        default: J.W = a.in[28]; J.WT = (bf16*)(ws + W_PGATE); J.K = D; J.ldn = D; J.col0 = 0; J.ncols = D; J.drow0 = 0; J.nbatch = 2; J.sstride = (size_t)D * D; J.dstride = (size_t)D * D; break;
    }
    return J;
}
DI void convert_weights(const Frame& F, const Args& a) {
    LAS float* scr = (LAS float*)(F.lds + F.wave * 16384);
    const int gw = F.vcu * 8 + F.wave, NGW = F.G * 8;
    for (int jj = 0; jj < N_JOBS - 2; ++jj) {
        const int j = jj < 10 ? jj : jj + 2;
        const ConvJob J = get_job(a, j);
        const int nitems = J.nbatch * (J.K / 64) * (J.ncols / 32);
        for (int it = gw; it < nitems; it += NGW) transpose_item(J, it, scr, F.lane);
    }
}

DI void moe_absmax(const Frame& F, const Args& a) {
    const float* W = a.in[25]; unsigned* cmax = (unsigned*)(F.ws + WS_CTL) + CW_CMAX;
    const int gw = F.vcu * 8 + F.wave, NGW = F.G * 8, lane = F.lane;
    for (int it = gw; it < 8 * 4 * 224; it += NGW) {
        const int e = it / 896, r = it % 896, kb = r / 224, nb = r % 224;
        const float* p = W + ((size_t)e * D + kb * 256 + (lane >> 5)) * (2 * DFE) + nb * 32 + (lane & 31);
        float m = 0.f;
#pragma unroll 1
        for (int i0 = 0; i0 < 128; i0 += 32) {
            float tv[32];
#pragma unroll
            for (int i = 0; i < 32; ++i) tv[i] = __builtin_nontemporal_load(p + (size_t)(2 * (i0 + i)) * (2 * DFE));
#pragma unroll
            for (int i = 0; i < 32; ++i) m = fmaxf(m, fabsf(tv[i]));
        }
        m = fmaxf(m, __shfl_xor(m, 32));
        if (lane < 32) __hip_atomic_fetch_max(cmax + e * (2 * DFE) + nb * 32 + lane, __float_as_uint(m), __ATOMIC_RELAXED, __HIP_MEMORY_SCOPE_AGENT);
    }
}
DI void moe_quant(const Frame& F, const Args& a, int worker, int nworkers) {
    const float* W = a.in[25]; const unsigned* cmax = (const unsigned*)(F.ws + WS_CTL) + CW_CMAX; signed char* W8 = (signed char*)(F.ws + W_MGU); float* SB = (float*)(F.ws + WS_SB);
    LAS float* scr = (LAS float*)(F.lds + F.wave * 17408);
    const int gw = worker * 8 + F.wave, NGW = nworkers * 8, lane = F.lane;
    for (int it = gw; it < 8 * 8 * 224; it += NGW) {
        const int e = it / 1792, r = it % 1792, kb = r / 224, nb = r % 224, k0 = kb * 128, n0 = nb * 32;
        const float cm = __uint_as_float(__hip_atomic_load(cmax + e * (2 * DFE) + n0 + (lane & 31), __ATOMIC_RELAXED, __HIP_MEMORY_SCOPE_AGENT));
        const float inv = cm > 0.f ? 127.f / cm : 0.f;
        const float* p = W + ((size_t)e * D + k0 + (lane >> 5)) * (2 * DFE) + n0 + (lane & 31);
#pragma unroll 1
        for (int i0 = 0; i0 < 64; i0 += 32) {
            float tv[32];
#pragma unroll
            for (int i = 0; i < 32; ++i) tv[i] = __builtin_nontemporal_load(p + (size_t)(2 * (i0 + i)) * (2 * DFE));
#pragma unroll
            for (int i = 0; i < 32; ++i) scr[(2 * (i0 + i) + (lane >> 5)) * 33 + (lane & 31)] = tv[i] * inv;
        }
        asm volatile("s_waitcnt lgkmcnt(0)" ::: "memory");
        const int jg = n0 >= DFE ? n0 - DFE : n0;
        const int drow = (jg >> 7) * 256 + (jg & 127) + (n0 >= DFE ? 128 : 0);
        const int c = lane & 7;
#pragma unroll
        for (int j = 0; j < 4; ++j) { const int n = (lane >> 3) + 8 * j; const LAS float* sp = scr + (16 * c) * 33 + n;
            u32x4 o;
#pragma unroll
            for (int q = 0; q < 4; ++q) { const int b0 = __float2int_rn(sp[(4 * q) * 33]), b1 = __float2int_rn(sp[(4 * q + 1) * 33]), b2 = __float2int_rn(sp[(4 * q + 2) * 33]), b3 = __float2int_rn(sp[(4 * q + 3) * 33]);
                o[q] = (unsigned)(b0 & 0xff) | ((unsigned)(b1 & 0xff) << 8) | ((unsigned)(b2 & 0xff) << 16) | ((unsigned)(b3 & 0xff) << 24); }
            *(u32x4*)(W8 + ((size_t)e * (2 * DFE) + drow + n) * D + k0 + 16 * c) = o; }
        if (k0 == 0 && lane < 32) SB[(size_t)e * (2 * DFE) + drow + lane] = cm * (1.f / 127.f);
        asm volatile("s_waitcnt lgkmcnt(0)" ::: "memory");
    }
}

DI void load_row(const float* p, int lane, f32x4 (&v)[4]) {
    const f32x4* xr = (const f32x4*)p + lane;
#pragma unroll
    for (int j = 0; j < 4; ++j) v[j] = xr[64 * j];
}
DI float sumsq16(const f32x4 (&v)[4]) { float s = 0.f;
#pragma unroll
    for (int j = 0; j < 4; ++j) s += (v[j].x * v[j].x + v[j].y * v[j].y) + (v[j].z * v[j].z + v[j].w * v[j].w);
    return s; }
DI void store_bf16_row(bf16* orow, int lane, const f32x4 (&v)[4]) {
    u32x2* o8 = (u32x2*)orow + lane;
#pragma unroll
    for (int j = 0; j < 4; ++j) { u32x2 w; w.x = pk2(v[j].x, v[j].y); w.y = pk2(v[j].z, v[j].w); o8[64 * j] = w; }
}
DI void norm_plain(const Frame& F, const float* src, const float* g, bf16* dst) {
    f32x4 gv[4]; load_row(g, F.lane, gv);
    const int gw = F.vcu * 8 + F.wave, NGW = F.G * 8;
    for (int m = gw; m < T; m += NGW) {
        f32x4 v[4]; load_row(src + (size_t)m * D, F.lane, v);
        const float rstd = rsqrtf(wave_sum(sumsq16(v)) * (1.f / D) + EPS);
#pragma unroll
        for (int j = 0; j < 4; ++j) v[j] = v[j] * rstd * gv[j];
        store_bf16_row(dst + (size_t)m * D, F.lane, v);
    }
}
DI void norm_mix0(const Frame& F, const Args& a) {
    const float* x = a.in[0]; const float* g = a.in[2]; const float* win = a.in[6];
    bf16* dst = (bf16*)(F.ws + WS_HN); float* GA = (float*)(F.ws + WS_GA); float* BT = (float*)(F.ws + WS_BETA);
    f32x4 gv[4]; load_row(g, F.lane, gv);
    float w8[16][8];
#pragma unroll
    for (int j = 0; j < 4; ++j)
#pragma unroll
        for (int e = 0; e < 4; ++e) { const int k = 256 * j + 4 * F.lane + e; const f32x4 lo = *(const f32x4*)(win + (size_t)k * EV_IN + EV_N), hi = *(const f32x4*)(win + (size_t)k * EV_IN + EV_N + 4);
#pragma unroll
            for (int c = 0; c < 4; ++c) { w8[4 * j + e][c] = lo[c]; w8[4 * j + e][4 + c] = hi[c]; } }
    const int h4 = F.lane & 3;
    const float negA = -__expf(a.in[9][h4]), dtb = a.in[10][h4];
    const int gw = F.vcu * 8 + F.wave, NGW = F.G * 8;
    for (int m = gw; m < T; m += NGW) {
        f32x4 v[4]; load_row(x + (size_t)m * D, F.lane, v);
        const float rstd = rsqrtf(wave_sum(sumsq16(v)) * (1.f / D) + EPS);
#pragma unroll
        for (int j = 0; j < 4; ++j) v[j] = v[j] * rstd * gv[j];
        store_bf16_row(dst + (size_t)m * D, F.lane, v);
        float dsum[8];
#pragma unroll
        for (int c = 0; c < 8; ++c) { float s = 0.f;
#pragma unroll
            for (int j = 0; j < 4; ++j)
#pragma unroll
                for (int e = 0; e < 4; ++e) s += v[j][e] * w8[4 * j + e][c];
            dsum[c] = wave_sum(s); }
        float af = dsum[0], bfv = dsum[4];
        if (h4 == 1) { af = dsum[1]; bfv = dsum[5]; } else if (h4 == 2) { af = dsum[2]; bfv = dsum[6]; } else if (h4 == 3) { af = dsum[3]; bfv = dsum[7]; }
        const float z = af + dtb; const float sp = (z > 20.f) ? z : log1pf(__expf(z));
        if (F.lane < 4) { GA[(size_t)m * 4 + h4] = negA * sp; BT[(size_t)m * 4 + h4] = sigmoid_f(bfv); }
    }
}
DI void convert_p(const Frame& F, const float* p, bf16* dst) {
    const size_t n8 = (size_t)T * 256 / 8;
    for (size_t i = (size_t)F.vcu * 512 + F.tid; i < n8; i += (size_t)F.G * 512) {
        const f32x4 a = *(const f32x4*)(p + i * 8), b = *(const f32x4*)(p + i * 8 + 4);
        *(u32x4*)(dst + i * 8) = pg8::pack8(a, b);
    }
}
DI void norm_router(const Frame& F, const Args& a) {
    const float* h = a.out; const float* g = a.in[3] + D; const float* wr_ = a.in[24];
    signed char* dst = (signed char*)(F.ws + WS_HN); int* row_ts = (int*)(F.ws + WS_ROWTS); float* row_gate = (float*)(F.ws + WS_ROWGATE); float* row_sa = (float*)(F.ws + WS_ROWSA); unsigned* ctl = (unsigned*)(F.ws + WS_CTL);
    f32x4 gv[4]; load_row(g, F.lane, gv);
    float w8[16][8];
#pragma unroll
    for (int j = 0; j < 4; ++j)
#pragma unroll
        for (int e = 0; e < 4; ++e) { const int k = 256 * j + 4 * F.lane + e; const f32x4 lo = *(const f32x4*)(wr_ + (size_t)k * 8), hi = *(const f32x4*)(wr_ + (size_t)k * 8 + 4);
#pragma unroll
            for (int c = 0; c < 4; ++c) { w8[4 * j + e][c] = lo[c]; w8[4 * j + e][4 + c] = hi[c]; } }
    const int gw = F.vcu * 8 + F.wave, NGW = F.G * 8;
    if (gw == 0) { unsigned* z = (unsigned*)(dst + (size_t)T * D) + F.lane;
#pragma unroll
        for (int j = 0; j < 4; ++j) z[64 * j] = 0u; }
    for (int grp = gw; grp < T / 32; grp += NGW) {
        int e0 = 0, e1 = 1; float g0 = 0.f, g1 = 0.f, sav = 0.f;
        for (int rr = 0; rr < 32; ++rr) {
            const int m = grp * 32 + rr;
            f32x4 v[4]; load_row(h + (size_t)m * D, F.lane, v);
            const float rstd = rsqrtf(wave_sum(sumsq16(v)) * (1.f / D) + EPS);
#pragma unroll
            for (int j = 0; j < 4; ++j) v[j] = v[j] * rstd * gv[j];
            float am = 0.f;
#pragma unroll
            for (int j = 0; j < 4; ++j) am = fmaxf(fmaxf(am, fmaxf(fabsf(v[j].x), fabsf(v[j].y))), fmaxf(fabsf(v[j].z), fabsf(v[j].w)));
            am = wave_max(am);
            const float qinv = am > 0.f ? 127.f / am : 0.f;
            { unsigned* o4 = (unsigned*)(dst + (size_t)m * D) + F.lane;
#pragma unroll
              for (int j = 0; j < 4; ++j) { const int b0 = __float2int_rn(v[j].x * qinv), b1 = __float2int_rn(v[j].y * qinv), b2 = __float2int_rn(v[j].z * qinv), b3 = __float2int_rn(v[j].w * qinv);
                  o4[64 * j] = (unsigned)(b0 & 0xff) | ((unsigned)(b1 & 0xff) << 8) | ((unsigned)(b2 & 0xff) << 16) | ((unsigned)(b3 & 0xff) << 24); } }
            float lg[8];
#pragma unroll
            for (int c = 0; c < 8; ++c) { float s = 0.f;
#pragma unroll
                for (int j = 0; j < 4; ++j)
#pragma unroll
                    for (int e = 0; e < 4; ++e) s += v[j][e] * w8[4 * j + e][c];
                lg[c] = wave_sum(s); }
            int b0 = 0; float v0 = lg[0];
#pragma unroll
            for (int c = 1; c < 8; ++c) if (lg[c] > v0) { v0 = lg[c]; b0 = c; }
            int b1 = -1; float v1 = -INFINITY;
#pragma unroll
            for (int c = 0; c < 8; ++c) if (c != b0 && lg[c] > v1) { v1 = lg[c]; b1 = c; }
            const float ga = 1.f / (1.f + __expf(v1 - v0));
            if (F.lane == rr) { e0 = b0; e1 = b1; g0 = ga; g1 = 1.f - ga; sav = am * (1.f / 127.f); }
        }
        const bool act = F.lane < 32;
#pragma unroll
        for (int e = 0; e < 8; ++e) {
            const unsigned long long m0 = __ballot(act && e0 == e), m1 = __ballot(act && e1 == e);
            const int n0 = __popcll(m0), n1 = __popcll(m1);
            if (n0 + n1 == 0) continue;
            unsigned base = 0;
            if (F.lane == 0) base = __hip_atomic_fetch_add(ctl + CW_CNT + 64 * e, (unsigned)(n0 + n1), __ATOMIC_RELAXED, __HIP_MEMORY_SCOPE_AGENT);
            base = (unsigned)__builtin_amdgcn_readfirstlane((int)base);
            const unsigned long long below = (1ull << F.lane) - 1ull;
            const int tok = grp * 32 + F.lane;
            if (act && e0 == e) { const unsigned off = base + (unsigned)__popcll(m0 & below); row_ts[(size_t)e * CAP + off] = tok * 2; row_gate[(size_t)e * CAP + off] = g0; row_sa[(size_t)e * CAP + off] = sav; }
            if (act && e1 == e) { const unsigned off = base + (unsigned)n0 + (unsigned)__popcll(m1 & below); row_ts[(size_t)e * CAP + off] = tok * 2 + 1; row_gate[(size_t)e * CAP + off] = g1; row_sa[(size_t)e * CAP + off] = sav; }
        }
    }
}
DI void combine_norm(const Frame& F, const Args& a) {
    float* h = a.out; const float* g = a.in[4] + D; const bf16* ym = (const bf16*)(F.ws + WS_YMOE); bf16* dst = (bf16*)(F.ws + WS_HN);
    f32x4 gv[4]; load_row(g, F.lane, gv);
    const int gw = F.vcu * 8 + F.wave, NGW = F.G * 8;
    for (int m = gw; m < T; m += NGW) {
        f32x4 v[4]; load_row(h + (size_t)m * D, F.lane, v);
        const u32x2* y0 = (const u32x2*)(ym + (size_t)m * 2 * D) + F.lane; const u32x2* y1 = (const u32x2*)(ym + (size_t)m * 2 * D + D) + F.lane;
#pragma unroll
        for (int j = 0; j < 4; ++j) { const u32x2 p = y0[64 * j], q = y1[64 * j];
            v[j].x += bflo(p.x) + bflo(q.x); v[j].y += bfhi(p.x) + bfhi(q.x); v[j].z += bflo(p.y) + bflo(q.y); v[j].w += bfhi(p.y) + bfhi(q.y); }
        f32x4* hw = (f32x4*)(h + (size_t)m * D) + F.lane;
#pragma unroll
        for (int j = 0; j < 4; ++j) hw[64 * j] = v[j];
        const float rstd = rsqrtf(wave_sum(sumsq16(v)) * (1.f / D) + EPS);
#pragma unroll
        for (int j = 0; j < 4; ++j) v[j] = v[j] * rstd * gv[j];
        store_bf16_row(dst + (size_t)m * D, F.lane, v);
    }
}
DI void final_norm(const Frame& F, const Args& a) {
    float* h = a.out; const float* g = a.in[5];
    f32x4 gv[4]; load_row(g, F.lane, gv);
    const int gw = F.vcu * 8 + F.wave, NGW = F.G * 8;
    for (int m = gw; m < T; m += NGW) {
        f32x4 v[4]; load_row(h + (size_t)m * D, F.lane, v);
        const float rstd = rsqrtf(wave_sum(sumsq16(v)) * (1.f / D) + EPS);
        f32x4* hw = (f32x4*)(h + (size_t)m * D) + F.lane;
#pragma unroll
        for (int j = 0; j < 4; ++j) hw[64 * j] = v[j] * rstd * gv[j];
    }
}

DI void mixer_a(const Frame& F, const Args& a, int worker, int nworkers) {
    const bf16* U = (const bf16*)(F.ws + WS_U); bf16* Y = (bf16*)(F.ws + WS_Y); const float* cw = a.in[7];
    const size_t nitems = (size_t)T * 64;
    for (size_t it = (size_t)worker * 512 + F.tid; it < nitems; it += (size_t)nworkers * 512) {
        const int t = (int)(it >> 6), c8 = (int)(it & 63) * 8, s = t & (SEQ - 1);
        const u32x4 bg = *(const u32x4*)(U + (size_t)t * EVU + c8);
        const u32x4 z2 = *(const u32x4*)(U + (size_t)t * EVU + 512 + c8);
        u32x4 z1 = (u32x4){0u, 0u, 0u, 0u}, z0 = (u32x4){0u, 0u, 0u, 0u};
        if (s >= 1) z1 = *(const u32x4*)(U + (size_t)(t - 1) * EVU + 512 + c8);
        if (s >= 2) z0 = *(const u32x4*)(U + (size_t)(t - 2) * EVU + 512 + c8);
        float o[8];
#pragma unroll
        for (int q = 0; q < 4; ++q) {
            const int c = c8 + 2 * q;
            const float a0 = cw[c] * bflo(z0[q]) + cw[512 + c] * bflo(z1[q]) + cw[1024 + c] * bflo(z2[q]);
            const float a1 = cw[c + 1] * bfhi(z0[q]) + cw[512 + c + 1] * bfhi(z1[q]) + cw[1024 + c + 1] * bfhi(z2[q]);
            o[2 * q] = bflo(bg[q]) * a0; o[2 * q + 1] = bfhi(bg[q]) * a1;
        }
        u32x4 w; w.x = pk2(o[0], o[1]); w.y = pk2(o[2], o[3]); w.z = pk2(o[4], o[5]); w.w = pk2(o[6], o[7]);
        *(u32x4*)(Y + (size_t)t * D + c8) = w;
    }
}

constexpr int GA_GCS = 0, GA_BTS = 256, GA_KN = 1024, GA_KB = GA_KN + 17408, GA_QN = GA_KB + 17408, GA_VBT = GA_QN + 17408, GA_KGT = GA_VBT + 18432,
              GA_AM = GA_KGT + 18432, GA_TB = GA_AM + 17408, GA_QKS = GA_TB + 9216, GA_CW = GA_QKS + 9216, GA_END = GA_CW + 6144;
static_assert(GA_END <= 155648, "gdn-a lds");
DI void gdn_a(const Frame& F, const Args& a) {
    LAS unsigned char* L = F.lds;
    LAS float* gcs = (LAS float*)(L + GA_GCS); LAS float* bts = (LAS float*)(L + GA_BTS);
    LAS float* Am = (LAS float*)(L + GA_AM);
    const bf16* U = (const bf16*)(F.ws + WS_U); const float* GA = (const float*)(F.ws + WS_GA); const float* BT = (const float*)(F.ws + WS_BETA);
    float* EG = (float*)(F.ws + WS_EG); const float* cw = a.in[8];
    const int lane = F.lane, w = F.wave, r = lane & 31, hh = lane >> 5;
    for (int item = F.vcu; item < 4096; item += F.G) {
        const int bh = item >> 5, n = item & 31, b = bh >> 2, h = bh & 3, t0 = b * SEQ + n * 64;
        unsigned char* Gp = F.ws + WS_G + (size_t)item * G_ITEM;
        if (w == 0) {
            float gc = GA[(size_t)(t0 + lane) * 4 + h];
#pragma unroll
            for (int o = 1; o < 64; o <<= 1) { const float up = __shfl_up(gc, o); if (lane >= o) gc += up; }
            gcs[lane] = gc; bts[lane] = BT[(size_t)(t0 + lane) * 4 + h];
            if (lane == 63) EG[item] = __expf(gc);
        }
        for (int i = F.tid; i < 1536; i += 512) { const int part = i >> 9, rem = i & 511, j = rem >> 7, c = rem & 127; *(LAS float*)(L + GA_CW + i * 4) = cw[j * 1536 + part * 512 + h * 128 + c]; }
        const int g2 = (F.tid >> 4) * 2, c8 = (F.tid & 15) * 8;
        u32x4 xr[3][5];
#pragma unroll
        for (int part = 0; part < 3; ++part)
#pragma unroll
            for (int q = 0; q < 5; ++q) {
                xr[part][q] = (u32x4){0u, 0u, 0u, 0u};
                if (n * 64 + g2 - 3 + q >= 0) xr[part][q] = *(const u32x4*)(U + (size_t)(t0 + g2 - 3 + q) * EVU + 1024 + part * 512 + h * 128 + c8);
            }
        WG_BAR();
        const float glast = gcs[63];
#pragma unroll
        for (int part = 0; part < 3; ++part) {
#pragma unroll
            for (int tk = 0; tk < 2; ++tk) {
                const int tok = g2 + tk;
                float acc[8];
#pragma unroll
                for (int e = 0; e < 8; ++e) acc[e] = 0.f;
#pragma unroll
                for (int j = 0; j < 4; ++j) {
                    const u32x4 xv = xr[part][tk + j];
                    const f32x4 w0 = *(const LAS f32x4*)(L + GA_CW + ((part * 4 + j) * 128 + c8) * 4), w1 = *(const LAS f32x4*)(L + GA_CW + ((part * 4 + j) * 128 + c8 + 4) * 4);
                    acc[0] += w0[0] * bflo(xv[0]); acc[1] += w0[1] * bfhi(xv[0]); acc[2] += w0[2] * bflo(xv[1]); acc[3] += w0[3] * bfhi(xv[1]);
                    acc[4] += w1[0] * bflo(xv[2]); acc[5] += w1[1] * bfhi(xv[2]); acc[6] += w1[2] * bflo(xv[3]); acc[7] += w1[3] * bfhi(xv[3]);
                }
                float ss = 0.f;
#pragma unroll
                for (int e = 0; e < 8; ++e) { acc[e] = silu_f(acc[e]); ss += acc[e] * acc[e]; }
                ss = row16_sum(ss);
                const float beta = bts[tok], gc = gcs[tok];
                if (part == 0) {
                    const float sc = rsqrtf(ss + EPS) * 0.08838834764831845f, eg = __expf(gc);
                    u32x4 o; o.x = pk2(acc[0] * sc, acc[1] * sc); o.y = pk2(acc[2] * sc, acc[3] * sc); o.z = pk2(acc[4] * sc, acc[5] * sc); o.w = pk2(acc[6] * sc, acc[7] * sc);
                    *(LAS u32x4*)(L + GA_QN + tok * 272 + c8 * 2) = o;
                    const float s2 = sc * eg;
                    u32x4 g; g.x = pk2(acc[0] * s2, acc[1] * s2); g.y = pk2(acc[2] * s2, acc[3] * s2); g.z = pk2(acc[4] * s2, acc[5] * s2); g.w = pk2(acc[6] * s2, acc[7] * s2);
                    *(u32x4*)(Gp + G_QG + tok * 256 + c8 * 2) = g;
                } else if (part == 1) {
                    const float sc = rsqrtf(ss + EPS), sb = sc * beta, sg = sb * __expf(gc), sd = sc * __expf(glast - gc);
                    u32x4 o; o.x = pk2(acc[0] * sc, acc[1] * sc); o.y = pk2(acc[2] * sc, acc[3] * sc); o.z = pk2(acc[4] * sc, acc[5] * sc); o.w = pk2(acc[6] * sc, acc[7] * sc);
                    *(LAS u32x4*)(L + GA_KN + tok * 272 + c8 * 2) = o;
                    u32x4 p; p.x = pk2(acc[0] * sb, acc[1] * sb); p.y = pk2(acc[2] * sb, acc[3] * sb); p.z = pk2(acc[4] * sb, acc[5] * sb); p.w = pk2(acc[6] * sb, acc[7] * sb);
                    *(LAS u32x4*)(L + GA_KB + tok * 272 + c8 * 2) = p;
                    u32x4 d; d.x = pk2(acc[0] * sd, acc[1] * sd); d.y = pk2(acc[2] * sd, acc[3] * sd); d.z = pk2(acc[4] * sd, acc[5] * sd); d.w = pk2(acc[6] * sd, acc[7] * sd);
                    *(u32x4*)(Gp + G_KD + tok * 256 + c8 * 2) = d;
#pragma unroll
                    for (int e = 0; e < 8; ++e) *(LAS bf16*)(L + GA_KGT + (c8 + e) * 144 + tok * 2) = (bf16)(pk2(acc[e] * sg, 0.f) & 0xffffu);
                } else {
#pragma unroll
                    for (int e = 0; e < 8; ++e) *(LAS bf16*)(L + GA_VBT + (c8 + e) * 144 + tok * 2) = (bf16)(pk2(acc[e] * beta, 0.f) & 0xffffu);
                }
            }
        }
        WG_BAR();
        {
            const int mat = w >> 2, ti = (w >> 1) & 1, tj = w & 1;
            f32x16 x = zero16();
            if (ti >= tj) {
                const LAS unsigned char* ap = L + (mat ? GA_QN : GA_KB) + (32 * ti + r) * 272 + hh * 16;
                const LAS unsigned char* bp = L + GA_KN + (32 * tj + r) * 272 + hh * 16;
#pragma unroll
                for (int s = 0; s < 8; ++s) x = MFMA32(*(const LAS bf16x8*)(ap + 32 * s), *(const LAS bf16x8*)(bp + 32 * s), x);
            }
            const int j = 32 * tj + r; const float gj = gcs[j];
#pragma unroll
            for (int reg = 0; reg < 16; ++reg) {
                const int i = 32 * ti + crow(reg, hh);
                const float dec = __expf(gcs[i] - gj);
                if (mat == 0) Am[i * 68 + j] = (i > j) ? x[reg] * dec : 0.f;
                else *(LAS bf16*)(L + GA_QKS + i * 144 + j * 2) = (bf16)(pk2((i >= j) ? x[reg] * dec : 0.f, 0.f) & 0xffffu);
            }
        }
        WG_BAR();
        if (w == 0) {
            const int blk = hh, col = r;
            float Tr[32];
            const LAS float* Ab = Am + (blk * 32) * 68 + blk * 32;
#pragma unroll
            for (int i = 0; i < 32; ++i) {
                float acc = (i == col) ? 1.f : 0.f;
#pragma unroll
                for (int j = 0; j < i; ++j) acc -= Ab[i * 68 + j] * Tr[j];
                Tr[i] = acc;
            }
#pragma unroll
            for (int i = 0; i < 32; ++i) *(LAS bf16*)(L + GA_TB + (blk * 32 + i) * 144 + (blk * 32 + col) * 2) = (bf16)(pk2(Tr[i], 0.f) & 0xffffu);
#pragma unroll
            for (int i = 0; i < 16; ++i) *(LAS bf16*)(L + GA_TB + (2 * i + blk) * 144 + (32 + col) * 2) = (bf16)0;
            f32x16 P = zero16();
#pragma unroll
            for (int s = 0; s < 2; ++s) {
                const LAS float* arow = Am + (32 + r) * 68 + 16 * s + 8 * hh;
                const f32x4 a0 = *(const LAS f32x4*)arow, a1 = *(const LAS f32x4*)(arow + 4);
                const bf16x8 af = __builtin_bit_cast(bf16x8, pg8::pack8(a0, a1));
                float tv[8];
#pragma unroll
                for (int jj = 0; jj < 8; ++jj) { const float lo = Tr[16 * s + jj]; const float hi = __shfl(Tr[16 * s + 8 + jj], r); tv[jj] = hh ? hi : lo; }
                u32x4 tb; tb.x = pk2(tv[0], tv[1]); tb.y = pk2(tv[2], tv[3]); tb.z = pk2(tv[4], tv[5]); tb.w = pk2(tv[6], tv[7]);
                P = MFMA32(af, __builtin_bit_cast(bf16x8, tb), P);
            }
            f32x16 R = zero16();
#pragma unroll
            for (int s = 0; s < 2; ++s) {
                const LAS unsigned char* tp = L + GA_TB + (32 + r) * 144 + (32 + 16 * s + 4 * hh) * 2;
                const s16x4 lo = *(const LAS s16x4*)tp, hi = *(const LAS s16x4*)(tp + 16);
                R = MFMA32(cat8(lo, hi), pack_step(P, s), R);
            }
#pragma unroll
            for (int reg = 0; reg < 16; ++reg) *(LAS bf16*)(L + GA_TB + (32 + crow(reg, hh)) * 144 + r * 2) = (bf16)(pk2(-R[reg], 0.f) & 0xffffu);
        } else {
            for (int p = F.tid - 64; p < 512; p += 448) { const int row = p >> 3, c = p & 7; *(u32x4*)(Gp + G_QK + row * 128 + c * 16) = *(const LAS u32x4*)(L + GA_QKS + row * 144 + c * 16); }
        }
        WG_BAR();
        if (w < 4) {
#pragma unroll
            for (int q = 0; q < 2; ++q) {
                const int idx = w * 2 + q, ib = idx >> 2, db = idx & 3;
                f32x16 x = zero16();
                const LAS unsigned char* ap = L + GA_TB + (32 * ib + r) * 144 + hh * 16;
                const LAS unsigned char* bp = L + GA_VBT + (32 * db + r) * 144 + hh * 16;
#pragma unroll
                for (int s = 0; s < 4; ++s) if (ib || s < 2) x = MFMA32(*(const LAS bf16x8*)(ap + 32 * s), *(const LAS bf16x8*)(bp + 32 * s), x);
#pragma unroll
                for (int g = 0; g < 4; ++g) { u32x2 o; o.x = pk2(x[4 * g], x[4 * g + 1]); o.y = pk2(x[4 * g + 2], x[4 * g + 3]);
                    *(u32x2*)(Gp + G_UT + ((32 * db + r) * 64 + 32 * ib + 8 * g + 4 * hh) * 2) = o; }
            }
        } else {
#pragma unroll
            for (int q = 0; q < 2; ++q) {
                const int idx = (w - 4) * 2 + q, dkb = idx >> 1, ib = idx & 1;
                f32x16 x = zero16();
                const LAS unsigned char* ap = L + GA_KGT + (32 * dkb + r) * 144 + hh * 16;
                const LAS unsigned char* bp = L + GA_TB + (32 * ib + r) * 144 + hh * 16;
#pragma unroll
                for (int s = 0; s < 4; ++s) if (ib || s < 2) x = MFMA32(*(const LAS bf16x8*)(ap + 32 * s), *(const LAS bf16x8*)(bp + 32 * s), x);
#pragma unroll
                for (int g = 0; g < 4; ++g) { u32x2 o; o.x = pk2(x[4 * g], x[4 * g + 1]); o.y = pk2(x[4 * g + 2], x[4 * g + 3]);
                    *(u32x2*)(Gp + G_W + ((32 * ib + r) * 128 + 32 * dkb + 8 * g + 4 * hh) * 2) = o; }
            }
        }
        WG_BAR();
    }
}

constexpr int GB_ST = 0, GB_W = 34816, GB_QG = GB_W + 17408, GB_KD = GB_QG + 17408, GB_QK = GB_KD + 20480, GB_O = GB_QK + 9216, GB_END = GB_O + 33792;
static_assert(GB_END <= 140000, "gdn-b lds");
DI void gdn_b(const Frame& F, const Args& a, int worker, int nworkers) {
    LAS unsigned char* L = F.lds;
    const bf16* U = (const bf16*)(F.ws + WS_U); bf16* Y = (bf16*)(F.ws + WS_Y); const float* EG = (const float*)(F.ws + WS_EG); const float* gn = a.in[11];
    const int lane = F.lane, w = F.wave, r = lane & 31, hh = lane >> 5, dvb = w & 3, hf = w >> 2;
    const int q4 = (lane & 15) >> 2, p4 = lane & 3, g1 = (lane >> 4) & 1;
    const float gn0 = gn[2 * lane], gn1 = gn[2 * lane + 1];
    const unsigned src_t = (unsigned)F.tid * 16u;
    const unsigned dst_w = (unsigned)((F.tid >> 4) * 272 + (F.tid & 15) * 16);
    const unsigned dst_k = (unsigned)((F.tid >> 4) * 320 + (F.tid & 15) * 16);
    const unsigned dst_q = (unsigned)((F.tid >> 3) * 144 + (F.tid & 7) * 16);
    const unsigned ut_t = (unsigned)(((32 * dvb + r) * 64 + 4 * hh) * 2);
    for (int bh = worker; bh < 128; bh += nworkers) {
        const int b = bh >> 2, h = bh & 3;
        f32x16 Sacc[2] = {zero16(), zero16()};
        for (int p = F.tid; p < 34816 / 16; p += 512) *(LAS u32x4*)(L + GB_ST + p * 16) = (u32x4){0u, 0u, 0u, 0u};
        u32x4 nop[7]; u32x2 nui[2][4]; float neg; unsigned nog[8];
#define GB_PREFETCH(nn) do { const int _item = bh * 32 + (nn); const unsigned char* _Gp = F.ws + WS_G + (size_t)_item * G_ITEM; \
            unsigned _so = src_t, _uo = ut_t; asm volatile("" : "+v"(_so), "+v"(_uo)); \
            _Pragma("unroll") for (int k = 0; k < 7; ++k) { const unsigned char* _bk = _Gp + (8192 * k + (k >= 2 ? 16384 : 0)); nop[k] = *(const u32x4*)(_bk + _so); } \
            _Pragma("unroll") for (int tb = 0; tb < 2; ++tb) _Pragma("unroll") for (int g = 0; g < 4; ++g) { const unsigned char* _bu = _Gp + G_UT + (64 * tb + 16 * g); nui[tb][g] = *(const u32x2*)(_bu + _uo); } \
            neg = EG[_item]; \
            const bf16* _og = U + (size_t)(b * SEQ + (nn) * 64 + w * 8) * EVU + 2560 + h * 128; \
            unsigned _lo = (unsigned)lane * 4u; asm volatile("" : "+v"(_lo)); \
            _Pragma("unroll") for (int k = 0; k < 8; ++k) { const unsigned char* _bo = (const unsigned char*)(_og + (size_t)k * EVU); nog[k] = *(const unsigned*)(_bo + _lo); } } while (0)
        GB_PREFETCH(0);
        for (int n = 0; n < 32; ++n) {
            const int t0 = b * SEQ + n * 64;
            *(LAS u32x4*)(L + GB_W + dst_w) = nop[0]; *(LAS u32x4*)(L + GB_W + dst_w + 32 * 272) = nop[1];
            *(LAS u32x4*)(L + GB_QG + dst_w) = nop[2]; *(LAS u32x4*)(L + GB_QG + dst_w + 32 * 272) = nop[3];
            *(LAS u32x4*)(L + GB_KD + dst_k) = nop[4]; *(LAS u32x4*)(L + GB_KD + dst_k + 32 * 320) = nop[5];
            *(LAS u32x4*)(L + GB_QK + dst_q) = nop[6];
            u32x2 ui[2][4]; unsigned og[8];
#pragma unroll
            for (int tb = 0; tb < 2; ++tb)
#pragma unroll
                for (int g = 0; g < 4; ++g) ui[tb][g] = nui[tb][g];
#pragma unroll
            for (int k = 0; k < 8; ++k) og[k] = nog[k];
            const float eg = neg;
            WG_BAR();
            if (n + 1 < 32) GB_PREFETCH(n + 1);
            f32x16 x0 = zero16(), x1 = zero16(), o = zero16();
            {
                const LAS unsigned char* sp = L + GB_ST + (32 * dvb + r) * 272 + hh * 16;
                const LAS unsigned char* wp = L + GB_W + r * 272 + hh * 16;
                const LAS unsigned char* qp = L + GB_QG + (32 * hf + r) * 272 + hh * 16;
#pragma unroll
                for (int s = 0; s < 8; ++s) {
                    const bf16x8 sf = *(const LAS bf16x8*)(sp + 32 * s);
                    x0 = MFMA32(*(const LAS bf16x8*)(wp + 32 * s), sf, x0);
                    x1 = MFMA32(*(const LAS bf16x8*)(wp + 32 * 272 + 32 * s), sf, x1);
                    o = MFMA32(*(const LAS bf16x8*)(qp + 32 * s), sf, o);
                }
            }
            bf16x8 pv[2][2];
#pragma unroll
            for (int g = 0; g < 4; ++g) {
                x0[4 * g] = bflo(ui[0][g].x) - x0[4 * g]; x0[4 * g + 1] = bfhi(ui[0][g].x) - x0[4 * g + 1]; x0[4 * g + 2] = bflo(ui[0][g].y) - x0[4 * g + 2]; x0[4 * g + 3] = bfhi(ui[0][g].y) - x0[4 * g + 3];
                x1[4 * g] = bflo(ui[1][g].x) - x1[4 * g]; x1[4 * g + 1] = bfhi(ui[1][g].x) - x1[4 * g + 1]; x1[4 * g + 2] = bflo(ui[1][g].y) - x1[4 * g + 2]; x1[4 * g + 3] = bfhi(ui[1][g].y) - x1[4 * g + 3];
            }
            pv[0][0] = pack_step(x0, 0); pv[0][1] = pack_step(x0, 1); pv[1][0] = pack_step(x1, 0); pv[1][1] = pack_step(x1, 1);
#pragma unroll
            for (int tb = 0; tb < 2; ++tb) {
                if (tb <= hf) {
#pragma unroll
                    for (int s = 0; s < 2; ++s) {
                        const LAS unsigned char* kp = L + GB_QK + (32 * hf + r) * 144 + (32 * tb + 16 * s + 4 * hh) * 2;
                        o = MFMA32(cat8(*(const LAS s16x4*)kp, *(const LAS s16x4*)(kp + 16)), pv[tb][s], o);
                    }
                }
            }
            {
                LAS float* Ol = (LAS float*)(L + GB_O) + (32 * hf + 4 * hh) * 132 + 32 * dvb + r;
#pragma unroll
                for (int reg = 0; reg < 16; ++reg) Ol[((reg & 3) + 8 * (reg >> 2)) * 132] = o[reg];
            }
#pragma unroll
            for (int d2 = 0; d2 < 2; ++d2) {
                const int db = 2 * hf + d2;
                f32x16 x = Sacc[d2] * eg;
                const LAS unsigned char* kb = L + GB_KD + (4 * hh + q4) * 320 + (32 * db + 16 * g1 + 4 * p4) * 2;
#pragma unroll
                for (int tb = 0; tb < 2; ++tb)
#pragma unroll
                    for (int s = 0; s < 2; ++s) {
                        const LAS unsigned char* kp = kb + (32 * tb + 16 * s) * 320;
                        x = MFMA32(cat8(vtr(kp), vtr(kp + 8 * 320)), pv[tb][s], x);
                    }
                Sacc[d2] = x;
            }
            WG_BAR();
#pragma unroll
            for (int d2 = 0; d2 < 2; ++d2) {
                const int db = 2 * hf + d2;
#pragma unroll
                for (int g = 0; g < 4; ++g) { u32x2 ov; ov.x = pk2(Sacc[d2][4 * g], Sacc[d2][4 * g + 1]); ov.y = pk2(Sacc[d2][4 * g + 2], Sacc[d2][4 * g + 3]);
                    *(LAS u32x2*)(L + GB_ST + (32 * dvb + r) * 272 + (32 * db + 8 * g + 4 * hh) * 2) = ov; }
            }
            {
                const LAS float* Ol = (const LAS float*)(L + GB_O) + (w * 8) * 132 + 2 * lane;
                bf16* yp = Y + (size_t)(t0 + w * 8) * D + 512 + h * 128 + 2 * lane;
#pragma unroll
                for (int k = 0; k < 8; ++k) {
                    const f32x2_t v = *(const LAS f32x2_t*)(Ol + k * 132);
                    const float rstd = rsqrtf(wave_sum(v.x * v.x + v.y * v.y) * (1.f / 128.f) + EPS);
                    *(unsigned*)(yp + (size_t)k * D) = pk2(v.x * rstd * gn0 * silu_f(bflo(og[k])), v.y * rstd * gn1 * silu_f(bfhi(og[k])));
                }
            }
        }
        WG_BAR();
    }
#undef GB_PREFETCH
}

constexpr int AT_STAGE = 38912, AT_K = 0, AT_V = 18432, AT_BIAS = 2 * AT_STAGE, AT_END = AT_BIAS + 512;
DI void attn_stage_load(const bf16* U1, int trow, int h, int tid, u32x4 (&st)[4]) {
#pragma unroll
    for (int p = 0; p < 4; ++p) { const int idx = tid + 512 * p, row = idx >> 5, c = idx & 31;
        st[p] = *(const u32x4*)(U1 + (size_t)(trow + row) * OD_N + (c < 16 ? 512 + h * 128 + c * 8 : 1024 + h * 128 + (c - 16) * 8)); }
}
DI void attn_stage_store(LAS unsigned char* sb, int tid, const u32x4 (&st)[4]) {
#pragma unroll
    for (int p = 0; p < 4; ++p) { const int idx = tid + 512 * p, row = idx >> 5, c = idx & 31;
        if (c < 16) { const int e = c * 8, mp = e >> 6, wi = e & 63; *(LAS u32x4*)(sb + AT_K + mp * 9216 + row * 144 + wi * 2) = st[p]; }
        else *(LAS u32x4*)(sb + AT_V + row * 320 + (c - 16) * 16) = st[p]; }
}
DI void attn_phase(const Frame& F, const Args& a) {
    LAS unsigned char* L = F.lds;
    const bf16* U1 = (const bf16*)(F.ws + WS_U); bf16* Y = (bf16*)(F.ws + WS_Y);
    const float* lamp = a.in[14]; const float* dng = a.in[15]; const float* relb = a.in[21];
    const int lane = F.lane, w = F.wave, r = lane & 31, hh = lane >> 5, mp = w >> 2, qs = w & 3;
    const int q4 = (lane & 15) >> 2, p4 = lane & 3, g1 = (lane >> 4) & 1;
    const float lam = __expf(wave_sum(lamp[lane] * lamp[64 + lane])) - __expf(wave_sum(lamp[128 + lane] * lamp[192 + lane])) + LAMBDA_INIT;
    const float c1 = 0.125f * LOG2E;
    LAS float* btab = (LAS float*)(L + AT_BIAS);
    LAS float* exch = (LAS float*)L;
    for (int item = F.vcu; item < 256; item += F.G) {
        const int bh = item >> 1, par = item & 1, b = bh >> 2, h = bh & 3, trow0 = b * SEQ;
        WG_BAR();
        if (F.tid < 128) { const int n = F.tid; int bucket = n;
            if (n >= 16) { const int lg = 16 + (int)(__logf((float)n / 16.f) / 2.0794415416798357f * 16.f); bucket = lg < 31 ? lg : 31; }
            btab[n] = relb[bucket * 4 + h] * LOG2E; }
        const float bias_far = relb[31 * 4 + h] * LOG2E;
        for (int ui = 0; ui < 8; ++ui) {
            const int qblk = 2 * ui + ((ui ^ par) & 1);
            const int q0 = qblk * 128 + qs * 32, qpos = q0 + r, ntiles = 2 * (qblk + 1);
            bf16x8 qf[4];
            { const bf16* qp = U1 + (size_t)(trow0 + qpos) * OD_N + h * 128 + mp * 64 + 8 * hh;
#pragma unroll
              for (int s = 0; s < 4; ++s) qf[s] = *(const bf16x8*)(qp + 16 * s); }
            f32x16 O[4] = {zero16(), zero16(), zero16(), zero16()};
            float mrun = -INFINITY, lrun = 0.f;
            u32x4 st[4];
            attn_stage_load(U1, trow0, h, F.tid, st);
            attn_stage_store(L, F.tid, st);
            WG_BAR();
            for (int kt = 0; kt < ntiles; ++kt) {
                const bool more = kt + 1 < ntiles;
                if (more) attn_stage_load(U1, trow0 + (kt + 1) * 64, h, F.tid, st);
                const int key0 = kt * 64;
                if (key0 <= q0 + 31) {
                    const LAS unsigned char* sb = L + (kt & 1) * AT_STAGE;
                    const LAS unsigned char* kb = sb + AT_K + mp * 9216 + r * 144 + hh * 16;
                    f32x16 x0 = zero16(), x1 = zero16();
#pragma unroll
                    for (int s = 0; s < 4; ++s) { x0 = MFMA32(*(const LAS bf16x8*)(kb + 32 * s), qf[s], x0); x1 = MFMA32(*(const LAS bf16x8*)(kb + 32 * 144 + 32 * s), qf[s], x1); }
                    if (q0 - (key0 + 63) >= 128) {
#pragma unroll
                        for (int reg = 0; reg < 16; ++reg) { x0[reg] = x0[reg] * c1 + bias_far; x1[reg] = x1[reg] * c1 + bias_far; }
                    } else {
#pragma unroll
                        for (int reg = 0; reg < 16; ++reg) {
                            const int d0 = qpos - (key0 + crow(reg, hh)), d1 = d0 - 32;
                            const float b0 = btab[d0 < 0 ? 0 : (d0 > 127 ? 127 : d0)], b1 = btab[d1 < 0 ? 0 : (d1 > 127 ? 127 : d1)];
                            x0[reg] = (d0 >= 0) ? x0[reg] * c1 + b0 : -INFINITY; x1[reg] = (d1 >= 0) ? x1[reg] * c1 + b1 : -INFINITY;
                        }
                    }
                    float mx = x0[0];
#pragma unroll
                    for (int reg = 1; reg < 16; ++reg) mx = fmaxf(mx, x0[reg]);
#pragma unroll
                    for (int reg = 0; reg < 16; ++reg) mx = fmaxf(mx, x1[reg]);
                    mx = fmaxf(mx, __shfl_xor(mx, 32));
                    if (__any(mx - mrun > 6.f)) {
                        const float mnew = fmaxf(mrun, mx), alpha = __builtin_amdgcn_exp2f(mrun - mnew); mrun = mnew;
                        lrun *= alpha;
#pragma unroll
                        for (int db = 0; db < 4; ++db) O[db] = O[db] * alpha;
                    }
                    float rs = 0.f;
#pragma unroll
                    for (int reg = 0; reg < 16; ++reg) { x0[reg] = __builtin_amdgcn_exp2f(x0[reg] - mrun); x1[reg] = __builtin_amdgcn_exp2f(x1[reg] - mrun); rs += x0[reg] + x1[reg]; }
                    lrun += rs;
                    bf16x8 pf[2][2]; pf[0][0] = pack_step(x0, 0); pf[0][1] = pack_step(x0, 1); pf[1][0] = pack_step(x1, 0); pf[1][1] = pack_step(x1, 1);
                    const LAS unsigned char* vb = sb + AT_V + (4 * hh + q4) * 320 + (16 * g1 + 4 * p4) * 2;
#pragma unroll
                    for (int db = 0; db < 4; ++db)
#pragma unroll
                        for (int kh = 0; kh < 2; ++kh)
#pragma unroll
                            for (int s = 0; s < 2; ++s) {
                                const LAS unsigned char* vp = vb + (32 * kh + 16 * s) * 320 + 64 * db;
                                O[db] = MFMA32(cat8(vtr(vp), vtr(vp + 8 * 320)), pf[kh][s], O[db]);
                            }
                }
                if (more) attn_stage_store(L + ((kt + 1) & 1) * AT_STAGE, F.tid, st);
                WG_BAR();
            }
            const float ltot = lrun + __shfl_xor(lrun, 32);
            const float inv = 1.f / ltot;
            if (mp == 1) {
                const float sc = inv * lam;
#pragma unroll
                for (int db = 0; db < 4; ++db)
#pragma unroll
                    for (int reg = 0; reg < 16; ++reg) exch[(qs * 64 + db * 16 + reg) * 64 + lane] = O[db][reg] * sc;
            }
            WG_BAR();
            if (mp == 0) {
                float ss = 0.f;
#pragma unroll
                for (int db = 0; db < 4; ++db)
#pragma unroll
                    for (int reg = 0; reg < 16; ++reg) { const float o = O[db][reg] * inv - exch[(qs * 64 + db * 16 + reg) * 64 + lane]; O[db][reg] = o; ss += o * o; }
                ss += __shfl_xor(ss, 32);
                const float rstd = rsqrtf(ss * (1.f / 128.f) + EPS) * (1.f - LAMBDA_INIT);
                bf16* yp = Y + (size_t)(trow0 + qpos) * D + h * 128;
#pragma unroll
                for (int db = 0; db < 4; ++db)
#pragma unroll
                    for (int g = 0; g < 4; ++g) { const int d = 32 * db + 8 * g + 4 * hh; const f32x4 gv = *(const f32x4*)(dng + d);
                        u32x2 o; o.x = pk2(O[db][4 * g] * rstd * gv[0], O[db][4 * g + 1] * rstd * gv[1]); o.y = pk2(O[db][4 * g + 2] * rstd * gv[2], O[db][4 * g + 3] * rstd * gv[3]);
                        *(u32x2*)(yp + d) = o; }
            }
            WG_BAR();
        }
    }
}

constexpr int CF_GLU = 0, CF_RED = 96256, CF_STAT = CF_RED + 4096, CF_END = CF_STAT + 512;
DI void conformer_phase(const Frame& F, const Args& a) {
    LAS unsigned char* L = F.lds;
    const bf16* U1 = (const bf16*)(F.ws + WS_U); bf16* Y = (bf16*)(F.ws + WS_Y);
    const float* cw = a.in[16]; const float* cb = a.in[17]; const float* lg = a.in[18]; const float* lb = a.in[19];
    const int c = F.tid;
    float wv[31];
#pragma unroll
    for (int j = 0; j < 31; ++j) wv[j] = cw[j * 512 + c];
    const float bias = cb[c], lng = lg[c], lnb = lb[c];
    LAS float* red = (LAS float*)(L + CF_RED); LAS float* stat = (LAS float*)(L + CF_STAT);
    for (int tile = F.vcu; tile < T / 64; tile += F.G) {
        const int t0 = tile * 64, s0 = t0 & (SEQ - 1);
        WG_BAR();
        for (int it = F.tid; it < 94 * 64; it += 512) {
            const int row = it >> 6, c8 = (it & 63) * 8;
            u32x4 o = (u32x4){0u, 0u, 0u, 0u};
            if (s0 + row - 30 >= 0) {
                const bf16* up = U1 + (size_t)(t0 + row - 30) * OD_N + 1536 + c8;
                const u32x4 ga = *(const u32x4*)up, gb = *(const u32x4*)(up + 512);
#pragma unroll
                for (int q = 0; q < 4; ++q) o[q] = pk2(bflo(ga[q]) * sigmoid_f(bflo(gb[q])), bfhi(ga[q]) * sigmoid_f(bfhi(gb[q])));
            }
            *(LAS u32x4*)(L + CF_GLU + row * 1024 + c8 * 2) = o;
        }
        WG_BAR();
        float out[64];
#pragma unroll
        for (int tt = 0; tt < 64; ++tt) {
            float acc = bias;
#pragma unroll
            for (int j = 0; j < 31; ++j) acc += wv[j] * bf2f(*(const LAS bf16*)(L + CF_GLU + (tt + j) * 1024 + c * 2));
            out[tt] = acc;
            const float s1 = wave_sum(acc), s2 = wave_sum(acc * acc);
            if (F.lane == 0) { red[(tt * 8 + F.wave) * 2] = s1; red[(tt * 8 + F.wave) * 2 + 1] = s2; }
        }
        WG_BAR();
        if (F.tid < 64) { float s1 = 0.f, s2 = 0.f;
#pragma unroll
            for (int q = 0; q < 8; ++q) { s1 += red[(F.tid * 8 + q) * 2]; s2 += red[(F.tid * 8 + q) * 2 + 1]; }
            const float mean = s1 * (1.f / 512.f); const float var = fmaxf(s2 * (1.f / 512.f) - mean * mean, 0.f);
            stat[F.tid * 2] = mean; stat[F.tid * 2 + 1] = rsqrtf(var + EPS); }
        WG_BAR();
#pragma unroll
        for (int tt = 0; tt < 64; ++tt) {
            const float v = (out[tt] - stat[tt * 2]) * stat[tt * 2 + 1] * lng + lnb;
            Y[(size_t)(t0 + tt) * D + 512 + c] = (bf16)(pk2(silu_f(v), 0.f) & 0xffffu);
        }
    }
}

constexpr int NPH = 26;
__global__ void __launch_bounds__(512, 2) fwd_kernel(Args args) {
    extern __shared__ __attribute__((aligned(16))) unsigned char lds_raw[];
    Frame F;
    F.lds = (LAS unsigned char*)lds_raw; F.ws = args.ws;
    F.tid = threadIdx.x; F.lane = F.tid & 63; F.wave = __builtin_amdgcn_readfirstlane(F.tid >> 6);
    F.G = gridDim.x; { const int bx = blockIdx.x; F.vcu = (F.G % 8 == 0) ? (bx % 8) * (F.G / 8) + bx / 8 : bx; }
    volatile LAS unsigned* MISC = (volatile LAS unsigned*)(F.lds + LDS_MISC);
    if (F.tid < 64) MISC[F.tid] = 0u;
    __syncthreads();
    unsigned* ctl = (unsigned*)(F.ws + WS_CTL);
    const bool multi = (args.ph_hi - args.ph_lo) > 1;
    XcdBarrier bar; bar.bar = ctl + CW_BAR; bar.x = 0; bar.st = MISC + 8;
    if (multi) bar = xcd_barrier_post(ctl + CW_BAR, MISC + 8);
    const int lo = args.ph_lo, hi = args.ph_hi;
#define IN(k) (lo <= (k) && (k) < hi)
#define SEAM(k) do { if (IN(k) && IN((k) + 1)) xcd_barrier(bar); } while (0)
    unsigned char* ws = F.ws;
    bf16* HN = (bf16*)(ws + WS_HN); bf16* UB = (bf16*)(ws + WS_U); bf16* YB = (bf16*)(ws + WS_Y);
    const int bx = (int)blockIdx.x;

    if (IN(0)) { convert_weights(F, args); moe_absmax(F, args); norm_mix0(F, args); } SEAM(0);
    if (IN(1)) { pg8::SchedDense S; S.init(HN, ws + W_EVIN, T, EV_N, D, F.G, bx); pg8::EpiEvIn E{UB}; pg8::gemm_phase(F.lds, S, E); } SEAM(1);
    if (IN(2)) { gdn_a(F, args); } SEAM(2);
    if (IN(3)) { if ((bx & 1) == 0) gdn_b(F, args, bx >> 1, (F.G + 1) >> 1); else { mixer_a(F, args, bx >> 1, F.G >> 1); moe_quant(F, args, bx >> 1, F.G >> 1); } } SEAM(3);
    if (IN(4)) { pg8::SchedDense S; S.init(YB, ws + W_EVOUT, T, D, D, F.G, bx); pg8::EpiResid E{args.in[0], args.out}; pg8::gemm_phase(F.lds, S, E); } SEAM(4);
    if (IN(5)) { norm_plain(F, args.out, args.in[3], HN); } SEAM(5);
    if (IN(6)) { pg8::SchedDense S; S.init(HN, ws + W_FFGU, T, 2 * DFF, D, F.G, bx); pg8::EpiSwiGLU E{UB, DFF}; pg8::gemm_phase(F.lds, S, E); } SEAM(6);
    if (IN(7)) { pg8::SchedDense S; S.init(UB, ws + W_FFD, T, D, DFF, F.G, bx); pg8::EpiResid E{args.out, args.out}; pg8::gemm_phase(F.lds, S, E); } SEAM(7);
    if (IN(8)) { norm_plain(F, args.out, args.in[4], HN); convert_p(F, args.in[1], (bf16*)(ws + WS_GX)); } SEAM(8);
    if (IN(9)) { pg8::SchedDense S; S.init(ws + WS_GX, ws + W_PPROJ, T, D, 256, F.G, bx); pg8::EpiStoreBf16 E{UB, D}; pg8::gemm_phase(F.lds, S, E); } SEAM(9);
    if (IN(10)) { pg8::SchedDense S; S.init(HN, ws + W_PGATE, T, D, D, F.G, bx); pg8::EpiPleGate E{args.out, UB}; pg8::gemm_phase(F.lds, S, E); } SEAM(10);
    if (IN(11)) { norm_plain(F, args.out, args.in[2] + D, HN); } SEAM(11);
    if (IN(12)) { pg8::SchedDense S; S.init(HN, ws + W_ODIN, T, OD_N, D, F.G, bx); pg8::EpiStoreBf16 E{UB, OD_N}; pg8::gemm_phase(F.lds, S, E); } SEAM(12);
    if (IN(13)) { attn_phase(F, args); conformer_phase(F, args); } SEAM(13);
    if (IN(14)) { pg8::SchedDense S; S.init(YB, ws + W_ODOUT, T, D, D, F.G, bx); pg8::EpiResid E{args.out, args.out}; pg8::gemm_phase(F.lds, S, E); } SEAM(14);
    if (IN(15)) { norm_router(F, args); } SEAM(15);
#define MOE_PART(part, phg, phd) \
    if (IN(phg) || IN(phd)) { \
        LAS int* tab = (LAS int*)(F.lds + LDS_MISC + 256); \
        if (F.tid == 0) { int pb = 0; for (int e = 0; e < 8; ++e) { const int c = (int)__hip_atomic_load(ctl + CW_CNT + 64 * e, __ATOMIC_RELAXED, __HIP_MEMORY_SCOPE_AGENT); tab[e] = c; tab[8 + e] = pb; pb += (c + 255) >> 8; } tab[16] = pb; } \
        __syncthreads(); \
        const int nbt = tab[16]; int nMp = nbt - (part) * MOE_NBP; nMp = nMp < 0 ? 0 : (nMp > MOE_NBP ? MOE_NBP : nMp); \
        if (IN(phg)) { pg8::SchedMoeGU S; S.A = (const char*)HN; S.Bt = (const char*)(ws + W_MGU); S.K = D / 2; S.nM = nMp; S.nN = 2 * DFE / 256; S.G = F.G; S.c = bx; S.blk0 = (part) * MOE_NBP; S.bstride = (size_t)2 * DFE * D; \
            S.row_ts = (const int*)(ws + WS_ROWTS); S.tab = tab; S.gather = true; pg8::EpiSwiGLUI8 E{(bf16*)(ws + WS_GX), DFE, (const float*)(ws + WS_ROWSA), (const float*)(ws + WS_SB)}; pg8::gemm_phase(F.lds, S, E); } \
        SEAM(phg); \
        if (IN(phd)) { pg8::SchedMoeDown S; S.A = (const char*)(ws + WS_GX); S.Bt = (const char*)(ws + W_MD); S.K = DFE; S.nM = nMp; S.nN = D / 256; S.G = F.G; S.c = bx; S.blk0 = (part) * MOE_NBP; S.bstride = (size_t)D * DFE * 2; \
            S.row_ts = (const int*)(ws + WS_ROWTS); S.tab = tab; S.gather = false; pg8::EpiMoeDown E{(bf16*)(ws + WS_YMOE), (const int*)(ws + WS_ROWTS), (const float*)(ws + WS_ROWGATE)}; pg8::gemm_phase(F.lds, S, E); } \
        SEAM(phd); \
    }
    MOE_PART(0, 16, 17)
    MOE_PART(1, 18, 19)
    MOE_PART(2, 20, 21)
    if (IN(22)) { combine_norm(F, args); convert_p(F, args.in[1] + (size_t)T * 256, (bf16*)(ws + WS_GX)); } SEAM(22);
    if (IN(23)) { pg8::SchedDense S; S.init(ws + WS_GX, ws + W_PPROJ + (size_t)D * 256 * 2, T, D, 256, F.G, bx); pg8::EpiStoreBf16 E{UB, D}; pg8::gemm_phase(F.lds, S, E); } SEAM(23);
    if (IN(24)) { pg8::SchedDense S; S.init(HN, ws + W_PGATE + (size_t)D * D * 2, T, D, D, F.G, bx); pg8::EpiPleGate E{args.out, UB}; pg8::gemm_phase(F.lds, S, E); } SEAM(24);
    if (IN(25)) { final_norm(F, args); }
#undef IN
#undef SEAM
}

#ifndef MK_MULTI_LAUNCH
#define MK_MULTI_LAUNCH 0
#endif
extern "C" void kernel_launch(void* const* d_in, const int* in_sizes, int n_in, void* d_out, int out_size, void* d_ws, size_t ws_size, hipStream_t stream) {
    static int grid = 0;
    if (grid == 0) {
        if (n_in != 29 || out_size != T * D || ws_size < WS_END) { fprintf(stderr, "kernel_launch: unexpected shapes (n_in %d out %d ws %zu)\n", n_in, out_size, ws_size); grid = -1; return; }
        int dev = 0, cus = 0, per_cu = 0;
        if (hipGetDevice(&dev) != hipSuccess || hipDeviceGetAttribute(&cus, hipDeviceAttributeMultiprocessorCount, dev) != hipSuccess) { grid = -1; return; }
        if (hipFuncSetAttribute((const void*)fwd_kernel, hipFuncAttributeMaxDynamicSharedMemorySize, LDS_BYTES) != hipSuccess) { fprintf(stderr, "kernel_launch: LDS attribute failed\n"); grid = -1; return; }
        if (hipOccupancyMaxActiveBlocksPerMultiprocessor(&per_cu, (const void*)fwd_kernel, 512, LDS_BYTES) != hipSuccess || per_cu < 1) { fprintf(stderr, "kernel_launch: occupancy query says %d\n", per_cu); }
        (void)hipGetLastError();
        grid = cus;
    }
    if (grid < 0) return;
    (void)hipMemsetAsync((char*)d_ws + WS_CTL, 0, CTL_BYTES, stream);
    Args a{};
    for (int i = 0; i < 29; ++i) a.in[i] = (const float*)d_in[i];
    a.out = (float*)d_out; a.ws = (unsigned char*)d_ws;
#if MK_MULTI_LAUNCH
    for (int ph = 0; ph < NPH; ++ph) { a.ph_lo = ph; a.ph_hi = ph + 1; hipLaunchKernelGGL(fwd_kernel, dim3(grid), dim3(512), LDS_BYTES, stream, a); }
#else
    a.ph_lo = 0; a.ph_hi = NPH;
    hipLaunchKernelGGL(fwd_kernel, dim3(grid), dim3(512), LDS_BYTES, stream, a);
#endif
}
```

```cpp
#include <hip/hip_runtime.h>
#include <stdint.h>
#include <stdio.h>

#define DI __device__ __forceinline__
#define LAS __attribute__((address_space(3)))
#define GAS __attribute__((address_space(1)))
typedef unsigned short bf16;
typedef short bf16x8 __attribute__((ext_vector_type(8)));
typedef short s16x4 __attribute__((ext_vector_type(4)));
typedef short v4i16_t __attribute__((ext_vector_type(4)));
typedef float f32x4 __attribute__((ext_vector_type(4)));
typedef float f32x16 __attribute__((ext_vector_type(16)));
typedef float f32x2_t __attribute__((ext_vector_type(2)));
typedef __bf16 bf16x2_t __attribute__((ext_vector_type(2)));
typedef unsigned u32x4 __attribute__((ext_vector_type(4)));
typedef unsigned u32x2 __attribute__((ext_vector_type(2)));
typedef int i32x4 __attribute__((ext_vector_type(4)));
typedef GAS unsigned gu32;

constexpr int T = 65536, D = 1024, SEQ = 2048, NBATCH = 32;
constexpr int EV_IN = 3592, EV_N = 3584, EVU = 3072;
constexpr int OD_N = 2560;
constexpr int DFF = 2816, DFE = 3584, NE = 8, CAP = 65536;
constexpr int MOE_NBP = 174, MOE_NPART = 3;
constexpr float EPS = 1e-6f;
constexpr float LOG2E = 1.4426950408889634f;
constexpr float LAMBDA_INIT = 0.35550906f;

constexpr size_t MiB = 1u << 20;
constexpr size_t WS_CTL = 0, CTL_BYTES = 1 * MiB;
constexpr size_t WS_GA = 1 * MiB, WS_BETA = 2 * MiB, WS_ROWTS = 3 * MiB, WS_ROWGATE = 5 * MiB, WS_EG = 7 * MiB, WS_ROWSA = 8 * MiB, WS_SB = 10 * MiB, WS_SA = 11 * MiB;
constexpr size_t WS_W = 16 * MiB;
constexpr size_t W_EVIN = WS_W;
constexpr size_t W_EVOUT = W_EVIN + (size_t)EV_N * D;
constexpr size_t W_FFGU = W_EVOUT + (size_t)D * D * 2;
constexpr size_t W_FFD = W_FFGU + (size_t)2 * DFF * D;
constexpr size_t W_ODIN = W_FFD + (size_t)D * DFF * 2;
constexpr size_t W_ODOUT = W_ODIN + (size_t)OD_N * D;
constexpr size_t W_MGU = W_ODOUT + (size_t)D * D * 2;
constexpr size_t W_MD = W_MGU + (size_t)NE * 2 * DFE * D;
constexpr size_t W_PPROJ = W_MD + (size_t)NE * D * DFE * 2;
constexpr size_t W_PGATE = W_PPROJ + (size_t)2 * D * 256 * 2;
constexpr size_t W_END = W_PGATE + (size_t)2 * D * D;
constexpr int SBO_MOE = 0, SBO_EVIN = NE * 2 * DFE, SBO_FFGU = SBO_EVIN + EV_N, SBO_ODIN = SBO_FFGU + 2 * DFF, SBO_PGATE = SBO_ODIN + OD_N, SBO_END = SBO_PGATE + 2 * D;
constexpr size_t WS_HN = 222 * MiB;
constexpr size_t WS_G = 222 * MiB;
constexpr size_t WS_GX = 352 * MiB;
constexpr size_t WS_U = 512 * MiB;
constexpr size_t WS_Y = 896 * MiB;
constexpr size_t WS_YMOE = 768 * MiB;
constexpr size_t WS_END = 1024 * MiB;
static_assert(W_END <= WS_HN, "weights fit");
static_assert(WS_G + (size_t)4096 * 73728 <= WS_U, "gdn intermediates fit");
static_assert(WS_GX + (size_t)MOE_NBP * 256 * DFE * 2 <= WS_YMOE, "moe act fits");
constexpr size_t G_ITEM = 73728;
constexpr size_t G_W = 0, G_UT = 16384, G_QG = 32768, G_KD = 49152, G_QK = 65536;

constexpr int CW_CNT = 64;
constexpr int CW_BAR = 4096;
constexpr int CW_CMAX = 65536;

constexpr int LDS_BYTES = 160 * 1024;
constexpr int LDS_MISC = 131072 + 24576;
DI float bf2f(unsigned short b) { return __uint_as_float(((unsigned)b) << 16); }
DI float bflo(unsigned u) { return __uint_as_float(u << 16); }
DI float bfhi(unsigned u) { return __uint_as_float(u & 0xffff0000u); }
DI unsigned pk2(float lo, float hi) { f32x2_t v = {lo, hi}; bf16x2_t b = __builtin_convertvector(v, bf16x2_t); return __builtin_bit_cast(unsigned, b); }
DI float dppf(float v, const int ctrl_sel) {
    int r;
    switch (ctrl_sel) {
        case 0: r = __builtin_amdgcn_update_dpp(0, __builtin_bit_cast(int, v), 0xB1, 0xF, 0xF, true); break;
        case 1: r = __builtin_amdgcn_update_dpp(0, __builtin_bit_cast(int, v), 0x4E, 0xF, 0xF, true); break;
        case 2: r = __builtin_amdgcn_update_dpp(0, __builtin_bit_cast(int, v), 0x141, 0xF, 0xF, true); break;
        default: r = __builtin_amdgcn_update_dpp(0, __builtin_bit_cast(int, v), 0x140, 0xF, 0xF, true); break;
    }
    return __builtin_bit_cast(float, r);
}
DI float row16_sum(float v) { v += dppf(v, 0); v += dppf(v, 1); v += dppf(v, 2); v += dppf(v, 3); return v; }
DI float rlane(float v, int l) { return __builtin_bit_cast(float, __builtin_amdgcn_readlane(__builtin_bit_cast(int, v), l)); }
DI float wave_sum(float v) { v = row16_sum(v); return (rlane(v, 0) + rlane(v, 16)) + (rlane(v, 32) + rlane(v, 48)); }
DI float wave_max(float v) { v = fmaxf(v, dppf(v, 0)); v = fmaxf(v, dppf(v, 1)); v = fmaxf(v, dppf(v, 2)); v = fmaxf(v, dppf(v, 3)); return fmaxf(fmaxf(rlane(v, 0), rlane(v, 16)), fmaxf(rlane(v, 32), rlane(v, 48))); }
DI float silu_f(float x) { return x / (1.f + __expf(-x)); }
DI float sigmoid_f(float x) { return 1.f / (1.f + __expf(-x)); }
DI int crow(int reg, int hh) { return (reg & 3) + 8 * (reg >> 2) + 4 * hh; }
DI bf16x8 pack_step(const f32x16& x, int s) {
    u32x4 p;
    p[0] = pk2(x[8 * s + 0], x[8 * s + 1]); p[1] = pk2(x[8 * s + 2], x[8 * s + 3]); p[2] = pk2(x[8 * s + 4], x[8 * s + 5]); p[3] = pk2(x[8 * s + 6], x[8 * s + 7]);
    return __builtin_bit_cast(bf16x8, p);
}
DI s16x4 vtr(const LAS unsigned char* p) { return __builtin_bit_cast(s16x4, __builtin_amdgcn_ds_read_tr16_b64_v4i16((LAS v4i16_t*)p)); }
DI bf16x8 cat8(s16x4 lo, s16x4 hi) { return __builtin_shufflevector(lo, hi, 0, 1, 2, 3, 4, 5, 6, 7); }
#define MFMA32(a, b, c) __builtin_amdgcn_mfma_f32_32x32x16_bf16((a), (b), (c), 0, 0, 0)
DI f32x16 zero16() { f32x16 z; for (int i = 0; i < 16; ++i) z[i] = 0.f; return z; }
#define WG_BAR() __syncthreads()

#define XB_TMO      128
#define XB_XCNT(j)  (256  + 64 * (j))
#define XB_XSUB(j)  (1280 + 64 * (j))
#define XB_XGEN(j)  (2304 + 64 * (j))
#define XB_TOP      3328
#define XB_TOPGEN   3392
#define XCD_BAR_WORDS 3456
#define XB_SPIN_CAP (1u << 22)
DI unsigned xb_ld(unsigned* p)              { return __hip_atomic_load(p, __ATOMIC_RELAXED, __HIP_MEMORY_SCOPE_AGENT); }
DI unsigned xb_add(unsigned* p, unsigned v) { return __hip_atomic_fetch_add(p, v, __ATOMIC_RELAXED, __HIP_MEMORY_SCOPE_AGENT); }
DI unsigned xb_xcc_id() { return (unsigned)__builtin_amdgcn_s_getreg((3 << 11) | 20) & 0xFu; }
#define XB_SPIN(cond, bar) do { unsigned _sp = 0; while (cond) { __builtin_amdgcn_s_sleep(1); \
    if ((++_sp & 255u) == 0u) { if (xb_ld(&(bar)[XB_TMO])) break; if (_sp > XB_SPIN_CAP) { atomicAdd(&(bar)[XB_TMO], 1u); break; } } } } while (0)
struct XcdBarrier { unsigned* bar; unsigned x; volatile LAS unsigned* st; };
DI XcdBarrier xcd_barrier_post(unsigned* bar, volatile LAS unsigned* st) {
    XcdBarrier b; b.bar = bar; b.x = xb_xcc_id(); b.st = st;
    if (threadIdx.x == 0) (void)xb_add(&bar[XB_XCNT(b.x)], 1u);
    return b;
}
DI void xcd_barrier_complete(unsigned* bar, unsigned x, unsigned& nloc, unsigned& nx) {
    const unsigned G = gridDim.x * gridDim.y * gridDim.z;
    unsigned sum, cnt, mine, sp = 0u;
    for (;;) {
        sum = 0u; cnt = 0u; mine = 0u;
#pragma unroll
        for (unsigned j = 0; j < 16; ++j) { const unsigned c = xb_ld(&bar[XB_XCNT(j)]); sum += c; cnt += (c > 0u) ? 1u : 0u; mine = (j == x) ? c : mine; }
        if (sum == G) break;
        __builtin_amdgcn_s_sleep(1);
        if ((++sp & 255u) == 0u) { if (xb_ld(&bar[XB_TMO])) break; if (sp > XB_SPIN_CAP) { atomicAdd(&bar[XB_TMO], 1u); break; } }
    }
    nloc = mine > 0u ? mine : 1u; nx = cnt > 0u ? cnt : 1u;
}
DI void xcd_barrier(const XcdBarrier& b) {
    asm volatile("s_waitcnt vmcnt(0)" ::: "memory");
    __syncthreads();
    if (threadIdx.x == 0) {
        unsigned* bar = b.bar;
        __builtin_amdgcn_s_waitcnt(0);
        unsigned nloc = b.st[0], nx = b.st[1];
        if (nloc == 0u) { xcd_barrier_complete(bar, b.x, nloc, nx); b.st[0] = nloc; b.st[1] = nx; }
        const unsigned old = xb_add(&bar[XB_XSUB(b.x)], 1u);
        const unsigned gen = old / nloc;
        if (old + 1u == (gen + 1u) * nloc) {
            __builtin_amdgcn_fence(__ATOMIC_RELEASE, "agent");
            asm volatile("s_waitcnt vmcnt(0)" ::: "memory");
            const unsigned og = xb_add(&bar[XB_TOP], 1u);
            const unsigned tg = og / nx;
            if (og + 1u == (tg + 1u) * nx) xb_add(&bar[XB_TOPGEN], 1u);
            else XB_SPIN(xb_ld(&bar[XB_TOPGEN]) == tg, bar);
            __builtin_amdgcn_fence(__ATOMIC_ACQUIRE, "agent");
            xb_add(&bar[XB_XGEN(b.x)], 1u);
            asm volatile("s_waitcnt vmcnt(0)" ::: "memory");
        } else {
            XB_SPIN(xb_ld(&bar[XB_XGEN(b.x)]) == gen, bar);
            __builtin_amdgcn_fence(__ATOMIC_ACQUIRE, "agent");
            asm volatile("s_waitcnt vmcnt(0)" ::: "memory");
        }
    }
    __syncthreads();
}

struct Args { const float* in[29]; float* out; unsigned char* ws; int ph_lo, ph_hi; };
struct Frame {
    LAS unsigned char* lds;
    unsigned char* ws;
    int tid, lane, wave, G, vcu;
};

namespace pg8 {
constexpr int BM = 256, BK = 64, HALF = 128, HTB = HALF * BK * 2, STAGE_BYTES = 8 * HTB, NXCD = 8, WGM = 8;
__host__ __device__ __forceinline__ int lds_byte(int r, int c) { const int st = (r >> 4) * 2 + (c >> 5), rr = r & 15, cc = c & 31, ob = rr * 64 + cc * 2; return st * 1024 + (ob ^ (((ob >> 9) & 1) << 5)); }
__host__ __device__ __forceinline__ void stage_rc(int b, int& R, int& C) { const int st = b / 1024, sb = b % 1024, swz = sb ^ (((sb >> 9) & 1) << 5); R = (st >> 1) * 16 + swz / 64; C = (st & 1) * 32 + (swz % 64) / 2; }
__host__ __device__ __forceinline__ int perm32(int rho) { const int n = rho >> 4, i = rho & 15; return 8 * (i >> 2) + 4 * n + (i & 3); }

struct Unit { int pm, pn, e, lb, rows; };

DI bool static_unit(int i, int G, int c, int nM, int nN, int& pm, int& pn) {
    const int nwg = nM * nN; const long L = (long)i * G + c; if (L >= nwg) return false;
    int wgid = (int)L; { const int q = nwg / NXCD, r = nwg % NXCD, xcd = wgid % NXCD, off = wgid / NXCD; wgid = (xcd < r ? xcd * (q + 1) : r * (q + 1) + (xcd - r) * q) + off; }
    const int nig = WGM * nN, gid = wgid / nig, fm = gid * WGM, gsz = (nM - fm) < WGM ? (nM - fm) : WGM;
    pm = fm + ((wgid % nig) % gsz); pn = (wgid % nig) / gsz; return true;
}
struct SchedDense {
    static constexpr bool GATHER = false;
    const char* A; const char* Bt; int K, nM, nN, G, c;
    DI void init(const void* A_, const void* Bt_, int M, int N, int K_, int G_, int c_) { A = (const char*)A_; Bt = (const char*)Bt_; K = K_; nM = M / BM; nN = N / BM; G = G_; c = c_; }
    DI bool next(int i, Unit& u) const { u.e = 0; u.rows = 256; const bool ok = static_unit(i, G, c, nM, nN, u.pm, u.pn); u.lb = u.pm; return ok; }
    DI const char* a_base(const Unit& u) const { return A + (size_t)u.pm * BM * K * 2; }
    DI const char* b_base(const Unit& u) const { return Bt + (size_t)u.pn * BM * K * 2; }
    DI void ts_load(const Unit&, const int (&)[2], int (&)[2][2]) const {}
    DI void a_offs(const Unit&, const int (&R)[2], const int (&C)[2], const int (&)[2][2], unsigned (&o)[2][2]) const {
#pragma unroll
        for (int h = 0; h < 2; ++h)
#pragma unroll
            for (int i = 0; i < 2; ++i) o[h][i] = (unsigned)((h * HALF + R[i]) * K + C[i]) * 2u;
    }
};
struct SchedMoe {
    const char* A; const char* Bt; int K, nM, nN, G, c, blk0; size_t bstride; const int* row_ts; const LAS int* tab; bool gather;
    DI bool next(int i, Unit& u) const {
        int pm, pn; if (!static_unit(i, G, c, nM, nN, pm, pn)) return false;
        const int gb = blk0 + pm; int e = 0;
#pragma unroll
        for (int j = 1; j < 8; ++j) e += (gb >= tab[8 + j]) ? 1 : 0;
        e = __builtin_amdgcn_readfirstlane(e);
        const int lb = gb - __builtin_amdgcn_readfirstlane(tab[8 + e]); const int rem = __builtin_amdgcn_readfirstlane(tab[e]) - lb * 256;
        u.pm = pm; u.pn = pn; u.e = e; u.lb = lb; u.rows = rem < 256 ? rem : 256; return true;
    }
    DI const char* b_base(const Unit& u) const { return Bt + (size_t)u.e * bstride + (size_t)u.pn * BM * K * 2; }
};
struct SchedMoeGU : SchedMoe {
    static constexpr bool GATHER = true;
    DI const char* a_base(const Unit&) const { return A; }
    DI void ts_load(const Unit& u, const int (&R)[2], int (&ts)[2][2]) const {
#pragma unroll
        for (int h = 0; h < 2; ++h)
#pragma unroll
            for (int i = 0; i < 2; ++i) { const int lr = h * HALF + R[i]; ts[h][i] = (lr < u.rows) ? row_ts[(size_t)u.e * CAP + u.lb * 256 + lr] : (T << 1); }
    }
    DI void a_offs(const Unit&, const int (&)[2], const int (&C)[2], const int (&ts)[2][2], unsigned (&o)[2][2]) const {
#pragma unroll
        for (int h = 0; h < 2; ++h)
#pragma unroll
            for (int i = 0; i < 2; ++i) o[h][i] = ((unsigned)(ts[h][i] >> 1) * (unsigned)K + (unsigned)C[i]) * 2u;
    }
};
struct SchedMoeDown : SchedMoe {
    static constexpr bool GATHER = false;
    DI const char* a_base(const Unit& u) const { return A + (size_t)u.pm * BM * K * 2; }
    DI void ts_load(const Unit&, const int (&)[2], int (&)[2][2]) const {}
    DI void a_offs(const Unit&, const int (&R)[2], const int (&C)[2], const int (&)[2][2], unsigned (&o)[2][2]) const {
#pragma unroll
        for (int h = 0; h < 2; ++h)
#pragma unroll
            for (int i = 0; i < 2; ++i) o[h][i] = (unsigned)((h * HALF + R[i]) * K + C[i]) * 2u;
    }
};

typedef f32x4 Acc[2][2][4][2];
typedef i32x4 AccI[2][2][4][2];
template <bool I8> struct AccSel { typedef f32x4 type; };
template <> struct AccSel<true> { typedef i32x4 type; };
DI u32x4 pack8(const f32x4& v0, const f32x4& v1) { u32x4 w; w.x = pk2(v0[0], v0[1]); w.y = pk2(v0[2], v0[3]); w.z = pk2(v1[0], v1[1]); w.w = pk2(v1[2], v1[3]); return w; }

struct EpiStoreBf16 {
    static constexpr bool PERM = true, I8 = false;
    bf16* O; int ldc;
    DI void operator()(const Acc& acc, const Unit& u, int wr, int wc, int fr, int fq) const {
        const int row0 = u.pm * BM + wr * 64 + fr, col0 = u.pn * BM + wc * 32 + 8 * fq;
#pragma unroll
        for (int ai = 0; ai < 2; ++ai)
#pragma unroll
            for (int m = 0; m < 4; ++m) { bf16* rowp = O + (size_t)(row0 + ai * HALF + m * 16) * ldc + col0;
#pragma unroll
                for (int bj = 0; bj < 2; ++bj) *(u32x4*)(rowp + bj * HALF) = pack8(acc[ai][bj][m][0], acc[ai][bj][m][1]); }
    }
};
struct EpiEvIn {
    static constexpr bool PERM = true, I8 = false;
    bf16* O;
    DI void operator()(const Acc& acc, const Unit& u, int wr, int wc, int fr, int fq) const {
        const int row0 = u.pm * BM + wr * 64 + fr;
        if (u.pn >= 2 && u.pn < 6) {
            const int col0 = 512 + (u.pn - 2) * HALF + wc * 32 + 8 * fq;
#pragma unroll
            for (int ai = 0; ai < 2; ++ai)
#pragma unroll
                for (int m = 0; m < 4; ++m) { bf16* rowp = O + (size_t)(row0 + ai * HALF + m * 16) * EVU + col0;
                    *(u32x4*)rowp = pack8(acc[ai][0][m][0] * acc[ai][1][m][0], acc[ai][0][m][1] * acc[ai][1][m][1]); }
        } else {
            const int col0 = u.pn * BM - (u.pn >= 6 ? 512 : 0) + wc * 32 + 8 * fq;
#pragma unroll
            for (int ai = 0; ai < 2; ++ai)
#pragma unroll
                for (int m = 0; m < 4; ++m) { bf16* rowp = O + (size_t)(row0 + ai * HALF + m * 16) * EVU + col0;
#pragma unroll
                    for (int bj = 0; bj < 2; ++bj) *(u32x4*)(rowp + bj * HALF) = pack8(acc[ai][bj][m][0], acc[ai][bj][m][1]); }
        }
    }
};
struct EpiSwiGLU {
    static constexpr bool PERM = true, I8 = false;
    bf16* O; int ldc;
    DI void operator()(const Acc& acc, const Unit& u, int wr, int wc, int fr, int fq) const {
        const int row0 = u.pm * BM + wr * 64 + fr, col0 = u.pn * HALF + wc * 32 + 8 * fq;
#pragma unroll
        for (int ai = 0; ai < 2; ++ai)
#pragma unroll
            for (int m = 0; m < 4; ++m) { bf16* rowp = O + (size_t)(row0 + ai * HALF + m * 16) * ldc + col0;
                f32x4 v0, v1;
#pragma unroll
                for (int j = 0; j < 4; ++j) { v0[j] = silu_f(acc[ai][0][m][0][j]) * acc[ai][1][m][0][j]; v1[j] = silu_f(acc[ai][0][m][1][j]) * acc[ai][1][m][1][j]; }
                *(u32x4*)rowp = pack8(v0, v1); }
    }
};
struct EpiSwiGLUI8 {
    static constexpr bool PERM = true, I8 = true;
    bf16* O; int ldc; const float* row_sa; const float* sb;
    DI void operator()(const AccI& acc, const Unit& u, int wr, int wc, int fr, int fq) const {
        const int row0 = u.pm * BM + wr * 64 + fr, col0 = u.pn * HALF + wc * 32 + 8 * fq; const size_t rbase = (size_t)u.e * CAP + u.lb * 256;
        const float* sbp = sb + (size_t)u.e * (2 * DFE) + u.pn * BM + wc * 32 + 8 * fq;
        const f32x4 sg0 = *(const f32x4*)sbp, sg1 = *(const f32x4*)(sbp + 4), su0 = *(const f32x4*)(sbp + HALF), su1 = *(const f32x4*)(sbp + HALF + 4);
#pragma unroll
        for (int ai = 0; ai < 2; ++ai)
#pragma unroll
            for (int m = 0; m < 4; ++m) { const int lr = ai * HALF + wr * 64 + m * 16 + fr; bf16* rowp = O + (size_t)(row0 + ai * HALF + m * 16) * ldc + col0;
                const float ra = (lr < u.rows) ? row_sa[rbase + lr] : 0.f;
                f32x4 v0, v1;
#pragma unroll
                for (int j = 0; j < 4; ++j) { v0[j] = silu_f((float)acc[ai][0][m][0][j] * (ra * sg0[j])) * ((float)acc[ai][1][m][0][j] * (ra * su0[j])); v1[j] = silu_f((float)acc[ai][0][m][1][j] * (ra * sg1[j])) * ((float)acc[ai][1][m][1][j] * (ra * su1[j])); }
                *(u32x4*)rowp = pack8(v0, v1); }
    }
};
struct EpiEvInI8 {
    static constexpr bool PERM = true, I8 = true;
    bf16* O; const float* sa; const float* sb;
    DI void operator()(const AccI& acc, const Unit& u, int wr, int wc, int fr, int fq) const {
        const int row0 = u.pm * BM + wr * 64 + fr;
        const float* sbp = sb + u.pn * BM + wc * 32 + 8 * fq;
        const f32x4 s00 = *(const f32x4*)sbp, s01 = *(const f32x4*)(sbp + 4), s10 = *(const f32x4*)(sbp + HALF), s11 = *(const f32x4*)(sbp + HALF + 4);
        if (u.pn >= 2 && u.pn < 6) {
            const int col0 = 512 + (u.pn - 2) * HALF + wc * 32 + 8 * fq;
#pragma unroll
            for (int ai = 0; ai < 2; ++ai)
#pragma unroll
                for (int m = 0; m < 4; ++m) { const int row = row0 + ai * HALF + m * 16; const float ra = sa[row]; bf16* rowp = O + (size_t)row * EVU + col0;
                    f32x4 v0, v1;
#pragma unroll
                    for (int j = 0; j < 4; ++j) { v0[j] = ((float)acc[ai][0][m][0][j] * (ra * s00[j])) * ((float)acc[ai][1][m][0][j] * (ra * s10[j])); v1[j] = ((float)acc[ai][0][m][1][j] * (ra * s01[j])) * ((float)acc[ai][1][m][1][j] * (ra * s11[j])); }
                    *(u32x4*)rowp = pack8(v0, v1); }
        } else {
            const int col0 = u.pn * BM - (u.pn >= 6 ? 512 : 0) + wc * 32 + 8 * fq;
#pragma unroll
            for (int ai = 0; ai < 2; ++ai)
#pragma unroll
                for (int m = 0; m < 4; ++m) { const int row = row0 + ai * HALF + m * 16; const float ra = sa[row]; bf16* rowp = O + (size_t)row * EVU + col0;
                    f32x4 v0, v1, v2, v3;
#pragma unroll
                    for (int j = 0; j < 4; ++j) { v0[j] = (float)acc[ai][0][m][0][j] * (ra * s00[j]); v1[j] = (float)acc[ai][0][m][1][j] * (ra * s01[j]); v2[j] = (float)acc[ai][1][m][0][j] * (ra * s10[j]); v3[j] = (float)acc[ai][1][m][1][j] * (ra * s11[j]); }
                    *(u32x4*)rowp = pack8(v0, v1); *(u32x4*)(rowp + HALF) = pack8(v2, v3); }
        }
    }
};
struct EpiStoreBf16I8 {
    static constexpr bool PERM = true, I8 = true;
    bf16* O; int ldc; const float* sa; const float* sb;
    DI void operator()(const AccI& acc, const Unit& u, int wr, int wc, int fr, int fq) const {
        const int row0 = u.pm * BM + wr * 64 + fr, col0 = u.pn * BM + wc * 32 + 8 * fq;
        const float* sbp = sb + col0;
        const f32x4 s00 = *(const f32x4*)sbp, s01 = *(const f32x4*)(sbp + 4), s10 = *(const f32x4*)(sbp + HALF), s11 = *(const f32x4*)(sbp + HALF + 4);
#pragma unroll
        for (int ai = 0; ai < 2; ++ai)
#pragma unroll
            for (int m = 0; m < 4; ++m) { const int row = row0 + ai * HALF + m * 16; const float ra = sa[row]; bf16* rowp = O + (size_t)row * ldc + col0;
                f32x4 v0, v1, v2, v3;
#pragma unroll
                for (int j = 0; j < 4; ++j) { v0[j] = (float)acc[ai][0][m][0][j] * (ra * s00[j]); v1[j] = (float)acc[ai][0][m][1][j] * (ra * s01[j]); v2[j] = (float)acc[ai][1][m][0][j] * (ra * s10[j]); v3[j] = (float)acc[ai][1][m][1][j] * (ra * s11[j]); }
                *(u32x4*)rowp = pack8(v0, v1); *(u32x4*)(rowp + HALF) = pack8(v2, v3); }
    }
};
struct EpiPleGateI8 {
    static constexpr bool PERM = false, I8 = true;
    float* h; const bf16* tmp; const float* sa; const float* sb;
    DI void operator()(const AccI& acc, const Unit& u, int wr, int wc, int fr, int fq) const {
        const int row0 = u.pm * BM + wr * 64 + fr, col0 = u.pn * BM + wc * 32 + 4 * fq;
        f32x4 sv[2][2];
#pragma unroll
        for (int bj = 0; bj < 2; ++bj)
#pragma unroll
            for (int n = 0; n < 2; ++n) sv[bj][n] = *(const f32x4*)(sb + col0 + bj * HALF + n * 16);
#pragma unroll
        for (int ai = 0; ai < 2; ++ai)
#pragma unroll
            for (int m = 0; m < 4; ++m) { const int row = row0 + ai * HALF + m * 16; const float ra = sa[row]; const size_t off = (size_t)row * D + col0;
#pragma unroll
                for (int bj = 0; bj < 2; ++bj)
#pragma unroll
                    for (int n = 0; n < 2; ++n) { const size_t o = off + bj * HALF + n * 16; const f32x4 b = *(const f32x4*)(h + o); const u32x2 t = *(const u32x2*)(tmp + o); const i32x4 a = acc[ai][bj][m][n]; const f32x4 sc = sv[bj][n] * ra;
                        f32x4 r; r[0] = b[0] + bflo(t.x) * sigmoid_f((float)a[0] * sc[0]); r[1] = b[1] + bfhi(t.x) * sigmoid_f((float)a[1] * sc[1]); r[2] = b[2] + bflo(t.y) * sigmoid_f((float)a[2] * sc[2]); r[3] = b[3] + bfhi(t.y) * sigmoid_f((float)a[3] * sc[3]);
                        *(f32x4*)(h + o) = r; } }
    }
};
struct EpiResid {
    static constexpr bool PERM = false, I8 = false;
    const float* base; float* out;
    DI void operator()(const Acc& acc, const Unit& u, int wr, int wc, int fr, int fq) const {
        const int row0 = u.pm * BM + wr * 64 + fr, col0 = u.pn * BM + wc * 32 + 4 * fq;
#pragma unroll
        for (int ai = 0; ai < 2; ++ai)
#pragma unroll
            for (int m = 0; m < 4; ++m) { const size_t off = (size_t)(row0 + ai * HALF + m * 16) * D + col0;
#pragma unroll
                for (int bj = 0; bj < 2; ++bj)
#pragma unroll
                    for (int n = 0; n < 2; ++n) { const f32x4 b = *(const f32x4*)(base + off + bj * HALF + n * 16); *(f32x4*)(out + off + bj * HALF + n * 16) = b + acc[ai][bj][m][n]; } }
    }
};
struct EpiPleGate {
    static constexpr bool PERM = false, I8 = false;
    float* h; const bf16* tmp;
    DI void operator()(const Acc& acc, const Unit& u, int wr, int wc, int fr, int fq) const {
        const int row0 = u.pm * BM + wr * 64 + fr, col0 = u.pn * BM + wc * 32 + 4 * fq;
#pragma unroll
        for (int ai = 0; ai < 2; ++ai)
#pragma unroll
            for (int m = 0; m < 4; ++m) { const size_t off = (size_t)(row0 + ai * HALF + m * 16) * D + col0;
#pragma unroll
                for (int bj = 0; bj < 2; ++bj)
#pragma unroll
                    for (int n = 0; n < 2; ++n) { const size_t o = off + bj * HALF + n * 16; const f32x4 b = *(const f32x4*)(h + o); const u32x2 t = *(const u32x2*)(tmp + o); const f32x4 a = acc[ai][bj][m][n];
                        f32x4 r; r[0] = b[0] + bflo(t.x) * sigmoid_f(a[0]); r[1] = b[1] + bfhi(t.x) * sigmoid_f(a[1]); r[2] = b[2] + bflo(t.y) * sigmoid_f(a[2]); r[3] = b[3] + bfhi(t.y) * sigmoid_f(a[3]);
                        *(f32x4*)(h + o) = r; } }
    }
};
struct EpiMoeDown {
    static constexpr bool PERM = true, I8 = false;
    bf16* Y; const int* row_ts; const float* row_gate;
    DI void operator()(const Acc& acc, const Unit& u, int wr, int wc, int fr, int fq) const {
        const int col0 = u.pn * BM + wc * 32 + 8 * fq; const size_t rbase = (size_t)u.e * CAP + u.lb * 256;
#pragma unroll
        for (int ai = 0; ai < 2; ++ai)
#pragma unroll
            for (int m = 0; m < 4; ++m) { const int lr = ai * HALF + wr * 64 + m * 16 + fr;
                if (lr < u.rows) { const int ts = row_ts[rbase + lr]; const float g = row_gate[rbase + lr]; bf16* rowp = Y + (size_t)ts * D + col0;
#pragma unroll
                    for (int bj = 0; bj < 2; ++bj) *(u32x4*)(rowp + bj * HALF) = pack8(acc[ai][bj][m][0] * g, acc[ai][bj][m][1] * g); } }
    }
};

DI f32x4 mma16(const bf16x8& a, const bf16x8& b, const f32x4& c) { return __builtin_amdgcn_mfma_f32_16x16x32_bf16(a, b, c, 0, 0, 0); }
DI i32x4 mma16(const bf16x8& a, const bf16x8& b, const i32x4& c) { return __builtin_amdgcn_mfma_i32_16x16x64_i8(__builtin_bit_cast(i32x4, a), __builtin_bit_cast(i32x4, b), c, 0, 0, 0); }
template <class Epi, class Sched>
DI void gemm_phase(LAS unsigned char* lds, const Sched& S, const Epi& E) {
    constexpr bool GATHER = Sched::GATHER; constexpr bool I8 = Epi::I8; typedef typename AccSel<I8>::type acc_t;
    const int tid = threadIdx.x, wid = __builtin_amdgcn_readfirstlane(tid >> 6), lane = tid & 63, wr = wid >> 2, wc = wid & 3, fr = lane & 15, fq = lane >> 4;
    const int K = S.K, nt = K / BK;
    int Rr[2], Cc[2]; unsigned voffB[2];
#pragma unroll
    for (int i = 0; i < 2; ++i) { int R, C; stage_rc(tid * 16 + i * 8192, R, C); Rr[i] = R; Cc[i] = C; const int Rb = Epi::PERM ? ((R & ~31) + perm32(R & 31)) : R; voffB[i] = (unsigned)(Rb * K + C) * 2u; }
    const size_t kstep = (size_t)(BK * 2);
    const size_t hstep = (size_t)HALF * K * 2;
    const unsigned ldsw = (unsigned)wid * 1024u;
    const int aoff = lds_byte(wr * 64 + fr, fq * 8), boff = lds_byte(wc * 32 + fr, fq * 8);
#define PG8_SA(b, h) (((b) * 2 + (h)) * HTB)
#define PG8_SB(b, h) ((4 + (b) * 2 + (h)) * HTB)
#define PG8_STAGE(bufoff, gbase, voff) do { _Pragma("unroll") for (int _i = 0; _i < 2; ++_i) \
        __builtin_amdgcn_global_load_lds((const unsigned*)((const char*)(gbase) + (voff)[_i]), (LAS unsigned*)(lds + (bufoff) + ldsw + _i * 8192), 16, 0, 0); } while (0)
#define PG8_LDA(dst, b, h) do { _Pragma("unroll") for (int m = 0; m < 4; ++m) _Pragma("unroll") for (int k = 0; k < 2; ++k) dst[m][k] = *(const LAS bf16x8*)(lds + PG8_SA(b, h) + aoff + m * 2048 + k * 1024); } while (0)
#define PG8_LDB(dst, b, h) do { _Pragma("unroll") for (int n = 0; n < 2; ++n) _Pragma("unroll") for (int k = 0; k < 2; ++k) dst[n][k] = *(const LAS bf16x8*)(lds + PG8_SB(b, h) + boff + n * 2048 + k * 1024); } while (0)
#define PG8_MMA(ai, bj, At, Bt) do { __builtin_amdgcn_s_setprio(1); _Pragma("unroll") for (int m = 0; m < 4; ++m) _Pragma("unroll") for (int n = 0; n < 2; ++n) _Pragma("unroll") for (int k = 0; k < 2; ++k) \
        acc[ai][bj][m][n] = mma16(Bt[n][k], At[m][k], acc[ai][bj][m][n]); __builtin_amdgcn_s_setprio(0); } while (0)
#define PG8_WAIT_V(n) asm volatile("s_waitcnt vmcnt(" #n ")" ::: "memory")
#define PG8_WAIT_L(n) asm volatile("s_waitcnt lgkmcnt(" #n ")" ::: "memory")
#define PG8_BAR __builtin_amdgcn_s_barrier()
#define PG8_SCHED __builtin_amdgcn_sched_barrier(0)
    Unit cur, nxt, nn; int ui = 0;
    if (!S.next(0, cur)) return;
    acc_t acc[2][2][4][2];
#pragma unroll
    for (int a = 0; a < 2; ++a)
#pragma unroll
        for (int b = 0; b < 2; ++b)
#pragma unroll
            for (int m = 0; m < 4; ++m)
#pragma unroll
                for (int n = 0; n < 2; ++n) acc[a][b][m][n] = (acc_t){0, 0, 0, 0};
    bf16x8 At[4][2], B0[2][2], B1[2][2];
    unsigned vA[2][2], nvA[2][2]; int pts[2][2] = {{0, 0}, {0, 0}};
    { int ts0[2][2] = {{0, 0}, {0, 0}}; S.ts_load(cur, Rr, ts0); S.a_offs(cur, Rr, Cc, ts0, vA); }
    bool has_next = S.next(1, nxt);
    if (GATHER && has_next) S.ts_load(nxt, Rr, pts);
    const char* cA = S.a_base(cur); const char* cB = S.b_base(cur);
    PG8_STAGE(PG8_SB(0, 0), cB, voffB); PG8_STAGE(PG8_SB(0, 1), cB + hstep, voffB); PG8_STAGE(PG8_SA(0, 0), cA, vA[0]); PG8_STAGE(PG8_SA(0, 1), cA, vA[1]);
    if (wr == 1) PG8_BAR;
    PG8_WAIT_V(2); PG8_BAR;
    PG8_STAGE(PG8_SB(1, 0), cB + kstep, voffB); PG8_STAGE(PG8_SA(1, 0), cA + kstep, vA[0]); PG8_STAGE(PG8_SB(1, 1), cB + hstep + kstep, voffB);
    PG8_WAIT_V(6); PG8_BAR;
    for (;;) {
        const char* nA = has_next ? S.a_base(nxt) : cA; const char* nB = has_next ? S.b_base(nxt) : cB;
        if (has_next) S.a_offs(nxt, Rr, Cc, pts, nvA);
        else {
#pragma unroll
            for (int h = 0; h < 2; ++h)
#pragma unroll
                for (int i = 0; i < 2; ++i) nvA[h][i] = vA[h][i];
        }
        const bool has_nn = has_next && S.next(ui + 2, nn);
        if (GATHER && has_nn) S.ts_load(nn, Rr, pts);
        for (int t = 0; t < nt; t += 2) {
            const bool last = (t == nt - 2);
            const char* a1 = cA + (size_t)(t + 1) * kstep;
            const char* a2 = last ? nA : cA + (size_t)(t + 2) * kstep; const char* b2 = last ? nB : cB + (size_t)(t + 2) * kstep;
            const char* a3 = a2 + kstep; const char* b3 = b2 + kstep;
            unsigned w0[2], w1[2];
            if (GATHER) { w0[0] = last ? nvA[0][0] : vA[0][0]; w0[1] = last ? nvA[0][1] : vA[0][1]; w1[0] = last ? nvA[1][0] : vA[1][0]; w1[1] = last ? nvA[1][1] : vA[1][1]; }
            else { w0[0] = vA[0][0]; w0[1] = vA[0][1]; w1[0] = vA[1][0]; w1[1] = vA[1][1]; }
            PG8_LDB(B0, 0, 0); PG8_LDB(B1, 0, 1); PG8_SCHED; PG8_LDA(At, 0, 0); PG8_STAGE(PG8_SA(1, 1), a1, vA[1]);
            PG8_WAIT_V(8); PG8_WAIT_L(0); PG8_BAR; PG8_MMA(0, 0, At, B0); PG8_MMA(0, 1, At, B1); PG8_BAR; PG8_SCHED;
            PG8_LDA(At, 0, 1); PG8_STAGE(PG8_SB(0, 0), b2, voffB); PG8_STAGE(PG8_SB(0, 1), b2 + hstep, voffB); PG8_STAGE(PG8_SA(0, 0), a2, w0);
            PG8_WAIT_V(8); PG8_WAIT_L(0); PG8_BAR; PG8_MMA(1, 0, At, B0); PG8_MMA(1, 1, At, B1); PG8_BAR; PG8_SCHED;
            PG8_LDB(B0, 1, 0); PG8_LDB(B1, 1, 1); PG8_SCHED; PG8_LDA(At, 1, 0); PG8_STAGE(PG8_SA(0, 1), a2, w1);
            PG8_WAIT_V(8); PG8_WAIT_L(0); PG8_BAR; PG8_MMA(0, 0, At, B0); PG8_MMA(0, 1, At, B1); PG8_BAR; PG8_SCHED;
            PG8_LDA(At, 1, 1); PG8_STAGE(PG8_SB(1, 0), b3, voffB); PG8_STAGE(PG8_SB(1, 1), b3 + hstep, voffB); PG8_STAGE(PG8_SA(1, 0), a3, w0);
            PG8_WAIT_V(8); PG8_WAIT_L(0); PG8_BAR; PG8_MMA(1, 0, At, B0); PG8_MMA(1, 1, At, B1); PG8_BAR; PG8_SCHED;
        }
        if (wr == 0) PG8_BAR;
        E(acc, cur, wr, wc, fr, fq);
        if (!has_next) break;
#pragma unroll
        for (int a = 0; a < 2; ++a)
#pragma unroll
            for (int b = 0; b < 2; ++b)
#pragma unroll
                for (int m = 0; m < 4; ++m)
#pragma unroll
                    for (int n = 0; n < 2; ++n) acc[a][b][m][n] = (acc_t){0, 0, 0, 0};
        cur = nxt; cA = nA; cB = nB; ++ui;
#pragma unroll
        for (int h = 0; h < 2; ++h)
#pragma unroll
            for (int i = 0; i < 2; ++i) vA[h][i] = nvA[h][i];
        nxt = nn; has_next = has_nn;
        if (wr == 1) PG8_BAR;
    }
    PG8_WAIT_V(0);
    PG8_BAR;
#undef PG8_SA
#undef PG8_SB
#undef PG8_STAGE
#undef PG8_LDA
#undef PG8_LDB
#undef PG8_MMA
#undef PG8_WAIT_V
#undef PG8_WAIT_L
#undef PG8_BAR
#undef PG8_SCHED
}
}

struct ConvJob { const float* W; bf16* WT; int K, ldn, col0, ncols, drow0, mode, nbatch; size_t sstride, dstride; };
DI void transpose_item(const ConvJob& J, int item, LAS float* scr, int lane) {
    const int per = (J.K / 64) * (J.ncols / 32); const int bi = item / per; int r = item - bi * per;
    const int nblk = J.ncols / 32, kb = r / nblk, nb = r % nblk, k0 = 64 * kb, j0 = 32 * nb;
    const float* W = J.W + (size_t)bi * J.sstride; bf16* WT = J.WT + (size_t)bi * J.dstride;
    float tv[32];
#pragma unroll
    for (int i = 0; i < 32; ++i) { const int kk = 2 * i + (lane >> 5); tv[i] = __builtin_nontemporal_load(W + (size_t)(k0 + kk) * J.ldn + J.col0 + j0 + (lane & 31)); }
#pragma unroll
    for (int i = 0; i < 32; ++i) { const int kk = 2 * i + (lane >> 5); scr[kk * 33 + (lane & 31)] = tv[i]; }
    asm volatile("s_waitcnt lgkmcnt(0)" ::: "memory");
    const int c = lane & 7;
    const int drow = J.drow0 + (J.mode ? ((j0 >> 7) * 256 + (j0 & 127)) : j0);
#pragma unroll
    for (int j = 0; j < 4; ++j) { const int n = (lane >> 3) + 8 * j; const LAS float* s = scr + (8 * c) * 33 + n;
        u32x4 o; o.x = pk2(s[0 * 33], s[1 * 33]); o.y = pk2(s[2 * 33], s[3 * 33]); o.z = pk2(s[4 * 33], s[5 * 33]); o.w = pk2(s[6 * 33], s[7 * 33]);
        *(u32x4*)(WT + (size_t)(drow + n) * J.K + k0 + 8 * c) = o; }
    asm volatile("s_waitcnt lgkmcnt(0)" ::: "memory");
}
constexpr int N_JOBS = 15;
DI ConvJob get_job(const Args& a, int j) {
    unsigned char* ws = a.ws; ConvJob J; J.nbatch = 1; J.sstride = 0; J.dstride = 0; J.mode = 0;
    switch (j) {
        case 0: J.W = a.in[6]; J.WT = (bf16*)(ws + W_EVIN); J.K = D; J.ldn = EV_IN; J.col0 = 0; J.ncols = 512; J.drow0 = 0; break;
        case 1: J.W = a.in[6]; J.WT = (bf16*)(ws + W_EVIN); J.K = D; J.ldn = EV_IN; J.col0 = 512; J.ncols = 512; J.drow0 = 512; J.mode = 1; break;
        case 2: J.W = a.in[6]; J.WT = (bf16*)(ws + W_EVIN); J.K = D; J.ldn = EV_IN; J.col0 = 1024; J.ncols = 512; J.drow0 = 640; J.mode = 1; break;
        case 3: J.W = a.in[6]; J.WT = (bf16*)(ws + W_EVIN); J.K = D; J.ldn = EV_IN; J.col0 = 1536; J.ncols = 2048; J.drow0 = 1536; break;
        case 4: J.W = a.in[12]; J.WT = (bf16*)(ws + W_EVOUT); J.K = D; J.ldn = D; J.col0 = 0; J.ncols = D; J.drow0 = 0; break;
        case 5: J.W = a.in[22]; J.WT = (bf16*)(ws + W_FFGU); J.K = D; J.ldn = 2 * DFF; J.col0 = 0; J.ncols = DFF; J.drow0 = 0; J.mode = 1; break;
        case 6: J.W = a.in[22]; J.WT = (bf16*)(ws + W_FFGU); J.K = D; J.ldn = 2 * DFF; J.col0 = DFF; J.ncols = DFF; J.drow0 = 128; J.mode = 1; break;
        case 7: J.W = a.in[23]; J.WT = (bf16*)(ws + W_FFD); J.K = DFF; J.ldn = D; J.col0 = 0; J.ncols = D; J.drow0 = 0; break;
        case 8: J.W = a.in[13]; J.WT = (bf16*)(ws + W_ODIN); J.K = D; J.ldn = OD_N; J.col0 = 0; J.ncols = OD_N; J.drow0 = 0; break;
        case 9: J.W = a.in[20]; J.WT = (bf16*)(ws + W_ODOUT); J.K = D; J.ldn = D; J.col0 = 0; J.ncols = D; J.drow0 = 0; break;
        case 10: J.W = a.in[25]; J.WT = (bf16*)(ws + W_MGU); J.K = D; J.ldn = 2 * DFE; J.col0 = 0; J.ncols = DFE; J.drow0 = 0; J.mode = 1; J.nbatch = NE; J.sstride = (size_t)D * 2 * DFE; J.dstride = (size_t)2 * DFE * D; break;
        case 11: J.W = a.in[25]; J.WT = (bf16*)(ws + W_MGU); J.K = D; J.ldn = 2 * DFE; J.col0 = DFE; J.ncols = DFE; J.drow0 = 128; J.mode = 1; J.nbatch = NE; J.sstride = (size_t)D * 2 * DFE; J.dstride = (size_t)2 * DFE * D; break;
        case 12: J.W = a.in[26]; J.WT = (bf16*)(ws + W_MD); J.K = DFE; J.ldn = D; J.col0 = 0; J.ncols = D; J.drow0 = 0; J.nbatch = NE; J.sstride = (size_t)DFE * D; J.dstride = (size_t)D * DFE; break;
        case 13: J.W = a.in[27]; J.WT = (bf16*)(ws + W_PPROJ); J.K = 256; J.ldn = D; J.col0 = 0; J.ncols = D; J.drow0 = 0; J.nbatch = 2; J.sstride = (size_t)256 * D; J.dstride = (size_t)D * 256; break;
        default: J.W = a.in[28]; J.WT = (bf16*)(ws + W_PGATE); J.K = D; J.ldn = D; J.col0 = 0; J.ncols = D; J.drow0 = 0; J.nbatch = 2; J.sstride = (size_t)D * D; J.dstride = (size_t)D * D; break;
    }
    return J;
}
DI void convert_weights(const Frame& F, const Args& a) {
    LAS float* scr = (LAS float*)(F.lds + F.wave * 16384);
    const int gw = F.vcu * 8 + F.wave, NGW = F.G * 8;
    for (int jj = 0; jj < 5; ++jj) {
        const int j = jj == 0 ? 4 : jj == 1 ? 7 : jj == 2 ? 9 : jj == 3 ? 12 : 13;
        const ConvJob J = get_job(a, j);
        const int nitems = J.nbatch * (J.K / 64) * (J.ncols / 32);
        for (int it = gw; it < nitems; it += NGW) transpose_item(J, it, scr, F.lane);
    }
}

struct QJob { const float* W; signed char* W8; int ldn, col0, ncols, drow0, mode, nbatch, rows_pb, sbo; size_t sstride; };
constexpr int N_QJOBS = 10;
DI QJob get_qjob(const Args& a, int j) {
    unsigned char* ws = a.ws; QJob J; J.nbatch = 1; J.sstride = 0; J.mode = 0; J.rows_pb = 0;
    switch (j) {
        case 0: J.W = a.in[6]; J.W8 = (signed char*)(ws + W_EVIN); J.ldn = EV_IN; J.col0 = 0; J.ncols = 512; J.drow0 = 0; J.sbo = SBO_EVIN; break;
        case 1: J.W = a.in[6]; J.W8 = (signed char*)(ws + W_EVIN); J.ldn = EV_IN; J.col0 = 512; J.ncols = 512; J.drow0 = 512; J.mode = 1; J.sbo = SBO_EVIN; break;
        case 2: J.W = a.in[6]; J.W8 = (signed char*)(ws + W_EVIN); J.ldn = EV_IN; J.col0 = 1024; J.ncols = 512; J.drow0 = 640; J.mode = 1; J.sbo = SBO_EVIN; break;
        case 3: J.W = a.in[6]; J.W8 = (signed char*)(ws + W_EVIN); J.ldn = EV_IN; J.col0 = 1536; J.ncols = 2048; J.drow0 = 1536; J.sbo = SBO_EVIN; break;
        case 4: J.W = a.in[22]; J.W8 = (signed char*)(ws + W_FFGU); J.ldn = 2 * DFF; J.col0 = 0; J.ncols = DFF; J.drow0 = 0; J.mode = 1; J.sbo = SBO_FFGU; break;
        case 5: J.W = a.in[22]; J.W8 = (signed char*)(ws + W_FFGU); J.ldn = 2 * DFF; J.col0 = DFF; J.ncols = DFF; J.drow0 = 128; J.mode = 1; J.sbo = SBO_FFGU; break;
        case 6: J.W = a.in[13]; J.W8 = (signed char*)(ws + W_ODIN); J.ldn = OD_N; J.col0 = 0; J.ncols = OD_N; J.drow0 = 0; J.sbo = SBO_ODIN; break;
        case 7: J.W = a.in[28]; J.W8 = (signed char*)(ws + W_PGATE); J.ldn = D; J.col0 = 0; J.ncols = D; J.drow0 = 0; J.sbo = SBO_PGATE; J.nbatch = 2; J.rows_pb = D; J.sstride = (size_t)D * D; break;
        case 8: J.W = a.in[25]; J.W8 = (signed char*)(ws + W_MGU); J.ldn = 2 * DFE; J.col0 = 0; J.ncols = DFE; J.drow0 = 0; J.mode = 1; J.sbo = SBO_MOE; J.nbatch = NE; J.rows_pb = 2 * DFE; J.sstride = (size_t)D * 2 * DFE; break;
        default: J.W = a.in[25]; J.W8 = (signed char*)(ws + W_MGU); J.ldn = 2 * DFE; J.col0 = DFE; J.ncols = DFE; J.drow0 = 128; J.mode = 1; J.sbo = SBO_MOE; J.nbatch = NE; J.rows_pb = 2 * DFE; J.sstride = (size_t)D * 2 * DFE; break;
    }
    return J;
}
DI int q_drow(const QJob& J, int j0) { return J.drow0 + (J.mode ? ((j0 >> 7) * 256 + (j0 & 127)) : j0); }
DI void absmax_jobs(const Frame& F, const Args& a, int jlo, int jhi, int worker, int nworkers) {
    unsigned* cmax = (unsigned*)(F.ws + WS_CTL) + CW_CMAX;
    const int gw = worker * 8 + F.wave, NGW = nworkers * 8, lane = F.lane;
    for (int j = jlo; j < jhi; ++j) {
        const QJob J = get_qjob(a, j);
        const int nblk = J.ncols / 32, per = 4 * nblk, nitems = J.nbatch * per;
        for (int it = gw; it < nitems; it += NGW) {
            const int bi = it / per, r = it - bi * per, kb = r / nblk, nb = r - kb * nblk;
            const float* p = J.W + (size_t)bi * J.sstride + (size_t)(kb * 256 + (lane >> 5)) * J.ldn + J.col0 + nb * 32 + (lane & 31);
            float m = 0.f;
#pragma unroll 1
            for (int i0 = 0; i0 < 128; i0 += 32) {
                float tv[32];
#pragma unroll
                for (int i = 0; i < 32; ++i) tv[i] = __builtin_nontemporal_load(p + (size_t)(2 * (i0 + i)) * J.ldn);
#pragma unroll
                for (int i = 0; i < 32; ++i) m = fmaxf(m, fabsf(tv[i]));
            }
            m = fmaxf(m, __shfl_xor(m, 32));
            if (lane < 32) __hip_atomic_fetch_max(cmax + J.sbo + bi * J.rows_pb + q_drow(J, nb * 32) + lane, __float_as_uint(m), __ATOMIC_RELAXED, __HIP_MEMORY_SCOPE_AGENT);
        }
    }
}
DI void quant_jobs(const Frame& F, const Args& a, int jlo, int jhi, int worker, int nworkers) {
    const unsigned* cmax = (const unsigned*)(F.ws + WS_CTL) + CW_CMAX; float* SB = (float*)(F.ws + WS_SB);
    LAS float* scr = (LAS float*)(F.lds + F.wave * 17408);
    const int gw = worker * 8 + F.wave, NGW = nworkers * 8, lane = F.lane;
    for (int j = jlo; j < jhi; ++j) {
        const QJob J = get_qjob(a, j);
        const int nblk = J.ncols / 32, per = 8 * nblk, nitems = J.nbatch * per;
        for (int it = gw; it < nitems; it += NGW) {
            const int bi = it / per, r = it - bi * per, kb = r / nblk, nb = r - kb * nblk, k0 = kb * 128, j0 = nb * 32;
            const int srow = J.sbo + bi * J.rows_pb + q_drow(J, j0);
            const float cm = __uint_as_float(__hip_atomic_load(cmax + srow + (lane & 31), __ATOMIC_RELAXED, __HIP_MEMORY_SCOPE_AGENT));
            const float inv = cm > 0.f ? 127.f / cm : 0.f;
            const float* p = J.W + (size_t)bi * J.sstride + (size_t)(k0 + (lane >> 5)) * J.ldn + J.col0 + j0 + (lane & 31);
#pragma unroll 1
            for (int i0 = 0; i0 < 64; i0 += 32) {
                float tv[32];
#pragma unroll
                for (int i = 0; i < 32; ++i) tv[i] = __builtin_nontemporal_load(p + (size_t)(2 * (i0 + i)) * J.ldn);
#pragma unroll
                for (int i = 0; i < 32; ++i) scr[(2 * (i0 + i) + (lane >> 5)) * 33 + (lane & 31)] = tv[i] * inv;
            }
            asm volatile("s_waitcnt lgkmcnt(0)" ::: "memory");
            const int drow = bi * J.rows_pb + q_drow(J, j0);
            const int c = lane & 7;
#pragma unroll
            for (int jj = 0; jj < 4; ++jj) { const int n = (lane >> 3) + 8 * jj; const LAS float* sp = scr + (16 * c) * 33 + n;
                u32x4 o;
#pragma unroll
                for (int q = 0; q < 4; ++q) { const int b0 = __float2int_rn(sp[(4 * q) * 33]), b1 = __float2int_rn(sp[(4 * q + 1) * 33]), b2 = __float2int_rn(sp[(4 * q + 2) * 33]), b3 = __float2int_rn(sp[(4 * q + 3) * 33]);
                    o[q] = (unsigned)(b0 & 0xff) | ((unsigned)(b1 & 0xff) << 8) | ((unsigned)(b2 & 0xff) << 16) | ((unsigned)(b3 & 0xff) << 24); }
                *(u32x4*)(J.W8 + (size_t)(drow + n) * D + k0 + 16 * c) = o; }
            if (k0 == 0 && lane < 32) SB[srow + lane] = cm * (1.f / 127.f);
            asm volatile("s_waitcnt lgkmcnt(0)" ::: "memory");
        }
    }
}

DI void load_row(const float* p, int lane, f32x4 (&v)[4]) {
    const f32x4* xr = (const f32x4*)p + lane;
#pragma unroll
    for (int j = 0; j < 4; ++j) v[j] = xr[64 * j];
}
DI float sumsq16(const f32x4 (&v)[4]) { float s = 0.f;
#pragma unroll
    for (int j = 0; j < 4; ++j) s += (v[j].x * v[j].x + v[j].y * v[j].y) + (v[j].z * v[j].z + v[j].w * v[j].w);
    return s; }
DI void store_bf16_row(bf16* orow, int lane, const f32x4 (&v)[4]) {
    u32x2* o8 = (u32x2*)orow + lane;
#pragma unroll
    for (int j = 0; j < 4; ++j) { u32x2 w; w.x = pk2(v[j].x, v[j].y); w.y = pk2(v[j].z, v[j].w); o8[64 * j] = w; }
}
DI float quant_row_store(signed char* drow, int lane, const f32x4 (&v)[4]) {
    float am = 0.f;
#pragma unroll
    for (int j = 0; j < 4; ++j) am = fmaxf(fmaxf(am, fmaxf(fabsf(v[j].x), fabsf(v[j].y))), fmaxf(fabsf(v[j].z), fabsf(v[j].w)));
    am = wave_max(am);
    const float qinv = am > 0.f ? 127.f / am : 0.f;
    unsigned* o4 = (unsigned*)drow + lane;
#pragma unroll
    for (int j = 0; j < 4; ++j) { const int b0 = __float2int_rn(v[j].x * qinv), b1 = __float2int_rn(v[j].y * qinv), b2 = __float2int_rn(v[j].z * qinv), b3 = __float2int_rn(v[j].w * qinv);
        o4[64 * j] = (unsigned)(b0 & 0xff) | ((unsigned)(b1 & 0xff) << 8) | ((unsigned)(b2 & 0xff) << 16) | ((unsigned)(b3 & 0xff) << 24); }
    return am * (1.f / 127.f);
}
DI void norm_plain(const Frame& F, const float* src, const float* g, signed char* dst, float* SA) {
    f32x4 gv[4]; load_row(g, F.lane, gv);
    const int gw = F.vcu * 8 + F.wave, NGW = F.G * 8;
    for (int m = gw; m < T; m += NGW) {
        f32x4 v[4]; load_row(src + (size_t)m * D, F.lane, v);
        const float rstd = rsqrtf(wave_sum(sumsq16(v)) * (1.f / D) + EPS);
#pragma unroll
        for (int j = 0; j < 4; ++j) v[j] = v[j] * rstd * gv[j];
        const float sc = quant_row_store(dst + (size_t)m * D, F.lane, v);
        if (F.lane == 0) SA[m] = sc;
    }
}
DI void norm_mix0(const Frame& F, const Args& a) {
    const float* x = a.in[0]; const float* g = a.in[2]; const float* win = a.in[6];
    signed char* dst = (signed char*)(F.ws + WS_HN); float* SA = (float*)(F.ws + WS_SA); float* GA = (float*)(F.ws + WS_GA); float* BT = (float*)(F.ws + WS_BETA);
    f32x4 gv[4]; load_row(g, F.lane, gv);
    float w8[16][8];
#pragma unroll
    for (int j = 0; j < 4; ++j)
#pragma unroll
        for (int e = 0; e < 4; ++e) { const int k = 256 * j + 4 * F.lane + e; const f32x4 lo = *(const f32x4*)(win + (size_t)k * EV_IN + EV_N), hi = *(const f32x4*)(win + (size_t)k * EV_IN + EV_N + 4);
#pragma unroll
            for (int c = 0; c < 4; ++c) { w8[4 * j + e][c] = lo[c]; w8[4 * j + e][4 + c] = hi[c]; } }
    const int h4 = F.lane & 3;
    const float negA = -__expf(a.in[9][h4]), dtb = a.in[10][h4];
    const int gw = F.vcu * 8 + F.wave, NGW = F.G * 8;
    for (int m = gw; m < T; m += NGW) {
        f32x4 v[4]; load_row(x + (size_t)m * D, F.lane, v);
        const float rstd = rsqrtf(wave_sum(sumsq16(v)) * (1.f / D) + EPS);
#pragma unroll
        for (int j = 0; j < 4; ++j) v[j] = v[j] * rstd * gv[j];
        { const float sc = quant_row_store(dst + (size_t)m * D, F.lane, v); if (F.lane == 0) SA[m] = sc; }
        float dsum[8];
#pragma unroll
        for (int c = 0; c < 8; ++c) { float s = 0.f;
#pragma unroll
            for (int j = 0; j < 4; ++j)
#pragma unroll
                for (int e = 0; e < 4; ++e) s += v[j][e] * w8[4 * j + e][c];
            dsum[c] = wave_sum(s); }
        float af = dsum[0], bfv = dsum[4];
        if (h4 == 1) { af = dsum[1]; bfv = dsum[5]; } else if (h4 == 2) { af = dsum[2]; bfv = dsum[6]; } else if (h4 == 3) { af = dsum[3]; bfv = dsum[7]; }
        const float z = af + dtb; const float sp = (z > 20.f) ? z : log1pf(__expf(z));
        if (F.lane < 4) { GA[(size_t)m * 4 + h4] = negA * sp; BT[(size_t)m * 4 + h4] = sigmoid_f(bfv); }
    }
}
DI void convert_p(const Frame& F, const float* p, bf16* dst) {
    const size_t n8 = (size_t)T * 256 / 8;
    for (size_t i = (size_t)F.vcu * 512 + F.tid; i < n8; i += (size_t)F.G * 512) {
        const f32x4 a = *(const f32x4*)(p + i * 8), b = *(const f32x4*)(p + i * 8 + 4);
        *(u32x4*)(dst + i * 8) = pg8::pack8(a, b);
    }
}
DI void norm_router(const Frame& F, const Args& a) {
    const float* h = a.out; const float* g = a.in[3] + D; const float* wr_ = a.in[24];
    signed char* dst = (signed char*)(F.ws + WS_HN); int* row_ts = (int*)(F.ws + WS_ROWTS); float* row_gate = (float*)(F.ws + WS_ROWGATE); float* row_sa = (float*)(F.ws + WS_ROWSA); unsigned* ctl = (unsigned*)(F.ws + WS_CTL);
    f32x4 gv[4]; load_row(g, F.lane, gv);
    float w8[16][8];
#pragma unroll
    for (int j = 0; j < 4; ++j)
#pragma unroll
        for (int e = 0; e < 4; ++e) { const int k = 256 * j + 4 * F.lane + e; const f32x4 lo = *(const f32x4*)(wr_ + (size_t)k * 8), hi = *(const f32x4*)(wr_ + (size_t)k * 8 + 4);
#pragma unroll
            for (int c = 0; c < 4; ++c) { w8[4 * j + e][c] = lo[c]; w8[4 * j + e][4 + c] = hi[c]; } }
    const int gw = F.vcu * 8 + F.wave, NGW = F.G * 8;
    if (gw == 0) { unsigned* z = (unsigned*)(dst + (size_t)T * D) + F.lane;
#pragma unroll
        for (int j = 0; j < 4; ++j) z[64 * j] = 0u; }
    for (int grp = gw; grp < T / 32; grp += NGW) {
        int e0 = 0, e1 = 1; float g0 = 0.f, g1 = 0.f, sav = 0.f;
        for (int rr = 0; rr < 32; ++rr) {
            const int m = grp * 32 + rr;
            f32x4 v[4]; load_row(h + (size_t)m * D, F.lane, v);
            const float rstd = rsqrtf(wave_sum(sumsq16(v)) * (1.f / D) + EPS);
#pragma unroll
            for (int j = 0; j < 4; ++j) v[j] = v[j] * rstd * gv[j];
            float am = 0.f;
#pragma unroll
            for (int j = 0; j < 4; ++j) am = fmaxf(fmaxf(am, fmaxf(fabsf(v[j].x), fabsf(v[j].y))), fmaxf(fabsf(v[j].z), fabsf(v[j].w)));
            am = wave_max(am);
            const float qinv = am > 0.f ? 127.f / am : 0.f;
            { unsigned* o4 = (unsigned*)(dst + (size_t)m * D) + F.lane;
#pragma unroll
              for (int j = 0; j < 4; ++j) { const int b0 = __float2int_rn(v[j].x * qinv), b1 = __float2int_rn(v[j].y * qinv), b2 = __float2int_rn(v[j].z * qinv), b3 = __float2int_rn(v[j].w * qinv);
                  o4[64 * j] = (unsigned)(b0 & 0xff) | ((unsigned)(b1 & 0xff) << 8) | ((unsigned)(b2 & 0xff) << 16) | ((unsigned)(b3 & 0xff) << 24); } }
            float lg[8];
#pragma unroll
            for (int c = 0; c < 8; ++c) { float s = 0.f;
#pragma unroll
                for (int j = 0; j < 4; ++j)
#pragma unroll
                    for (int e = 0; e < 4; ++e) s += v[j][e] * w8[4 * j + e][c];
                lg[c] = wave_sum(s); }
            int b0 = 0; float v0 = lg[0];
#pragma unroll
            for (int c = 1; c < 8; ++c) if (lg[c] > v0) { v0 = lg[c]; b0 = c; }
            int b1 = -1; float v1 = -INFINITY;
#pragma unroll
            for (int c = 0; c < 8; ++c) if (c != b0 && lg[c] > v1) { v1 = lg[c]; b1 = c; }
            const float ga = 1.f / (1.f + __expf(v1 - v0));
            if (F.lane == rr) { e0 = b0; e1 = b1; g0 = ga; g1 = 1.f - ga; sav = am * (1.f / 127.f); }
        }
        const bool act = F.lane < 32;
#pragma unroll
        for (int e = 0; e < 8; ++e) {
            const unsigned long long m0 = __ballot(act && e0 == e), m1 = __ballot(act && e1 == e);
            const int n0 = __popcll(m0), n1 = __popcll(m1);
            if (n0 + n1 == 0) continue;
            unsigned base = 0;
            if (F.lane == 0) base = __hip_atomic_fetch_add(ctl + CW_CNT + 64 * e, (unsigned)(n0 + n1), __ATOMIC_RELAXED, __HIP_MEMORY_SCOPE_AGENT);
            base = (unsigned)__builtin_amdgcn_readfirstlane((int)base);
            const unsigned long long below = (1ull << F.lane) - 1ull;
            const int tok = grp * 32 + F.lane;
            if (act && e0 == e) { const unsigned off = base + (unsigned)__popcll(m0 & below); row_ts[(size_t)e * CAP + off] = tok * 2; row_gate[(size_t)e * CAP + off] = g0; row_sa[(size_t)e * CAP + off] = sav; }
            if (act && e1 == e) { const unsigned off = base + (unsigned)n0 + (unsigned)__popcll(m1 & below); row_ts[(size_t)e * CAP + off] = tok * 2 + 1; row_gate[(size_t)e * CAP + off] = g1; row_sa[(size_t)e * CAP + off] = sav; }
        }
    }
}
DI void combine_norm(const Frame& F, const Args& a) {
    float* h = a.out; const float* g = a.in[4] + D; const bf16* ym = (const bf16*)(F.ws + WS_YMOE); signed char* dst = (signed char*)(F.ws + WS_HN); float* SA = (float*)(F.ws + WS_SA);
    f32x4 gv[4]; load_row(g, F.lane, gv);
    const int gw = F.vcu * 8 + F.wave, NGW = F.G * 8;
    for (int m = gw; m < T; m += NGW) {
        f32x4 v[4]; load_row(h + (size_t)m * D, F.lane, v);
        const u32x2* y0 = (const u32x2*)(ym + (size_t)m * 2 * D) + F.lane; const u32x2* y1 = (const u32x2*)(ym + (size_t)m * 2 * D + D) + F.lane;
#pragma unroll
        for (int j = 0; j < 4; ++j) { const u32x2 p = y0[64 * j], q = y1[64 * j];
            v[j].x += bflo(p.x) + bflo(q.x); v[j].y += bfhi(p.x) + bfhi(q.x); v[j].z += bflo(p.y) + bflo(q.y); v[j].w += bfhi(p.y) + bfhi(q.y); }
        f32x4* hw = (f32x4*)(h + (size_t)m * D) + F.lane;
#pragma unroll
        for (int j = 0; j < 4; ++j) hw[64 * j] = v[j];
        const float rstd = rsqrtf(wave_sum(sumsq16(v)) * (1.f / D) + EPS);
#pragma unroll
        for (int j = 0; j < 4; ++j) v[j] = v[j] * rstd * gv[j];
        { const float sc = quant_row_store(dst + (size_t)m * D, F.lane, v); if (F.lane == 0) SA[m] = sc; }
    }
}
DI void final_norm(const Frame& F, const Args& a) {
    float* h = a.out; const float* g = a.in[5];
    f32x4 gv[4]; load_row(g, F.lane, gv);
    const int gw = F.vcu * 8 + F.wave, NGW = F.G * 8;
    for (int m = gw; m < T; m += NGW) {
        f32x4 v[4]; load_row(h + (size_t)m * D, F.lane, v);
        const float rstd = rsqrtf(wave_sum(sumsq16(v)) * (1.f / D) + EPS);
        f32x4* hw = (f32x4*)(h + (size_t)m * D) + F.lane;
#pragma unroll
        for (int j = 0; j < 4; ++j) hw[64 * j] = v[j] * rstd * gv[j];
    }
}

DI void mixer_a(const Frame& F, const Args& a, int worker, int nworkers) {
    const bf16* U = (const bf16*)(F.ws + WS_U); bf16* Y = (bf16*)(F.ws + WS_Y); const float* cw = a.in[7];
    const size_t nitems = (size_t)T * 64;
    for (size_t it = (size_t)worker * 512 + F.tid; it < nitems; it += (size_t)nworkers * 512) {
        const int t = (int)(it >> 6), c8 = (int)(it & 63) * 8, s = t & (SEQ - 1);
        const u32x4 bg = *(const u32x4*)(U + (size_t)t * EVU + c8);
        const u32x4 z2 = *(const u32x4*)(U + (size_t)t * EVU + 512 + c8);
        u32x4 z1 = (u32x4){0u, 0u, 0u, 0u}, z0 = (u32x4){0u, 0u, 0u, 0u};
        if (s >= 1) z1 = *(const u32x4*)(U + (size_t)(t - 1) * EVU + 512 + c8);
        if (s >= 2) z0 = *(const u32x4*)(U + (size_t)(t - 2) * EVU + 512 + c8);
        float o[8];
#pragma unroll
        for (int q = 0; q < 4; ++q) {
            const int c = c8 + 2 * q;
            const float a0 = cw[c] * bflo(z0[q]) + cw[512 + c] * bflo(z1[q]) + cw[1024 + c] * bflo(z2[q]);
            const float a1 = cw[c + 1] * bfhi(z0[q]) + cw[512 + c + 1] * bfhi(z1[q]) + cw[1024 + c + 1] * bfhi(z2[q]);
            o[2 * q] = bflo(bg[q]) * a0; o[2 * q + 1] = bfhi(bg[q]) * a1;
        }
        u32x4 w; w.x = pk2(o[0], o[1]); w.y = pk2(o[2], o[3]); w.z = pk2(o[4], o[5]); w.w = pk2(o[6], o[7]);
        *(u32x4*)(Y + (size_t)t * D + c8) = w;
    }
}

constexpr int GA_GCS = 0, GA_BTS = 256, GA_KN = 1024, GA_KB = GA_KN + 17408, GA_QN = GA_KB + 17408, GA_VBT = GA_QN + 17408, GA_KGT = GA_VBT + 18432,
              GA_AM = GA_KGT + 18432, GA_TB = GA_AM + 17408, GA_QKS = GA_TB + 9216, GA_CW = GA_QKS + 9216, GA_END = GA_CW + 6144;
static_assert(GA_END <= 155648, "gdn-a lds");
DI void gdn_a(const Frame& F, const Args& a) {
    LAS unsigned char* L = F.lds;
    LAS float* gcs = (LAS float*)(L + GA_GCS); LAS float* bts = (LAS float*)(L + GA_BTS);
    LAS float* Am = (LAS float*)(L + GA_AM);
    const bf16* U = (const bf16*)(F.ws + WS_U); const float* GA = (const float*)(F.ws + WS_GA); const float* BT = (const float*)(F.ws + WS_BETA);
    float* EG = (float*)(F.ws + WS_EG); const float* cw = a.in[8];
    const int lane = F.lane, w = F.wave, r = lane & 31, hh = lane >> 5;
    for (int item = F.vcu; item < 4096; item += F.G) {
        const int bh = item >> 5, n = item & 31, b = bh >> 2, h = bh & 3, t0 = b * SEQ + n * 64;
        unsigned char* Gp = F.ws + WS_G + (size_t)item * G_ITEM;
        if (w == 0) {
            float gc = GA[(size_t)(t0 + lane) * 4 + h];
#pragma unroll
            for (int o = 1; o < 64; o <<= 1) { const float up = __shfl_up(gc, o); if (lane >= o) gc += up; }
            gcs[lane] = gc; bts[lane] = BT[(size_t)(t0 + lane) * 4 + h];
            if (lane == 63) EG[item] = __expf(gc);
        }
        for (int i = F.tid; i < 1536; i += 512) { const int part = i >> 9, rem = i & 511, j = rem >> 7, c = rem & 127; *(LAS float*)(L + GA_CW + i * 4) = cw[j * 1536 + part * 512 + h * 128 + c]; }
        const int g2 = (F.tid >> 4) * 2, c8 = (F.tid & 15) * 8;
        u32x4 xr[3][5];
#pragma unroll
        for (int part = 0; part < 3; ++part)
#pragma unroll
            for (int q = 0; q < 5; ++q) {
                xr[part][q] = (u32x4){0u, 0u, 0u, 0u};
                if (n * 64 + g2 - 3 + q >= 0) xr[part][q] = *(const u32x4*)(U + (size_t)(t0 + g2 - 3 + q) * EVU + 1024 + part * 512 + h * 128 + c8);
            }
        WG_BAR();
        const float glast = gcs[63];
#pragma unroll
        for (int part = 0; part < 3; ++part) {
#pragma unroll
            for (int tk = 0; tk < 2; ++tk) {
                const int tok = g2 + tk;
                float acc[8];
#pragma unroll
                for (int e = 0; e < 8; ++e) acc[e] = 0.f;
#pragma unroll
                for (int j = 0; j < 4; ++j) {
                    const u32x4 xv = xr[part][tk + j];
                    const f32x4 w0 = *(const LAS f32x4*)(L + GA_CW + ((part * 4 + j) * 128 + c8) * 4), w1 = *(const LAS f32x4*)(L + GA_CW + ((part * 4 + j) * 128 + c8 + 4) * 4);
                    acc[0] += w0[0] * bflo(xv[0]); acc[1] += w0[1] * bfhi(xv[0]); acc[2] += w0[2] * bflo(xv[1]); acc[3] += w0[3] * bfhi(xv[1]);
                    acc[4] += w1[0] * bflo(xv[2]); acc[5] += w1[1] * bfhi(xv[2]); acc[6] += w1[2] * bflo(xv[3]); acc[7] += w1[3] * bfhi(xv[3]);
                }
                float ss = 0.f;
#pragma unroll
                for (int e = 0; e < 8; ++e) { acc[e] = silu_f(acc[e]); ss += acc[e] * acc[e]; }
                ss = row16_sum(ss);
                const float beta = bts[tok], gc = gcs[tok];
                if (part == 0) {
                    const float sc = rsqrtf(ss + EPS) * 0.08838834764831845f, eg = __expf(gc);
                    u32x4 o; o.x = pk2(acc[0] * sc, acc[1] * sc); o.y = pk2(acc[2] * sc, acc[3] * sc); o.z = pk2(acc[4] * sc, acc[5] * sc); o.w = pk2(acc[6] * sc, acc[7] * sc);
                    *(LAS u32x4*)(L + GA_QN + tok * 272 + c8 * 2) = o;
                    const float s2 = sc * eg;
                    u32x4 g; g.x = pk2(acc[0] * s2, acc[1] * s2); g.y = pk2(acc[2] * s2, acc[3] * s2); g.z = pk2(acc[4] * s2, acc[5] * s2); g.w = pk2(acc[6] * s2, acc[7] * s2);
                    *(u32x4*)(Gp + G_QG + tok * 256 + c8 * 2) = g;
                } else if (part == 1) {
                    const float sc = rsqrtf(ss + EPS), sb = sc * beta, sg = sb * __expf(gc), sd = sc * __expf(glast - gc);
                    u32x4 o; o.x = pk2(acc[0] * sc, acc[1] * sc); o.y = pk2(acc[2] * sc, acc[3] * sc); o.z = pk2(acc[4] * sc, acc[5] * sc); o.w = pk2(acc[6] * sc, acc[7] * sc);
                    *(LAS u32x4*)(L + GA_KN + tok * 272 + c8 * 2) = o;
                    u32x4 p; p.x = pk2(acc[0] * sb, acc[1] * sb); p.y = pk2(acc[2] * sb, acc[3] * sb); p.z = pk2(acc[4] * sb, acc[5] * sb); p.w = pk2(acc[6] * sb, acc[7] * sb);
                    *(LAS u32x4*)(L + GA_KB + tok * 272 + c8 * 2) = p;
                    u32x4 d; d.x = pk2(acc[0] * sd, acc[1] * sd); d.y = pk2(acc[2] * sd, acc[3] * sd); d.z = pk2(acc[4] * sd, acc[5] * sd); d.w = pk2(acc[6] * sd, acc[7] * sd);
                    *(u32x4*)(Gp + G_KD + tok * 256 + c8 * 2) = d;
#pragma unroll
                    for (int e = 0; e < 8; ++e) *(LAS bf16*)(L + GA_KGT + (c8 + e) * 144 + tok * 2) = (bf16)(pk2(acc[e] * sg, 0.f) & 0xffffu);
                } else {
#pragma unroll
                    for (int e = 0; e < 8; ++e) *(LAS bf16*)(L + GA_VBT + (c8 + e) * 144 + tok * 2) = (bf16)(pk2(acc[e] * beta, 0.f) & 0xffffu);
                }
            }
        }
        WG_BAR();
        {
            const int mat = w >> 2, ti = (w >> 1) & 1, tj = w & 1;
            f32x16 x = zero16();
            if (ti >= tj) {
                const LAS unsigned char* ap = L + (mat ? GA_QN : GA_KB) + (32 * ti + r) * 272 + hh * 16;
                const LAS unsigned char* bp = L + GA_KN + (32 * tj + r) * 272 + hh * 16;
#pragma unroll
                for (int s = 0; s < 8; ++s) x = MFMA32(*(const LAS bf16x8*)(ap + 32 * s), *(const LAS bf16x8*)(bp + 32 * s), x);
            }
            const int j = 32 * tj + r; const float gj = gcs[j];
#pragma unroll
            for (int reg = 0; reg < 16; ++reg) {
                const int i = 32 * ti + crow(reg, hh);
                const float dec = __expf(gcs[i] - gj);
                if (mat == 0) Am[i * 68 + j] = (i > j) ? x[reg] * dec : 0.f;
                else *(LAS bf16*)(L + GA_QKS + i * 144 + j * 2) = (bf16)(pk2((i >= j) ? x[reg] * dec : 0.f, 0.f) & 0xffffu);
            }
        }
        WG_BAR();
        if (w == 0) {
            const int blk = hh, col = r;
            float Tr[32];
            const LAS float* Ab = Am + (blk * 32) * 68 + blk * 32;
#pragma unroll
            for (int i = 0; i < 32; ++i) {
                float acc = (i == col) ? 1.f : 0.f;
#pragma unroll
                for (int j = 0; j < i; ++j) acc -= Ab[i * 68 + j] * Tr[j];
                Tr[i] = acc;
            }
#pragma unroll
            for (int i = 0; i < 32; ++i) *(LAS bf16*)(L + GA_TB + (blk * 32 + i) * 144 + (blk * 32 + col) * 2) = (bf16)(pk2(Tr[i], 0.f) & 0xffffu);
#pragma unroll
            for (int i = 0; i < 16; ++i) *(LAS bf16*)(L + GA_TB + (2 * i + blk) * 144 + (32 + col) * 2) = (bf16)0;
            f32x16 P = zero16();
#pragma unroll
            for (int s = 0; s < 2; ++s) {
                const LAS float* arow = Am + (32 + r) * 68 + 16 * s + 8 * hh;
                const f32x4 a0 = *(const LAS f32x4*)arow, a1 = *(const LAS f32x4*)(arow + 4);
                const bf16x8 af = __builtin_bit_cast(bf16x8, pg8::pack8(a0, a1));
                float tv[8];
#pragma unroll
                for (int jj = 0; jj < 8; ++jj) { const float lo = Tr[16 * s + jj]; const float hi = __shfl(Tr[16 * s + 8 + jj], r); tv[jj] = hh ? hi : lo; }
                u32x4 tb; tb.x = pk2(tv[0], tv[1]); tb.y = pk2(tv[2], tv[3]); tb.z = pk2(tv[4], tv[5]); tb.w = pk2(tv[6], tv[7]);
                P = MFMA32(af, __builtin_bit_cast(bf16x8, tb), P);
            }
            f32x16 R = zero16();
#pragma unroll
            for (int s = 0; s < 2; ++s) {
                const LAS unsigned char* tp = L + GA_TB + (32 + r) * 144 + (32 + 16 * s + 4 * hh) * 2;
                const s16x4 lo = *(const LAS s16x4*)tp, hi = *(const LAS s16x4*)(tp + 16);
                R = MFMA32(cat8(lo, hi), pack_step(P, s), R);
            }
#pragma unroll
            for (int reg = 0; reg < 16; ++reg) *(LAS bf16*)(L + GA_TB + (32 + crow(reg, hh)) * 144 + r * 2) = (bf16)(pk2(-R[reg], 0.f) & 0xffffu);
        } else {
            for (int p = F.tid - 64; p < 512; p += 448) { const int row = p >> 3, c = p & 7; *(u32x4*)(Gp + G_QK + row * 128 + c * 16) = *(const LAS u32x4*)(L + GA_QKS + row * 144 + c * 16); }
        }
        WG_BAR();
        if (w < 4) {
#pragma unroll
            for (int q = 0; q < 2; ++q) {
                const int idx = w * 2 + q, ib = idx >> 2, db = idx & 3;
                f32x16 x = zero16();
                const LAS unsigned char* ap = L + GA_TB + (32 * ib + r) * 144 + hh * 16;
                const LAS unsigned char* bp = L + GA_VBT + (32 * db + r) * 144 + hh * 16;
#pragma unroll
                for (int s = 0; s < 4; ++s) if (ib || s < 2) x = MFMA32(*(const LAS bf16x8*)(ap + 32 * s), *(const LAS bf16x8*)(bp + 32 * s), x);
#pragma unroll
                for (int g = 0; g < 4; ++g) { u32x2 o; o.x = pk2(x[4 * g], x[4 * g + 1]); o.y = pk2(x[4 * g + 2], x[4 * g + 3]);
                    *(u32x2*)(Gp + G_UT + ((32 * db + r) * 64 + 32 * ib + 8 * g + 4 * hh) * 2) = o; }
            }
        } else {
#pragma unroll
            for (int q = 0; q < 2; ++q) {
                const int idx = (w - 4) * 2 + q, dkb = idx >> 1, ib = idx & 1;
                f32x16 x = zero16();
                const LAS unsigned char* ap = L + GA_KGT + (32 * dkb + r) * 144 + hh * 16;
                const LAS unsigned char* bp = L + GA_TB + (32 * ib + r) * 144 + hh * 16;
#pragma unroll
                for (int s = 0; s < 4; ++s) if (ib || s < 2) x = MFMA32(*(const LAS bf16x8*)(ap + 32 * s), *(const LAS bf16x8*)(bp + 32 * s), x);
#pragma unroll
                for (int g = 0; g < 4; ++g) { u32x2 o; o.x = pk2(x[4 * g], x[4 * g + 1]); o.y = pk2(x[4 * g + 2], x[4 * g + 3]);
                    *(u32x2*)(Gp + G_W + ((32 * ib + r) * 128 + 32 * dkb + 8 * g + 4 * hh) * 2) = o; }
            }
        }
        WG_BAR();
    }
}

constexpr int GB_ST = 0, GB_W = 34816, GB_QG = GB_W + 17408, GB_KD = GB_QG + 17408, GB_QK = GB_KD + 20480, GB_O = GB_QK + 9216, GB_END = GB_O + 33792;
static_assert(GB_END <= 140000, "gdn-b lds");
DI void gdn_b(const Frame& F, const Args& a, int worker, int nworkers) {
    LAS unsigned char* L = F.lds;
    const bf16* U = (const bf16*)(F.ws + WS_U); bf16* Y = (bf16*)(F.ws + WS_Y); const float* EG = (const float*)(F.ws + WS_EG); const float* gn = a.in[11];
    const int lane = F.lane, w = F.wave, r = lane & 31, hh = lane >> 5, dvb = w & 3, hf = w >> 2;
    const int q4 = (lane & 15) >> 2, p4 = lane & 3, g1 = (lane >> 4) & 1;
    const float gn0 = gn[2 * lane], gn1 = gn[2 * lane + 1];
    const unsigned src_t = (unsigned)F.tid * 16u;
    const unsigned dst_w = (unsigned)((F.tid >> 4) * 272 + (F.tid & 15) * 16);
    const unsigned dst_k = (unsigned)((F.tid >> 4) * 320 + (F.tid & 15) * 16);
    const unsigned dst_q = (unsigned)((F.tid >> 3) * 144 + (F.tid & 7) * 16);
    const unsigned ut_t = (unsigned)(((32 * dvb + r) * 64 + 4 * hh) * 2);
    for (int bh = worker; bh < 128; bh += nworkers) {
        const int b = bh >> 2, h = bh & 3;
        f32x16 Sacc[2] = {zero16(), zero16()};
        for (int p = F.tid; p < 34816 / 16; p += 512) *(LAS u32x4*)(L + GB_ST + p * 16) = (u32x4){0u, 0u, 0u, 0u};
        u32x4 nop[7]; u32x2 nui[2][4]; float neg; unsigned nog[8];
#define GB_PREFETCH(nn) do { const int _item = bh * 32 + (nn); const unsigned char* _Gp = F.ws + WS_G + (size_t)_item * G_ITEM; \
            unsigned _so = src_t, _uo = ut_t; asm volatile("" : "+v"(_so), "+v"(_uo)); \
            _Pragma("unroll") for (int k = 0; k < 7; ++k) { const unsigned char* _bk = _Gp + (8192 * k + (k >= 2 ? 16384 : 0)); nop[k] = *(const u32x4*)(_bk + _so); } \
            _Pragma("unroll") for (int tb = 0; tb < 2; ++tb) _Pragma("unroll") for (int g = 0; g < 4; ++g) { const unsigned char* _bu = _Gp + G_UT + (64 * tb + 16 * g); nui[tb][g] = *(const u32x2*)(_bu + _uo); } \
            neg = EG[_item]; \
            const bf16* _og = U + (size_t)(b * SEQ + (nn) * 64 + w * 8) * EVU + 2560 + h * 128; \
            unsigned _lo = (unsigned)lane * 4u; asm volatile("" : "+v"(_lo)); \
            _Pragma("unroll") for (int k = 0; k < 8; ++k) { const unsigned char* _bo = (const unsigned char*)(_og + (size_t)k * EVU); nog[k] = *(const unsigned*)(_bo + _lo); } } while (0)
        GB_PREFETCH(0);
        for (int n = 0; n < 32; ++n) {
            const int t0 = b * SEQ + n * 64;
            *(LAS u32x4*)(L + GB_W + dst_w) = nop[0]; *(LAS u32x4*)(L + GB_W + dst_w + 32 * 272) = nop[1];
            *(LAS u32x4*)(L + GB_QG + dst_w) = nop[2]; *(LAS u32x4*)(L + GB_QG + dst_w + 32 * 272) = nop[3];
            *(LAS u32x4*)(L + GB_KD + dst_k) = nop[4]; *(LAS u32x4*)(L + GB_KD + dst_k + 32 * 320) = nop[5];
            *(LAS u32x4*)(L + GB_QK + dst_q) = nop[6];
            u32x2 ui[2][4]; unsigned og[8];
#pragma unroll
            for (int tb = 0; tb < 2; ++tb)
#pragma unroll
                for (int g = 0; g < 4; ++g) ui[tb][g] = nui[tb][g];
#pragma unroll
            for (int k = 0; k < 8; ++k) og[k] = nog[k];
            const float eg = neg;
            WG_BAR();
            if (n + 1 < 32) GB_PREFETCH(n + 1);
            f32x16 x0 = zero16(), x1 = zero16(), o = zero16();
            {
                const LAS unsigned char* sp = L + GB_ST + (32 * dvb + r) * 272 + hh * 16;
                const LAS unsigned char* wp = L + GB_W + r * 272 + hh * 16;
                const LAS unsigned char* qp = L + GB_QG + (32 * hf + r) * 272 + hh * 16;
#pragma unroll
                for (int s = 0; s < 8; ++s) {
                    const bf16x8 sf = *(const LAS bf16x8*)(sp + 32 * s);
                    x0 = MFMA32(*(const LAS bf16x8*)(wp + 32 * s), sf, x0);
                    x1 = MFMA32(*(const LAS bf16x8*)(wp + 32 * 272 + 32 * s), sf, x1);
                    o = MFMA32(*(const LAS bf16x8*)(qp + 32 * s), sf, o);
                }
            }
            bf16x8 pv[2][2];
#pragma unroll
            for (int g = 0; g < 4; ++g) {
                x0[4 * g] = bflo(ui[0][g].x) - x0[4 * g]; x0[4 * g + 1] = bfhi(ui[0][g].x) - x0[4 * g + 1]; x0[4 * g + 2] = bflo(ui[0][g].y) - x0[4 * g + 2]; x0[4 * g + 3] = bfhi(ui[0][g].y) - x0[4 * g + 3];
                x1[4 * g] = bflo(ui[1][g].x) - x1[4 * g]; x1[4 * g + 1] = bfhi(ui[1][g].x) - x1[4 * g + 1]; x1[4 * g + 2] = bflo(ui[1][g].y) - x1[4 * g + 2]; x1[4 * g + 3] = bfhi(ui[1][g].y) - x1[4 * g + 3];
            }
            pv[0][0] = pack_step(x0, 0); pv[0][1] = pack_step(x0, 1); pv[1][0] = pack_step(x1, 0); pv[1][1] = pack_step(x1, 1);
#pragma unroll
            for (int tb = 0; tb < 2; ++tb) {
                if (tb <= hf) {
#pragma unroll
                    for (int s = 0; s < 2; ++s) {
                        const LAS unsigned char* kp = L + GB_QK + (32 * hf + r) * 144 + (32 * tb + 16 * s + 4 * hh) * 2;
                        o = MFMA32(cat8(*(const LAS s16x4*)kp, *(const LAS s16x4*)(kp + 16)), pv[tb][s], o);
                    }
                }
            }
            {
                LAS float* Ol = (LAS float*)(L + GB_O) + (32 * hf + 4 * hh) * 132 + 32 * dvb + r;
#pragma unroll
                for (int reg = 0; reg < 16; ++reg) Ol[((reg & 3) + 8 * (reg >> 2)) * 132] = o[reg];
            }
#pragma unroll
            for (int d2 = 0; d2 < 2; ++d2) {
                const int db = 2 * hf + d2;
                f32x16 x = Sacc[d2] * eg;
                const LAS unsigned char* kb = L + GB_KD + (4 * hh + q4) * 320 + (32 * db + 16 * g1 + 4 * p4) * 2;
#pragma unroll
                for (int tb = 0; tb < 2; ++tb)
#pragma unroll
                    for (int s = 0; s < 2; ++s) {
                        const LAS unsigned char* kp = kb + (32 * tb + 16 * s) * 320;
                        x = MFMA32(cat8(vtr(kp), vtr(kp + 8 * 320)), pv[tb][s], x);
                    }
                Sacc[d2] = x;
            }
            WG_BAR();
#pragma unroll
            for (int d2 = 0; d2 < 2; ++d2) {
                const int db = 2 * hf + d2;
#pragma unroll
                for (int g = 0; g < 4; ++g) { u32x2 ov; ov.x = pk2(Sacc[d2][4 * g], Sacc[d2][4 * g + 1]); ov.y = pk2(Sacc[d2][4 * g + 2], Sacc[d2][4 * g + 3]);
                    *(LAS u32x2*)(L + GB_ST + (32 * dvb + r) * 272 + (32 * db + 8 * g + 4 * hh) * 2) = ov; }
            }
            {
                const LAS float* Ol = (const LAS float*)(L + GB_O) + (w * 8) * 132 + 2 * lane;
                bf16* yp = Y + (size_t)(t0 + w * 8) * D + 512 + h * 128 + 2 * lane;
#pragma unroll
                for (int k = 0; k < 8; ++k) {
                    const f32x2_t v = *(const LAS f32x2_t*)(Ol + k * 132);
                    const float rstd = rsqrtf(wave_sum(v.x * v.x + v.y * v.y) * (1.f / 128.f) + EPS);
                    *(unsigned*)(yp + (size_t)k * D) = pk2(v.x * rstd * gn0 * silu_f(bflo(og[k])), v.y * rstd * gn1 * silu_f(bfhi(og[k])));
                }
            }
        }
        WG_BAR();
    }
#undef GB_PREFETCH
}

constexpr int AT_STAGE = 38912, AT_K = 0, AT_V = 18432, AT_BIAS = 2 * AT_STAGE, AT_END = AT_BIAS + 512;
DI void attn_stage_load(const bf16* U1, int trow, int h, int tid, u32x4 (&st)[4]) {
#pragma unroll
    for (int p = 0; p < 4; ++p) { const int idx = tid + 512 * p, row = idx >> 5, c = idx & 31;
        st[p] = *(const u32x4*)(U1 + (size_t)(trow + row) * OD_N + (c < 16 ? 512 + h * 128 + c * 8 : 1024 + h * 128 + (c - 16) * 8)); }
}
DI void attn_stage_store(LAS unsigned char* sb, int tid, const u32x4 (&st)[4]) {
#pragma unroll
    for (int p = 0; p < 4; ++p) { const int idx = tid + 512 * p, row = idx >> 5, c = idx & 31;
        if (c < 16) { const int e = c * 8, mp = e >> 6, wi = e & 63; *(LAS u32x4*)(sb + AT_K + mp * 9216 + row * 144 + wi * 2) = st[p]; }
        else *(LAS u32x4*)(sb + AT_V + row * 320 + (c - 16) * 16) = st[p]; }
}
DI void attn_phase(const Frame& F, const Args& a) {
    LAS unsigned char* L = F.lds;
    const bf16* U1 = (const bf16*)(F.ws + WS_U); bf16* Y = (bf16*)(F.ws + WS_Y);
    const float* lamp = a.in[14]; const float* dng = a.in[15]; const float* relb = a.in[21];
    const int lane = F.lane, w = F.wave, r = lane & 31, hh = lane >> 5, mp = w >> 2, qs = w & 3;
    const int q4 = (lane & 15) >> 2, p4 = lane & 3, g1 = (lane >> 4) & 1;
    const float lam = __expf(wave_sum(lamp[lane] * lamp[64 + lane])) - __expf(wave_sum(lamp[128 + lane] * lamp[192 + lane])) + LAMBDA_INIT;
    const float c1 = 0.125f * LOG2E;
    LAS float* btab = (LAS float*)(L + AT_BIAS);
    LAS float* exch = (LAS float*)L;
    for (int item = F.vcu; item < 256; item += F.G) {
        const int bh = item >> 1, par = item & 1, b = bh >> 2, h = bh & 3, trow0 = b * SEQ;
        WG_BAR();
        if (F.tid < 128) { const int n = F.tid; int bucket = n;
            if (n >= 16) { const int lg = 16 + (int)(__logf((float)n / 16.f) / 2.0794415416798357f * 16.f); bucket = lg < 31 ? lg : 31; }
            btab[n] = relb[bucket * 4 + h] * LOG2E; }
        const float bias_far = relb[31 * 4 + h] * LOG2E;
        for (int ui = 0; ui < 8; ++ui) {
            const int qblk = 2 * ui + ((ui ^ par) & 1);
            const int q0 = qblk * 128 + qs * 32, qpos = q0 + r, ntiles = 2 * (qblk + 1);
            bf16x8 qf[4];
            { const bf16* qp = U1 + (size_t)(trow0 + qpos) * OD_N + h * 128 + mp * 64 + 8 * hh;
#pragma unroll
              for (int s = 0; s < 4; ++s) qf[s] = *(const bf16x8*)(qp + 16 * s); }
            f32x16 O[4] = {zero16(), zero16(), zero16(), zero16()};
            float mrun = -INFINITY, lrun = 0.f;
            u32x4 st[4];
            attn_stage_load(U1, trow0, h, F.tid, st);
            attn_stage_store(L, F.tid, st);
            WG_BAR();
            for (int kt = 0; kt < ntiles; ++kt) {
                const bool more = kt + 1 < ntiles;
                if (more) attn_stage_load(U1, trow0 + (kt + 1) * 64, h, F.tid, st);
                const int key0 = kt * 64;
                if (key0 <= q0 + 31) {
                    const LAS unsigned char* sb = L + (kt & 1) * AT_STAGE;
                    const LAS unsigned char* kb = sb + AT_K + mp * 9216 + r * 144 + hh * 16;
                    f32x16 x0 = zero16(), x1 = zero16();
#pragma unroll
                    for (int s = 0; s < 4; ++s) { x0 = MFMA32(*(const LAS bf16x8*)(kb + 32 * s), qf[s], x0); x1 = MFMA32(*(const LAS bf16x8*)(kb + 32 * 144 + 32 * s), qf[s], x1); }
                    if (q0 - (key0 + 63) >= 128) {
#pragma unroll
                        for (int reg = 0; reg < 16; ++reg) { x0[reg] = x0[reg] * c1 + bias_far; x1[reg] = x1[reg] * c1 + bias_far; }
                    } else {
#pragma unroll
                        for (int reg = 0; reg < 16; ++reg) {
                            const int d0 = qpos - (key0 + crow(reg, hh)), d1 = d0 - 32;
                            const float b0 = btab[d0 < 0 ? 0 : (d0 > 127 ? 127 : d0)], b1 = btab[d1 < 0 ? 0 : (d1 > 127 ? 127 : d1)];
                            x0[reg] = (d0 >= 0) ? x0[reg] * c1 + b0 : -INFINITY; x1[reg] = (d1 >= 0) ? x1[reg] * c1 + b1 : -INFINITY;
                        }
                    }
                    float mx = x0[0];
#pragma unroll
                    for (int reg = 1; reg < 16; ++reg) mx = fmaxf(mx, x0[reg]);
#pragma unroll
                    for (int reg = 0; reg < 16; ++reg) mx = fmaxf(mx, x1[reg]);
                    mx = fmaxf(mx, __shfl_xor(mx, 32));
                    if (__any(mx - mrun > 6.f)) {
                        const float mnew = fmaxf(mrun, mx), alpha = __builtin_amdgcn_exp2f(mrun - mnew); mrun = mnew;
                        lrun *= alpha;
#pragma unroll
                        for (int db = 0; db < 4; ++db) O[db] = O[db] * alpha;
                    }
                    float rs = 0.f;
#pragma unroll
                    for (int reg = 0; reg < 16; ++reg) { x0[reg] = __builtin_amdgcn_exp2f(x0[reg] - mrun); x1[reg] = __builtin_amdgcn_exp2f(x1[reg] - mrun); rs += x0[reg] + x1[reg]; }
                    lrun += rs;
                    bf16x8 pf[2][2]; pf[0][0] = pack_step(x0, 0); pf[0][1] = pack_step(x0, 1); pf[1][0] = pack_step(x1, 0); pf[1][1] = pack_step(x1, 1);
                    const LAS unsigned char* vb = sb + AT_V + (4 * hh + q4) * 320 + (16 * g1 + 4 * p4) * 2;
#pragma unroll
                    for (int db = 0; db < 4; ++db)
#pragma unroll
                        for (int kh = 0; kh < 2; ++kh)
#pragma unroll
                            for (int s = 0; s < 2; ++s) {
                                const LAS unsigned char* vp = vb + (32 * kh + 16 * s) * 320 + 64 * db;
                                O[db] = MFMA32(cat8(vtr(vp), vtr(vp + 8 * 320)), pf[kh][s], O[db]);
                            }
                }
                if (more) attn_stage_store(L + ((kt + 1) & 1) * AT_STAGE, F.tid, st);
                WG_BAR();
            }
            const float ltot = lrun + __shfl_xor(lrun, 32);
            const float inv = 1.f / ltot;
            if (mp == 1) {
                const float sc = inv * lam;
#pragma unroll
                for (int db = 0; db < 4; ++db)
#pragma unroll
                    for (int reg = 0; reg < 16; ++reg) exch[(qs * 64 + db * 16 + reg) * 64 + lane] = O[db][reg] * sc;
            }
            WG_BAR();
            if (mp == 0) {
                float ss = 0.f;
#pragma unroll
                for (int db = 0; db < 4; ++db)
#pragma unroll
                    for (int reg = 0; reg < 16; ++reg) { const float o = O[db][reg] * inv - exch[(qs * 64 + db * 16 + reg) * 64 + lane]; O[db][reg] = o; ss += o * o; }
                ss += __shfl_xor(ss, 32);
                const float rstd = rsqrtf(ss * (1.f / 128.f) + EPS) * (1.f - LAMBDA_INIT);
                bf16* yp = Y + (size_t)(trow0 + qpos) * D + h * 128;
#pragma unroll
                for (int db = 0; db < 4; ++db)
#pragma unroll
                    for (int g = 0; g < 4; ++g) { const int d = 32 * db + 8 * g + 4 * hh; const f32x4 gv = *(const f32x4*)(dng + d);
                        u32x2 o; o.x = pk2(O[db][4 * g] * rstd * gv[0], O[db][4 * g + 1] * rstd * gv[1]); o.y = pk2(O[db][4 * g + 2] * rstd * gv[2], O[db][4 * g + 3] * rstd * gv[3]);
                        *(u32x2*)(yp + d) = o; }
            }
            WG_BAR();
        }
    }
}

constexpr int CF_GLU = 0, CF_RED = 96256, CF_STAT = CF_RED + 4096, CF_END = CF_STAT + 512;
DI void conformer_phase(const Frame& F, const Args& a) {
    LAS unsigned char* L = F.lds;
    const bf16* U1 = (const bf16*)(F.ws + WS_U); bf16* Y = (bf16*)(F.ws + WS_Y);
    const float* cw = a.in[16]; const float* cb = a.in[17]; const float* lg = a.in[18]; const float* lb = a.in[19];
    const int c = F.tid;
    float wv[31];
#pragma unroll
    for (int j = 0; j < 31; ++j) wv[j] = cw[j * 512 + c];
    const float bias = cb[c], lng = lg[c], lnb = lb[c];
    LAS float* red = (LAS float*)(L + CF_RED); LAS float* stat = (LAS float*)(L + CF_STAT);
    for (int tile = F.vcu; tile < T / 64; tile += F.G) {
        const int t0 = tile * 64, s0 = t0 & (SEQ - 1);
        WG_BAR();
        for (int it = F.tid; it < 94 * 64; it += 512) {
            const int row = it >> 6, c8 = (it & 63) * 8;
            u32x4 o = (u32x4){0u, 0u, 0u, 0u};
            if (s0 + row - 30 >= 0) {
                const bf16* up = U1 + (size_t)(t0 + row - 30) * OD_N + 1536 + c8;
                const u32x4 ga = *(const u32x4*)up, gb = *(const u32x4*)(up + 512);
#pragma unroll
                for (int q = 0; q < 4; ++q) o[q] = pk2(bflo(ga[q]) * sigmoid_f(bflo(gb[q])), bfhi(ga[q]) * sigmoid_f(bfhi(gb[q])));
            }
            *(LAS u32x4*)(L + CF_GLU + row * 1024 + c8 * 2) = o;
        }
        WG_BAR();
        float out[64];
#pragma unroll
        for (int tt = 0; tt < 64; ++tt) {
            float acc = bias;
#pragma unroll
            for (int j = 0; j < 31; ++j) acc += wv[j] * bf2f(*(const LAS bf16*)(L + CF_GLU + (tt + j) * 1024 + c * 2));
            out[tt] = acc;
            const float s1 = wave_sum(acc), s2 = wave_sum(acc * acc);
            if (F.lane == 0) { red[(tt * 8 + F.wave) * 2] = s1; red[(tt * 8 + F.wave) * 2 + 1] = s2; }
        }
        WG_BAR();
        if (F.tid < 64) { float s1 = 0.f, s2 = 0.f;
#pragma unroll
            for (int q = 0; q < 8; ++q) { s1 += red[(F.tid * 8 + q) * 2]; s2 += red[(F.tid * 8 + q) * 2 + 1]; }
            const float mean = s1 * (1.f / 512.f); const float var = fmaxf(s2 * (1.f / 512.f) - mean * mean, 0.f);
            stat[F.tid * 2] = mean; stat[F.tid * 2 + 1] = rsqrtf(var + EPS); }
        WG_BAR();
#pragma unroll
        for (int tt = 0; tt < 64; ++tt) {
            const float v = (out[tt] - stat[tt * 2]) * stat[tt * 2 + 1] * lng + lnb;
            Y[(size_t)(t0 + tt) * D + 512 + c] = (bf16)(pk2(silu_f(v), 0.f) & 0xffffu);
        }
    }
}

constexpr int NPH = 26;
__global__ void __launch_bounds__(512, 2) fwd_kernel(Args args) {
    extern __shared__ __attribute__((aligned(16))) unsigned char lds_raw[];
    Frame F;
    F.lds = (LAS unsigned char*)lds_raw; F.ws = args.ws;
    F.tid = threadIdx.x; F.lane = F.tid & 63; F.wave = __builtin_amdgcn_readfirstlane(F.tid >> 6);
    F.G = gridDim.x; { const int bx = blockIdx.x; F.vcu = (F.G % 8 == 0) ? (bx % 8) * (F.G / 8) + bx / 8 : bx; }
    volatile LAS unsigned* MISC = (volatile LAS unsigned*)(F.lds + LDS_MISC);
    if (F.tid < 64) MISC[F.tid] = 0u;
    __syncthreads();
    unsigned* ctl = (unsigned*)(F.ws + WS_CTL);
    const bool multi = (args.ph_hi - args.ph_lo) > 1;
    XcdBarrier bar; bar.bar = ctl + CW_BAR; bar.x = 0; bar.st = MISC + 8;
    if (multi) bar = xcd_barrier_post(ctl + CW_BAR, MISC + 8);
    const int lo = args.ph_lo, hi = args.ph_hi;
#define IN(k) (lo <= (k) && (k) < hi)
#define SEAM(k) do { if (IN(k) && IN((k) + 1)) xcd_barrier(bar); } while (0)
    unsigned char* ws = F.ws;
    bf16* HN = (bf16*)(ws + WS_HN); signed char* HN8 = (signed char*)(ws + WS_HN); bf16* UB = (bf16*)(ws + WS_U); bf16* YB = (bf16*)(ws + WS_Y); float* SAp = (float*)(ws + WS_SA); const float* SBp = (const float*)(ws + WS_SB);
    const int bx = (int)blockIdx.x;

    if (IN(0)) { absmax_jobs(F, args, 0, 4, F.vcu, F.G); if (multi) xcd_barrier(bar); quant_jobs(F, args, 0, 4, F.vcu, F.G); absmax_jobs(F, args, 4, N_QJOBS, F.vcu, F.G); convert_weights(F, args); norm_mix0(F, args); } SEAM(0);
    if (IN(1)) { pg8::SchedDense S; S.init(HN, ws + W_EVIN, T, EV_N, D / 2, F.G, bx); pg8::EpiEvInI8 E{UB, SAp, SBp + SBO_EVIN}; pg8::gemm_phase(F.lds, S, E); } SEAM(1);
    if (IN(2)) { gdn_a(F, args); } SEAM(2);
    if (IN(3)) { if ((bx & 1) == 0) gdn_b(F, args, bx >> 1, (F.G + 1) >> 1); else { mixer_a(F, args, bx >> 1, F.G >> 1); quant_jobs(F, args, 4, N_QJOBS, bx >> 1, F.G >> 1); } } SEAM(3);
    if (IN(4)) { pg8::SchedDense S; S.init(YB, ws + W_EVOUT, T, D, D, F.G, bx); pg8::EpiResid E{args.in[0], args.out}; pg8::gemm_phase(F.lds, S, E); } SEAM(4);
    if (IN(5)) { norm_plain(F, args.out, args.in[3], HN8, SAp); } SEAM(5);
    if (IN(6)) { pg8::SchedDense S; S.init(HN, ws + W_FFGU, T, 2 * DFF, D / 2, F.G, bx); pg8::EpiSwiGLUI8 E{UB, DFF, SAp, SBp + SBO_FFGU}; pg8::gemm_phase(F.lds, S, E); } SEAM(6);
    if (IN(7)) { pg8::SchedDense S; S.init(UB, ws + W_FFD, T, D, DFF, F.G, bx); pg8::EpiResid E{args.out, args.out}; pg8::gemm_phase(F.lds, S, E); } SEAM(7);
    if (IN(8)) { norm_plain(F, args.out, args.in[4], HN8, SAp); convert_p(F, args.in[1], (bf16*)(ws + WS_GX)); } SEAM(8);
    if (IN(9)) { pg8::SchedDense S; S.init(ws + WS_GX, ws + W_PPROJ, T, D, 256, F.G, bx); pg8::EpiStoreBf16 E{UB, D}; pg8::gemm_phase(F.lds, S, E); } SEAM(9);
    if (IN(10)) { pg8::SchedDense S; S.init(HN, ws + W_PGATE, T, D, D / 2, F.G, bx); pg8::EpiPleGateI8 E{args.out, UB, SAp, SBp + SBO_PGATE}; pg8::gemm_phase(F.lds, S, E); } SEAM(10);
    if (IN(11)) { norm_plain(F, args.out, args.in[2] + D, HN8, SAp); } SEAM(11);
    if (IN(12)) { pg8::SchedDense S; S.init(HN, ws + W_ODIN, T, OD_N, D / 2, F.G, bx); pg8::EpiStoreBf16I8 E{UB, OD_N, SAp, SBp + SBO_ODIN}; pg8::gemm_phase(F.lds, S, E); } SEAM(12);
    if (IN(13)) { attn_phase(F, args); conformer_phase(F, args); } SEAM(13);
    if (IN(14)) { pg8::SchedDense S; S.init(YB, ws + W_ODOUT, T, D, D, F.G, bx); pg8::EpiResid E{args.out, args.out}; pg8::gemm_phase(F.lds, S, E); } SEAM(14);
    if (IN(15)) { norm_router(F, args); } SEAM(15);
#define MOE_PART(part, phg, phd) \
    if (IN(phg) || IN(phd)) { \
        LAS int* tab = (LAS int*)(F.lds + LDS_MISC + 256); \
        if (F.tid == 0) { int pb = 0; for (int e = 0; e < 8; ++e) { const int c = (int)__hip_atomic_load(ctl + CW_CNT + 64 * e, __ATOMIC_RELAXED, __HIP_MEMORY_SCOPE_AGENT); tab[e] = c; tab[8 + e] = pb; pb += (c + 255) >> 8; } tab[16] = pb; } \
        __syncthreads(); \
        const int nbt = tab[16]; int nMp = nbt - (part) * MOE_NBP; nMp = nMp < 0 ? 0 : (nMp > MOE_NBP ? MOE_NBP : nMp); \
        if (IN(phg)) { pg8::SchedMoeGU S; S.A = (const char*)HN; S.Bt = (const char*)(ws + W_MGU); S.K = D / 2; S.nM = nMp; S.nN = 2 * DFE / 256; S.G = F.G; S.c = bx; S.blk0 = (part) * MOE_NBP; S.bstride = (size_t)2 * DFE * D; \
            S.row_ts = (const int*)(ws + WS_ROWTS); S.tab = tab; S.gather = true; pg8::EpiSwiGLUI8 E{(bf16*)(ws + WS_GX), DFE, (const float*)(ws + WS_ROWSA), (const float*)(ws + WS_SB)}; pg8::gemm_phase(F.lds, S, E); } \
        SEAM(phg); \
        if (IN(phd)) { pg8::SchedMoeDown S; S.A = (const char*)(ws + WS_GX); S.Bt = (const char*)(ws + W_MD); S.K = DFE; S.nM = nMp; S.nN = D / 256; S.G = F.G; S.c = bx; S.blk0 = (part) * MOE_NBP; S.bstride = (size_t)D * DFE * 2; \
            S.row_ts = (const int*)(ws + WS_ROWTS); S.tab = tab; S.gather = false; pg8::EpiMoeDown E{(bf16*)(ws + WS_YMOE), (const int*)(ws + WS_ROWTS), (const float*)(ws + WS_ROWGATE)}; pg8::gemm_phase(F.lds, S, E); } \
        SEAM(phd); \
    }
    MOE_PART(0, 16, 17)
    MOE_PART(1, 18, 19)
    MOE_PART(2, 20, 21)
    if (IN(22)) { combine_norm(F, args); convert_p(F, args.in[1] + (size_t)T * 256, (bf16*)(ws + WS_GX)); } SEAM(22);
    if (IN(23)) { pg8::SchedDense S; S.init(ws + WS_GX, ws + W_PPROJ + (size_t)D * 256 * 2, T, D, 256, F.G, bx); pg8::EpiStoreBf16 E{UB, D}; pg8::gemm_phase(F.lds, S, E); } SEAM(23);
    if (IN(24)) { pg8::SchedDense S; S.init(HN, ws + W_PGATE + (size_t)D * D, T, D, D / 2, F.G, bx); pg8::EpiPleGateI8 E{args.out, UB, SAp, SBp + SBO_PGATE + D}; pg8::gemm_phase(F.lds, S, E); } SEAM(24);
    if (IN(25)) { final_norm(F, args); }
#undef IN
#undef SEAM
}

#ifndef MK_MULTI_LAUNCH
#define MK_MULTI_LAUNCH 0
#endif
extern "C" void kernel_launch(void* const* d_in, const int* in_sizes, int n_in, void* d_out, int out_size, void* d_ws, size_t ws_size, hipStream_t stream) {
    static int grid = 0;
    if (grid == 0) {
        if (n_in != 29 || out_size != T * D || ws_size < WS_END) { fprintf(stderr, "kernel_launch: unexpected shapes (n_in %d out %d ws %zu)\n", n_in, out_size, ws_size); grid = -1; return; }
        int dev = 0, cus = 0, per_cu = 0;
        if (hipGetDevice(&dev) != hipSuccess || hipDeviceGetAttribute(&cus, hipDeviceAttributeMultiprocessorCount, dev) != hipSuccess) { grid = -1; return; }
        if (hipFuncSetAttribute((const void*)fwd_kernel, hipFuncAttributeMaxDynamicSharedMemorySize, LDS_BYTES) != hipSuccess) { fprintf(stderr, "kernel_launch: LDS attribute failed\n"); grid = -1; return; }
        if (hipOccupancyMaxActiveBlocksPerMultiprocessor(&per_cu, (const void*)fwd_kernel, 512, LDS_BYTES) != hipSuccess || per_cu < 1) { fprintf(stderr, "kernel_launch: occupancy query says %d\n", per_cu); }
        (void)hipGetLastError();
        grid = cus;
    }
    if (grid < 0) return;
    (void)hipMemsetAsync((char*)d_ws + WS_CTL, 0, CTL_BYTES, stream);
    Args a{};
    for (int i = 0; i < 29; ++i) a.in[i] = (const float*)d_in[i];
    a.out = (float*)d_out; a.ws = (unsigned char*)d_ws;
#if MK_MULTI_LAUNCH
    for (int ph = 0; ph < NPH; ++ph) { a.ph_lo = ph; a.ph_hi = ph + 1; hipLaunchKernelGGL(fwd_kernel, dim3(grid), dim3(512), LDS_BYTES, stream, a); }
#else
    a.ph_lo = 0; a.ph_hi = NPH;
    hipLaunchKernelGGL(fwd_kernel, dim3(grid), dim3(512), LDS_BYTES, stream, a);
#endif
}
```

```cpp
#include <hip/hip_runtime.h>
#include <stdint.h>
#include <stdio.h>

#define DI __device__ __forceinline__
#define LAS __attribute__((address_space(3)))
#define GAS __attribute__((address_space(1)))
typedef unsigned short bf16;
typedef short bf16x8 __attribute__((ext_vector_type(8)));
typedef short s16x4 __attribute__((ext_vector_type(4)));
typedef short v4i16_t __attribute__((ext_vector_type(4)));
typedef float f32x4 __attribute__((ext_vector_type(4)));
typedef float f32x16 __attribute__((ext_vector_type(16)));
typedef float f32x2_t __attribute__((ext_vector_type(2)));
typedef __bf16 bf16x2_t __attribute__((ext_vector_type(2)));
typedef unsigned u32x4 __attribute__((ext_vector_type(4)));
typedef unsigned u32x2 __attribute__((ext_vector_type(2)));
typedef int i32x4 __attribute__((ext_vector_type(4)));
typedef GAS unsigned gu32;

constexpr int T = 65536, D = 1024, SEQ = 2048, NBATCH = 32;
constexpr int EV_IN = 3592, EV_N = 3584, EVU = 3072;
constexpr int OD_N = 2560;
constexpr int DFF = 2816, DFE = 3584, NE = 8, CAP = 65536;
constexpr int MOE_NBP = 520, MOE_NPART = 1;
constexpr float ACT8_SCALE = 16.f;
constexpr float EPS = 1e-6f;
constexpr float LOG2E = 1.4426950408889634f;
constexpr float LAMBDA_INIT = 0.35550906f;

constexpr size_t MiB = 1u << 20;
constexpr size_t WS_CTL = 0, CTL_BYTES = 1 * MiB;
constexpr size_t WS_GA = 1 * MiB, WS_BETA = 2 * MiB, WS_ROWTS = 3 * MiB, WS_ROWGATE = 5 * MiB, WS_EG = 7 * MiB, WS_ROWSA = 8 * MiB, WS_SB = 10 * MiB, WS_SA = 11 * MiB;
constexpr size_t WS_W = 16 * MiB;
constexpr size_t W_EVIN = WS_W;
constexpr size_t W_EVOUT = W_EVIN + (size_t)EV_N * D;
constexpr size_t W_FFGU = W_EVOUT + (size_t)D * D * 2;
constexpr size_t W_FFD = W_FFGU + (size_t)2 * DFF * D;
constexpr size_t W_ODIN = W_FFD + (size_t)D * DFF * 2;
constexpr size_t W_ODOUT = W_ODIN + (size_t)OD_N * D;
constexpr size_t W_MGU = W_ODOUT + (size_t)D * D * 2;
constexpr size_t W_MD = W_MGU + (size_t)NE * 2 * DFE * D;
constexpr size_t W_PPROJ = W_MD + (size_t)NE * D * DFE;
constexpr size_t W_PGATE = W_PPROJ + (size_t)2 * D * 256 * 2;
constexpr size_t W_END = W_PGATE + (size_t)2 * D * D;
constexpr int SBO_MOE = 0, SBO_EVIN = NE * 2 * DFE, SBO_FFGU = SBO_EVIN + EV_N, SBO_ODIN = SBO_FFGU + 2 * DFF, SBO_PGATE = SBO_ODIN + OD_N, SBO_MD = SBO_PGATE + 2 * D, SBO_END = SBO_MD + NE * D;
constexpr size_t WS_HN = 222 * MiB;
constexpr size_t WS_G = 222 * MiB;
constexpr size_t WS_GX = 352 * MiB;
constexpr size_t WS_ACT8 = 288 * MiB;
constexpr size_t WS_U = 512 * MiB;
constexpr size_t WS_Y = 896 * MiB;
constexpr size_t WS_YMOE = 768 * MiB;
constexpr size_t WS_END = 1024 * MiB;
static_assert(W_END <= WS_HN, "weights fit");
static_assert(WS_G + (size_t)4096 * 73728 <= WS_U, "gdn intermediates fit");
static_assert(WS_ACT8 + (size_t)MOE_NBP * 256 * DFE <= WS_YMOE && WS_HN + (size_t)(T + 1) * D <= WS_ACT8, "moe act fits");
constexpr size_t G_ITEM = 73728;
constexpr size_t G_W = 0, G_UT = 16384, G_QG = 32768, G_KD = 49152, G_QK = 65536;

constexpr int CW_CNT = 64;
constexpr int CW_BAR = 4096;
constexpr int CW_CMAX = 65536;

constexpr int LDS_BYTES = 160 * 1024;
constexpr int LDS_MISC = 131072 + 24576;
DI float bf2f(unsigned short b) { return __uint_as_float(((unsigned)b) << 16); }
DI float bflo(unsigned u) { return __uint_as_float(u << 16); }
DI float bfhi(unsigned u) { return __uint_as_float(u & 0xffff0000u); }
DI unsigned pk2(float lo, float hi) { f32x2_t v = {lo, hi}; bf16x2_t b = __builtin_convertvector(v, bf16x2_t); return __builtin_bit_cast(unsigned, b); }
DI float dppf(float v, const int ctrl_sel) {
    int r;
    switch (ctrl_sel) {
        case 0: r = __builtin_amdgcn_update_dpp(0, __builtin_bit_cast(int, v), 0xB1, 0xF, 0xF, true); break;
        case 1: r = __builtin_amdgcn_update_dpp(0, __builtin_bit_cast(int, v), 0x4E, 0xF, 0xF, true); break;
        case 2: r = __builtin_amdgcn_update_dpp(0, __builtin_bit_cast(int, v), 0x141, 0xF, 0xF, true); break;
        default: r = __builtin_amdgcn_update_dpp(0, __builtin_bit_cast(int, v), 0x140, 0xF, 0xF, true); break;
    }
    return __builtin_bit_cast(float, r);
}
DI float row16_sum(float v) { v += dppf(v, 0); v += dppf(v, 1); v += dppf(v, 2); v += dppf(v, 3); return v; }
DI float rlane(float v, int l) { return __builtin_bit_cast(float, __builtin_amdgcn_readlane(__builtin_bit_cast(int, v), l)); }
DI float wave_sum(float v) { v = row16_sum(v); return (rlane(v, 0) + rlane(v, 16)) + (rlane(v, 32) + rlane(v, 48)); }
DI float wave_max(float v) { v = fmaxf(v, dppf(v, 0)); v = fmaxf(v, dppf(v, 1)); v = fmaxf(v, dppf(v, 2)); v = fmaxf(v, dppf(v, 3)); return fmaxf(fmaxf(rlane(v, 0), rlane(v, 16)), fmaxf(rlane(v, 32), rlane(v, 48))); }
DI float sigmoid_f(float x) { return __builtin_amdgcn_rcpf(1.f + __builtin_amdgcn_exp2f(x * -1.4426950408889634f)); }
DI float silu_f(float x) { return x * sigmoid_f(x); }
DI int crow(int reg, int hh) { return (reg & 3) + 8 * (reg >> 2) + 4 * hh; }
DI bf16x8 pack_step(const f32x16& x, int s) {
    u32x4 p;
    p[0] = pk2(x[8 * s + 0], x[8 * s + 1]); p[1] = pk2(x[8 * s + 2], x[8 * s + 3]); p[2] = pk2(x[8 * s + 4], x[8 * s + 5]); p[3] = pk2(x[8 * s + 6], x[8 * s + 7]);
    return __builtin_bit_cast(bf16x8, p);
}
DI s16x4 vtr(const LAS unsigned char* p) { return __builtin_bit_cast(s16x4, __builtin_amdgcn_ds_read_tr16_b64_v4i16((LAS v4i16_t*)p)); }
DI bf16x8 cat8(s16x4 lo, s16x4 hi) { return __builtin_shufflevector(lo, hi, 0, 1, 2, 3, 4, 5, 6, 7); }
#define MFMA32(a, b, c) __builtin_amdgcn_mfma_f32_32x32x16_bf16((a), (b), (c), 0, 0, 0)
DI f32x16 zero16() { f32x16 z; for (int i = 0; i < 16; ++i) z[i] = 0.f; return z; }
#define WG_BAR() __syncthreads()

#define XB_TMO      128
#define XB_XCNT(j)  (256  + 64 * (j))
#define XB_XSUB(j)  (1280 + 64 * (j))
#define XB_XGEN(j)  (2304 + 64 * (j))
#define XB_TOP      3328
#define XB_TOPGEN   3392
#define XCD_BAR_WORDS 3456
#define XB_SPIN_CAP (1u << 22)
DI unsigned xb_ld(unsigned* p)              { return __hip_atomic_load(p, __ATOMIC_RELAXED, __HIP_MEMORY_SCOPE_AGENT); }
DI unsigned xb_add(unsigned* p, unsigned v) { return __hip_atomic_fetch_add(p, v, __ATOMIC_RELAXED, __HIP_MEMORY_SCOPE_AGENT); }
DI unsigned xb_xcc_id() { return (unsigned)__builtin_amdgcn_s_getreg((3 << 11) | 20) & 0xFu; }
#define XB_SPIN(cond, bar) do { unsigned _sp = 0; while (cond) { __builtin_amdgcn_s_sleep(1); \
    if ((++_sp & 255u) == 0u) { if (xb_ld(&(bar)[XB_TMO])) break; if (_sp > XB_SPIN_CAP) { atomicAdd(&(bar)[XB_TMO], 1u); break; } } } } while (0)
struct XcdBarrier { unsigned* bar; unsigned x; volatile LAS unsigned* st; };
DI XcdBarrier xcd_barrier_post(unsigned* bar, volatile LAS unsigned* st) {
    XcdBarrier b; b.bar = bar; b.x = xb_xcc_id(); b.st = st;
    if (threadIdx.x == 0) (void)xb_add(&bar[XB_XCNT(b.x)], 1u);
    return b;
}
DI void xcd_barrier_complete(unsigned* bar, unsigned x, unsigned& nloc, unsigned& nx) {
    const unsigned G = gridDim.x * gridDim.y * gridDim.z;
    unsigned sum, cnt, mine, sp = 0u;
    for (;;) {
        sum = 0u; cnt = 0u; mine = 0u;
#pragma unroll
        for (unsigned j = 0; j < 16; ++j) { const unsigned c = xb_ld(&bar[XB_XCNT(j)]); sum += c; cnt += (c > 0u) ? 1u : 0u; mine = (j == x) ? c : mine; }
        if (sum == G) break;
        __builtin_amdgcn_s_sleep(1);
        if ((++sp & 255u) == 0u) { if (xb_ld(&bar[XB_TMO])) break; if (sp > XB_SPIN_CAP) { atomicAdd(&bar[XB_TMO], 1u); break; } }
    }
    nloc = mine > 0u ? mine : 1u; nx = cnt > 0u ? cnt : 1u;
}
DI void xcd_barrier(const XcdBarrier& b) {
    asm volatile("s_waitcnt vmcnt(0)" ::: "memory");
    __syncthreads();
    if (threadIdx.x == 0) {
        unsigned* bar = b.bar;
        __builtin_amdgcn_s_waitcnt(0);
        unsigned nloc = b.st[0], nx = b.st[1];
        if (nloc == 0u) { xcd_barrier_complete(bar, b.x, nloc, nx); b.st[0] = nloc; b.st[1] = nx; }
        const unsigned old = xb_add(&bar[XB_XSUB(b.x)], 1u);
        const unsigned gen = old / nloc;
        if (old + 1u == (gen + 1u) * nloc) {
            __builtin_amdgcn_fence(__ATOMIC_RELEASE, "agent");
            asm volatile("s_waitcnt vmcnt(0)" ::: "memory");
            const unsigned og = xb_add(&bar[XB_TOP], 1u);
            const unsigned tg = og / nx;
            if (og + 1u == (tg + 1u) * nx) xb_add(&bar[XB_TOPGEN], 1u);
            else XB_SPIN(xb_ld(&bar[XB_TOPGEN]) == tg, bar);
            __builtin_amdgcn_fence(__ATOMIC_ACQUIRE, "agent");
            xb_add(&bar[XB_XGEN(b.x)], 1u);
            asm volatile("s_waitcnt vmcnt(0)" ::: "memory");
        } else {
            XB_SPIN(xb_ld(&bar[XB_XGEN(b.x)]) == gen, bar);
            __builtin_amdgcn_fence(__ATOMIC_ACQUIRE, "agent");
            asm volatile("s_waitcnt vmcnt(0)" ::: "memory");
        }
    }
    __syncthreads();
}

struct Args { const float* in[29]; float* out; unsigned char* ws; int ph_lo, ph_hi; };
struct Frame {
    LAS unsigned char* lds;
    unsigned char* ws;
    int tid, lane, wave, G, vcu;
};

namespace pg8 {
constexpr int BM = 256, BK = 64, HALF = 128, HTB = HALF * BK * 2, STAGE_BYTES = 8 * HTB, NXCD = 8, WGM = 8;
__host__ __device__ __forceinline__ int lds_byte(int r, int c) { const int st = (r >> 4) * 2 + (c >> 5), rr = r & 15, cc = c & 31, ob = rr * 64 + cc * 2; return st * 1024 + (ob ^ (((ob >> 9) & 1) << 5)); }
__host__ __device__ __forceinline__ void stage_rc(int b, int& R, int& C) { const int st = b / 1024, sb = b % 1024, swz = sb ^ (((sb >> 9) & 1) << 5); R = (st >> 1) * 16 + swz / 64; C = (st & 1) * 32 + (swz % 64) / 2; }
__host__ __device__ __forceinline__ int perm32(int rho) { const int n = rho >> 4, i = rho & 15; return 8 * (i >> 2) + 4 * n + (i & 3); }

struct Unit { int pm, pn, e, lb, rows; };

DI bool static_unit(int i, int G, int c, int nM, int nN, int& pm, int& pn) {
    const int nwg = nM * nN; const long L = (long)i * G + c; if (L >= nwg) return false;
    int wgid = (int)L; { const int q = nwg / NXCD, r = nwg % NXCD, xcd = wgid % NXCD, off = wgid / NXCD; wgid = (xcd < r ? xcd * (q + 1) : r * (q + 1) + (xcd - r) * q) + off; }
    const int nig = WGM * nN, gid = wgid / nig, fm = gid * WGM, gsz = (nM - fm) < WGM ? (nM - fm) : WGM;
    pm = fm + ((wgid % nig) % gsz); pn = (wgid % nig) / gsz; return true;
}
struct SchedDense {
    static constexpr bool GATHER = false;
    const char* A; const char* Bt; int K, nM, nN, G, c;
    DI void init(const void* A_, const void* Bt_, int M, int N, int K_, int G_, int c_) { A = (const char*)A_; Bt = (const char*)Bt_; K = K_; nM = M / BM; nN = N / BM; G = G_; c = c_; }
    DI bool next(int i, Unit& u) const { u.e = 0; u.rows = 256; const bool ok = static_unit(i, G, c, nM, nN, u.pm, u.pn); u.lb = u.pm; return ok; }
    DI const char* a_base(const Unit& u) const { return A + (size_t)u.pm * BM * K * 2; }
    DI const char* b_base(const Unit& u) const { return Bt + (size_t)u.pn * BM * K * 2; }
    DI void ts_load(const Unit&, const int (&)[2], int (&)[2][2]) const {}
    DI void a_offs(const Unit&, const int (&R)[2], const int (&C)[2], const int (&)[2][2], unsigned (&o)[2][2]) const {
#pragma unroll
        for (int h = 0; h < 2; ++h)
#pragma unroll
            for (int i = 0; i < 2; ++i) o[h][i] = (unsigned)((h * HALF + R[i]) * K + C[i]) * 2u;
    }
};
struct SchedMoe {
    const char* A; const char* Bt; int K, nM, nN, G, c, blk0; size_t bstride; const int* row_ts; const LAS int* tab; bool gather;
    DI bool next(int i, Unit& u) const {
        int pm, pn; if (!static_unit(i, G, c, nM, nN, pm, pn)) return false;
        const int gb = blk0 + pm; int e = 0;
#pragma unroll
        for (int j = 1; j < 8; ++j) e += (gb >= tab[8 + j]) ? 1 : 0;
        e = __builtin_amdgcn_readfirstlane(e);
        const int lb = gb - __builtin_amdgcn_readfirstlane(tab[8 + e]); const int rem = __builtin_amdgcn_readfirstlane(tab[e]) - lb * 256;
        u.pm = pm; u.pn = pn; u.e = e; u.lb = lb; u.rows = rem < 256 ? rem : 256; return true;
    }
    DI const char* b_base(const Unit& u) const { return Bt + (size_t)u.e * bstride + (size_t)u.pn * BM * K * 2; }
};
struct SchedMoeGU : SchedMoe {
    static constexpr bool GATHER = true;
    DI const char* a_base(const Unit&) const { return A; }
    DI void ts_load(const Unit& u, const int (&R)[2], int (&ts)[2][2]) const {
#pragma unroll
        for (int h = 0; h < 2; ++h)
#pragma unroll
            for (int i = 0; i < 2; ++i) { const int lr = h * HALF + R[i]; ts[h][i] = (lr < u.rows) ? row_ts[(size_t)u.e * CAP + u.lb * 256 + lr] : (T << 1); }
    }
    DI void a_offs(const Unit&, const int (&)[2], const int (&C)[2], const int (&ts)[2][2], unsigned (&o)[2][2]) const {
#pragma unroll
        for (int h = 0; h < 2; ++h)
#pragma unroll
            for (int i = 0; i < 2; ++i) o[h][i] = ((unsigned)(ts[h][i] >> 1) * (unsigned)K + (unsigned)C[i]) * 2u;
    }
};
struct SchedMoeDown : SchedMoe {
    static constexpr bool GATHER = false;
    DI const char* a_base(const Unit& u) const { return A + (size_t)u.pm * BM * K * 2; }
    DI void ts_load(const Unit&, const int (&)[2], int (&)[2][2]) const {}
    DI void a_offs(const Unit&, const int (&R)[2], const int (&C)[2], const int (&)[2][2], unsigned (&o)[2][2]) const {
#pragma unroll
        for (int h = 0; h < 2; ++h)
#pragma unroll
            for (int i = 0; i < 2; ++i) o[h][i] = (unsigned)((h * HALF + R[i]) * K + C[i]) * 2u;
    }
};

typedef f32x4 Acc[2][2][4][2];
typedef i32x4 AccI[2][2][4][2];
template <bool I8> struct AccSel { typedef f32x4 type; };
template <> struct AccSel<true> { typedef i32x4 type; };
DI u32x4 pack8(const f32x4& v0, const f32x4& v1) { u32x4 w; w.x = pk2(v0[0], v0[1]); w.y = pk2(v0[2], v0[3]); w.z = pk2(v1[0], v1[1]); w.w = pk2(v1[2], v1[3]); return w; }

struct EpiStoreBf16 {
    static constexpr bool PERM = true; static constexpr int MODE = 0;
    bf16* O; int ldc;
    DI void operator()(const Acc& acc, const Unit& u, int wr, int wc, int fr, int fq) const {
        const int row0 = u.pm * BM + wr * 64 + fr, col0 = u.pn * BM + wc * 32 + 8 * fq;
#pragma unroll
        for (int ai = 0; ai < 2; ++ai)
#pragma unroll
            for (int m = 0; m < 4; ++m) { bf16* rowp = O + (size_t)(row0 + ai * HALF + m * 16) * ldc + col0;
#pragma unroll
                for (int bj = 0; bj < 2; ++bj) *(u32x4*)(rowp + bj * HALF) = pack8(acc[ai][bj][m][0], acc[ai][bj][m][1]); }
    }
};
struct EpiEvIn {
    static constexpr bool PERM = true; static constexpr int MODE = 0;
    bf16* O;
    DI void operator()(const Acc& acc, const Unit& u, int wr, int wc, int fr, int fq) const {
        const int row0 = u.pm * BM + wr * 64 + fr;
        if (u.pn >= 2 && u.pn < 6) {
            const int col0 = 512 + (u.pn - 2) * HALF + wc * 32 + 8 * fq;
#pragma unroll
            for (int ai = 0; ai < 2; ++ai)
#pragma unroll
                for (int m = 0; m < 4; ++m) { bf16* rowp = O + (size_t)(row0 + ai * HALF + m * 16) * EVU + col0;
                    *(u32x4*)rowp = pack8(acc[ai][0][m][0] * acc[ai][1][m][0], acc[ai][0][m][1] * acc[ai][1][m][1]); }
        } else {
            const int col0 = u.pn * BM - (u.pn >= 6 ? 512 : 0) + wc * 32 + 8 * fq;
#pragma unroll
            for (int ai = 0; ai < 2; ++ai)
#pragma unroll
                for (int m = 0; m < 4; ++m) { bf16* rowp = O + (size_t)(row0 + ai * HALF + m * 16) * EVU + col0;
#pragma unroll
                    for (int bj = 0; bj < 2; ++bj) *(u32x4*)(rowp + bj * HALF) = pack8(acc[ai][bj][m][0], acc[ai][bj][m][1]); }
        }
    }
};
struct EpiSwiGLU {
    static constexpr bool PERM = true; static constexpr int MODE = 0;
    bf16* O; int ldc;
    DI void operator()(const Acc& acc, const Unit& u, int wr, int wc, int fr, int fq) const {
        const int row0 = u.pm * BM + wr * 64 + fr, col0 = u.pn * HALF + wc * 32 + 8 * fq;
#pragma unroll
        for (int ai = 0; ai < 2; ++ai)
#pragma unroll
            for (int m = 0; m < 4; ++m) { bf16* rowp = O + (size_t)(row0 + ai * HALF + m * 16) * ldc + col0;
                f32x4 v0, v1;
#pragma unroll
                for (int j = 0; j < 4; ++j) { v0[j] = silu_f(acc[ai][0][m][0][j]) * acc[ai][1][m][0][j]; v1[j] = silu_f(acc[ai][0][m][1][j]) * acc[ai][1][m][1][j]; }
                *(u32x4*)rowp = pack8(v0, v1); }
    }
};
template <bool OUT8> struct EpiSwiGLUI8T {
    static constexpr bool PERM = true; static constexpr int MODE = 1;
    bf16* O; int ldc; const float* row_sa; const float* sb;
    DI void operator()(const AccI& acc, const Unit& u, int wr, int wc, int fr, int fq) const {
        const int row0 = u.pm * BM + wr * 64 + fr, col0 = u.pn * HALF + wc * 32 + 8 * fq; const size_t rbase = (size_t)u.e * CAP + u.lb * 256;
        const float* sbp = sb + (size_t)u.e * (2 * DFE) + u.pn * BM + wc * 32 + 8 * fq;
        const f32x4 sg0 = *(const f32x4*)sbp, sg1 = *(const f32x4*)(sbp + 4), su0 = *(const f32x4*)(sbp + HALF), su1 = *(const f32x4*)(sbp + HALF + 4);
#pragma unroll
        for (int ai = 0; ai < 2; ++ai)
#pragma unroll
            for (int m = 0; m < 4; ++m) { const int lr = ai * HALF + wr * 64 + m * 16 + fr; bf16* rowp = O + (size_t)(row0 + ai * HALF + m * 16) * ldc + col0;
                const float ra = (lr < u.rows) ? row_sa[rbase + lr] : 0.f;
                f32x4 v0, v1;
#pragma unroll
                for (int j = 0; j < 4; ++j) { v0[j] = silu_f((float)acc[ai][0][m][0][j] * (ra * sg0[j])) * ((float)acc[ai][1][m][0][j] * (ra * su0[j])); v1[j] = silu_f((float)acc[ai][0][m][1][j] * (ra * sg1[j])) * ((float)acc[ai][1][m][1][j] * (ra * su1[j])); }
                if constexpr (OUT8) {
                    unsigned char* p8 = (unsigned char*)O + (size_t)(row0 + ai * HALF + m * 16) * ldc + col0;
#pragma unroll
                    for (int j = 0; j < 4; ++j) { v0[j] = fminf(fmaxf(v0[j] * ACT8_SCALE, -448.f), 448.f); v1[j] = fminf(fmaxf(v1[j] * ACT8_SCALE, -448.f), 448.f); }
                    int p0 = 0, p1 = 0; p0 = __builtin_amdgcn_cvt_pk_fp8_f32(v0[0], v0[1], p0, false); p0 = __builtin_amdgcn_cvt_pk_fp8_f32(v0[2], v0[3], p0, true);
                    p1 = __builtin_amdgcn_cvt_pk_fp8_f32(v1[0], v1[1], p1, false); p1 = __builtin_amdgcn_cvt_pk_fp8_f32(v1[2], v1[3], p1, true);
                    *(u32x2*)p8 = (u32x2){(unsigned)p0, (unsigned)p1};
                } else *(u32x4*)rowp = pack8(v0, v1); }
    }
};
typedef EpiSwiGLUI8T<false> EpiSwiGLUI8;
typedef EpiSwiGLUI8T<true> EpiSwiGLUI8F8;
struct EpiEvInI8 {
    static constexpr bool PERM = true; static constexpr int MODE = 1;
    bf16* O; const float* sa; const float* sb;
    DI void operator()(const AccI& acc, const Unit& u, int wr, int wc, int fr, int fq) const {
        const int row0 = u.pm * BM + wr * 64 + fr;
        const float* sbp = sb + u.pn * BM + wc * 32 + 8 * fq;
        const f32x4 s00 = *(const f32x4*)sbp, s01 = *(const f32x4*)(sbp + 4), s10 = *(const f32x4*)(sbp + HALF), s11 = *(const f32x4*)(sbp + HALF + 4);
        if (u.pn >= 2 && u.pn < 6) {
            const int col0 = 512 + (u.pn - 2) * HALF + wc * 32 + 8 * fq;
#pragma unroll
            for (int ai = 0; ai < 2; ++ai)
#pragma unroll
                for (int m = 0; m < 4; ++m) { const int row = row0 + ai * HALF + m * 16; const float ra = sa[row]; bf16* rowp = O + (size_t)row * EVU + col0;
                    f32x4 v0, v1;
#pragma unroll
                    for (int j = 0; j < 4; ++j) { v0[j] = ((float)acc[ai][0][m][0][j] * (ra * s00[j])) * ((float)acc[ai][1][m][0][j] * (ra * s10[j])); v1[j] = ((float)acc[ai][0][m][1][j] * (ra * s01[j])) * ((float)acc[ai][1][m][1][j] * (ra * s11[j])); }
                    *(u32x4*)rowp = pack8(v0, v1); }
        } else {
            const int col0 = u.pn * BM - (u.pn >= 6 ? 512 : 0) + wc * 32 + 8 * fq;
#pragma unroll
            for (int ai = 0; ai < 2; ++ai)
#pragma unroll
                for (int m = 0; m < 4; ++m) { const int row = row0 + ai * HALF + m * 16; const float ra = sa[row]; bf16* rowp = O + (size_t)row * EVU + col0;
                    f32x4 v0, v1, v2, v3;
#pragma unroll
                    for (int j = 0; j < 4; ++j) { v0[j] = (float)acc[ai][0][m][0][j] * (ra * s00[j]); v1[j] = (float)acc[ai][0][m][1][j] * (ra * s01[j]); v2[j] = (float)acc[ai][1][m][0][j] * (ra * s10[j]); v3[j] = (float)acc[ai][1][m][1][j] * (ra * s11[j]); }
                    *(u32x4*)rowp = pack8(v0, v1); *(u32x4*)(rowp + HALF) = pack8(v2, v3); }
        }
    }
};
struct EpiStoreBf16I8 {
    static constexpr bool PERM = true; static constexpr int MODE = 1;
    bf16* O; int ldc; const float* sa; const float* sb;
    DI void operator()(const AccI& acc, const Unit& u, int wr, int wc, int fr, int fq) const {
        const int row0 = u.pm * BM + wr * 64 + fr, col0 = u.pn * BM + wc * 32 + 8 * fq;
        const float* sbp = sb + col0;
        const f32x4 s00 = *(const f32x4*)sbp, s01 = *(const f32x4*)(sbp + 4), s10 = *(const f32x4*)(sbp + HALF), s11 = *(const f32x4*)(sbp + HALF + 4);
#pragma unroll
        for (int ai = 0; ai < 2; ++ai)
#pragma unroll
            for (int m = 0; m < 4; ++m) { const int row = row0 + ai * HALF + m * 16; const float ra = sa[row]; bf16* rowp = O + (size_t)row * ldc + col0;
                f32x4 v0, v1, v2, v3;
#pragma unroll
                for (int j = 0; j < 4; ++j) { v0[j] = (float)acc[ai][0][m][0][j] * (ra * s00[j]); v1[j] = (float)acc[ai][0][m][1][j] * (ra * s01[j]); v2[j] = (float)acc[ai][1][m][0][j] * (ra * s10[j]); v3[j] = (float)acc[ai][1][m][1][j] * (ra * s11[j]); }
                *(u32x4*)rowp = pack8(v0, v1); *(u32x4*)(rowp + HALF) = pack8(v2, v3); }
    }
};
struct EpiPleGateI8 {
    static constexpr bool PERM = false; static constexpr int MODE = 1;
    float* h; const bf16* tmp; const float* sa; const float* sb;
    DI void operator()(const AccI& acc, const Unit& u, int wr, int wc, int fr, int fq) const {
        const int row0 = u.pm * BM + wr * 64 + fr, col0 = u.pn * BM + wc * 32 + 4 * fq;
        f32x4 sv[2][2];
#pragma unroll
        for (int bj = 0; bj < 2; ++bj)
#pragma unroll
            for (int n = 0; n < 2; ++n) sv[bj][n] = *(const f32x4*)(sb + col0 + bj * HALF + n * 16);
#pragma unroll
        for (int ai = 0; ai < 2; ++ai)
#pragma unroll
            for (int m = 0; m < 4; ++m) { const int row = row0 + ai * HALF + m * 16; const float ra = sa[row]; const size_t off = (size_t)row * D + col0;
#pragma unroll
                for (int bj = 0; bj < 2; ++bj)
#pragma unroll
                    for (int n = 0; n < 2; ++n) { const size_t o = off + bj * HALF + n * 16; const f32x4 b = *(const f32x4*)(h + o); const u32x2 t = *(const u32x2*)(tmp + o); const i32x4 a = acc[ai][bj][m][n]; const f32x4 sc = sv[bj][n] * ra;
                        f32x4 r; r[0] = b[0] + bflo(t.x) * sigmoid_f((float)a[0] * sc[0]); r[1] = b[1] + bfhi(t.x) * sigmoid_f((float)a[1] * sc[1]); r[2] = b[2] + bflo(t.y) * sigmoid_f((float)a[2] * sc[2]); r[3] = b[3] + bfhi(t.y) * sigmoid_f((float)a[3] * sc[3]);
                        *(f32x4*)(h + o) = r; } }
    }
};
struct EpiResid {
    static constexpr bool PERM = false; static constexpr int MODE = 0;
    const float* base; float* out;
    DI void operator()(const Acc& acc, const Unit& u, int wr, int wc, int fr, int fq) const {
        const int row0 = u.pm * BM + wr * 64 + fr, col0 = u.pn * BM + wc * 32 + 4 * fq;
#pragma unroll
        for (int ai = 0; ai < 2; ++ai)
#pragma unroll
            for (int m = 0; m < 4; ++m) { const size_t off = (size_t)(row0 + ai * HALF + m * 16) * D + col0;
#pragma unroll
                for (int bj = 0; bj < 2; ++bj)
#pragma unroll
                    for (int n = 0; n < 2; ++n) { const f32x4 b = *(const f32x4*)(base + off + bj * HALF + n * 16); *(f32x4*)(out + off + bj * HALF + n * 16) = b + acc[ai][bj][m][n]; } }
    }
};
struct EpiPleGate {
    static constexpr bool PERM = false; static constexpr int MODE = 0;
    float* h; const bf16* tmp;
    DI void operator()(const Acc& acc, const Unit& u, int wr, int wc, int fr, int fq) const {
        const int row0 = u.pm * BM + wr * 64 + fr, col0 = u.pn * BM + wc * 32 + 4 * fq;
#pragma unroll
        for (int ai = 0; ai < 2; ++ai)
#pragma unroll
            for (int m = 0; m < 4; ++m) { const size_t off = (size_t)(row0 + ai * HALF + m * 16) * D + col0;
#pragma unroll
                for (int bj = 0; bj < 2; ++bj)
#pragma unroll
                    for (int n = 0; n < 2; ++n) { const size_t o = off + bj * HALF + n * 16; const f32x4 b = *(const f32x4*)(h + o); const u32x2 t = *(const u32x2*)(tmp + o); const f32x4 a = acc[ai][bj][m][n];
                        f32x4 r; r[0] = b[0] + bflo(t.x) * sigmoid_f(a[0]); r[1] = b[1] + bfhi(t.x) * sigmoid_f(a[1]); r[2] = b[2] + bflo(t.y) * sigmoid_f(a[2]); r[3] = b[3] + bfhi(t.y) * sigmoid_f(a[3]);
                        *(f32x4*)(h + o) = r; } }
    }
};
struct EpiMoeDown {
    static constexpr bool PERM = true; static constexpr int MODE = 2;
    bf16* Y; const int* row_ts; const float* row_gate; const float* sb;
    DI void operator()(const Acc& acc, const Unit& u, int wr, int wc, int fr, int fq) const {
        int fro = fr; asm volatile("" : "+v"(fro));
        fr = fro;
        const int col0 = u.pn * BM + wc * 32 + 8 * fq; const size_t rbase = (size_t)u.e * CAP + u.lb * 256;
        const float* sbp = sb + (size_t)u.e * D + col0;
        const f32x4 sc[2][2] = {{*(const f32x4*)sbp * (1.f / ACT8_SCALE), *(const f32x4*)(sbp + 4) * (1.f / ACT8_SCALE)}, {*(const f32x4*)(sbp + HALF) * (1.f / ACT8_SCALE), *(const f32x4*)(sbp + HALF + 4) * (1.f / ACT8_SCALE)}};
#pragma unroll
        for (int ai = 0; ai < 2; ++ai)
#pragma unroll
            for (int m = 0; m < 4; ++m) { const int lr = ai * HALF + wr * 64 + m * 16 + fr;
                if (lr < u.rows) { const int ts = row_ts[rbase + lr]; const float g = row_gate[rbase + lr]; bf16* rowp = Y + (size_t)ts * D + col0;
#pragma unroll
                    for (int bj = 0; bj < 2; ++bj) *(u32x4*)(rowp + bj * HALF) = pack8(acc[ai][bj][m][0] * (sc[bj][0] * g), acc[ai][bj][m][1] * (sc[bj][1] * g)); } }
    }
};

DI f32x4 mma16(const bf16x8& a, const bf16x8& b, const f32x4& c) { return __builtin_amdgcn_mfma_f32_16x16x32_bf16(a, b, c, 0, 0, 0); }
DI i32x4 mma16(const bf16x8& a, const bf16x8& b, const i32x4& c) { return __builtin_amdgcn_mfma_i32_16x16x64_i8(__builtin_bit_cast(i32x4, a), __builtin_bit_cast(i32x4, b), c, 0, 0, 0); }
typedef int i32x8 __attribute__((ext_vector_type(8)));
DI f32x4 mma_fp8(const bf16x8& a0, const bf16x8& a1, const bf16x8& b0, const bf16x8& b1, const f32x4& c) {
    const i32x4 x0 = __builtin_bit_cast(i32x4, a0), x1 = __builtin_bit_cast(i32x4, a1), y0 = __builtin_bit_cast(i32x4, b0), y1 = __builtin_bit_cast(i32x4, b1);
    const i32x8 a = __builtin_shufflevector(x0, x1, 0, 1, 2, 3, 4, 5, 6, 7), b = __builtin_shufflevector(y0, y1, 0, 1, 2, 3, 4, 5, 6, 7);
    f32x4 d = c; const int sc = 0x7f7f7f7f;
    asm("v_mfma_scale_f32_16x16x128_f8f6f4 %0, %1, %2, %0, %3, %3 op_sel_hi:[0,0,0]" : "+v"(d) : "v"(a), "v"(b), "v"(sc));
    return d;
}
template <class Epi, class Sched>
DI void gemm_phase(LAS unsigned char* lds, const Sched& S, const Epi& E) {
    constexpr bool GATHER = Sched::GATHER; constexpr int MODE = Epi::MODE; typedef typename AccSel<MODE == 1>::type acc_t;
    const int tid = threadIdx.x, wid = __builtin_amdgcn_readfirstlane(tid >> 6), lane = tid & 63, wr = wid >> 2, wc = wid & 3, fr = lane & 15, fq = lane >> 4;
    const int K = S.K, nt = K / BK;
    int Rr[2], Cc[2]; unsigned voffB[2];
#pragma unroll
    for (int i = 0; i < 2; ++i) { int R, C; stage_rc(tid * 16 + i * 8192, R, C); Rr[i] = R; Cc[i] = C; const int Rb = Epi::PERM ? ((R & ~31) + perm32(R & 31)) : R; voffB[i] = (unsigned)(Rb * K + C) * 2u; }
    const size_t kstep = (size_t)(BK * 2);
    const size_t hstep = (size_t)HALF * K * 2;
    const unsigned ldsw = (unsigned)wid * 1024u;
    const int aoff = lds_byte(wr * 64 + fr, fq * 8), boff = lds_byte(wc * 32 + fr, fq * 8);
#define PG8_SA(b, h) (((b) * 2 + (h)) * HTB)
#define PG8_SB(b, h) ((4 + (b) * 2 + (h)) * HTB)
#define PG8_STAGE(bufoff, gbase, voff) do { _Pragma("unroll") for (int _i = 0; _i < 2; ++_i) \
        __builtin_amdgcn_global_load_lds((const unsigned*)((const char*)(gbase) + (voff)[_i]), (LAS unsigned*)(lds + (bufoff) + ldsw + _i * 8192), 16, 0, 0); } while (0)
#define PG8_LDA(dst, b, h) do { _Pragma("unroll") for (int m = 0; m < 4; ++m) _Pragma("unroll") for (int k = 0; k < 2; ++k) dst[m][k] = *(const LAS bf16x8*)(lds + PG8_SA(b, h) + aoff + m * 2048 + k * 1024); } while (0)
#define PG8_LDB(dst, b, h) do { _Pragma("unroll") for (int n = 0; n < 2; ++n) _Pragma("unroll") for (int k = 0; k < 2; ++k) dst[n][k] = *(const LAS bf16x8*)(lds + PG8_SB(b, h) + boff + n * 2048 + k * 1024); } while (0)
#define PG8_MMA(ai, bj, At, Bt) do { __builtin_amdgcn_s_setprio(1); _Pragma("unroll") for (int m = 0; m < 4; ++m) _Pragma("unroll") for (int n = 0; n < 2; ++n) { \
        if constexpr (MODE == 2) acc[ai][bj][m][n] = mma_fp8(Bt[n][0], Bt[n][1], At[m][0], At[m][1], acc[ai][bj][m][n]); \
        else { _Pragma("unroll") for (int k = 0; k < 2; ++k) acc[ai][bj][m][n] = mma16(Bt[n][k], At[m][k], acc[ai][bj][m][n]); } } __builtin_amdgcn_s_setprio(0); } while (0)
#define PG8_WAIT_V(n) asm volatile("s_waitcnt vmcnt(" #n ")" ::: "memory")
#define PG8_WAIT_L(n) asm volatile("s_waitcnt lgkmcnt(" #n ")" ::: "memory")
#define PG8_BAR __builtin_amdgcn_s_barrier()
#define PG8_SCHED __builtin_amdgcn_sched_barrier(0)
    Unit cur, nxt, nn; int ui = 0;
    if (!S.next(0, cur)) return;
    acc_t acc[2][2][4][2];
#pragma unroll
    for (int a = 0; a < 2; ++a)
#pragma unroll
        for (int b = 0; b < 2; ++b)
#pragma unroll
            for (int m = 0; m < 4; ++m)
#pragma unroll
                for (int n = 0; n < 2; ++n) acc[a][b][m][n] = (acc_t){0, 0, 0, 0};
    bf16x8 At[4][2], B0[2][2], B1[2][2];
    unsigned vA[2][2], nvA[2][2]; int pts[2][2] = {{0, 0}, {0, 0}};
    { int ts0[2][2] = {{0, 0}, {0, 0}}; S.ts_load(cur, Rr, ts0); S.a_offs(cur, Rr, Cc, ts0, vA); }
    bool has_next = S.next(1, nxt);
    if (GATHER && has_next) S.ts_load(nxt, Rr, pts);
    const char* cA = S.a_base(cur); const char* cB = S.b_base(cur);
    PG8_STAGE(PG8_SB(0, 0), cB, voffB); PG8_STAGE(PG8_SB(0, 1), cB + hstep, voffB); PG8_STAGE(PG8_SA(0, 0), cA, vA[0]); PG8_STAGE(PG8_SA(0, 1), cA, vA[1]);
    if (wr == 1) PG8_BAR;
    PG8_WAIT_V(2); PG8_BAR;
    PG8_STAGE(PG8_SB(1, 0), cB + kstep, voffB); PG8_STAGE(PG8_SA(1, 0), cA + kstep, vA[0]); PG8_STAGE(PG8_SB(1, 1), cB + hstep + kstep, voffB);
    PG8_WAIT_V(6); PG8_BAR;
    for (;;) {
        const char* nA = has_next ? S.a_base(nxt) : cA; const char* nB = has_next ? S.b_base(nxt) : cB;
        if constexpr (GATHER) {
            if (has_next) S.a_offs(nxt, Rr, Cc, pts, nvA);
            else {
#pragma unroll
                for (int h = 0; h < 2; ++h)
#pragma unroll
                    for (int i = 0; i < 2; ++i) nvA[h][i] = vA[h][i];
            }
        }
        const bool has_nn = has_next && S.next(ui + 2, nn);
        if (GATHER && has_nn) S.ts_load(nn, Rr, pts);
        for (int t = 0; t < nt; t += 2) {
            const bool last = (t == nt - 2);
            const char* a1 = cA + (size_t)(t + 1) * kstep;
            const char* a2 = last ? nA : cA + (size_t)(t + 2) * kstep; const char* b2 = last ? nB : cB + (size_t)(t + 2) * kstep;
            const char* a3 = a2 + kstep; const char* b3 = b2 + kstep;
            unsigned w0[2], w1[2];
            if (GATHER) { w0[0] = last ? nvA[0][0] : vA[0][0]; w0[1] = last ? nvA[0][1] : vA[0][1]; w1[0] = last ? nvA[1][0] : vA[1][0]; w1[1] = last ? nvA[1][1] : vA[1][1]; }
            else { w0[0] = vA[0][0]; w0[1] = vA[0][1]; w1[0] = vA[1][0]; w1[1] = vA[1][1]; }
            PG8_LDB(B0, 0, 0); PG8_LDB(B1, 0, 1); PG8_SCHED; PG8_LDA(At, 0, 0); PG8_STAGE(PG8_SA(1, 1), a1, vA[1]);
            PG8_WAIT_V(8); PG8_WAIT_L(0); PG8_BAR; PG8_MMA(0, 0, At, B0); PG8_MMA(0, 1, At, B1); PG8_BAR; PG8_SCHED;
            PG8_LDA(At, 0, 1); PG8_STAGE(PG8_SB(0, 0), b2, voffB); PG8_STAGE(PG8_SB(0, 1), b2 + hstep, voffB); PG8_STAGE(PG8_SA(0, 0), a2, w0);
            PG8_WAIT_V(8); PG8_WAIT_L(0); PG8_BAR; PG8_MMA(1, 0, At, B0); PG8_MMA(1, 1, At, B1); PG8_BAR; PG8_SCHED;
            PG8_LDB(B0, 1, 0); PG8_LDB(B1, 1, 1); PG8_SCHED; PG8_LDA(At, 1, 0); PG8_STAGE(PG8_SA(0, 1), a2, w1);
            PG8_WAIT_V(8); PG8_WAIT_L(0); PG8_BAR; PG8_MMA(0, 0, At, B0); PG8_MMA(0, 1, At, B1); PG8_BAR; PG8_SCHED;
            PG8_LDA(At, 1, 1); PG8_STAGE(PG8_SB(1, 0), b3, voffB); PG8_STAGE(PG8_SB(1, 1), b3 + hstep, voffB); PG8_STAGE(PG8_SA(1, 0), a3, w0);
            PG8_WAIT_V(8); PG8_WAIT_L(0); PG8_BAR; PG8_MMA(1, 0, At, B0); PG8_MMA(1, 1, At, B1); PG8_BAR; PG8_SCHED;
        }
        if (wr == 0) PG8_BAR;
        if constexpr (MODE == 2) asm volatile("s_nop 15\n\ts_nop 7" ::: "memory");
        E(acc, cur, wr, wc, fr, fq);
        if (!has_next) break;
#pragma unroll
        for (int a = 0; a < 2; ++a)
#pragma unroll
            for (int b = 0; b < 2; ++b)
#pragma unroll
                for (int m = 0; m < 4; ++m)
#pragma unroll
                    for (int n = 0; n < 2; ++n) acc[a][b][m][n] = (acc_t){0, 0, 0, 0};
        cur = nxt; cA = nA; cB = nB; ++ui;
        if constexpr (GATHER) {
#pragma unroll
            for (int h = 0; h < 2; ++h)
#pragma unroll
                for (int i = 0; i < 2; ++i) vA[h][i] = nvA[h][i];
        }
        nxt = nn; has_next = has_nn;
        if (wr == 1) PG8_BAR;
    }
    PG8_WAIT_V(0);
    PG8_BAR;
#undef PG8_SA
#undef PG8_SB
#undef PG8_STAGE
#undef PG8_LDA
#undef PG8_LDB
#undef PG8_MMA
#undef PG8_WAIT_V
#undef PG8_WAIT_L
#undef PG8_BAR
#undef PG8_SCHED
}
}

struct ConvJob { const float* W; bf16* WT; int K, ldn, col0, ncols, drow0, mode, nbatch; size_t sstride, dstride; };
DI void transpose_item(const ConvJob& J, int item, LAS float* scr, int lane) {
    const int per = (J.K / 64) * (J.ncols / 32); const int bi = item / per; int r = item - bi * per;
    const int nblk = J.ncols / 32, kb = r / nblk, nb = r % nblk, k0 = 64 * kb, j0 = 32 * nb;
    const float* W = J.W + (size_t)bi * J.sstride; bf16* WT = J.WT + (size_t)bi * J.dstride;
    float tv[32];
#pragma unroll
    for (int i = 0; i < 32; ++i) { const int kk = 2 * i + (lane >> 5); tv[i] = __builtin_nontemporal_load(W + (size_t)(k0 + kk) * J.ldn + J.col0 + j0 + (lane & 31)); }
#pragma unroll
    for (int i = 0; i < 32; ++i) { const int kk = 2 * i + (lane >> 5); scr[kk * 33 + (lane & 31)] = tv[i]; }
    asm volatile("s_waitcnt lgkmcnt(0)" ::: "memory");
    const int c = lane & 7;
    const int drow = J.drow0 + (J.mode ? ((j0 >> 7) * 256 + (j0 & 127)) : j0);
#pragma unroll
    for (int j = 0; j < 4; ++j) { const int n = (lane >> 3) + 8 * j; const LAS float* s = scr + (8 * c) * 33 + n;
        u32x4 o; o.x = pk2(s[0 * 33], s[1 * 33]); o.y = pk2(s[2 * 33], s[3 * 33]); o.z = pk2(s[4 * 33], s[5 * 33]); o.w = pk2(s[6 * 33], s[7 * 33]);
        *(u32x4*)(WT + (size_t)(drow + n) * J.K + k0 + 8 * c) = o; }
    asm volatile("s_waitcnt lgkmcnt(0)" ::: "memory");
}
constexpr int N_JOBS = 15;
DI ConvJob get_job(const Args& a, int j) {
    unsigned char* ws = a.ws; ConvJob J; J.nbatch = 1; J.sstride = 0; J.dstride = 0; J.mode = 0;
    switch (j) {
        case 0: J.W = a.in[6]; J.WT = (bf16*)(ws + W_EVIN); J.K = D; J.ldn = EV_IN; J.col0 = 0; J.ncols = 512; J.drow0 = 0; break;
        case 1: J.W = a.in[6]; J.WT = (bf16*)(ws + W_EVIN); J.K = D; J.ldn = EV_IN; J.col0 = 512; J.ncols = 512; J.drow0 = 512; J.mode = 1; break;
        case 2: J.W = a.in[6]; J.WT = (bf16*)(ws + W_EVIN); J.K = D; J.ldn = EV_IN; J.col0 = 1024; J.ncols = 512; J.drow0 = 640; J.mode = 1; break;
        case 3: J.W = a.in[6]; J.WT = (bf16*)(ws + W_EVIN); J.K = D; J.ldn = EV_IN; J.col0 = 1536; J.ncols = 2048; J.drow0 = 1536; break;
        case 4: J.W = a.in[12]; J.WT = (bf16*)(ws + W_EVOUT); J.K = D; J.ldn = D; J.col0 = 0; J.ncols = D; J.drow0 = 0; break;
        case 5: J.W = a.in[22]; J.WT = (bf16*)(ws + W_FFGU); J.K = D; J.ldn = 2 * DFF; J.col0 = 0; J.ncols = DFF; J.drow0 = 0; J.mode = 1; break;
        case 6: J.W = a.in[22]; J.WT = (bf16*)(ws + W_FFGU); J.K = D; J.ldn = 2 * DFF; J.col0 = DFF; J.ncols = DFF; J.drow0 = 128; J.mode = 1; break;
        case 7: J.W = a.in[23]; J.WT = (bf16*)(ws + W_FFD); J.K = DFF; J.ldn = D; J.col0 = 0; J.ncols = D; J.drow0 = 0; break;
        case 8: J.W = a.in[13]; J.WT = (bf16*)(ws + W_ODIN); J.K = D; J.ldn = OD_N; J.col0 = 0; J.ncols = OD_N; J.drow0 = 0; break;
        case 9: J.W = a.in[20]; J.WT = (bf16*)(ws + W_ODOUT); J.K = D; J.ldn = D; J.col0 = 0; J.ncols = D; J.drow0 = 0; break;
        case 10: J.W = a.in[25]; J.WT = (bf16*)(ws + W_MGU); J.K = D; J.ldn = 2 * DFE; J.col0 = 0; J.ncols = DFE; J.drow0 = 0; J.mode = 1; J.nbatch = NE; J.sstride = (size_t)D * 2 * DFE; J.dstride = (size_t)2 * DFE * D; break;
        case 11: J.W = a.in[25]; J.WT = (bf16*)(ws + W_MGU); J.K = D; J.ldn = 2 * DFE; J.col0 = DFE; J.ncols = DFE; J.drow0 = 128; J.mode = 1; J.nbatch = NE; J.sstride = (size_t)D * 2 * DFE; J.dstride = (size_t)2 * DFE * D; break;
        case 12: J.W = a.in[26]; J.WT = (bf16*)(ws + W_MD); J.K = DFE; J.ldn = D; J.col0 = 0; J.ncols = D; J.drow0 = 0; J.nbatch = NE; J.sstride = (size_t)DFE * D; J.dstride = (size_t)D * DFE; break;
        case 13: J.W = a.in[27]; J.WT = (bf16*)(ws + W_PPROJ); J.K = 256; J.ldn = D; J.col0 = 0; J.ncols = D; J.drow0 = 0; J.nbatch = 2; J.sstride = (size_t)256 * D; J.dstride = (size_t)D * 256; break;
        default: J.W = a.in[28]; J.WT = (bf16*)(ws + W_PGATE); J.K = D; J.ldn = D; J.col0 = 0; J.ncols = D; J.drow0 = 0; J.nbatch = 2; J.sstride = (size_t)D * D; J.dstride = (size_t)D * D; break;
    }
    return J;
}
DI void convert_weights(const Frame& F, const Args& a) {
    LAS float* scr = (LAS float*)(F.lds + F.wave * 16384);
    const int gw = F.vcu * 8 + F.wave, NGW = F.G * 8;
    for (int jj = 0; jj < 4; ++jj) {
        const int j = jj == 0 ? 4 : jj == 1 ? 7 : jj == 2 ? 9 : 13;
        const ConvJob J = get_job(a, j);
        const int nitems = J.nbatch * (J.K / 64) * (J.ncols / 32);
        for (int it = gw; it < nitems; it += NGW) transpose_item(J, it, scr, F.lane);
    }
}

struct QJob { const float* W; signed char* W8; int ldn, col0, ncols, drow0, mode, nbatch, rows_pb, sbo, K, fp8; size_t sstride; };
constexpr int N_QJOBS = 11;
DI QJob get_qjob(const Args& a, int j) {
    unsigned char* ws = a.ws; QJob J; J.nbatch = 1; J.sstride = 0; J.mode = 0; J.rows_pb = 0; J.K = D; J.fp8 = 0;
    switch (j) {
        case 10: J.W = a.in[26]; J.W8 = (signed char*)(ws + W_MD); J.ldn = D; J.col0 = 0; J.ncols = D; J.drow0 = 0; J.sbo = SBO_MD; J.nbatch = NE; J.rows_pb = D; J.sstride = (size_t)DFE * D; J.K = DFE; J.fp8 = 1; break;
        case 0: J.W = a.in[6]; J.W8 = (signed char*)(ws + W_EVIN); J.ldn = EV_IN; J.col0 = 0; J.ncols = 512; J.drow0 = 0; J.sbo = SBO_EVIN; break;
        case 1: J.W = a.in[6]; J.W8 = (signed char*)(ws + W_EVIN); J.ldn = EV_IN; J.col0 = 512; J.ncols = 512; J.drow0 = 512; J.mode = 1; J.sbo = SBO_EVIN; break;
        case 2: J.W = a.in[6]; J.W8 = (signed char*)(ws + W_EVIN); J.ldn = EV_IN; J.col0 = 1024; J.ncols = 512; J.drow0 = 640; J.mode = 1; J.sbo = SBO_EVIN; break;
        case 3: J.W = a.in[6]; J.W8 = (signed char*)(ws + W_EVIN); J.ldn = EV_IN; J.col0 = 1536; J.ncols = 2048; J.drow0 = 1536; J.sbo = SBO_EVIN; break;
        case 4: J.W = a.in[22]; J.W8 = (signed char*)(ws + W_FFGU); J.ldn = 2 * DFF; J.col0 = 0; J.ncols = DFF; J.drow0 = 0; J.mode = 1; J.sbo = SBO_FFGU; break;
        case 5: J.W = a.in[22]; J.W8 = (signed char*)(ws + W_FFGU); J.ldn = 2 * DFF; J.col0 = DFF; J.ncols = DFF; J.drow0 = 128; J.mode = 1; J.sbo = SBO_FFGU; break;
        case 6: J.W = a.in[13]; J.W8 = (signed char*)(ws + W_ODIN); J.ldn = OD_N; J.col0 = 0; J.ncols = OD_N; J.drow0 = 0; J.sbo = SBO_ODIN; break;
        case 7: J.W = a.in[28]; J.W8 = (signed char*)(ws + W_PGATE); J.ldn = D; J.col0 = 0; J.ncols = D; J.drow0 = 0; J.sbo = SBO_PGATE; J.nbatch = 2; J.rows_pb = D; J.sstride = (size_t)D * D; break;
        case 8: J.W = a.in[25]; J.W8 = (signed char*)(ws + W_MGU); J.ldn = 2 * DFE; J.col0 = 0; J.ncols = DFE; J.drow0 = 0; J.mode = 1; J.sbo = SBO_MOE; J.nbatch = NE; J.rows_pb = 2 * DFE; J.sstride = (size_t)D * 2 * DFE; break;
        default: J.W = a.in[25]; J.W8 = (signed char*)(ws + W_MGU); J.ldn = 2 * DFE; J.col0 = DFE; J.ncols = DFE; J.drow0 = 128; J.mode = 1; J.sbo = SBO_MOE; J.nbatch = NE; J.rows_pb = 2 * DFE; J.sstride = (size_t)D * 2 * DFE; break;
    }
    return J;
}
DI int q_drow(const QJob& J, int j0) { return J.drow0 + (J.mode ? ((j0 >> 7) * 256 + (j0 & 127)) : j0); }
DI void absmax_jobs(const Frame& F, const Args& a, int jlo, int jhi, int worker, int nworkers) {
    unsigned* cmax = (unsigned*)(F.ws + WS_CTL) + CW_CMAX;
    const int gw = worker * 8 + F.wave, NGW = nworkers * 8, lane = F.lane;
    for (int j = jlo; j < jhi; ++j) {
        const QJob J = get_qjob(a, j);
        const int nblk = J.ncols / 32, per = (J.K / 256) * nblk, nitems = J.nbatch * per;
        for (int it = gw; it < nitems; it += NGW) {
            const int bi = it / per, r = it - bi * per, kb = r / nblk, nb = r - kb * nblk;
            const float* p = J.W + (size_t)bi * J.sstride + (size_t)(kb * 256 + (lane >> 5)) * J.ldn + J.col0 + nb * 32 + (lane & 31);
            float m = 0.f;
#pragma unroll 1
            for (int i0 = 0; i0 < 128; i0 += 32) {
                float tv[32];
#pragma unroll
                for (int i = 0; i < 32; ++i) tv[i] = __builtin_nontemporal_load(p + (size_t)(2 * (i0 + i)) * J.ldn);
#pragma unroll
                for (int i = 0; i < 32; ++i) m = fmaxf(m, fabsf(tv[i]));
            }
            m = fmaxf(m, __shfl_xor(m, 32));
            if (lane < 32) __hip_atomic_fetch_max(cmax + J.sbo + bi * J.rows_pb + q_drow(J, nb * 32) + lane, __float_as_uint(m), __ATOMIC_RELAXED, __HIP_MEMORY_SCOPE_AGENT);
        }
    }
}
DI void quant_jobs(const Frame& F, const Args& a, int jlo, int jhi, int worker, int nworkers) {
    const unsigned* cmax = (const unsigned*)(F.ws + WS_CTL) + CW_CMAX; float* SB = (float*)(F.ws + WS_SB);
    LAS float* scr = (LAS float*)(F.lds + F.wave * 17408);
    const int gw = worker * 8 + F.wave, NGW = nworkers * 8, lane = F.lane;
    for (int j = jlo; j < jhi; ++j) {
        const QJob J = get_qjob(a, j);
        const int nblk = J.ncols / 32, per = (J.K / 128) * nblk, nitems = J.nbatch * per;
        const float qmax = J.fp8 ? 448.f : 127.f;
        for (int it = gw; it < nitems; it += NGW) {
            const int bi = it / per, r = it - bi * per, kb = r / nblk, nb = r - kb * nblk, k0 = kb * 128, j0 = nb * 32;
            const int srow = J.sbo + bi * J.rows_pb + q_drow(J, j0);
            const float cm = __uint_as_float(__hip_atomic_load(cmax + srow + (lane & 31), __ATOMIC_RELAXED, __HIP_MEMORY_SCOPE_AGENT));
            const float inv = cm > 0.f ? qmax / cm : 0.f;
            const float* p = J.W + (size_t)bi * J.sstride + (size_t)(k0 + (lane >> 5)) * J.ldn + J.col0 + j0 + (lane & 31);
#pragma unroll 1
            for (int i0 = 0; i0 < 64; i0 += 32) {
                float tv[32];
#pragma unroll
                for (int i = 0; i < 32; ++i) tv[i] = __builtin_nontemporal_load(p + (size_t)(2 * (i0 + i)) * J.ldn);
#pragma unroll
                for (int i = 0; i < 32; ++i) scr[(2 * (i0 + i) + (lane >> 5)) * 33 + (lane & 31)] = tv[i] * inv;
            }
            asm volatile("s_waitcnt lgkmcnt(0)" ::: "memory");
            const int drow = bi * J.rows_pb + q_drow(J, j0);
            const int c = lane & 7;
#pragma unroll
            for (int jj = 0; jj < 4; ++jj) { const int n = (lane >> 3) + 8 * jj; const LAS float* sp = scr + (16 * c) * 33 + n;
                u32x4 o;
#pragma unroll
                for (int q = 0; q < 4; ++q) { const float f0 = sp[(4 * q) * 33], f1 = sp[(4 * q + 1) * 33], f2 = sp[(4 * q + 2) * 33], f3 = sp[(4 * q + 3) * 33];
                    if (J.fp8) { int pk = 0; pk = __builtin_amdgcn_cvt_pk_fp8_f32(f0, f1, pk, false); pk = __builtin_amdgcn_cvt_pk_fp8_f32(f2, f3, pk, true); o[q] = (unsigned)pk; }
                    else { const int b0 = __float2int_rn(f0), b1 = __float2int_rn(f1), b2 = __float2int_rn(f2), b3 = __float2int_rn(f3);
                        o[q] = (unsigned)(b0 & 0xff) | ((unsigned)(b1 & 0xff) << 8) | ((unsigned)(b2 & 0xff) << 16) | ((unsigned)(b3 & 0xff) << 24); } }
                *(u32x4*)(J.W8 + (size_t)(drow + n) * J.K + k0 + 16 * c) = o; }
            if (k0 == 0 && lane < 32) SB[srow + lane] = cm / qmax;
            asm volatile("s_waitcnt lgkmcnt(0)" ::: "memory");
        }
    }
}

DI void load_row(const float* p, int lane, f32x4 (&v)[4]) {
    const f32x4* xr = (const f32x4*)p + lane;
#pragma unroll
    for (int j = 0; j < 4; ++j) v[j] = xr[64 * j];
}
DI float sumsq16(const f32x4 (&v)[4]) { float s = 0.f;
#pragma unroll
    for (int j = 0; j < 4; ++j) s += (v[j].x * v[j].x + v[j].y * v[j].y) + (v[j].z * v[j].z + v[j].w * v[j].w);
    return s; }
DI void store_bf16_row(bf16* orow, int lane, const f32x4 (&v)[4]) {
    u32x2* o8 = (u32x2*)orow + lane;
#pragma unroll
    for (int j = 0; j < 4; ++j) { u32x2 w; w.x = pk2(v[j].x, v[j].y); w.y = pk2(v[j].z, v[j].w); o8[64 * j] = w; }
}
DI float quant_row_store(signed char* drow, int lane, const f32x4 (&v)[4]) {
    float am = 0.f;
#pragma unroll
    for (int j = 0; j < 4; ++j) am = fmaxf(fmaxf(am, fmaxf(fabsf(v[j].x), fabsf(v[j].y))), fmaxf(fabsf(v[j].z), fabsf(v[j].w)));
    am = wave_max(am);
    const float qinv = am > 0.f ? 127.f / am : 0.f;
    unsigned* o4 = (unsigned*)drow + lane;
#pragma unroll
    for (int j = 0; j < 4; ++j) { const int b0 = __float2int_rn(v[j].x * qinv), b1 = __float2int_rn(v[j].y * qinv), b2 = __float2int_rn(v[j].z * qinv), b3 = __float2int_rn(v[j].w * qinv);
        o4[64 * j] = (unsigned)(b0 & 0xff) | ((unsigned)(b1 & 0xff) << 8) | ((unsigned)(b2 & 0xff) << 16) | ((unsigned)(b3 & 0xff) << 24); }
    return am * (1.f / 127.f);
}
DI void norm_plain(const Frame& F, const float* src, const float* g, signed char* dst, float* SA) {
    f32x4 gv[4]; load_row(g, F.lane, gv);
    const int gw = F.vcu * 8 + F.wave, NGW = F.G * 8;
    for (int m = gw; m < T; m += NGW) {
        f32x4 v[4]; load_row(src + (size_t)m * D, F.lane, v);
        const float rstd = rsqrtf(wave_sum(sumsq16(v)) * (1.f / D) + EPS);
#pragma unroll
        for (int j = 0; j < 4; ++j) v[j] = v[j] * rstd * gv[j];
        const float sc = quant_row_store(dst + (size_t)m * D, F.lane, v);
        if (F.lane == 0) SA[m] = sc;
    }
}
DI void norm_mix0(const Frame& F, const Args& a) {
    const float* x = a.in[0]; const float* g = a.in[2]; const float* win = a.in[6];
    signed char* dst = (signed char*)(F.ws + WS_HN); float* SA = (float*)(F.ws + WS_SA); float* GA = (float*)(F.ws + WS_GA); float* BT = (float*)(F.ws + WS_BETA);
    f32x4 gv[4]; load_row(g, F.lane, gv);
    float w8[16][8];
#pragma unroll
    for (int j = 0; j < 4; ++j)
#pragma unroll
        for (int e = 0; e < 4; ++e) { const int k = 256 * j + 4 * F.lane + e; const f32x4 lo = *(const f32x4*)(win + (size_t)k * EV_IN + EV_N), hi = *(const f32x4*)(win + (size_t)k * EV_IN + EV_N + 4);
#pragma unroll
            for (int c = 0; c < 4; ++c) { w8[4 * j + e][c] = lo[c]; w8[4 * j + e][4 + c] = hi[c]; } }
    const int h4 = F.lane & 3;
    const float negA = -__expf(a.in[9][h4]), dtb = a.in[10][h4];
    const int gw = F.vcu * 8 + F.wave, NGW = F.G * 8;
    for (int m = gw; m < T; m += NGW) {
        f32x4 v[4]; load_row(x + (size_t)m * D, F.lane, v);
        const float rstd = rsqrtf(wave_sum(sumsq16(v)) * (1.f / D) + EPS);
#pragma unroll
        for (int j = 0; j < 4; ++j) v[j] = v[j] * rstd * gv[j];
        { const float sc = quant_row_store(dst + (size_t)m * D, F.lane, v); if (F.lane == 0) SA[m] = sc; }
        float dsum[8];
#pragma unroll
        for (int c = 0; c < 8; ++c) { float s = 0.f;
#pragma unroll
            for (int j = 0; j < 4; ++j)
#pragma unroll
                for (int e = 0; e < 4; ++e) s += v[j][e] * w8[4 * j + e][c];
            dsum[c] = wave_sum(s); }
        float af = dsum[0], bfv = dsum[4];
        if (h4 == 1) { af = dsum[1]; bfv = dsum[5]; } else if (h4 == 2) { af = dsum[2]; bfv = dsum[6]; } else if (h4 == 3) { af = dsum[3]; bfv = dsum[7]; }
        const float z = af + dtb; const float sp = (z > 20.f) ? z : log1pf(__expf(z));
        if (F.lane < 4) { GA[(size_t)m * 4 + h4] = negA * sp; BT[(size_t)m * 4 + h4] = sigmoid_f(bfv); }
    }
}
DI void convert_p(const Frame& F, const float* p, bf16* dst) {
    const size_t n8 = (size_t)T * 256 / 8;
    for (size_t i = (size_t)F.vcu * 512 + F.tid; i < n8; i += (size_t)F.G * 512) {
        const f32x4 a = *(const f32x4*)(p + i * 8), b = *(const f32x4*)(p + i * 8 + 4);
        *(u32x4*)(dst + i * 8) = pg8::pack8(a, b);
    }
}
DI void norm_router(const Frame& F, const Args& a) {
    const float* h = a.out; const float* g = a.in[3] + D; const float* wr_ = a.in[24];
    signed char* dst = (signed char*)(F.ws + WS_HN); int* row_ts = (int*)(F.ws + WS_ROWTS); float* row_gate = (float*)(F.ws + WS_ROWGATE); float* row_sa = (float*)(F.ws + WS_ROWSA); unsigned* ctl = (unsigned*)(F.ws + WS_CTL);
    f32x4 gv[4]; load_row(g, F.lane, gv);
    float w8[16][8];
#pragma unroll
    for (int j = 0; j < 4; ++j)
#pragma unroll
        for (int e = 0; e < 4; ++e) { const int k = 256 * j + 4 * F.lane + e; const f32x4 lo = *(const f32x4*)(wr_ + (size_t)k * 8), hi = *(const f32x4*)(wr_ + (size_t)k * 8 + 4);
#pragma unroll
            for (int c = 0; c < 4; ++c) { w8[4 * j + e][c] = lo[c]; w8[4 * j + e][4 + c] = hi[c]; } }
    const int gw = F.vcu * 8 + F.wave, NGW = F.G * 8;
    if (gw == 0) { unsigned* z = (unsigned*)(dst + (size_t)T * D) + F.lane;
#pragma unroll
        for (int j = 0; j < 4; ++j) z[64 * j] = 0u; }
    for (int grp = gw; grp < T / 32; grp += NGW) {
        int e0 = 0, e1 = 1; float g0 = 0.f, g1 = 0.f, sav = 0.f;
        for (int rr = 0; rr < 32; ++rr) {
            const int m = grp * 32 + rr;
            f32x4 v[4]; load_row(h + (size_t)m * D, F.lane, v);
            const float rstd = rsqrtf(wave_sum(sumsq16(v)) * (1.f / D) + EPS);
#pragma unroll
            for (int j = 0; j < 4; ++j) v[j] = v[j] * rstd * gv[j];
            float am = 0.f;
#pragma unroll
            for (int j = 0; j < 4; ++j) am = fmaxf(fmaxf(am, fmaxf(fabsf(v[j].x), fabsf(v[j].y))), fmaxf(fabsf(v[j].z), fabsf(v[j].w)));
            am = wave_max(am);
            const float qinv = am > 0.f ? 127.f / am : 0.f;
            { unsigned* o4 = (unsigned*)(dst + (size_t)m * D) + F.lane;
#pragma unroll
              for (int j = 0; j < 4; ++j) { const int b0 = __float2int_rn(v[j].x * qinv), b1 = __float2int_rn(v[j].y * qinv), b2 = __float2int_rn(v[j].z * qinv), b3 = __float2int_rn(v[j].w * qinv);
                  o4[64 * j] = (unsigned)(b0 & 0xff) | ((unsigned)(b1 & 0xff) << 8) | ((unsigned)(b2 & 0xff) << 16) | ((unsigned)(b3 & 0xff) << 24); } }
            float lg[8];
#pragma unroll
            for (int c = 0; c < 8; ++c) { float s = 0.f;
#pragma unroll
                for (int j = 0; j < 4; ++j)
#pragma unroll
                    for (int e = 0; e < 4; ++e) s += v[j][e] * w8[4 * j + e][c];
                lg[c] = wave_sum(s); }
            int b0 = 0; float v0 = lg[0];
#pragma unroll
            for (int c = 1; c < 8; ++c) if (lg[c] > v0) { v0 = lg[c]; b0 = c; }
            int b1 = -1; float v1 = -INFINITY;
#pragma unroll
            for (int c = 0; c < 8; ++c) if (c != b0 && lg[c] > v1) { v1 = lg[c]; b1 = c; }
            const float ga = 1.f / (1.f + __expf(v1 - v0));
            if (F.lane == rr) { e0 = b0; e1 = b1; g0 = ga; g1 = 1.f - ga; sav = am * (1.f / 127.f); }
        }
        const bool act = F.lane < 32;
#pragma unroll
        for (int e = 0; e < 8; ++e) {
            const unsigned long long m0 = __ballot(act && e0 == e), m1 = __ballot(act && e1 == e);
            const int n0 = __popcll(m0), n1 = __popcll(m1);
            if (n0 + n1 == 0) continue;
            unsigned base = 0;
            if (F.lane == 0) base = __hip_atomic_fetch_add(ctl + CW_CNT + 64 * e, (unsigned)(n0 + n1), __ATOMIC_RELAXED, __HIP_MEMORY_SCOPE_AGENT);
            base = (unsigned)__builtin_amdgcn_readfirstlane((int)base);
            const unsigned long long below = (1ull << F.lane) - 1ull;
            const int tok = grp * 32 + F.lane;
            if (act && e0 == e) { const unsigned off = base + (unsigned)__popcll(m0 & below); row_ts[(size_t)e * CAP + off] = tok * 2; row_gate[(size_t)e * CAP + off] = g0; row_sa[(size_t)e * CAP + off] = sav; }
            if (act && e1 == e) { const unsigned off = base + (unsigned)n0 + (unsigned)__popcll(m1 & below); row_ts[(size_t)e * CAP + off] = tok * 2 + 1; row_gate[(size_t)e * CAP + off] = g1; row_sa[(size_t)e * CAP + off] = sav; }
        }
    }
}
DI void combine_norm(const Frame& F, const Args& a) {
    float* h = a.out; const float* g = a.in[4] + D; const bf16* ym = (const bf16*)(F.ws + WS_YMOE); signed char* dst = (signed char*)(F.ws + WS_HN); float* SA = (float*)(F.ws + WS_SA);
    f32x4 gv[4]; load_row(g, F.lane, gv);
    const int gw = F.vcu * 8 + F.wave, NGW = F.G * 8;
    for (int m = gw; m < T; m += NGW) {
        f32x4 v[4]; load_row(h + (size_t)m * D, F.lane, v);
        const u32x2* y0 = (const u32x2*)(ym + (size_t)m * 2 * D) + F.lane; const u32x2* y1 = (const u32x2*)(ym + (size_t)m * 2 * D + D) + F.lane;
#pragma unroll
        for (int j = 0; j < 4; ++j) { const u32x2 p = y0[64 * j], q = y1[64 * j];
            v[j].x += bflo(p.x) + bflo(q.x); v[j].y += bfhi(p.x) + bfhi(q.x); v[j].z += bflo(p.y) + bflo(q.y); v[j].w += bfhi(p.y) + bfhi(q.y); }
        f32x4* hw = (f32x4*)(h + (size_t)m * D) + F.lane;
#pragma unroll
        for (int j = 0; j < 4; ++j) hw[64 * j] = v[j];
        const float rstd = rsqrtf(wave_sum(sumsq16(v)) * (1.f / D) + EPS);
#pragma unroll
        for (int j = 0; j < 4; ++j) v[j] = v[j] * rstd * gv[j];
        { const float sc = quant_row_store(dst + (size_t)m * D, F.lane, v); if (F.lane == 0) SA[m] = sc; }
    }
}
DI void final_norm(const Frame& F, const Args& a) {
    float* h = a.out; const float* g = a.in[5];
    f32x4 gv[4]; load_row(g, F.lane, gv);
    const int gw = F.vcu * 8 + F.wave, NGW = F.G * 8;
    for (int m = gw; m < T; m += NGW) {
        f32x4 v[4]; load_row(h + (size_t)m * D, F.lane, v);
        const float rstd = rsqrtf(wave_sum(sumsq16(v)) * (1.f / D) + EPS);
        f32x4* hw = (f32x4*)(h + (size_t)m * D) + F.lane;
#pragma unroll
        for (int j = 0; j < 4; ++j) hw[64 * j] = v[j] * rstd * gv[j];
    }
}

DI void mixer_a(const Frame& F, const Args& a, int worker, int nworkers) {
    const bf16* U = (const bf16*)(F.ws + WS_U); bf16* Y = (bf16*)(F.ws + WS_Y); const float* cw = a.in[7];
    const size_t nitems = (size_t)T * 64;
    for (size_t it = (size_t)worker * 512 + F.tid; it < nitems; it += (size_t)nworkers * 512) {
        const int t = (int)(it >> 6), c8 = (int)(it & 63) * 8, s = t & (SEQ - 1);
        const u32x4 bg = *(const u32x4*)(U + (size_t)t * EVU + c8);
        const u32x4 z2 = *(const u32x4*)(U + (size_t)t * EVU + 512 + c8);
        u32x4 z1 = (u32x4){0u, 0u, 0u, 0u}, z0 = (u32x4){0u, 0u, 0u, 0u};
        if (s >= 1) z1 = *(const u32x4*)(U + (size_t)(t - 1) * EVU + 512 + c8);
        if (s >= 2) z0 = *(const u32x4*)(U + (size_t)(t - 2) * EVU + 512 + c8);
        float o[8];
#pragma unroll
        for (int q = 0; q < 4; ++q) {
            const int c = c8 + 2 * q;
            const float a0 = cw[c] * bflo(z0[q]) + cw[512 + c] * bflo(z1[q]) + cw[1024 + c] * bflo(z2[q]);
            const float a1 = cw[c + 1] * bfhi(z0[q]) + cw[512 + c + 1] * bfhi(z1[q]) + cw[1024 + c + 1] * bfhi(z2[q]);
            o[2 * q] = bflo(bg[q]) * a0; o[2 * q + 1] = bfhi(bg[q]) * a1;
        }
        u32x4 w; w.x = pk2(o[0], o[1]); w.y = pk2(o[2], o[3]); w.z = pk2(o[4], o[5]); w.w = pk2(o[6], o[7]);
        *(u32x4*)(Y + (size_t)t * D + c8) = w;
    }
}

constexpr int GA_GCS = 0, GA_BTS = 256, GA_KN = 1024, GA_KB = GA_KN + 17408, GA_QN = GA_KB + 17408, GA_VBT = GA_QN + 17408, GA_KGT = GA_VBT + 18432,
              GA_AM = GA_KGT + 18432, GA_TB = GA_AM + 17408, GA_QKS = GA_TB + 9216, GA_CW = GA_QKS + 9216, GA_END = GA_CW + 6144;
static_assert(GA_END <= 155648, "gdn-a lds");
DI void gdn_a(const Frame& F, const Args& a) {
    LAS unsigned char* L = F.lds;
    LAS float* gcs = (LAS float*)(L + GA_GCS); LAS float* bts = (LAS float*)(L + GA_BTS);
    LAS float* Am = (LAS float*)(L + GA_AM);
    const bf16* U = (const bf16*)(F.ws + WS_U); const float* GA = (const float*)(F.ws + WS_GA); const float* BT = (const float*)(F.ws + WS_BETA);
    float* EG = (float*)(F.ws + WS_EG); const float* cw = a.in[8];
    const int lane = F.lane, w = F.wave, r = lane & 31, hh = lane >> 5;
    for (int item = F.vcu; item < 4096; item += F.G) {
        const int bh = item >> 5, n = item & 31, b = bh >> 2, h = bh & 3, t0 = b * SEQ + n * 64;
        unsigned char* Gp = F.ws + WS_G + (size_t)item * G_ITEM;
        if (w == 0) {
            float gc = GA[(size_t)(t0 + lane) * 4 + h];
#pragma unroll
            for (int o = 1; o < 64; o <<= 1) { const float up = __shfl_up(gc, o); if (lane >= o) gc += up; }
            gcs[lane] = gc; bts[lane] = BT[(size_t)(t0 + lane) * 4 + h];
            if (lane == 63) EG[item] = __expf(gc);
        }
        for (int i = F.tid; i < 1536; i += 512) { const int part = i >> 9, rem = i & 511, j = rem >> 7, c = rem & 127; *(LAS float*)(L + GA_CW + i * 4) = cw[j * 1536 + part * 512 + h * 128 + c]; }
        const int g2 = (F.tid >> 4) * 2, c8 = (F.tid & 15) * 8;
        u32x4 xr[3][5];
#pragma unroll
        for (int part = 0; part < 3; ++part)
#pragma unroll
            for (int q = 0; q < 5; ++q) {
                xr[part][q] = (u32x4){0u, 0u, 0u, 0u};
                if (n * 64 + g2 - 3 + q >= 0) xr[part][q] = *(const u32x4*)(U + (size_t)(t0 + g2 - 3 + q) * EVU + 1024 + part * 512 + h * 128 + c8);
            }
        WG_BAR();
        const float glast = gcs[63];
#pragma unroll
        for (int part = 0; part < 3; ++part) {
#pragma unroll
            for (int tk = 0; tk < 2; ++tk) {
                const int tok = g2 + tk;
                float acc[8];
#pragma unroll
                for (int e = 0; e < 8; ++e) acc[e] = 0.f;
#pragma unroll
                for (int j = 0; j < 4; ++j) {
                    const u32x4 xv = xr[part][tk + j];
                    const f32x4 w0 = *(const LAS f32x4*)(L + GA_CW + ((part * 4 + j) * 128 + c8) * 4), w1 = *(const LAS f32x4*)(L + GA_CW + ((part * 4 + j) * 128 + c8 + 4) * 4);
                    acc[0] += w0[0] * bflo(xv[0]); acc[1] += w0[1] * bfhi(xv[0]); acc[2] += w0[2] * bflo(xv[1]); acc[3] += w0[3] * bfhi(xv[1]);
                    acc[4] += w1[0] * bflo(xv[2]); acc[5] += w1[1] * bfhi(xv[2]); acc[6] += w1[2] * bflo(xv[3]); acc[7] += w1[3] * bfhi(xv[3]);
                }
                float ss = 0.f;
#pragma unroll
                for (int e = 0; e < 8; ++e) { acc[e] = silu_f(acc[e]); ss += acc[e] * acc[e]; }
                ss = row16_sum(ss);
                const float beta = bts[tok], gc = gcs[tok];
                if (part == 0) {
                    const float sc = rsqrtf(ss + EPS) * 0.08838834764831845f, eg = __expf(gc);
                    u32x4 o; o.x = pk2(acc[0] * sc, acc[1] * sc); o.y = pk2(acc[2] * sc, acc[3] * sc); o.z = pk2(acc[4] * sc, acc[5] * sc); o.w = pk2(acc[6] * sc, acc[7] * sc);
                    *(LAS u32x4*)(L + GA_QN + tok * 272 + c8 * 2) = o;
                    const float s2 = sc * eg;
                    u32x4 g; g.x = pk2(acc[0] * s2, acc[1] * s2); g.y = pk2(acc[2] * s2, acc[3] * s2); g.z = pk2(acc[4] * s2, acc[5] * s2); g.w = pk2(acc[6] * s2, acc[7] * s2);
                    *(u32x4*)(Gp + G_QG + tok * 256 + c8 * 2) = g;
                } else if (part == 1) {
                    const float sc = rsqrtf(ss + EPS), sb = sc * beta, sg = sb * __expf(gc), sd = sc * __expf(glast - gc);
                    u32x4 o; o.x = pk2(acc[0] * sc, acc[1] * sc); o.y = pk2(acc[2] * sc, acc[3] * sc); o.z = pk2(acc[4] * sc, acc[5] * sc); o.w = pk2(acc[6] * sc, acc[7] * sc);
                    *(LAS u32x4*)(L + GA_KN + tok * 272 + c8 * 2) = o;
                    u32x4 p; p.x = pk2(acc[0] * sb, acc[1] * sb); p.y = pk2(acc[2] * sb, acc[3] * sb); p.z = pk2(acc[4] * sb, acc[5] * sb); p.w = pk2(acc[6] * sb, acc[7] * sb);
                    *(LAS u32x4*)(L + GA_KB + tok * 272 + c8 * 2) = p;
                    u32x4 d; d.x = pk2(acc[0] * sd, acc[1] * sd); d.y = pk2(acc[2] * sd, acc[3] * sd); d.z = pk2(acc[4] * sd, acc[5] * sd); d.w = pk2(acc[6] * sd, acc[7] * sd);
                    *(u32x4*)(Gp + G_KD + tok * 256 + c8 * 2) = d;
#pragma unroll
                    for (int e = 0; e < 8; ++e) *(LAS bf16*)(L + GA_KGT + (c8 + e) * 144 + tok * 2) = (bf16)(pk2(acc[e] * sg, 0.f) & 0xffffu);
                } else {
#pragma unroll
                    for (int e = 0; e < 8; ++e) *(LAS bf16*)(L + GA_VBT + (c8 + e) * 144 + tok * 2) = (bf16)(pk2(acc[e] * beta, 0.f) & 0xffffu);
                }
            }
        }
        WG_BAR();
        {
            const int mat = w >> 2, ti = (w >> 1) & 1, tj = w & 1;
            f32x16 x = zero16();
            if (ti >= tj) {
                const LAS unsigned char* ap = L + (mat ? GA_QN : GA_KB) + (32 * ti + r) * 272 + hh * 16;
                const LAS unsigned char* bp = L + GA_KN + (32 * tj + r) * 272 + hh * 16;
#pragma unroll
                for (int s = 0; s < 8; ++s) x = MFMA32(*(const LAS bf16x8*)(ap + 32 * s), *(const LAS bf16x8*)(bp + 32 * s), x);
            }
            const int j = 32 * tj + r; const float gj = gcs[j];
#pragma unroll
            for (int reg = 0; reg < 16; ++reg) {
                const int i = 32 * ti + crow(reg, hh);
                const float dec = __expf(gcs[i] - gj);
                if (mat == 0) Am[i * 68 + j] = (i > j) ? x[reg] * dec : 0.f;
                else *(LAS bf16*)(L + GA_QKS + i * 144 + j * 2) = (bf16)(pk2((i >= j) ? x[reg] * dec : 0.f, 0.f) & 0xffffu);
            }
        }
        WG_BAR();
        if (w == 0) {
            const int blk = hh, col = r;
            float Tr[32];
            const LAS float* Ab = Am + (blk * 32) * 68 + blk * 32;
#pragma unroll
            for (int i = 0; i < 32; ++i) {
                float acc = (i == col) ? 1.f : 0.f;
#pragma unroll
                for (int j = 0; j < i; ++j) acc -= Ab[i * 68 + j] * Tr[j];
                Tr[i] = acc;
            }
#pragma unroll
            for (int i = 0; i < 32; ++i) *(LAS bf16*)(L + GA_TB + (blk * 32 + i) * 144 + (blk * 32 + col) * 2) = (bf16)(pk2(Tr[i], 0.f) & 0xffffu);
#pragma unroll
            for (int i = 0; i < 16; ++i) *(LAS bf16*)(L + GA_TB + (2 * i + blk) * 144 + (32 + col) * 2) = (bf16)0;
            f32x16 P = zero16();
#pragma unroll
            for (int s = 0; s < 2; ++s) {
                const LAS float* arow = Am + (32 + r) * 68 + 16 * s + 8 * hh;
                const f32x4 a0 = *(const LAS f32x4*)arow, a1 = *(const LAS f32x4*)(arow + 4);
                const bf16x8 af = __builtin_bit_cast(bf16x8, pg8::pack8(a0, a1));
                float tv[8];
#pragma unroll
                for (int jj = 0; jj < 8; ++jj) { const float lo = Tr[16 * s + jj]; const float hi = __shfl(Tr[16 * s + 8 + jj], r); tv[jj] = hh ? hi : lo; }
                u32x4 tb; tb.x = pk2(tv[0], tv[1]); tb.y = pk2(tv[2], tv[3]); tb.z = pk2(tv[4], tv[5]); tb.w = pk2(tv[6], tv[7]);
                P = MFMA32(af, __builtin_bit_cast(bf16x8, tb), P);
            }
            f32x16 R = zero16();
#pragma unroll
            for (int s = 0; s < 2; ++s) {
                const LAS unsigned char* tp = L + GA_TB + (32 + r) * 144 + (32 + 16 * s + 4 * hh) * 2;
                const s16x4 lo = *(const LAS s16x4*)tp, hi = *(const LAS s16x4*)(tp + 16);
                R = MFMA32(cat8(lo, hi), pack_step(P, s), R);
            }
#pragma unroll
            for (int reg = 0; reg < 16; ++reg) *(LAS bf16*)(L + GA_TB + (32 + crow(reg, hh)) * 144 + r * 2) = (bf16)(pk2(-R[reg], 0.f) & 0xffffu);
        } else {
            for (int p = F.tid - 64; p < 512; p += 448) { const int row = p >> 3, c = p & 7; *(u32x4*)(Gp + G_QK + row * 128 + c * 16) = *(const LAS u32x4*)(L + GA_QKS + row * 144 + c * 16); }
        }
        WG_BAR();
        if (w < 4) {
#pragma unroll
            for (int q = 0; q < 2; ++q) {
                const int idx = w * 2 + q, ib = idx >> 2, db = idx & 3;
                f32x16 x = zero16();
                const LAS unsigned char* ap = L + GA_TB + (32 * ib + r) * 144 + hh * 16;
                const LAS unsigned char* bp = L + GA_VBT + (32 * db + r) * 144 + hh * 16;
#pragma unroll
                for (int s = 0; s < 4; ++s) if (ib || s < 2) x = MFMA32(*(const LAS bf16x8*)(ap + 32 * s), *(const LAS bf16x8*)(bp + 32 * s), x);
#pragma unroll
                for (int g = 0; g < 4; ++g) { u32x2 o; o.x = pk2(x[4 * g], x[4 * g + 1]); o.y = pk2(x[4 * g + 2], x[4 * g + 3]);
                    *(u32x2*)(Gp + G_UT + ((32 * db + r) * 64 + 32 * ib + 8 * g + 4 * hh) * 2) = o; }
            }
        } else {
#pragma unroll
            for (int q = 0; q < 2; ++q) {
                const int idx = (w - 4) * 2 + q, dkb = idx >> 1, ib = idx & 1;
                f32x16 x = zero16();
                const LAS unsigned char* ap = L + GA_KGT + (32 * dkb + r) * 144 + hh * 16;
                const LAS unsigned char* bp = L + GA_TB + (32 * ib + r) * 144 + hh * 16;
#pragma unroll
                for (int s = 0; s < 4; ++s) if (ib || s < 2) x = MFMA32(*(const LAS bf16x8*)(ap + 32 * s), *(const LAS bf16x8*)(bp + 32 * s), x);
#pragma unroll
                for (int g = 0; g < 4; ++g) { u32x2 o; o.x = pk2(x[4 * g], x[4 * g + 1]); o.y = pk2(x[4 * g + 2], x[4 * g + 3]);
                    *(u32x2*)(Gp + G_W + ((32 * ib + r) * 128 + 32 * dkb + 8 * g + 4 * hh) * 2) = o; }
            }
        }
        WG_BAR();
    }
}

constexpr int GB_ST = 0, GB_W = 34816, GB_QG = GB_W + 17408, GB_KD = GB_QG + 17408, GB_QK = GB_KD + 20480, GB_O = GB_QK + 9216, GB_END = GB_O + 33792;
static_assert(GB_END <= 140000, "gdn-b lds");
DI void gdn_b(const Frame& F, const Args& a, int worker, int nworkers) {
    LAS unsigned char* L = F.lds;
    const bf16* U = (const bf16*)(F.ws + WS_U); bf16* Y = (bf16*)(F.ws + WS_Y); const float* EG = (const float*)(F.ws + WS_EG); const float* gn = a.in[11];
    const int lane = F.lane, w = F.wave, r = lane & 31, hh = lane >> 5, dvb = w & 3, hf = w >> 2;
    const int q4 = (lane & 15) >> 2, p4 = lane & 3, g1 = (lane >> 4) & 1;
    const float gn0 = gn[2 * lane], gn1 = gn[2 * lane + 1];
    const unsigned src_t = (unsigned)F.tid * 16u;
    const unsigned dst_w = (unsigned)((F.tid >> 4) * 272 + (F.tid & 15) * 16);
    const unsigned dst_k = (unsigned)((F.tid >> 4) * 320 + (F.tid & 15) * 16);
    const unsigned dst_q = (unsigned)((F.tid >> 3) * 144 + (F.tid & 7) * 16);
    const unsigned ut_t = (unsigned)(((32 * dvb + r) * 64 + 4 * hh) * 2);
    for (int bh = worker; bh < 128; bh += nworkers) {
        const int b = bh >> 2, h = bh & 3;
        f32x16 Sacc[2] = {zero16(), zero16()};
        for (int p = F.tid; p < 34816 / 16; p += 512) *(LAS u32x4*)(L + GB_ST + p * 16) = (u32x4){0u, 0u, 0u, 0u};
        u32x4 nop[7]; u32x2 nui[2][4]; float neg; unsigned nog[8];
#define GB_PREFETCH(nn) do { const int _item = bh * 32 + (nn); const unsigned char* _Gp = F.ws + WS_G + (size_t)_item * G_ITEM; \
            unsigned _so = src_t, _uo = ut_t; asm volatile("" : "+v"(_so), "+v"(_uo)); \
            _Pragma("unroll") for (int k = 0; k < 7; ++k) { const unsigned char* _bk = _Gp + (8192 * k + (k >= 2 ? 16384 : 0)); nop[k] = *(const u32x4*)(_bk + _so); } \
            _Pragma("unroll") for (int tb = 0; tb < 2; ++tb) _Pragma("unroll") for (int g = 0; g < 4; ++g) { const unsigned char* _bu = _Gp + G_UT + (64 * tb + 16 * g); nui[tb][g] = *(const u32x2*)(_bu + _uo); } \
            neg = EG[_item]; \
            const bf16* _og = U + (size_t)(b * SEQ + (nn) * 64 + w * 8) * EVU + 2560 + h * 128; \
            unsigned _lo = (unsigned)lane * 4u; asm volatile("" : "+v"(_lo)); \
            _Pragma("unroll") for (int k = 0; k < 8; ++k) { const unsigned char* _bo = (const unsigned char*)(_og + (size_t)k * EVU); nog[k] = *(const unsigned*)(_bo + _lo); } } while (0)
        GB_PREFETCH(0);
        for (int n = 0; n < 32; ++n) {
            const int t0 = b * SEQ + n * 64;
            *(LAS u32x4*)(L + GB_W + dst_w) = nop[0]; *(LAS u32x4*)(L + GB_W + dst_w + 32 * 272) = nop[1];
            *(LAS u32x4*)(L + GB_QG + dst_w) = nop[2]; *(LAS u32x4*)(L + GB_QG + dst_w + 32 * 272) = nop[3];
            *(LAS u32x4*)(L + GB_KD + dst_k) = nop[4]; *(LAS u32x4*)(L + GB_KD + dst_k + 32 * 320) = nop[5];
            *(LAS u32x4*)(L + GB_QK + dst_q) = nop[6];
            u32x2 ui[2][4]; unsigned og[8];
#pragma unroll
            for (int tb = 0; tb < 2; ++tb)
#pragma unroll
                for (int g = 0; g < 4; ++g) ui[tb][g] = nui[tb][g];
#pragma unroll
            for (int k = 0; k < 8; ++k) og[k] = nog[k];
            const float eg = neg;
            WG_BAR();
            if (n + 1 < 32) GB_PREFETCH(n + 1);
            f32x16 x0 = zero16(), x1 = zero16(), o = zero16();
            {
                const LAS unsigned char* sp = L + GB_ST + (32 * dvb + r) * 272 + hh * 16;
                const LAS unsigned char* wp = L + GB_W + r * 272 + hh * 16;
                const LAS unsigned char* qp = L + GB_QG + (32 * hf + r) * 272 + hh * 16;
#pragma unroll
                for (int s = 0; s < 8; ++s) {
                    const bf16x8 sf = *(const LAS bf16x8*)(sp + 32 * s);
                    x0 = MFMA32(*(const LAS bf16x8*)(wp + 32 * s), sf, x0);
                    x1 = MFMA32(*(const LAS bf16x8*)(wp + 32 * 272 + 32 * s), sf, x1);
                    o = MFMA32(*(const LAS bf16x8*)(qp + 32 * s), sf, o);
                }
            }
            bf16x8 pv[2][2];
#pragma unroll
            for (int g = 0; g < 4; ++g) {
                x0[4 * g] = bflo(ui[0][g].x) - x0[4 * g]; x0[4 * g + 1] = bfhi(ui[0][g].x) - x0[4 * g + 1]; x0[4 * g + 2] = bflo(ui[0][g].y) - x0[4 * g + 2]; x0[4 * g + 3] = bfhi(ui[0][g].y) - x0[4 * g + 3];
                x1[4 * g] = bflo(ui[1][g].x) - x1[4 * g]; x1[4 * g + 1] = bfhi(ui[1][g].x) - x1[4 * g + 1]; x1[4 * g + 2] = bflo(ui[1][g].y) - x1[4 * g + 2]; x1[4 * g + 3] = bfhi(ui[1][g].y) - x1[4 * g + 3];
            }
            pv[0][0] = pack_step(x0, 0); pv[0][1] = pack_step(x0, 1); pv[1][0] = pack_step(x1, 0); pv[1][1] = pack_step(x1, 1);
#pragma unroll
            for (int tb = 0; tb < 2; ++tb) {
                if (tb <= hf) {
#pragma unroll
                    for (int s = 0; s < 2; ++s) {
                        const LAS unsigned char* kp = L + GB_QK + (32 * hf + r) * 144 + (32 * tb + 16 * s + 4 * hh) * 2;
                        o = MFMA32(cat8(*(const LAS s16x4*)kp, *(const LAS s16x4*)(kp + 16)), pv[tb][s], o);
                    }
                }
            }
            {
                LAS float* Ol = (LAS float*)(L + GB_O) + (32 * hf + 4 * hh) * 132 + 32 * dvb + r;
#pragma unroll
                for (int reg = 0; reg < 16; ++reg) Ol[((reg & 3) + 8 * (reg >> 2)) * 132] = o[reg];
            }
#pragma unroll
            for (int d2 = 0; d2 < 2; ++d2) {
                const int db = 2 * hf + d2;
                f32x16 x = Sacc[d2] * eg;
                const LAS unsigned char* kb = L + GB_KD + (4 * hh + q4) * 320 + (32 * db + 16 * g1 + 4 * p4) * 2;
#pragma unroll
                for (int tb = 0; tb < 2; ++tb)
#pragma unroll
                    for (int s = 0; s < 2; ++s) {
                        const LAS unsigned char* kp = kb + (32 * tb + 16 * s) * 320;
                        x = MFMA32(cat8(vtr(kp), vtr(kp + 8 * 320)), pv[tb][s], x);
                    }
                Sacc[d2] = x;
            }
            WG_BAR();
#pragma unroll
            for (int d2 = 0; d2 < 2; ++d2) {
                const int db = 2 * hf + d2;
#pragma unroll
                for (int g = 0; g < 4; ++g) { u32x2 ov; ov.x = pk2(Sacc[d2][4 * g], Sacc[d2][4 * g + 1]); ov.y = pk2(Sacc[d2][4 * g + 2], Sacc[d2][4 * g + 3]);
                    *(LAS u32x2*)(L + GB_ST + (32 * dvb + r) * 272 + (32 * db + 8 * g + 4 * hh) * 2) = ov; }
            }
            {
                const LAS float* Ol = (const LAS float*)(L + GB_O) + (w * 8) * 132 + 2 * lane;
                bf16* yp = Y + (size_t)(t0 + w * 8) * D + 512 + h * 128 + 2 * lane;
#pragma unroll
                for (int k = 0; k < 8; ++k) {
                    const f32x2_t v = *(const LAS f32x2_t*)(Ol + k * 132);
                    const float rstd = rsqrtf(wave_sum(v.x * v.x + v.y * v.y) * (1.f / 128.f) + EPS);
                    *(unsigned*)(yp + (size_t)k * D) = pk2(v.x * rstd * gn0 * silu_f(bflo(og[k])), v.y * rstd * gn1 * silu_f(bfhi(og[k])));
                }
            }
        }
        WG_BAR();
    }
#undef GB_PREFETCH
}

constexpr int AT_STAGE = 38912, AT_K = 0, AT_V = 18432, AT_BIAS = 2 * AT_STAGE, AT_END = AT_BIAS + 512;
DI void attn_stage_load(const bf16* U1, int trow, int h, int tid, u32x4 (&st)[4]) {
#pragma unroll
    for (int p = 0; p < 4; ++p) { const int idx = tid + 512 * p, row = idx >> 5, c = idx & 31;
        st[p] = *(const u32x4*)(U1 + (size_t)(trow + row) * OD_N + (c < 16 ? 512 + h * 128 + c * 8 : 1024 + h * 128 + (c - 16) * 8)); }
}
DI void attn_stage_store(LAS unsigned char* sb, int tid, const u32x4 (&st)[4]) {
#pragma unroll
    for (int p = 0; p < 4; ++p) { const int idx = tid + 512 * p, row = idx >> 5, c = idx & 31;
        if (c < 16) { const int e = c * 8, mp = e >> 6, wi = e & 63; *(LAS u32x4*)(sb + AT_K + mp * 9216 + row * 144 + wi * 2) = st[p]; }
        else *(LAS u32x4*)(sb + AT_V + row * 320 + (c - 16) * 16) = st[p]; }
}
DI void attn_phase(const Frame& F, const Args& a) {
    LAS unsigned char* L = F.lds;
    const bf16* U1 = (const bf16*)(F.ws + WS_U); bf16* Y = (bf16*)(F.ws + WS_Y);
    const float* lamp = a.in[14]; const float* dng = a.in[15]; const float* relb = a.in[21];
    const int lane = F.lane, w = F.wave, r = lane & 31, hh = lane >> 5, mp = w >> 2, qs = w & 3;
    const int q4 = (lane & 15) >> 2, p4 = lane & 3, g1 = (lane >> 4) & 1;
    const float lam = __expf(wave_sum(lamp[lane] * lamp[64 + lane])) - __expf(wave_sum(lamp[128 + lane] * lamp[192 + lane])) + LAMBDA_INIT;
    const float c1 = 0.125f * LOG2E;
    LAS float* btab = (LAS float*)(L + AT_BIAS);
    LAS float* exch = (LAS float*)L;
    for (int item = F.vcu; item < 256; item += F.G) {
        const int bh = item >> 1, par = item & 1, b = bh >> 2, h = bh & 3, trow0 = b * SEQ;
        WG_BAR();
        if (F.tid < 128) { const int n = F.tid; int bucket = n;
            if (n >= 16) { const int lg = 16 + (int)(__logf((float)n / 16.f) / 2.0794415416798357f * 16.f); bucket = lg < 31 ? lg : 31; }
            btab[n] = relb[bucket * 4 + h] * LOG2E; }
        const float bias_far = relb[31 * 4 + h] * LOG2E;
        for (int ui = 0; ui < 8; ++ui) {
            const int qblk = 2 * ui + ((ui ^ par) & 1);
            const int q0 = qblk * 128 + qs * 32, qpos = q0 + r, ntiles = 2 * (qblk + 1);
            bf16x8 qf[4];
            { const bf16* qp = U1 + (size_t)(trow0 + qpos) * OD_N + h * 128 + mp * 64 + 8 * hh;
#pragma unroll
              for (int s = 0; s < 4; ++s) qf[s] = *(const bf16x8*)(qp + 16 * s); }
            f32x16 O[4] = {zero16(), zero16(), zero16(), zero16()};
            float mrun = -INFINITY, lrun = 0.f;
            u32x4 st[4];
            attn_stage_load(U1, trow0, h, F.tid, st);
            attn_stage_store(L, F.tid, st);
            WG_BAR();
            for (int kt = 0; kt < ntiles; ++kt) {
                const bool more = kt + 1 < ntiles;
                if (more) attn_stage_load(U1, trow0 + (kt + 1) * 64, h, F.tid, st);
                const int key0 = kt * 64;
                if (key0 <= q0 + 31) {
                    const LAS unsigned char* sb = L + (kt & 1) * AT_STAGE;
                    const LAS unsigned char* kb = sb + AT_K + mp * 9216 + r * 144 + hh * 16;
                    f32x16 x0 = zero16(), x1 = zero16();
#pragma unroll
                    for (int s = 0; s < 4; ++s) { x0 = MFMA32(*(const LAS bf16x8*)(kb + 32 * s), qf[s], x0); x1 = MFMA32(*(const LAS bf16x8*)(kb + 32 * 144 + 32 * s), qf[s], x1); }
                    if (q0 - (key0 + 63) >= 128) {
#pragma unroll
                        for (int reg = 0; reg < 16; ++reg) { x0[reg] = x0[reg] * c1 + bias_far; x1[reg] = x1[reg] * c1 + bias_far; }
                    } else {
#pragma unroll
                        for (int reg = 0; reg < 16; ++reg) {
                            const int d0 = qpos - (key0 + crow(reg, hh)), d1 = d0 - 32;
                            const float b0 = btab[d0 < 0 ? 0 : (d0 > 127 ? 127 : d0)], b1 = btab[d1 < 0 ? 0 : (d1 > 127 ? 127 : d1)];
                            x0[reg] = (d0 >= 0) ? x0[reg] * c1 + b0 : -INFINITY; x1[reg] = (d1 >= 0) ? x1[reg] * c1 + b1 : -INFINITY;
                        }
                    }
                    float mx = x0[0];
#pragma unroll
                    for (int reg = 1; reg < 16; ++reg) mx = fmaxf(mx, x0[reg]);
#pragma unroll
                    for (int reg = 0; reg < 16; ++reg) mx = fmaxf(mx, x1[reg]);
                    mx = fmaxf(mx, __shfl_xor(mx, 32));
                    if (__any(mx - mrun > 6.f)) {
                        const float mnew = fmaxf(mrun, mx), alpha = __builtin_amdgcn_exp2f(mrun - mnew); mrun = mnew;
                        lrun *= alpha;
#pragma unroll
                        for (int db = 0; db < 4; ++db) O[db] = O[db] * alpha;
                    }
                    float rs = 0.f;
#pragma unroll
                    for (int reg = 0; reg < 16; ++reg) { x0[reg] = __builtin_amdgcn_exp2f(x0[reg] - mrun); x1[reg] = __builtin_amdgcn_exp2f(x1[reg] - mrun); rs += x0[reg] + x1[reg]; }
                    lrun += rs;
                    bf16x8 pf[2][2]; pf[0][0] = pack_step(x0, 0); pf[0][1] = pack_step(x0, 1); pf[1][0] = pack_step(x1, 0); pf[1][1] = pack_step(x1, 1);
                    const LAS unsigned char* vb = sb + AT_V + (4 * hh + q4) * 320 + (16 * g1 + 4 * p4) * 2;
#pragma unroll
                    for (int db = 0; db < 4; ++db)
#pragma unroll
                        for (int kh = 0; kh < 2; ++kh)
#pragma unroll
                            for (int s = 0; s < 2; ++s) {
                                const LAS unsigned char* vp = vb + (32 * kh + 16 * s) * 320 + 64 * db;
                                O[db] = MFMA32(cat8(vtr(vp), vtr(vp + 8 * 320)), pf[kh][s], O[db]);
                            }
                }
                if (more) attn_stage_store(L + ((kt + 1) & 1) * AT_STAGE, F.tid, st);
                WG_BAR();
            }
            const float ltot = lrun + __shfl_xor(lrun, 32);
            const float inv = 1.f / ltot;
            if (mp == 1) {
                const float sc = inv * lam;
#pragma unroll
                for (int db = 0; db < 4; ++db)
#pragma unroll
                    for (int reg = 0; reg < 16; ++reg) exch[(qs * 64 + db * 16 + reg) * 64 + lane] = O[db][reg] * sc;
            }
            WG_BAR();
            if (mp == 0) {
                float ss = 0.f;
#pragma unroll
                for (int db = 0; db < 4; ++db)
#pragma unroll
                    for (int reg = 0; reg < 16; ++reg) { const float o = O[db][reg] * inv - exch[(qs * 64 + db * 16 + reg) * 64 + lane]; O[db][reg] = o; ss += o * o; }
                ss += __shfl_xor(ss, 32);
                const float rstd = rsqrtf(ss * (1.f / 128.f) + EPS) * (1.f - LAMBDA_INIT);
                bf16* yp = Y + (size_t)(trow0 + qpos) * D + h * 128;
#pragma unroll
                for (int db = 0; db < 4; ++db)
#pragma unroll
                    for (int g = 0; g < 4; ++g) { const int d = 32 * db + 8 * g + 4 * hh; const f32x4 gv = *(const f32x4*)(dng + d);
                        u32x2 o; o.x = pk2(O[db][4 * g] * rstd * gv[0], O[db][4 * g + 1] * rstd * gv[1]); o.y = pk2(O[db][4 * g + 2] * rstd * gv[2], O[db][4 * g + 3] * rstd * gv[3]);
                        *(u32x2*)(yp + d) = o; }
            }
            WG_BAR();
        }
    }
}

constexpr int CF_GLU = 0, CF_RED = 96256, CF_STAT = CF_RED + 4096, CF_END = CF_STAT + 512;
DI void conformer_phase(const Frame& F, const Args& a) {
    LAS unsigned char* L = F.lds;
    const bf16* U1 = (const bf16*)(F.ws + WS_U); bf16* Y = (bf16*)(F.ws + WS_Y);
    const float* cw = a.in[16]; const float* cb = a.in[17]; const float* lg = a.in[18]; const float* lb = a.in[19];
    const int c = F.tid;
    float wv[31];
#pragma unroll
    for (int j = 0; j < 31; ++j) wv[j] = cw[j * 512 + c];
    const float bias = cb[c], lng = lg[c], lnb = lb[c];
    LAS float* red = (LAS float*)(L + CF_RED); LAS float* stat = (LAS float*)(L + CF_STAT);
    for (int tile = F.vcu; tile < T / 64; tile += F.G) {
        const int t0 = tile * 64, s0 = t0 & (SEQ - 1);
        WG_BAR();
        for (int it = F.tid; it < 94 * 64; it += 512) {
            const int row = it >> 6, c8 = (it & 63) * 8;
            u32x4 o = (u32x4){0u, 0u, 0u, 0u};
            if (s0 + row - 30 >= 0) {
                const bf16* up = U1 + (size_t)(t0 + row - 30) * OD_N + 1536 + c8;
                const u32x4 ga = *(const u32x4*)up, gb = *(const u32x4*)(up + 512);
#pragma unroll
                for (int q = 0; q < 4; ++q) o[q] = pk2(bflo(ga[q]) * sigmoid_f(bflo(gb[q])), bfhi(ga[q]) * sigmoid_f(bfhi(gb[q])));
            }
            *(LAS u32x4*)(L + CF_GLU + row * 1024 + c8 * 2) = o;
        }
        WG_BAR();
        float out[64];
#pragma unroll
        for (int tt = 0; tt < 64; ++tt) {
            float acc = bias;
#pragma unroll
            for (int j = 0; j < 31; ++j) acc += wv[j] * bf2f(*(const LAS bf16*)(L + CF_GLU + (tt + j) * 1024 + c * 2));
            out[tt] = acc;
            const float s1 = wave_sum(acc), s2 = wave_sum(acc * acc);
            if (F.lane == 0) { red[(tt * 8 + F.wave) * 2] = s1; red[(tt * 8 + F.wave) * 2 + 1] = s2; }
        }
        WG_BAR();
        if (F.tid < 64) { float s1 = 0.f, s2 = 0.f;
#pragma unroll
            for (int q = 0; q < 8; ++q) { s1 += red[(F.tid * 8 + q) * 2]; s2 += red[(F.tid * 8 + q) * 2 + 1]; }
            const float mean = s1 * (1.f / 512.f); const float var = fmaxf(s2 * (1.f / 512.f) - mean * mean, 0.f);
            stat[F.tid * 2] = mean; stat[F.tid * 2 + 1] = rsqrtf(var + EPS); }
        WG_BAR();
#pragma unroll
        for (int tt = 0; tt < 64; ++tt) {
            const float v = (out[tt] - stat[tt * 2]) * stat[tt * 2 + 1] * lng + lnb;
            Y[(size_t)(t0 + tt) * D + 512 + c] = (bf16)(pk2(silu_f(v), 0.f) & 0xffffu);
        }
    }
}

constexpr int NPH = 26;
__global__ void __launch_bounds__(512, 2) fwd_kernel(Args args) {
    extern __shared__ __attribute__((aligned(16))) unsigned char lds_raw[];
    Frame F;
    F.lds = (LAS unsigned char*)lds_raw; F.ws = args.ws;
    F.tid = threadIdx.x; F.lane = F.tid & 63; F.wave = __builtin_amdgcn_readfirstlane(F.tid >> 6);
    F.G = gridDim.x; { const int bx = blockIdx.x; F.vcu = (F.G % 8 == 0) ? (bx % 8) * (F.G / 8) + bx / 8 : bx; }
    volatile LAS unsigned* MISC = (volatile LAS unsigned*)(F.lds + LDS_MISC);
    if (F.tid < 64) MISC[F.tid] = 0u;
    __syncthreads();
    unsigned* ctl = (unsigned*)(F.ws + WS_CTL);
    const bool multi = (args.ph_hi - args.ph_lo) > 1;
    XcdBarrier bar; bar.bar = ctl + CW_BAR; bar.x = 0; bar.st = MISC + 8;
    if (multi) bar = xcd_barrier_post(ctl + CW_BAR, MISC + 8);
    const int lo = args.ph_lo, hi = args.ph_hi;
#define IN(k) (lo <= (k) && (k) < hi)
#define SEAM(k) do { if (IN(k) && IN((k) + 1)) xcd_barrier(bar); } while (0)
    unsigned char* ws = F.ws;
    bf16* HN = (bf16*)(ws + WS_HN); signed char* HN8 = (signed char*)(ws + WS_HN); bf16* UB = (bf16*)(ws + WS_U); bf16* YB = (bf16*)(ws + WS_Y); float* SAp = (float*)(ws + WS_SA); const float* SBp = (const float*)(ws + WS_SB);
    const int bx = (int)blockIdx.x;

    if (IN(0)) { absmax_jobs(F, args, 0, 4, F.vcu, F.G); if (multi) xcd_barrier(bar); quant_jobs(F, args, 0, 4, F.vcu, F.G); absmax_jobs(F, args, 4, N_QJOBS, F.vcu, F.G); convert_weights(F, args); norm_mix0(F, args); } SEAM(0);
    if (IN(1)) { pg8::SchedDense S; S.init(HN, ws + W_EVIN, T, EV_N, D / 2, F.G, bx); pg8::EpiEvInI8 E{UB, SAp, SBp + SBO_EVIN}; pg8::gemm_phase(F.lds, S, E); } SEAM(1);
    if (IN(2)) { gdn_a(F, args); } SEAM(2);
    if (IN(3)) { if ((bx & 1) == 0) gdn_b(F, args, bx >> 1, (F.G + 1) >> 1); else { mixer_a(F, args, bx >> 1, F.G >> 1); quant_jobs(F, args, 4, N_QJOBS, bx >> 1, F.G >> 1); } } SEAM(3);
    if (IN(4)) { pg8::SchedDense S; S.init(YB, ws + W_EVOUT, T, D, D, F.G, bx); pg8::EpiResid E{args.in[0], args.out}; pg8::gemm_phase(F.lds, S, E); } SEAM(4);
    if (IN(5)) { norm_plain(F, args.out, args.in[3], HN8, SAp); } SEAM(5);
    if (IN(6)) { pg8::SchedDense S; S.init(HN, ws + W_FFGU, T, 2 * DFF, D / 2, F.G, bx); pg8::EpiSwiGLUI8 E{UB, DFF, SAp, SBp + SBO_FFGU}; pg8::gemm_phase(F.lds, S, E); } SEAM(6);
    if (IN(7)) { pg8::SchedDense S; S.init(UB, ws + W_FFD, T, D, DFF, F.G, bx); pg8::EpiResid E{args.out, args.out}; pg8::gemm_phase(F.lds, S, E); } SEAM(7);
    if (IN(8)) { norm_plain(F, args.out, args.in[4], HN8, SAp); convert_p(F, args.in[1], (bf16*)(ws + WS_GX)); } SEAM(8);
    if (IN(9)) { pg8::SchedDense S; S.init(ws + WS_GX, ws + W_PPROJ, T, D, 256, F.G, bx); pg8::EpiStoreBf16 E{UB, D}; pg8::gemm_phase(F.lds, S, E); } SEAM(9);
    if (IN(10)) { pg8::SchedDense S; S.init(HN, ws + W_PGATE, T, D, D / 2, F.G, bx); pg8::EpiPleGateI8 E{args.out, UB, SAp, SBp + SBO_PGATE}; pg8::gemm_phase(F.lds, S, E); } SEAM(10);
    if (IN(11)) { norm_plain(F, args.out, args.in[2] + D, HN8, SAp); } SEAM(11);
    if (IN(12)) { pg8::SchedDense S; S.init(HN, ws + W_ODIN, T, OD_N, D / 2, F.G, bx); pg8::EpiStoreBf16I8 E{UB, OD_N, SAp, SBp + SBO_ODIN}; pg8::gemm_phase(F.lds, S, E); } SEAM(12);
    if (IN(13)) { attn_phase(F, args); conformer_phase(F, args); } SEAM(13);
    if (IN(14)) { pg8::SchedDense S; S.init(YB, ws + W_ODOUT, T, D, D, F.G, bx); pg8::EpiResid E{args.out, args.out}; pg8::gemm_phase(F.lds, S, E); } SEAM(14);
    if (IN(15)) { norm_router(F, args); } SEAM(15);
#define MOE_PART(part, phg, phd) \
    if (IN(phg) || IN(phd)) { \
        LAS int* tab = (LAS int*)(F.lds + LDS_MISC + 256); \
        if (F.tid == 0) { int pb = 0; for (int e = 0; e < 8; ++e) { const int c = (int)__hip_atomic_load(ctl + CW_CNT + 64 * e, __ATOMIC_RELAXED, __HIP_MEMORY_SCOPE_AGENT); tab[e] = c; tab[8 + e] = pb; pb += (c + 255) >> 8; } tab[16] = pb; } \
        __syncthreads(); \
        const int nbt = tab[16]; int nMp = nbt - (part) * MOE_NBP; nMp = nMp < 0 ? 0 : (nMp > MOE_NBP ? MOE_NBP : nMp); \
        if (IN(phg)) { pg8::SchedMoeGU S; S.A = (const char*)HN; S.Bt = (const char*)(ws + W_MGU); S.K = D / 2; S.nM = nMp; S.nN = 2 * DFE / 256; S.G = F.G; S.c = bx; S.blk0 = (part) * MOE_NBP; S.bstride = (size_t)2 * DFE * D; \
            S.row_ts = (const int*)(ws + WS_ROWTS); S.tab = tab; S.gather = true; pg8::EpiSwiGLUI8F8 E{(bf16*)(ws + WS_ACT8), DFE, (const float*)(ws + WS_ROWSA), (const float*)(ws + WS_SB)}; pg8::gemm_phase(F.lds, S, E); } \
        SEAM(phg); \
        if (IN(phd)) { pg8::SchedMoeDown S; S.A = (const char*)(ws + WS_ACT8); S.Bt = (const char*)(ws + W_MD); S.K = DFE / 2; S.nM = nMp; S.nN = D / 256; S.G = F.G; S.c = bx; S.blk0 = (part) * MOE_NBP; S.bstride = (size_t)D * DFE; \
            S.row_ts = (const int*)(ws + WS_ROWTS); S.tab = tab; S.gather = false; pg8::EpiMoeDown E{(bf16*)(ws + WS_YMOE), (const int*)(ws + WS_ROWTS), (const float*)(ws + WS_ROWGATE), (const float*)(ws + WS_SB) + SBO_MD}; pg8::gemm_phase(F.lds, S, E); } \
        SEAM(phd); \
    }
    MOE_PART(0, 16, 17)
    if (IN(22)) { combine_norm(F, args); convert_p(F, args.in[1] + (size_t)T * 256, (bf16*)(ws + WS_GX)); } SEAM(22);
    if (IN(23)) { pg8::SchedDense S; S.init(ws + WS_GX, ws + W_PPROJ + (size_t)D * 256 * 2, T, D, 256, F.G, bx); pg8::EpiStoreBf16 E{UB, D}; pg8::gemm_phase(F.lds, S, E); } SEAM(23);
    if (IN(24)) { pg8::SchedDense S; S.init(HN, ws + W_PGATE + (size_t)D * D, T, D, D / 2, F.G, bx); pg8::EpiPleGateI8 E{args.out, UB, SAp, SBp + SBO_PGATE + D}; pg8::gemm_phase(F.lds, S, E); } SEAM(24);
    if (IN(25)) { final_norm(F, args); }
#undef IN
#undef SEAM
}

#ifndef MK_MULTI_LAUNCH
#define MK_MULTI_LAUNCH 0
#endif
extern "C" void kernel_launch(void* const* d_in, const int* in_sizes, int n_in, void* d_out, int out_size, void* d_ws, size_t ws_size, hipStream_t stream) {
    static int grid = 0;
    if (grid == 0) {
        if (n_in != 29 || out_size != T * D || ws_size < WS_END) { fprintf(stderr, "kernel_launch: unexpected shapes (n_in %d out %d ws %zu)\n", n_in, out_size, ws_size); grid = -1; return; }
        int dev = 0, cus = 0, per_cu = 0;
        if (hipGetDevice(&dev) != hipSuccess || hipDeviceGetAttribute(&cus, hipDeviceAttributeMultiprocessorCount, dev) != hipSuccess) { grid = -1; return; }
        if (hipFuncSetAttribute((const void*)fwd_kernel, hipFuncAttributeMaxDynamicSharedMemorySize, LDS_BYTES) != hipSuccess) { fprintf(stderr, "kernel_launch: LDS attribute failed\n"); grid = -1; return; }
        if (hipOccupancyMaxActiveBlocksPerMultiprocessor(&per_cu, (const void*)fwd_kernel, 512, LDS_BYTES) != hipSuccess || per_cu < 1) { fprintf(stderr, "kernel_launch: occupancy query says %d\n", per_cu); }
        (void)hipGetLastError();
        grid = cus;
    }
    if (grid < 0) return;
    (void)hipMemsetAsync((char*)d_ws + WS_CTL, 0, CTL_BYTES, stream);
    Args a{};
    for (int i = 0; i < 29; ++i) a.in[i] = (const float*)d_in[i];
    a.out = (float*)d_out; a.ws = (unsigned char*)d_ws;
#if MK_MULTI_LAUNCH
    for (int ph = 0; ph < NPH; ++ph) { a.ph_lo = ph; a.ph_hi = ph + 1; hipLaunchKernelGGL(fwd_kernel, dim3(grid), dim3(512), LDS_BYTES, stream, a); }
#else
    a.ph_lo = 0; a.ph_hi = NPH;
    hipLaunchKernelGGL(fwd_kernel, dim3(grid), dim3(512), LDS_BYTES, stream, a);
#endif
}
```

```cpp
#include <hip/hip_runtime.h>
#include <stdint.h>
#include <stdio.h>

#define DI __device__ __forceinline__
#define LAS __attribute__((address_space(3)))
#define GAS __attribute__((address_space(1)))
typedef unsigned short bf16;
typedef short bf16x8 __attribute__((ext_vector_type(8)));
typedef short s16x4 __attribute__((ext_vector_type(4)));
typedef short v4i16_t __attribute__((ext_vector_type(4)));
typedef float f32x4 __attribute__((ext_vector_type(4)));
typedef float f32x16 __attribute__((ext_vector_type(16)));
typedef float f32x2_t __attribute__((ext_vector_type(2)));
typedef __bf16 bf16x2_t __attribute__((ext_vector_type(2)));
typedef unsigned u32x4 __attribute__((ext_vector_type(4)));
typedef unsigned u32x2 __attribute__((ext_vector_type(2)));
typedef int i32x4 __attribute__((ext_vector_type(4)));
typedef GAS unsigned gu32;

constexpr int T = 65536, D = 1024, SEQ = 2048, NBATCH = 32;
constexpr int EV_IN = 3592, EV_N = 3584, EVU = 3072;
constexpr int OD_N = 2560;
constexpr int DFF = 2816, DFE = 3584, NE = 8, CAP = 65536;
constexpr int MOE_NBP = 520, MOE_NPART = 1;
constexpr float ACT8_SCALE = 16.f;
constexpr float EPS = 1e-6f;
constexpr float LOG2E = 1.4426950408889634f;
constexpr float LAMBDA_INIT = 0.35550906f;

constexpr size_t MiB = 1u << 20;
constexpr size_t WS_CTL = 0, CTL_BYTES = 1 * MiB;
constexpr size_t WS_GA = 1 * MiB, WS_BETA = 2 * MiB, WS_ROWTS = 3 * MiB, WS_ROWGATE = 5 * MiB, WS_EG = 7 * MiB, WS_ROWSA = 8 * MiB, WS_SB = 10 * MiB, WS_SA = 11 * MiB;
constexpr size_t WS_W = 16 * MiB;
constexpr size_t W_EVIN = WS_W;
constexpr size_t W_EVOUT = W_EVIN + (size_t)EV_N * D;
constexpr size_t W_FFGU = W_EVOUT + (size_t)D * D * 2;
constexpr size_t W_FFD = W_FFGU + (size_t)2 * DFF * D;
constexpr size_t W_ODIN = W_FFD + (size_t)D * DFF * 2;
constexpr size_t W_ODOUT = W_ODIN + (size_t)OD_N * D;
constexpr size_t W_MGU = W_ODOUT + (size_t)D * D * 2;
constexpr size_t W_MD = W_MGU + (size_t)NE * 2 * DFE * D;
constexpr size_t W_PPROJ = W_MD + (size_t)NE * D * DFE;
constexpr size_t W_PGATE = W_PPROJ + (size_t)2 * D * 256 * 2;
constexpr size_t W_END = W_PGATE + (size_t)2 * D * D;
constexpr int SBO_MOE = 0, SBO_EVIN = NE * 2 * DFE, SBO_FFGU = SBO_EVIN + EV_N, SBO_ODIN = SBO_FFGU + 2 * DFF, SBO_PGATE = SBO_ODIN + OD_N, SBO_MD = SBO_PGATE + 2 * D, SBO_END = SBO_MD + NE * D;
constexpr size_t WS_PB2 = 128 * MiB;
constexpr size_t WS_HN = 222 * MiB;
constexpr size_t WS_G = 222 * MiB;
constexpr size_t WS_GX = 352 * MiB;
constexpr size_t WS_ACT8 = 288 * MiB;
constexpr size_t WS_U0 = 512 * MiB;
constexpr size_t WS_U = 384 * MiB;
constexpr size_t WS_XB = 768 * MiB;
constexpr size_t WS_Y = 896 * MiB;
constexpr size_t WS_END = 1024 * MiB;
static_assert(W_END <= WS_PB2 && WS_PB2 + (size_t)T * 256 * 2 <= WS_HN, "weights fit");
static_assert(WS_G + (size_t)4096 * 73728 <= WS_U0, "gdn intermediates fit");
static_assert(WS_ACT8 + (size_t)MOE_NBP * 256 * DFE <= WS_XB && WS_HN + (size_t)(T + 1) * D <= WS_ACT8 && WS_U + (size_t)T * DFF * 2 <= WS_XB && WS_GX + (size_t)T * 256 * 2 <= WS_U, "moe act / ffn act fit");
constexpr size_t G_ITEM = 73728;
constexpr size_t G_W = 0, G_UT = 16384, G_QG = 32768, G_KD = 49152, G_QK = 65536;

constexpr int CW_CNT = 64;
constexpr int CW_BAR = 4096;
constexpr int CW_CMAX = 65536;

constexpr int LDS_BYTES = 160 * 1024;
constexpr int LDS_MISC = 131072 + 24576;
DI float bf2f(unsigned short b) { return __uint_as_float(((unsigned)b) << 16); }
DI float bflo(unsigned u) { return __uint_as_float(u << 16); }
DI float bfhi(unsigned u) { return __uint_as_float(u & 0xffff0000u); }
DI unsigned pk2(float lo, float hi) { f32x2_t v = {lo, hi}; bf16x2_t b = __builtin_convertvector(v, bf16x2_t); return __builtin_bit_cast(unsigned, b); }
DI float dppf(float v, const int ctrl_sel) {
    int r;
    switch (ctrl_sel) {
        case 0: r = __builtin_amdgcn_update_dpp(0, __builtin_bit_cast(int, v), 0xB1, 0xF, 0xF, true); break;
        case 1: r = __builtin_amdgcn_update_dpp(0, __builtin_bit_cast(int, v), 0x4E, 0xF, 0xF, true); break;
        case 2: r = __builtin_amdgcn_update_dpp(0, __builtin_bit_cast(int, v), 0x141, 0xF, 0xF, true); break;
        default: r = __builtin_amdgcn_update_dpp(0, __builtin_bit_cast(int, v), 0x140, 0xF, 0xF, true); break;
    }
    return __builtin_bit_cast(float, r);
}
DI float row16_sum(float v) { v += dppf(v, 0); v += dppf(v, 1); v += dppf(v, 2); v += dppf(v, 3); return v; }
DI float rlane(float v, int l) { return __builtin_bit_cast(float, __builtin_amdgcn_readlane(__builtin_bit_cast(int, v), l)); }
DI float wave_sum(float v) { v = row16_sum(v); return (rlane(v, 0) + rlane(v, 16)) + (rlane(v, 32) + rlane(v, 48)); }
DI float wave_max(float v) { v = fmaxf(v, dppf(v, 0)); v = fmaxf(v, dppf(v, 1)); v = fmaxf(v, dppf(v, 2)); v = fmaxf(v, dppf(v, 3)); return fmaxf(fmaxf(rlane(v, 0), rlane(v, 16)), fmaxf(rlane(v, 32), rlane(v, 48))); }
DI float dpp_ror8(float v) { return __builtin_bit_cast(float, __builtin_amdgcn_update_dpp(0, __builtin_bit_cast(int, v), 0x128, 0xF, 0xF, true)); }
DI void transpose_sum_row(float (&v)[64], int lane) {
    const bool b3 = (lane & 8) != 0, b2 = (lane & 4) != 0, b1 = (lane & 2) != 0, b0 = (lane & 1) != 0;
#pragma unroll
    for (int t = 0; t < 32; ++t) { const float keep = b3 ? v[t + 32] : v[t], send = b3 ? v[t] : v[t + 32]; v[t] = keep + dpp_ror8(send); }
#pragma unroll
    for (int t = 0; t < 16; ++t) { const float keep = b2 ? v[t + 16] : v[t], send = b2 ? v[t] : v[t + 16]; v[t] = keep + dppf(send, 2); }
#pragma unroll
    for (int t = 0; t < 8; ++t) { const float keep = b1 ? v[t + 8] : v[t], send = b1 ? v[t] : v[t + 8]; v[t] = keep + dppf(send, 1); }
#pragma unroll
    for (int t = 0; t < 4; ++t) { const float keep = b0 ? v[t + 4] : v[t], send = b0 ? v[t] : v[t + 4]; v[t] = keep + dppf(send, 0); }
}
DI void wave_sum8(float (&v)[8], int lane) {
    const bool b3 = (lane & 8) != 0, b2 = (lane & 4) != 0, b1 = (lane & 2) != 0;
#pragma unroll
    for (int t = 0; t < 4; ++t) { const float keep = b3 ? v[t + 4] : v[t], send = b3 ? v[t] : v[t + 4]; v[t] = keep + dpp_ror8(send); }
#pragma unroll
    for (int t = 0; t < 2; ++t) { const float keep = b2 ? v[t + 2] : v[t], send = b2 ? v[t] : v[t + 2]; v[t] = keep + dppf(send, 2); }
    float x; { const float keep = b1 ? v[1] : v[0], send = b1 ? v[0] : v[1]; x = keep + dppf(send, 1); }
    x += dppf(x, 0);
    x += __shfl_xor(x, 16); x += __shfl_xor(x, 32);
#pragma unroll
    for (int k = 0; k < 8; ++k) v[k] = rlane(x, 2 * k);
}
DI float sigmoid_f(float x) { return __builtin_amdgcn_rcpf(1.f + __builtin_amdgcn_exp2f(x * -1.4426950408889634f)); }
DI float silu_f(float x) { return x * sigmoid_f(x); }
DI int crow(int reg, int hh) { return (reg & 3) + 8 * (reg >> 2) + 4 * hh; }
DI bf16x8 pack_step(const f32x16& x, int s) {
    u32x4 p;
    p[0] = pk2(x[8 * s + 0], x[8 * s + 1]); p[1] = pk2(x[8 * s + 2], x[8 * s + 3]); p[2] = pk2(x[8 * s + 4], x[8 * s + 5]); p[3] = pk2(x[8 * s + 6], x[8 * s + 7]);
    return __builtin_bit_cast(bf16x8, p);
}
DI s16x4 vtr(const LAS unsigned char* p) { return __builtin_bit_cast(s16x4, __builtin_amdgcn_ds_read_tr16_b64_v4i16((LAS v4i16_t*)p)); }
DI bf16x8 cat8(s16x4 lo, s16x4 hi) { return __builtin_shufflevector(lo, hi, 0, 1, 2, 3, 4, 5, 6, 7); }
#define MFMA32(a, b, c) __builtin_amdgcn_mfma_f32_32x32x16_bf16((a), (b), (c), 0, 0, 0)
DI f32x16 zero16() { f32x16 z; for (int i = 0; i < 16; ++i) z[i] = 0.f; return z; }
#define WG_BAR() __syncthreads()
#define LDS_BAR() do { asm volatile("s_waitcnt lgkmcnt(0)" ::: "memory"); __builtin_amdgcn_s_barrier(); asm volatile("" ::: "memory"); } while (0)

#define XB_TMO      128
#define XB_XCNT(j)  (256  + 64 * (j))
#define XB_XSUB(j)  (1280 + 64 * (j))
#define XB_XGEN(j)  (2304 + 64 * (j))
#define XB_TOP      3328
#define XB_TOPGEN   3392
#define XCD_BAR_WORDS 3456
#define XB_SPIN_CAP (1u << 22)
DI unsigned xb_ld(unsigned* p)              { return __hip_atomic_load(p, __ATOMIC_RELAXED, __HIP_MEMORY_SCOPE_AGENT); }
DI unsigned xb_add(unsigned* p, unsigned v) { return __hip_atomic_fetch_add(p, v, __ATOMIC_RELAXED, __HIP_MEMORY_SCOPE_AGENT); }
DI unsigned xb_xcc_id() { return (unsigned)__builtin_amdgcn_s_getreg((3 << 11) | 20) & 0xFu; }
#define XB_SPIN(cond, bar) do { unsigned _sp = 0; while (cond) { __builtin_amdgcn_s_sleep(1); \
    if ((++_sp & 255u) == 0u) { if (xb_ld(&(bar)[XB_TMO])) break; if (_sp > XB_SPIN_CAP) { atomicAdd(&(bar)[XB_TMO], 1u); break; } } } } while (0)
struct XcdBarrier { unsigned* bar; unsigned x; volatile LAS unsigned* st; int wave; };
DI bool is_thread0(int wave) { int lane; asm volatile("v_mbcnt_lo_u32_b32 %0, -1, 0\n\tv_mbcnt_hi_u32_b32 %0, -1, %0" : "=v"(lane)); return wave == 0 && lane == 0; }
DI XcdBarrier xcd_barrier_post(unsigned* bar, volatile LAS unsigned* st, int wave) {
    XcdBarrier b; b.bar = bar; b.x = xb_xcc_id(); b.st = st; b.wave = wave;
    if (is_thread0(wave)) (void)xb_add(&bar[XB_XCNT(b.x)], 1u);
    return b;
}
DI void xcd_barrier_complete(unsigned* bar, unsigned x, unsigned& nloc, unsigned& nx) {
    const unsigned G = gridDim.x * gridDim.y * gridDim.z;
    unsigned sum, cnt, mine, sp = 0u;
    for (;;) {
        sum = 0u; cnt = 0u; mine = 0u;
#pragma unroll
        for (unsigned j = 0; j < 16; ++j) { const unsigned c = xb_ld(&bar[XB_XCNT(j)]); sum += c; cnt += (c > 0u) ? 1u : 0u; mine = (j == x) ? c : mine; }
        if (sum == G) break;
        __builtin_amdgcn_s_sleep(1);
        if ((++sp & 255u) == 0u) { if (xb_ld(&bar[XB_TMO])) break; if (sp > XB_SPIN_CAP) { atomicAdd(&bar[XB_TMO], 1u); break; } }
    }
    nloc = mine > 0u ? mine : 1u; nx = cnt > 0u ? cnt : 1u;
}
DI void xcd_barrier(const XcdBarrier& b) {
    asm volatile("s_waitcnt vmcnt(0)" ::: "memory");
    __syncthreads();
    if (is_thread0(b.wave)) {
        unsigned* bar = b.bar;
        __builtin_amdgcn_s_waitcnt(0);
        unsigned nloc = b.st[0], nx = b.st[1];
        if (nloc == 0u) { xcd_barrier_complete(bar, b.x, nloc, nx); b.st[0] = nloc; b.st[1] = nx; }
        const unsigned old = xb_add(&bar[XB_XSUB(b.x)], 1u);
        const unsigned gen = old / nloc;
        if (old + 1u == (gen + 1u) * nloc) {
            __builtin_amdgcn_fence(__ATOMIC_RELEASE, "agent");
            asm volatile("s_waitcnt vmcnt(0)" ::: "memory");
            const unsigned og = xb_add(&bar[XB_TOP], 1u);
            const unsigned tg = og / nx;
            if (og + 1u == (tg + 1u) * nx) xb_add(&bar[XB_TOPGEN], 1u);
            else XB_SPIN(xb_ld(&bar[XB_TOPGEN]) == tg, bar);
            __builtin_amdgcn_fence(__ATOMIC_ACQUIRE, "agent");
            xb_add(&bar[XB_XGEN(b.x)], 1u);
            asm volatile("s_waitcnt vmcnt(0)" ::: "memory");
        } else {
            XB_SPIN(xb_ld(&bar[XB_XGEN(b.x)]) == gen, bar);
            __builtin_amdgcn_fence(__ATOMIC_ACQUIRE, "agent");
            asm volatile("s_waitcnt vmcnt(0)" ::: "memory");
        }
    }
    __syncthreads();
}

struct Args { const float* in[29]; float* out; unsigned char* ws; int ph_lo, ph_hi; };
struct Frame {
    LAS unsigned char* lds;
    unsigned char* ws;
    int tid, lane, wave, G, vcu;
};

DI Frame phase_frame(const Frame& F0) {
    Frame F = F0; int lane;
    asm volatile("v_mbcnt_lo_u32_b32 %0, -1, 0\n\tv_mbcnt_hi_u32_b32 %0, -1, %0" : "=v"(lane));
    F.lane = lane; F.tid = F0.wave * 64 + lane; return F;
}
namespace pg8 {
constexpr int BM = 256, BK = 64, HALF = 128, HTB = HALF * BK * 2, STAGE_BYTES = 8 * HTB, NXCD = 8, WGM = 8;
__host__ __device__ __forceinline__ int lds_byte(int r, int c) { const int st = (r >> 4) * 2 + (c >> 5), rr = r & 15, cc = c & 31, ob = rr * 64 + cc * 2; return st * 1024 + (ob ^ (((ob >> 9) & 1) << 5)); }
__host__ __device__ __forceinline__ void stage_rc(int b, int& R, int& C) { const int st = b / 1024, sb = b % 1024, swz = sb ^ (((sb >> 9) & 1) << 5); R = (st >> 1) * 16 + swz / 64; C = (st & 1) * 32 + (swz % 64) / 2; }
__host__ __device__ __forceinline__ int perm32(int rho) { const int n = rho >> 4, i = rho & 15; return 8 * (i >> 2) + 4 * n + (i & 3); }

struct Unit { int pm, pn, e, lb, rows; };

DI bool static_unit(int i, int G, int c, int nM, int nN, int& pm, int& pn, int off = 0) {
    const int nwg = nM * nN; const long L = (long)i * G + c + off; if (L >= nwg) return false;
    int wgid = (int)L; { const int q = nwg / NXCD, r = nwg % NXCD, xcd = wgid % NXCD, off = wgid / NXCD; wgid = (xcd < r ? xcd * (q + 1) : r * (q + 1) + (xcd - r) * q) + off; }
    const int nig = WGM * nN, gid = wgid / nig, fm = gid * WGM, gsz = (nM - fm) < WGM ? (nM - fm) : WGM;
    pm = fm + ((wgid % nig) % gsz); pn = (wgid % nig) / gsz; return true;
}
struct SchedDense {
    static constexpr bool GATHER = false;
    const char* A; const char* Bt; int K, nM, nN, G, c, off, maxi;
    DI void init(const void* A_, const void* Bt_, int M, int N, int K_, int G_, int c_, int off_ = 0, int maxi_ = 1 << 30) { A = (const char*)A_; Bt = (const char*)Bt_; K = K_; nM = M / BM; nN = N / BM; G = G_; c = c_; off = off_; maxi = maxi_; }
    DI bool next(int i, Unit& u) const { u.e = 0; u.rows = 256; if (i >= maxi) return false; const bool ok = static_unit(i, G, c, nM, nN, u.pm, u.pn, off); u.lb = u.pm; return ok; }
    DI const char* a_base(const Unit& u) const { return A + (size_t)u.pm * BM * K * 2; }
    DI const char* b_base(const Unit& u) const { return Bt + (size_t)u.pn * BM * K * 2; }
    DI void ts_load(const Unit&, const int (&)[2], int (&)[2][2]) const {}
    DI void a_offs(const Unit&, const int (&R)[2], const int (&C)[2], const int (&)[2][2], unsigned (&o)[2][2]) const {
#pragma unroll
        for (int h = 0; h < 2; ++h)
#pragma unroll
            for (int i = 0; i < 2; ++i) o[h][i] = (unsigned)((h * HALF + R[i]) * K + C[i]) * 2u;
    }
};
struct SchedMoe {
    const char* A; const char* Bt; int K, nM, nN, G, c, blk0; size_t bstride; const int* row_ts; const LAS int* tab; bool gather;
    DI bool next(int i, Unit& u) const {
        int pm, pn; if (!static_unit(i, G, c, nM, nN, pm, pn)) return false;
        const int gb = blk0 + pm; int e = 0;
#pragma unroll
        for (int j = 1; j < 8; ++j) e += (gb >= tab[8 + j]) ? 1 : 0;
        e = __builtin_amdgcn_readfirstlane(e);
        const int lb = gb - __builtin_amdgcn_readfirstlane(tab[8 + e]); const int rem = __builtin_amdgcn_readfirstlane(tab[e]) - lb * 256;
        u.pm = pm; u.pn = pn; u.e = e; u.lb = lb; u.rows = rem < 256 ? rem : 256; return true;
    }
    DI const char* b_base(const Unit& u) const { return Bt + (size_t)u.e * bstride + (size_t)u.pn * BM * K * 2; }
};
struct SchedMoeGU : SchedMoe {
    static constexpr bool GATHER = true;
    DI const char* a_base(const Unit&) const { return A; }
    DI void ts_load(const Unit& u, const int (&R)[2], int (&ts)[2][2]) const {
#pragma unroll
        for (int h = 0; h < 2; ++h)
#pragma unroll
            for (int i = 0; i < 2; ++i) { const int lr = h * HALF + R[i]; ts[h][i] = (lr < u.rows) ? row_ts[(size_t)u.e * CAP + u.lb * 256 + lr] : (T << 1); }
    }
    DI void a_offs(const Unit&, const int (&)[2], const int (&C)[2], const int (&ts)[2][2], unsigned (&o)[2][2]) const {
#pragma unroll
        for (int h = 0; h < 2; ++h)
#pragma unroll
            for (int i = 0; i < 2; ++i) o[h][i] = ((unsigned)(ts[h][i] >> 1) * (unsigned)K + (unsigned)C[i]) * 2u;
    }
};
struct SchedMoeDown : SchedMoe {
    static constexpr bool GATHER = false;
    DI const char* a_base(const Unit& u) const { return A + (size_t)u.pm * BM * K * 2; }
    DI void ts_load(const Unit&, const int (&)[2], int (&)[2][2]) const {}
    DI void a_offs(const Unit&, const int (&R)[2], const int (&C)[2], const int (&)[2][2], unsigned (&o)[2][2]) const {
#pragma unroll
        for (int h = 0; h < 2; ++h)
#pragma unroll
            for (int i = 0; i < 2; ++i) o[h][i] = (unsigned)((h * HALF + R[i]) * K + C[i]) * 2u;
    }
};

typedef f32x4 Acc[2][2][4][2];
typedef i32x4 AccI[2][2][4][2];
template <bool I8> struct AccSel { typedef f32x4 type; };
template <> struct AccSel<true> { typedef i32x4 type; };
DI u32x4 pack8(const f32x4& v0, const f32x4& v1) { u32x4 w; w.x = pk2(v0[0], v0[1]); w.y = pk2(v0[2], v0[3]); w.z = pk2(v1[0], v1[1]); w.w = pk2(v1[2], v1[3]); return w; }

struct EpiStoreBf16 {
    static constexpr bool PERM = true; static constexpr int MODE = 0; static constexpr bool ALIGN = true;
    bf16* O; int ldc;
    struct Pre {}; DI void prefetch(Pre&, const Unit&, int, int, int, int) const {}
    DI void operator()(const Acc& acc, const Unit& u, int wr, int wc, int fr, int fq, const Pre&) const {
        const int row0 = u.pm * BM + wr * 64 + fr, col0 = u.pn * BM + wc * 32 + 8 * fq;
#pragma unroll
        for (int ai = 0; ai < 2; ++ai)
#pragma unroll
            for (int m = 0; m < 4; ++m) { bf16* rowp = O + (size_t)(row0 + ai * HALF + m * 16) * ldc + col0;
#pragma unroll
                for (int bj = 0; bj < 2; ++bj) *(u32x4*)(rowp + bj * HALF) = pack8(acc[ai][bj][m][0], acc[ai][bj][m][1]); }
    }
};
struct EpiEvIn {
    static constexpr bool PERM = true; static constexpr int MODE = 0; static constexpr bool ALIGN = true;
    bf16* O;
    struct Pre {}; DI void prefetch(Pre&, const Unit&, int, int, int, int) const {}
    DI void operator()(const Acc& acc, const Unit& u, int wr, int wc, int fr, int fq, const Pre&) const {
        const int row0 = u.pm * BM + wr * 64 + fr;
        if (u.pn >= 2 && u.pn < 6) {
            const int col0 = 512 + (u.pn - 2) * HALF + wc * 32 + 8 * fq;
#pragma unroll
            for (int ai = 0; ai < 2; ++ai)
#pragma unroll
                for (int m = 0; m < 4; ++m) { bf16* rowp = O + (size_t)(row0 + ai * HALF + m * 16) * EVU + col0;
                    *(u32x4*)rowp = pack8(acc[ai][0][m][0] * acc[ai][1][m][0], acc[ai][0][m][1] * acc[ai][1][m][1]); }
        } else {
            const int col0 = u.pn * BM - (u.pn >= 6 ? 512 : 0) + wc * 32 + 8 * fq;
#pragma unroll
            for (int ai = 0; ai < 2; ++ai)
#pragma unroll
                for (int m = 0; m < 4; ++m) { bf16* rowp = O + (size_t)(row0 + ai * HALF + m * 16) * EVU + col0;
#pragma unroll
                    for (int bj = 0; bj < 2; ++bj) *(u32x4*)(rowp + bj * HALF) = pack8(acc[ai][bj][m][0], acc[ai][bj][m][1]); }
        }
    }
};
struct EpiSwiGLU {
    static constexpr bool PERM = true; static constexpr int MODE = 0; static constexpr bool ALIGN = true;
    bf16* O; int ldc;
    struct Pre {}; DI void prefetch(Pre&, const Unit&, int, int, int, int) const {}
    DI void operator()(const Acc& acc, const Unit& u, int wr, int wc, int fr, int fq, const Pre&) const {
        const int row0 = u.pm * BM + wr * 64 + fr, col0 = u.pn * HALF + wc * 32 + 8 * fq;
#pragma unroll
        for (int ai = 0; ai < 2; ++ai)
#pragma unroll
            for (int m = 0; m < 4; ++m) { bf16* rowp = O + (size_t)(row0 + ai * HALF + m * 16) * ldc + col0;
                f32x4 v0, v1;
#pragma unroll
                for (int j = 0; j < 4; ++j) { v0[j] = silu_f(acc[ai][0][m][0][j]) * acc[ai][1][m][0][j]; v1[j] = silu_f(acc[ai][0][m][1][j]) * acc[ai][1][m][1][j]; }
                *(u32x4*)rowp = pack8(v0, v1); }
    }
};
template <bool OUT8> struct EpiSwiGLUI8T {
    static constexpr bool PERM = true; static constexpr int MODE = 1; static constexpr bool ALIGN = true;
    bf16* O; int ldc; const float* row_sa; const float* sb;
    struct Pre { f32x4 sl0, sl1, sp0, sp1; float ra[2][4]; };
    DI void prefetch(Pre& p, const Unit& u, int wr, int wc, int fr, int fq) const {
        const size_t rbase = (size_t)u.e * CAP + u.lb * 256;
        const float* sbp = sb + (size_t)u.e * (2 * DFE) + u.pn * BM + wc * 32 + 8 * fq;
        const f32x4 sg0 = *(const f32x4*)sbp, sg1 = *(const f32x4*)(sbp + 4), su0 = *(const f32x4*)(sbp + HALF), su1 = *(const f32x4*)(sbp + HALF + 4);
        p.sl0 = sg0 * (-LOG2E); p.sl1 = sg1 * (-LOG2E); p.sp0 = sg0 * su0 * (OUT8 ? ACT8_SCALE : 1.f); p.sp1 = sg1 * su1 * (OUT8 ? ACT8_SCALE : 1.f);
#pragma unroll
        for (int ai = 0; ai < 2; ++ai)
#pragma unroll
            for (int m = 0; m < 4; ++m) { const int lr = ai * HALF + wr * 64 + m * 16 + fr; p.ra[ai][m] = (lr < u.rows) ? row_sa[rbase + lr] : 0.f; }
    }
    DI f32x2_t pair(const i32x4& g, const i32x4& u, int h2, f32x2_t t1, f32x2_t t2) const {
        const f32x2_t gf = {(float)g[2 * h2], (float)g[2 * h2 + 1]}, uf = {(float)u[2 * h2], (float)u[2 * h2 + 1]};
        const f32x2_t ea = gf * t1;
        f32x2_t e = {__builtin_amdgcn_exp2f(ea.x), __builtin_amdgcn_exp2f(ea.y)};
        e = e + 1.f;
        const f32x2_t r = {__builtin_amdgcn_rcpf(e.x), __builtin_amdgcn_rcpf(e.y)};
        f32x2_t o = (gf * uf) * t2; o = o * r;
        if constexpr (OUT8) { o.x = __builtin_amdgcn_fmed3f(o.x, -448.f, 448.f); o.y = __builtin_amdgcn_fmed3f(o.y, -448.f, 448.f); }
        return o;
    }
    DI void operator()(const AccI& acc, const Unit& u, int wr, int wc, int fr, int fq, const Pre& p) const {
        const int row0 = u.pm * BM + wr * 64 + fr, col0 = u.pn * HALF + wc * 32 + 8 * fq;
#pragma unroll
        for (int ai = 0; ai < 2; ++ai)
#pragma unroll
            for (int m = 0; m < 4; ++m) {
                const float ra = p.ra[ai][m], ra2 = ra * ra;
                const f32x4 t1a = p.sl0 * ra, t1b = p.sl1 * ra, t2a = p.sp0 * ra2, t2b = p.sp1 * ra2;
                const f32x2_t o0 = pair(acc[ai][0][m][0], acc[ai][1][m][0], 0, (f32x2_t){t1a[0], t1a[1]}, (f32x2_t){t2a[0], t2a[1]});
                const f32x2_t o1 = pair(acc[ai][0][m][0], acc[ai][1][m][0], 1, (f32x2_t){t1a[2], t1a[3]}, (f32x2_t){t2a[2], t2a[3]});
                const f32x2_t o2 = pair(acc[ai][0][m][1], acc[ai][1][m][1], 0, (f32x2_t){t1b[0], t1b[1]}, (f32x2_t){t2b[0], t2b[1]});
                const f32x2_t o3 = pair(acc[ai][0][m][1], acc[ai][1][m][1], 1, (f32x2_t){t1b[2], t1b[3]}, (f32x2_t){t2b[2], t2b[3]});
                if constexpr (OUT8) {
                    unsigned char* p8 = (unsigned char*)O + (size_t)(row0 + ai * HALF + m * 16) * ldc + col0;
                    int p0 = 0, p1 = 0; p0 = __builtin_amdgcn_cvt_pk_fp8_f32(o0.x, o0.y, p0, false); p0 = __builtin_amdgcn_cvt_pk_fp8_f32(o1.x, o1.y, p0, true);
                    p1 = __builtin_amdgcn_cvt_pk_fp8_f32(o2.x, o2.y, p1, false); p1 = __builtin_amdgcn_cvt_pk_fp8_f32(o3.x, o3.y, p1, true);
                    *(u32x2*)p8 = (u32x2){(unsigned)p0, (unsigned)p1};
                } else {
                    bf16* rowp = O + (size_t)(row0 + ai * HALF + m * 16) * ldc + col0;
                    u32x4 w; w.x = pk2(o0.x, o0.y); w.y = pk2(o1.x, o1.y); w.z = pk2(o2.x, o2.y); w.w = pk2(o3.x, o3.y);
                    *(u32x4*)rowp = w;
                }
            }
    }
};
typedef EpiSwiGLUI8T<false> EpiSwiGLUI8;
typedef EpiSwiGLUI8T<true> EpiSwiGLUI8F8;
struct EpiEvInI8 {
    static constexpr bool PERM = true; static constexpr int MODE = 1; static constexpr bool ALIGN = true;
    bf16* O; const float* sa; const float* sb;
    struct Pre { f32x4 s00, s01, s10, s11; float ra[2][4]; };
    DI void prefetch(Pre& p, const Unit& u, int wr, int wc, int fr, int fq) const {
        const float* sbp = sb + u.pn * BM + wc * 32 + 8 * fq; const int row0 = u.pm * BM + wr * 64 + fr;
        p.s00 = *(const f32x4*)sbp; p.s01 = *(const f32x4*)(sbp + 4); p.s10 = *(const f32x4*)(sbp + HALF); p.s11 = *(const f32x4*)(sbp + HALF + 4);
#pragma unroll
        for (int ai = 0; ai < 2; ++ai)
#pragma unroll
            for (int m = 0; m < 4; ++m) p.ra[ai][m] = sa[row0 + ai * HALF + m * 16];
    }
    DI void operator()(const AccI& acc, const Unit& u, int wr, int wc, int fr, int fq, const Pre& p) const {
        const int row0 = u.pm * BM + wr * 64 + fr;
        const f32x4 s00 = p.s00, s01 = p.s01, s10 = p.s10, s11 = p.s11;
        if (u.pn >= 2 && u.pn < 6) {
            const int col0 = 512 + (u.pn - 2) * HALF + wc * 32 + 8 * fq;
#pragma unroll
            for (int ai = 0; ai < 2; ++ai)
#pragma unroll
                for (int m = 0; m < 4; ++m) { const int row = row0 + ai * HALF + m * 16; const float ra = p.ra[ai][m]; bf16* rowp = O + (size_t)row * EVU + col0;
                    f32x4 v0, v1;
#pragma unroll
                    for (int j = 0; j < 4; ++j) { v0[j] = ((float)acc[ai][0][m][0][j] * (ra * s00[j])) * ((float)acc[ai][1][m][0][j] * (ra * s10[j])); v1[j] = ((float)acc[ai][0][m][1][j] * (ra * s01[j])) * ((float)acc[ai][1][m][1][j] * (ra * s11[j])); }
                    *(u32x4*)rowp = pack8(v0, v1); }
        } else {
            const int col0 = u.pn * BM - (u.pn >= 6 ? 512 : 0) + wc * 32 + 8 * fq;
#pragma unroll
            for (int ai = 0; ai < 2; ++ai)
#pragma unroll
                for (int m = 0; m < 4; ++m) { const int row = row0 + ai * HALF + m * 16; const float ra = p.ra[ai][m]; bf16* rowp = O + (size_t)row * EVU + col0;
                    f32x4 v0, v1, v2, v3;
#pragma unroll
                    for (int j = 0; j < 4; ++j) { v0[j] = (float)acc[ai][0][m][0][j] * (ra * s00[j]); v1[j] = (float)acc[ai][0][m][1][j] * (ra * s01[j]); v2[j] = (float)acc[ai][1][m][0][j] * (ra * s10[j]); v3[j] = (float)acc[ai][1][m][1][j] * (ra * s11[j]); }
                    *(u32x4*)rowp = pack8(v0, v1); *(u32x4*)(rowp + HALF) = pack8(v2, v3); }
        }
    }
};
struct EpiStoreBf16I8 {
    static constexpr bool PERM = true; static constexpr int MODE = 1; static constexpr bool ALIGN = true;
    bf16* O; int ldc; const float* sa; const float* sb;
    struct Pre { f32x4 s00, s01, s10, s11; float ra[2][4]; };
    DI void prefetch(Pre& p, const Unit& u, int wr, int wc, int fr, int fq) const {
        const float* sbp = sb + u.pn * BM + wc * 32 + 8 * fq; const int row0 = u.pm * BM + wr * 64 + fr;
        p.s00 = *(const f32x4*)sbp; p.s01 = *(const f32x4*)(sbp + 4); p.s10 = *(const f32x4*)(sbp + HALF); p.s11 = *(const f32x4*)(sbp + HALF + 4);
#pragma unroll
        for (int ai = 0; ai < 2; ++ai)
#pragma unroll
            for (int m = 0; m < 4; ++m) p.ra[ai][m] = sa[row0 + ai * HALF + m * 16];
    }
    DI void operator()(const AccI& acc, const Unit& u, int wr, int wc, int fr, int fq, const Pre& p) const {
        const int row0 = u.pm * BM + wr * 64 + fr, col0 = u.pn * BM + wc * 32 + 8 * fq;
        const f32x4 s00 = p.s00, s01 = p.s01, s10 = p.s10, s11 = p.s11;
#pragma unroll
        for (int ai = 0; ai < 2; ++ai)
#pragma unroll
            for (int m = 0; m < 4; ++m) { const int row = row0 + ai * HALF + m * 16; const float ra = p.ra[ai][m]; bf16* rowp = O + (size_t)row * ldc + col0;
                f32x4 v0, v1, v2, v3;
#pragma unroll
                for (int j = 0; j < 4; ++j) { v0[j] = (float)acc[ai][0][m][0][j] * (ra * s00[j]); v1[j] = (float)acc[ai][0][m][1][j] * (ra * s01[j]); v2[j] = (float)acc[ai][1][m][0][j] * (ra * s10[j]); v3[j] = (float)acc[ai][1][m][1][j] * (ra * s11[j]); }
                *(u32x4*)rowp = pack8(v0, v1); *(u32x4*)(rowp + HALF) = pack8(v2, v3); }
    }
};
struct EpiPleGateI8 {
    static constexpr bool PERM = true; static constexpr int MODE = 1; static constexpr bool ALIGN = true;
    bf16* h; const bf16* tmp; const float* sa; const float* sb;
    struct Pre { f32x4 sv[2][2]; u32x4 bv[2][2]; u32x4 tv[2][2]; float ra[2]; };
    DI void load_batch(u32x4 (&bv)[2][2], u32x4 (&tv)[2][2], float (&ra)[2], const Unit& u, int wr, int wc, int fr, int fq, int ai, int mp) const {
        const int row0 = u.pm * BM + wr * 64 + fr, col0 = u.pn * BM + wc * 32 + 8 * fq;
#pragma unroll
        for (int mm = 0; mm < 2; ++mm) { const int row = row0 + ai * HALF + (2 * mp + mm) * 16; ra[mm] = sa[row]; const size_t off = (size_t)row * D + col0;
#pragma unroll
            for (int bj = 0; bj < 2; ++bj) { tv[mm][bj] = *(const u32x4*)(tmp + off + bj * HALF); bv[mm][bj] = *(const u32x4*)(h + off + bj * HALF); } }
    }
    DI void prefetch(Pre& p, const Unit& u, int wr, int wc, int fr, int fq) const {
        const int col0 = u.pn * BM + wc * 32 + 8 * fq;
#pragma unroll
        for (int bj = 0; bj < 2; ++bj)
#pragma unroll
            for (int n = 0; n < 2; ++n) p.sv[bj][n] = *(const f32x4*)(sb + col0 + bj * HALF + n * 4) * (-LOG2E);
        load_batch(p.bv, p.tv, p.ra, u, wr, wc, fr, fq, 0, 0);
    }
    DI void operator()(const AccI& acc, const Unit& u, int wr, int wc, int fr, int fq, const Pre& p) const {
        const int row0 = u.pm * BM + wr * 64 + fr, col0 = u.pn * BM + wc * 32 + 8 * fq;
#pragma unroll
        for (int ai = 0; ai < 2; ++ai)
#pragma unroll
            for (int mp = 0; mp < 2; ++mp) {
                u32x4 bv[2][2]; u32x4 tv[2][2]; float ra[2];
                if (ai == 0 && mp == 0) {
#pragma unroll
                    for (int mm = 0; mm < 2; ++mm) { ra[mm] = p.ra[mm];
#pragma unroll
                        for (int bj = 0; bj < 2; ++bj) { tv[mm][bj] = p.tv[mm][bj]; bv[mm][bj] = p.bv[mm][bj]; } }
                } else load_batch(bv, tv, ra, u, wr, wc, fr, fq, ai, mp);
                asm volatile("" ::: "memory");
#pragma unroll
                for (int mm = 0; mm < 2; ++mm) { const int m = 2 * mp + mm; const size_t off = (size_t)(row0 + ai * HALF + m * 16) * D + col0;
#pragma unroll
                    for (int bj = 0; bj < 2; ++bj) { f32x4 r[2];
#pragma unroll
                        for (int n = 0; n < 2; ++n) { const i32x4 a = acc[ai][bj][m][n]; const f32x4 sc = p.sv[bj][n] * ra[mm];
                            const unsigned t0 = n ? tv[mm][bj].z : tv[mm][bj].x, t1 = n ? tv[mm][bj].w : tv[mm][bj].y;
                            const unsigned b0 = n ? bv[mm][bj].z : bv[mm][bj].x, b1 = n ? bv[mm][bj].w : bv[mm][bj].y;
                            const f32x2_t e0 = (f32x2_t){(float)a[0], (float)a[1]} * (f32x2_t){sc[0], sc[1]}, e1 = (f32x2_t){(float)a[2], (float)a[3]} * (f32x2_t){sc[2], sc[3]};
                            const f32x2_t d0 = (f32x2_t){__builtin_amdgcn_exp2f(e0.x), __builtin_amdgcn_exp2f(e0.y)} + 1.f, d1 = (f32x2_t){__builtin_amdgcn_exp2f(e1.x), __builtin_amdgcn_exp2f(e1.y)} + 1.f;
                            const f32x2_t s0 = {__builtin_amdgcn_rcpf(d0.x), __builtin_amdgcn_rcpf(d0.y)}, s1 = {__builtin_amdgcn_rcpf(d1.x), __builtin_amdgcn_rcpf(d1.y)};
                            const f32x2_t q0 = (f32x2_t){bflo(t0), bfhi(t0)} * s0 + (f32x2_t){bflo(b0), bfhi(b0)}, q1 = (f32x2_t){bflo(t1), bfhi(t1)} * s1 + (f32x2_t){bflo(b1), bfhi(b1)};
                            r[n][0] = q0.x; r[n][1] = q0.y; r[n][2] = q1.x; r[n][3] = q1.y; }
                        *(u32x4*)(h + off + bj * HALF) = pack8(r[0], r[1]); } }
                asm volatile("" ::: "memory");
            }
    }
};
struct EpiResid {
    static constexpr bool PERM = true; static constexpr int MODE = 0; static constexpr bool ALIGN = true;
    const float* base; bf16* out;
    struct Pre { f32x4 bv[2][2][2]; };
    DI void load_batch(f32x4 (&bv)[2][2][2], const Unit& u, int wr, int wc, int fr, int fq, int ai, int mp) const {
        const int row0 = u.pm * BM + wr * 64 + fr, col0 = u.pn * BM + wc * 32 + 8 * fq;
#pragma unroll
        for (int mm = 0; mm < 2; ++mm) { const size_t off = (size_t)(row0 + ai * HALF + (2 * mp + mm) * 16) * D + col0;
#pragma unroll
            for (int bj = 0; bj < 2; ++bj)
#pragma unroll
                for (int n = 0; n < 2; ++n) bv[mm][bj][n] = __builtin_nontemporal_load((const f32x4*)(base + off + bj * HALF + n * 4)); }
    }
    DI void prefetch(Pre& p, const Unit& u, int wr, int wc, int fr, int fq) const { load_batch(p.bv, u, wr, wc, fr, fq, 0, 0); }
    DI void operator()(const Acc& acc, const Unit& u, int wr, int wc, int fr, int fq, const Pre& p) const {
        const int row0 = u.pm * BM + wr * 64 + fr, col0 = u.pn * BM + wc * 32 + 8 * fq;
#pragma unroll
        for (int ai = 0; ai < 2; ++ai)
#pragma unroll
            for (int mp = 0; mp < 2; ++mp) {
                f32x4 bv[2][2][2];
                if (ai == 0 && mp == 0) {
#pragma unroll
                    for (int mm = 0; mm < 2; ++mm)
#pragma unroll
                        for (int bj = 0; bj < 2; ++bj)
#pragma unroll
                            for (int n = 0; n < 2; ++n) bv[mm][bj][n] = p.bv[mm][bj][n];
                } else load_batch(bv, u, wr, wc, fr, fq, ai, mp);
                asm volatile("" ::: "memory");
#pragma unroll
                for (int mm = 0; mm < 2; ++mm) { const int m = 2 * mp + mm; const size_t off = (size_t)(row0 + ai * HALF + m * 16) * D + col0;
#pragma unroll
                    for (int bj = 0; bj < 2; ++bj) *(u32x4*)(out + off + bj * HALF) = pack8(bv[mm][bj][0] + acc[ai][bj][m][0], bv[mm][bj][1] + acc[ai][bj][m][1]); }
                asm volatile("" ::: "memory");
            }
    }
};
struct EpiResidB {
    static constexpr bool PERM = true; static constexpr int MODE = 0; static constexpr bool ALIGN = true;
    bf16* h;
    struct Pre { u32x4 bv[4][2]; };
    DI void load_batch(u32x4 (&bv)[4][2], const Unit& u, int wr, int wc, int fr, int fq, int ai) const {
        const int row0 = u.pm * BM + wr * 64 + fr, col0 = u.pn * BM + wc * 32 + 8 * fq;
#pragma unroll
        for (int m = 0; m < 4; ++m) { const size_t off = (size_t)(row0 + ai * HALF + m * 16) * D + col0;
#pragma unroll
            for (int bj = 0; bj < 2; ++bj) bv[m][bj] = *(const u32x4*)(h + off + bj * HALF); }
    }
    DI void prefetch(Pre& p, const Unit& u, int wr, int wc, int fr, int fq) const { load_batch(p.bv, u, wr, wc, fr, fq, 0); }
    DI void operator()(const Acc& acc, const Unit& u, int wr, int wc, int fr, int fq, const Pre& p) const {
        const int row0 = u.pm * BM + wr * 64 + fr, col0 = u.pn * BM + wc * 32 + 8 * fq;
        u32x4 b1[4][2]; load_batch(b1, u, wr, wc, fr, fq, 1);
        asm volatile("" ::: "memory");
#pragma unroll
        for (int ai = 0; ai < 2; ++ai) {
#pragma unroll
            for (int m = 0; m < 4; ++m) { const size_t off = (size_t)(row0 + ai * HALF + m * 16) * D + col0;
#pragma unroll
                for (int bj = 0; bj < 2; ++bj) { const u32x4 b = ai ? b1[m][bj] : p.bv[m][bj]; const f32x4 a0 = acc[ai][bj][m][0], a1 = acc[ai][bj][m][1];
                    f32x4 r0, r1; r0[0] = bflo(b.x) + a0[0]; r0[1] = bfhi(b.x) + a0[1]; r0[2] = bflo(b.y) + a0[2]; r0[3] = bfhi(b.y) + a0[3];
                    r1[0] = bflo(b.z) + a1[0]; r1[1] = bfhi(b.z) + a1[1]; r1[2] = bflo(b.w) + a1[2]; r1[3] = bfhi(b.w) + a1[3];
                    *(u32x4*)(h + off + bj * HALF) = pack8(r0, r1); } }
            asm volatile("" ::: "memory");
        }
    }
};
struct EpiPleGate {
    static constexpr bool PERM = false; static constexpr int MODE = 0; static constexpr bool ALIGN = true;
    float* h; const bf16* tmp;
    struct Pre {}; DI void prefetch(Pre&, const Unit&, int, int, int, int) const {}
    DI void operator()(const Acc& acc, const Unit& u, int wr, int wc, int fr, int fq, const Pre&) const {
        const int row0 = u.pm * BM + wr * 64 + fr, col0 = u.pn * BM + wc * 32 + 4 * fq;
#pragma unroll
        for (int ai = 0; ai < 2; ++ai)
#pragma unroll
            for (int m = 0; m < 4; ++m) { const size_t off = (size_t)(row0 + ai * HALF + m * 16) * D + col0;
#pragma unroll
                for (int bj = 0; bj < 2; ++bj)
#pragma unroll
                    for (int n = 0; n < 2; ++n) { const size_t o = off + bj * HALF + n * 16; const f32x4 b = *(const f32x4*)(h + o); const u32x2 t = *(const u32x2*)(tmp + o); const f32x4 a = acc[ai][bj][m][n];
                        f32x4 r; r[0] = b[0] + bflo(t.x) * sigmoid_f(a[0]); r[1] = b[1] + bfhi(t.x) * sigmoid_f(a[1]); r[2] = b[2] + bflo(t.y) * sigmoid_f(a[2]); r[3] = b[3] + bfhi(t.y) * sigmoid_f(a[3]);
                        *(f32x4*)(h + o) = r; } }
    }
};
struct EpiMoeDown {
    static constexpr bool PERM = true; static constexpr int MODE = 2; static constexpr bool ALIGN = true;
    bf16* Y; const int* row_ts; const float* row_gate; const float* sb;
    struct Pre { f32x4 sc[2][2]; int ts[2][4]; float g[2][4]; };
    DI void prefetch(Pre& p, const Unit& u, int wr, int wc, int fr, int fq) const {
        const int col0 = u.pn * BM + wc * 32 + 8 * fq; const size_t rbase = (size_t)u.e * CAP + u.lb * 256;
        const float* sbp = sb + (size_t)u.e * D + col0;
        p.sc[0][0] = *(const f32x4*)sbp; p.sc[0][1] = *(const f32x4*)(sbp + 4); p.sc[1][0] = *(const f32x4*)(sbp + HALF); p.sc[1][1] = *(const f32x4*)(sbp + HALF + 4);
#pragma unroll
        for (int ai = 0; ai < 2; ++ai)
#pragma unroll
            for (int m = 0; m < 4; ++m) { const int lr = ai * HALF + wr * 64 + m * 16 + fr; const bool ok = lr < u.rows; p.ts[ai][m] = ok ? row_ts[rbase + lr] : -1; p.g[ai][m] = ok ? row_gate[rbase + lr] : 0.f; }
    }
    DI void operator()(const Acc& acc, const Unit& u, int wr, int wc, int fr, int fq, const Pre& p) const {
        const int col0 = u.pn * BM + wc * 32 + 8 * fq;
#pragma unroll
        for (int ai = 0; ai < 2; ++ai)
#pragma unroll
            for (int m = 0; m < 4; ++m) {
                if (p.ts[ai][m] >= 0) { const float g = p.g[ai][m] * (1.f / ACT8_SCALE); bf16* rowp = Y + (size_t)p.ts[ai][m] * D + col0;
#pragma unroll
                    for (int bj = 0; bj < 2; ++bj) *(u32x4*)(rowp + bj * HALF) = pack8(acc[ai][bj][m][0] * (p.sc[bj][0] * g), acc[ai][bj][m][1] * (p.sc[bj][1] * g)); } }
    }
};

DI f32x4 mma16(const bf16x8& a, const bf16x8& b, const f32x4& c) { return __builtin_amdgcn_mfma_f32_16x16x32_bf16(a, b, c, 0, 0, 0); }
DI i32x4 mma16(const bf16x8& a, const bf16x8& b, const i32x4& c) { return __builtin_amdgcn_mfma_i32_16x16x64_i8(__builtin_bit_cast(i32x4, a), __builtin_bit_cast(i32x4, b), c, 0, 0, 0); }
typedef int i32x8 __attribute__((ext_vector_type(8)));
DI f32x4 mma_fp8(const bf16x8& a0, const bf16x8& a1, const bf16x8& b0, const bf16x8& b1, const f32x4& c) {
    const i32x4 x0 = __builtin_bit_cast(i32x4, a0), x1 = __builtin_bit_cast(i32x4, a1), y0 = __builtin_bit_cast(i32x4, b0), y1 = __builtin_bit_cast(i32x4, b1);
    const i32x8 a = __builtin_shufflevector(x0, x1, 0, 1, 2, 3, 4, 5, 6, 7), b = __builtin_shufflevector(y0, y1, 0, 1, 2, 3, 4, 5, 6, 7);
    f32x4 d = c; const int sc = 0x7f7f7f7f;
    asm("v_mfma_scale_f32_16x16x128_f8f6f4 %0, %1, %2, %0, %3, %3 op_sel_hi:[0,0,0]" : "+v"(d) : "v"(a), "v"(b), "v"(sc));
    return d;
}
template <class Epi, class Sched>
DI void gemm_phase(LAS unsigned char* lds, const Sched& S, const Epi& E, int wave_id) {
    constexpr bool GATHER = Sched::GATHER; constexpr int MODE = Epi::MODE; constexpr bool ALIGN = Epi::ALIGN; typedef typename AccSel<MODE == 1>::type acc_t;
    int lane_; asm volatile("v_mbcnt_lo_u32_b32 %0, -1, 0\n\tv_mbcnt_hi_u32_b32 %0, -1, %0" : "=v"(lane_));
    const int wid = wave_id, lane = lane_, tid = wid * 64 + lane, wr = wid >> 2, wc = wid & 3, fq = lane >> 4; int fr = lane & 15;
    const int K = S.K, nt = K / BK;
    int Rr[2], Cc[2]; unsigned voffB[2];
#pragma unroll
    for (int i = 0; i < 2; ++i) { int R, C; stage_rc(tid * 16 + i * 8192, R, C); Rr[i] = R; Cc[i] = C; const int Rb = Epi::PERM ? ((R & ~31) + perm32(R & 31)) : R; voffB[i] = (unsigned)(Rb * K + C) * 2u; }
    const size_t kstep = (size_t)(BK * 2);
    const size_t hstep = (size_t)HALF * K * 2;
    const unsigned ldsw = (unsigned)wid * 1024u;
    const int aoff = lds_byte(wr * 64 + fr, fq * 8), boff = lds_byte(wc * 32 + fr, fq * 8);
#define PG8_SA(b, h) (((b) * 2 + (h)) * HTB)
#define PG8_SB(b, h) ((4 + (b) * 2 + (h)) * HTB)
#define PG8_STAGE(bufoff, gbase, voff) do { _Pragma("unroll") for (int _i = 0; _i < 2; ++_i) \
        __builtin_amdgcn_global_load_lds((const unsigned*)((const char*)(gbase) + (voff)[_i]), (LAS unsigned*)(lds + (bufoff) + ldsw + _i * 8192), 16, 0, 0); } while (0)
#define PG8_LDA(dst, b, h) do { _Pragma("unroll") for (int m = 0; m < 4; ++m) _Pragma("unroll") for (int k = 0; k < 2; ++k) dst[m][k] = *(const LAS bf16x8*)(lds + PG8_SA(b, h) + aoff + m * 2048 + k * 1024); } while (0)
#define PG8_LDB(dst, b, h) do { _Pragma("unroll") for (int n = 0; n < 2; ++n) _Pragma("unroll") for (int k = 0; k < 2; ++k) dst[n][k] = *(const LAS bf16x8*)(lds + PG8_SB(b, h) + boff + n * 2048 + k * 1024); } while (0)
#define PG8_MMA(ai, bj, At, Bt) do { __builtin_amdgcn_s_setprio(1); _Pragma("unroll") for (int m = 0; m < 4; ++m) _Pragma("unroll") for (int n = 0; n < 2; ++n) { \
        if constexpr (MODE == 2) acc[ai][bj][m][n] = mma_fp8(Bt[n][0], Bt[n][1], At[m][0], At[m][1], acc[ai][bj][m][n]); \
        else { _Pragma("unroll") for (int k = 0; k < 2; ++k) acc[ai][bj][m][n] = mma16(Bt[n][k], At[m][k], acc[ai][bj][m][n]); } } __builtin_amdgcn_s_setprio(0); } while (0)
#define PG8_WAIT_V(n) asm volatile("s_waitcnt vmcnt(" #n ")" ::: "memory")
#define PG8_WAIT_L(n) asm volatile("s_waitcnt lgkmcnt(" #n ")" ::: "memory")
#define PG8_BAR __builtin_amdgcn_s_barrier()
#define PG8_SCHED __builtin_amdgcn_sched_barrier(0)
    Unit cur, nxt, nn; int ui = 0;
    if (!S.next(0, cur)) return;
    acc_t acc[2][2][4][2];
#pragma unroll
    for (int a = 0; a < 2; ++a)
#pragma unroll
        for (int b = 0; b < 2; ++b)
#pragma unroll
            for (int m = 0; m < 4; ++m)
#pragma unroll
                for (int n = 0; n < 2; ++n) acc[a][b][m][n] = (acc_t){0, 0, 0, 0};
    bf16x8 At[4][2], B0[2][2], B1[2][2];
    unsigned vA[2][2], nvA[2][2]; int pts[2][2] = {{0, 0}, {0, 0}};
    { int ts0[2][2] = {{0, 0}, {0, 0}}; S.ts_load(cur, Rr, ts0); S.a_offs(cur, Rr, Cc, ts0, vA); }
    bool has_next = S.next(1, nxt);
    if (GATHER && has_next) S.ts_load(nxt, Rr, pts);
    const char* cA = S.a_base(cur); const char* cB = S.b_base(cur);
    PG8_STAGE(PG8_SB(0, 0), cB, voffB); PG8_STAGE(PG8_SB(0, 1), cB + hstep, voffB); PG8_STAGE(PG8_SA(0, 0), cA, vA[0]); PG8_STAGE(PG8_SA(0, 1), cA, vA[1]);
    if (wr == 1) PG8_BAR;
    PG8_WAIT_V(2); PG8_BAR;
    PG8_STAGE(PG8_SB(1, 0), cB + kstep, voffB); PG8_STAGE(PG8_SA(1, 0), cA + kstep, vA[0]); PG8_STAGE(PG8_SB(1, 1), cB + hstep + kstep, voffB);
    PG8_WAIT_V(6); PG8_BAR;
    for (;;) {
        const char* nA = has_next ? S.a_base(nxt) : cA; const char* nB = has_next ? S.b_base(nxt) : cB;
        if constexpr (GATHER) {
            if (has_next) S.a_offs(nxt, Rr, Cc, pts, nvA);
            else {
#pragma unroll
                for (int h = 0; h < 2; ++h)
#pragma unroll
                    for (int i = 0; i < 2; ++i) nvA[h][i] = vA[h][i];
            }
        }
        const bool has_nn = has_next && S.next(ui + 2, nn);
        if (GATHER && has_nn) S.ts_load(nn, Rr, pts);
        for (int t = 0; t < nt; t += 2) {
            const bool last = (t == nt - 2);
            const char* a1 = cA + (size_t)(t + 1) * kstep;
            const char* a2 = last ? nA : cA + (size_t)(t + 2) * kstep; const char* b2 = last ? nB : cB + (size_t)(t + 2) * kstep;
            const char* a3 = a2 + kstep; const char* b3 = b2 + kstep;
            unsigned w0[2], w1[2];
            if (GATHER) { w0[0] = last ? nvA[0][0] : vA[0][0]; w0[1] = last ? nvA[0][1] : vA[0][1]; w1[0] = last ? nvA[1][0] : vA[1][0]; w1[1] = last ? nvA[1][1] : vA[1][1]; }
            else { w0[0] = vA[0][0]; w0[1] = vA[0][1]; w1[0] = vA[1][0]; w1[1] = vA[1][1]; }
            PG8_LDB(B0, 0, 0); PG8_LDB(B1, 0, 1); PG8_SCHED; PG8_LDA(At, 0, 0); PG8_STAGE(PG8_SA(1, 1), a1, vA[1]);
            PG8_WAIT_V(8); PG8_WAIT_L(0); PG8_BAR; PG8_MMA(0, 0, At, B0); PG8_MMA(0, 1, At, B1); PG8_BAR; PG8_SCHED;
            PG8_LDA(At, 0, 1); PG8_STAGE(PG8_SA(0, 0), a2, w0); PG8_STAGE(PG8_SB(0, 0), b2, voffB); PG8_STAGE(PG8_SB(0, 1), b2 + hstep, voffB);
            PG8_WAIT_V(8); PG8_WAIT_L(0); PG8_BAR; PG8_MMA(1, 0, At, B0); PG8_MMA(1, 1, At, B1); PG8_BAR; PG8_SCHED;
            PG8_LDB(B0, 1, 0); PG8_LDB(B1, 1, 1); PG8_SCHED; PG8_LDA(At, 1, 0); PG8_STAGE(PG8_SA(0, 1), a2, w1);
            PG8_WAIT_V(8); PG8_WAIT_L(0); PG8_BAR; PG8_MMA(0, 0, At, B0); PG8_MMA(0, 1, At, B1); PG8_BAR; PG8_SCHED;
            PG8_LDA(At, 1, 1); PG8_STAGE(PG8_SA(1, 0), a3, w0); PG8_STAGE(PG8_SB(1, 0), b3, voffB); PG8_STAGE(PG8_SB(1, 1), b3 + hstep, voffB);
            PG8_WAIT_V(8); PG8_WAIT_L(0); PG8_BAR; PG8_MMA(1, 0, At, B0); PG8_MMA(1, 1, At, B1); PG8_BAR; PG8_SCHED;
        }
        typename Epi::Pre pre; E.prefetch(pre, cur, wr, wc, fr, fq);
        if constexpr (ALIGN) { if (wr == 0) PG8_BAR; }
        if constexpr (MODE == 2) asm volatile("s_nop 15\n\ts_nop 7" ::: "memory");
        E(acc, cur, wr, wc, fr, fq, pre);
        if (!has_next) break;
#pragma unroll
        for (int a = 0; a < 2; ++a)
#pragma unroll
            for (int b = 0; b < 2; ++b)
#pragma unroll
                for (int m = 0; m < 4; ++m)
#pragma unroll
                    for (int n = 0; n < 2; ++n) acc[a][b][m][n] = (acc_t){0, 0, 0, 0};
        cur = nxt; cA = nA; cB = nB; ++ui;
        if constexpr (GATHER) {
#pragma unroll
            for (int h = 0; h < 2; ++h)
#pragma unroll
                for (int i = 0; i < 2; ++i) vA[h][i] = nvA[h][i];
        }
        nxt = nn; has_next = has_nn;
        if constexpr (ALIGN) { if (wr == 1) PG8_BAR; }
    }
    PG8_WAIT_V(0);
    if constexpr (!ALIGN) { if (wr == 0) PG8_BAR; }
    PG8_BAR;
#undef PG8_SA
#undef PG8_SB
#undef PG8_STAGE
#undef PG8_LDA
#undef PG8_LDB
#undef PG8_MMA
#undef PG8_WAIT_V
#undef PG8_WAIT_L
#undef PG8_BAR
#undef PG8_SCHED
}
}

struct ConvJob { const float* W; bf16* WT; int K, ldn, col0, ncols, drow0, mode, nbatch; size_t sstride, dstride; };
DI void transpose_item(const ConvJob& J, int item, LAS float* scr, int lane) {
    const int per = (J.K / 64) * (J.ncols / 32); const int bi = item / per; int r = item - bi * per;
    const int nblk = J.ncols / 32, kb = r / nblk, nb = r % nblk, k0 = 64 * kb, j0 = 32 * nb;
    const float* W = J.W + (size_t)bi * J.sstride; bf16* WT = J.WT + (size_t)bi * J.dstride;
    float tv[32];
#pragma unroll
    for (int i = 0; i < 32; ++i) { const int kk = 2 * i + (lane >> 5); tv[i] = __builtin_nontemporal_load(W + (size_t)(k0 + kk) * J.ldn + J.col0 + j0 + (lane & 31)); }
#pragma unroll
    for (int i = 0; i < 32; ++i) { const int kk = 2 * i + (lane >> 5); scr[kk * 33 + (lane & 31)] = tv[i]; }
    asm volatile("s_waitcnt lgkmcnt(0)" ::: "memory");
    const int c = lane & 7;
    const int drow = J.drow0 + (J.mode ? ((j0 >> 7) * 256 + (j0 & 127)) : j0);
#pragma unroll
    for (int j = 0; j < 4; ++j) { const int n = (lane >> 3) + 8 * j; const LAS float* s = scr + (8 * c) * 33 + n;
        u32x4 o; o.x = pk2(s[0 * 33], s[1 * 33]); o.y = pk2(s[2 * 33], s[3 * 33]); o.z = pk2(s[4 * 33], s[5 * 33]); o.w = pk2(s[6 * 33], s[7 * 33]);
        *(u32x4*)(WT + (size_t)(drow + n) * J.K + k0 + 8 * c) = o; }
    asm volatile("s_waitcnt lgkmcnt(0)" ::: "memory");
}
constexpr int N_JOBS = 15;
DI ConvJob get_job(const Args& a, int j) {
    unsigned char* ws = a.ws; ConvJob J; J.nbatch = 1; J.sstride = 0; J.dstride = 0; J.mode = 0;
    switch (j) {
        case 0: J.W = a.in[6]; J.WT = (bf16*)(ws + W_EVIN); J.K = D; J.ldn = EV_IN; J.col0 = 0; J.ncols = 512; J.drow0 = 0; break;
        case 1: J.W = a.in[6]; J.WT = (bf16*)(ws + W_EVIN); J.K = D; J.ldn = EV_IN; J.col0 = 512; J.ncols = 512; J.drow0 = 512; J.mode = 1; break;
        case 2: J.W = a.in[6]; J.WT = (bf16*)(ws + W_EVIN); J.K = D; J.ldn = EV_IN; J.col0 = 1024; J.ncols = 512; J.drow0 = 640; J.mode = 1; break;
        case 3: J.W = a.in[6]; J.WT = (bf16*)(ws + W_EVIN); J.K = D; J.ldn = EV_IN; J.col0 = 1536; J.ncols = 2048; J.drow0 = 1536; break;
        case 4: J.W = a.in[12]; J.WT = (bf16*)(ws + W_EVOUT); J.K = D; J.ldn = D; J.col0 = 0; J.ncols = D; J.drow0 = 0; break;
        case 5: J.W = a.in[22]; J.WT = (bf16*)(ws + W_FFGU); J.K = D; J.ldn = 2 * DFF; J.col0 = 0; J.ncols = DFF; J.drow0 = 0; J.mode = 1; break;
        case 6: J.W = a.in[22]; J.WT = (bf16*)(ws + W_FFGU); J.K = D; J.ldn = 2 * DFF; J.col0 = DFF; J.ncols = DFF; J.drow0 = 128; J.mode = 1; break;
        case 7: J.W = a.in[23]; J.WT = (bf16*)(ws + W_FFD); J.K = DFF; J.ldn = D; J.col0 = 0; J.ncols = D; J.drow0 = 0; break;
        case 8: J.W = a.in[13]; J.WT = (bf16*)(ws + W_ODIN); J.K = D; J.ldn = OD_N; J.col0 = 0; J.ncols = OD_N; J.drow0 = 0; break;
        case 9: J.W = a.in[20]; J.WT = (bf16*)(ws + W_ODOUT); J.K = D; J.ldn = D; J.col0 = 0; J.ncols = D; J.drow0 = 0; break;
        case 10: J.W = a.in[25]; J.WT = (bf16*)(ws + W_MGU); J.K = D; J.ldn = 2 * DFE; J.col0 = 0; J.ncols = DFE; J.drow0 = 0; J.mode = 1; J.nbatch = NE; J.sstride = (size_t)D * 2 * DFE; J.dstride = (size_t)2 * DFE * D; break;
        case 11: J.W = a.in[25]; J.WT = (bf16*)(ws + W_MGU); J.K = D; J.ldn = 2 * DFE; J.col0 = DFE; J.ncols = DFE; J.drow0 = 128; J.mode = 1; J.nbatch = NE; J.sstride = (size_t)D * 2 * DFE; J.dstride = (size_t)2 * DFE * D; break;
        case 12: J.W = a.in[26]; J.WT = (bf16*)(ws + W_MD); J.K = DFE; J.ldn = D; J.col0 = 0; J.ncols = D; J.drow0 = 0; J.nbatch = NE; J.sstride = (size_t)DFE * D; J.dstride = (size_t)D * DFE; break;
        case 13: J.W = a.in[27]; J.WT = (bf16*)(ws + W_PPROJ); J.K = 256; J.ldn = D; J.col0 = 0; J.ncols = D; J.drow0 = 0; J.nbatch = 2; J.sstride = (size_t)256 * D; J.dstride = (size_t)D * 256; break;
        default: J.W = a.in[28]; J.WT = (bf16*)(ws + W_PGATE); J.K = D; J.ldn = D; J.col0 = 0; J.ncols = D; J.drow0 = 0; J.nbatch = 2; J.sstride = (size_t)D * D; J.dstride = (size_t)D * D; break;
    }
    return J;
}
DI void convert_weights(const Frame& F, const Args& a) {
    LAS float* scr = (LAS float*)(F.lds + F.wave * 16384);
    const int gw = F.vcu * 8 + F.wave, NGW = F.G * 8;
    for (int jj = 0; jj < 4; ++jj) {
        const int j = jj == 0 ? 4 : jj == 1 ? 7 : jj == 2 ? 9 : 13;
        const ConvJob J = get_job(a, j);
        const int nitems = J.nbatch * (J.K / 64) * (J.ncols / 32);
        for (int it = gw; it < nitems; it += NGW) transpose_item(J, it, scr, F.lane);
    }
}

struct QJob { const float* W; signed char* W8; int ldn, col0, ncols, drow0, mode, nbatch, rows_pb, sbo, K, fp8; size_t sstride; };
constexpr int N_QJOBS = 11;
DI QJob get_qjob(const Args& a, int j) {
    unsigned char* ws = a.ws; QJob J; J.nbatch = 1; J.sstride = 0; J.mode = 0; J.rows_pb = 0; J.K = D; J.fp8 = 0;
    switch (j) {
        case 10: J.W = a.in[26]; J.W8 = (signed char*)(ws + W_MD); J.ldn = D; J.col0 = 0; J.ncols = D; J.drow0 = 0; J.sbo = SBO_MD; J.nbatch = NE; J.rows_pb = D; J.sstride = (size_t)DFE * D; J.K = DFE; J.fp8 = 1; break;
        case 0: J.W = a.in[6]; J.W8 = (signed char*)(ws + W_EVIN); J.ldn = EV_IN; J.col0 = 0; J.ncols = 512; J.drow0 = 0; J.sbo = SBO_EVIN; break;
        case 1: J.W = a.in[6]; J.W8 = (signed char*)(ws + W_EVIN); J.ldn = EV_IN; J.col0 = 512; J.ncols = 512; J.drow0 = 512; J.mode = 1; J.sbo = SBO_EVIN; break;
        case 2: J.W = a.in[6]; J.W8 = (signed char*)(ws + W_EVIN); J.ldn = EV_IN; J.col0 = 1024; J.ncols = 512; J.drow0 = 640; J.mode = 1; J.sbo = SBO_EVIN; break;
        case 3: J.W = a.in[6]; J.W8 = (signed char*)(ws + W_EVIN); J.ldn = EV_IN; J.col0 = 1536; J.ncols = 2048; J.drow0 = 1536; J.sbo = SBO_EVIN; break;
        case 4: J.W = a.in[22]; J.W8 = (signed char*)(ws + W_FFGU); J.ldn = 2 * DFF; J.col0 = 0; J.ncols = DFF; J.drow0 = 0; J.mode = 1; J.sbo = SBO_FFGU; break;
        case 5: J.W = a.in[22]; J.W8 = (signed char*)(ws + W_FFGU); J.ldn = 2 * DFF; J.col0 = DFF; J.ncols = DFF; J.drow0 = 128; J.mode = 1; J.sbo = SBO_FFGU; break;
        case 6: J.W = a.in[13]; J.W8 = (signed char*)(ws + W_ODIN); J.ldn = OD_N; J.col0 = 0; J.ncols = OD_N; J.drow0 = 0; J.sbo = SBO_ODIN; break;
        case 7: J.W = a.in[28]; J.W8 = (signed char*)(ws + W_PGATE); J.ldn = D; J.col0 = 0; J.ncols = D; J.drow0 = 0; J.sbo = SBO_PGATE; J.nbatch = 2; J.rows_pb = D; J.sstride = (size_t)D * D; break;
        case 8: J.W = a.in[25]; J.W8 = (signed char*)(ws + W_MGU); J.ldn = 2 * DFE; J.col0 = 0; J.ncols = DFE; J.drow0 = 0; J.mode = 1; J.sbo = SBO_MOE; J.nbatch = NE; J.rows_pb = 2 * DFE; J.sstride = (size_t)D * 2 * DFE; break;
        default: J.W = a.in[25]; J.W8 = (signed char*)(ws + W_MGU); J.ldn = 2 * DFE; J.col0 = DFE; J.ncols = DFE; J.drow0 = 128; J.mode = 1; J.sbo = SBO_MOE; J.nbatch = NE; J.rows_pb = 2 * DFE; J.sstride = (size_t)D * 2 * DFE; break;
    }
    return J;
}
DI int q_drow(const QJob& J, int j0) { return J.drow0 + (J.mode ? ((j0 >> 7) * 256 + (j0 & 127)) : j0); }
DI void absmax_jobs(const Frame& F, const Args& a, int jlo, int jhi, int worker, int nworkers) {
    unsigned* cmax = (unsigned*)(F.ws + WS_CTL) + CW_CMAX;
    const int gw = worker * 8 + F.wave, NGW = nworkers * 8, lane = F.lane;
    for (int j = jlo; j < jhi; ++j) {
        const QJob J = get_qjob(a, j);
        const int nblk = J.ncols / 256, per = (J.K / 64) * nblk, nitems = J.nbatch * per;
        for (int it = gw; it < nitems; it += NGW) {
            const int bi = it / per, r = it - bi * per, kb = r / nblk, nb = r - kb * nblk;
            if (J.fp8 && (kb % 14) != 0) continue;
            const float* p = J.W + (size_t)bi * J.sstride + (size_t)(kb * 64) * J.ldn + J.col0 + nb * 256 + 4 * lane;
            f32x4 m = (f32x4){0.f, 0.f, 0.f, 0.f};
#pragma unroll 1
            for (int i0 = 0; i0 < 64; i0 += 16) {
                f32x4 tv[16];
#pragma unroll
                for (int i = 0; i < 16; ++i) tv[i] = __builtin_nontemporal_load((const f32x4*)(p + (size_t)(i0 + i) * J.ldn));
#pragma unroll
                for (int i = 0; i < 16; ++i) { m[0] = fmaxf(m[0], fabsf(tv[i][0])); m[1] = fmaxf(m[1], fabsf(tv[i][1])); m[2] = fmaxf(m[2], fabsf(tv[i][2])); m[3] = fmaxf(m[3], fabsf(tv[i][3])); }
            }
            unsigned* cp = cmax + J.sbo + bi * J.rows_pb + q_drow(J, nb * 256 + 4 * lane);
#pragma unroll
            for (int e = 0; e < 4; ++e) __hip_atomic_fetch_max(cp + e, __float_as_uint(m[e]), __ATOMIC_RELAXED, __HIP_MEMORY_SCOPE_AGENT);
        }
    }
}
DI void quant_jobs(const Frame& F, const Args& a, int jlo, int jhi, int worker, int nworkers) {
    const unsigned* cmax = (const unsigned*)(F.ws + WS_CTL) + CW_CMAX; float* SB = (float*)(F.ws + WS_SB);
    LAS float* scr = (LAS float*)(F.lds + F.wave * 17408);
    const int gw = worker * 8 + F.wave, NGW = nworkers * 8, lane = F.lane;
    for (int j = jlo; j < jhi; ++j) {
        const QJob J = get_qjob(a, j);
        const int nblk = J.ncols / 32, per = (J.K / 128) * nblk, nitems = J.nbatch * per;
        const float qmax = J.fp8 ? 448.f : 127.f;
        for (int it = gw; it < nitems; it += NGW) {
            const int bi = it / per, r = it - bi * per, kb = r / nblk, nb = r - kb * nblk, k0 = kb * 128, j0 = nb * 32;
            const int srow = J.sbo + bi * J.rows_pb + q_drow(J, j0);
            float cm = __uint_as_float(__hip_atomic_load(cmax + srow + (lane & 31), __ATOMIC_RELAXED, __HIP_MEMORY_SCOPE_AGENT));
            if (J.fp8) cm *= 4.f;
            const float inv = cm > 0.f ? qmax / cm : 0.f;
            const char* pb = (const char*)(J.W + (size_t)bi * J.sstride + (size_t)k0 * J.ldn + J.col0 + j0);
            const unsigned lo = (unsigned)((lane >> 5) * J.ldn + (lane & 31)) * 4u;
            {
                float tv[64];
#pragma unroll
                for (int i = 0; i < 64; ++i) tv[i] = __builtin_nontemporal_load((const float*)(pb + (lo + (unsigned)(2 * i * J.ldn) * 4u)));
#pragma unroll
                for (int i = 0; i < 64; ++i) scr[(2 * i + (lane >> 5)) * 33 + (lane & 31)] = tv[i] * inv;
            }
            asm volatile("s_waitcnt lgkmcnt(0)" ::: "memory");
            const int drow = bi * J.rows_pb + q_drow(J, j0);
            const int c = lane & 7;
#pragma unroll
            for (int jj = 0; jj < 4; ++jj) { const int n = (lane >> 3) + 8 * jj; const LAS float* sp = scr + (16 * c) * 33 + n;
                u32x4 o;
#pragma unroll
                for (int q = 0; q < 4; ++q) { float f0 = sp[(4 * q) * 33], f1 = sp[(4 * q + 1) * 33], f2 = sp[(4 * q + 2) * 33], f3 = sp[(4 * q + 3) * 33];
                    if (J.fp8) { int pk = 0; f0 = __builtin_amdgcn_fmed3f(f0, -448.f, 448.f); f1 = __builtin_amdgcn_fmed3f(f1, -448.f, 448.f); f2 = __builtin_amdgcn_fmed3f(f2, -448.f, 448.f); f3 = __builtin_amdgcn_fmed3f(f3, -448.f, 448.f);
                        pk = __builtin_amdgcn_cvt_pk_fp8_f32(f0, f1, pk, false); pk = __builtin_amdgcn_cvt_pk_fp8_f32(f2, f3, pk, true); o[q] = (unsigned)pk; }
                    else { const int b0 = __float2int_rn(f0), b1 = __float2int_rn(f1), b2 = __float2int_rn(f2), b3 = __float2int_rn(f3);
                        o[q] = (unsigned)(b0 & 0xff) | ((unsigned)(b1 & 0xff) << 8) | ((unsigned)(b2 & 0xff) << 16) | ((unsigned)(b3 & 0xff) << 24); } }
                *(u32x4*)(J.W8 + (size_t)(drow + n) * J.K + k0 + 16 * c) = o; }
            if (k0 == 0 && lane < 32) SB[srow + lane] = cm / qmax;
            asm volatile("s_waitcnt lgkmcnt(0)" ::: "memory");
        }
    }
}

DI void quant_k1024(const Frame& F, const Args& a, int jlo, int jhi, int worker, int nworkers) {
    float* SB = (float*)(F.ws + WS_SB);
    LAS float* scr = (LAS float*)(F.lds + F.wave * 17408);
    LAS float* cmx = (LAS float*)(F.lds + 8 * 17408);
    const int lane = F.lane, q = F.wave; int rot = 0;
#pragma unroll
    for (int j = jlo; j < jhi; ++j) {
        const QJob J = get_qjob(a, j);
        const int nblk = J.ncols / 32, nitems = J.nbatch * nblk;
        const int w0 = (worker + nworkers - (rot % nworkers)) % nworkers; rot += nitems;
        for (int it = w0; it < nitems; it += nworkers) {
            const int bi = it / nblk, nb = it - bi * nblk, j0 = nb * 32;
            const char* pb = (const char*)(J.W + (size_t)bi * J.sstride + (size_t)(128 * q) * J.ldn + J.col0 + j0);
            const unsigned lo = (unsigned)((lane >> 5) * J.ldn + (lane & 31)) * 4u;
            float v[64]; float m = 0.f;
#pragma unroll
            for (int i = 0; i < 64; ++i) v[i] = __builtin_nontemporal_load((const float*)(pb + (lo + (unsigned)(2 * i * J.ldn) * 4u)));
#pragma unroll
            for (int i = 0; i < 64; ++i) m = fmaxf(m, fabsf(v[i]));
            m = fmaxf(m, __shfl_xor(m, 32));
            if (lane < 32) cmx[q * 32 + lane] = m;
            LDS_BAR();
            float cm = cmx[lane & 31];
#pragma unroll
            for (int t = 1; t < 8; ++t) cm = fmaxf(cm, cmx[t * 32 + (lane & 31)]);
            const float inv = cm > 0.f ? 127.f / cm : 0.f;
            const int srow = J.sbo + bi * J.rows_pb + q_drow(J, j0), drow = bi * J.rows_pb + q_drow(J, j0);
#pragma unroll
            for (int i = 0; i < 64; ++i) scr[(2 * i + (lane >> 5)) * 33 + (lane & 31)] = v[i] * inv;
            asm volatile("s_waitcnt lgkmcnt(0)" ::: "memory");
            const int c = lane & 7, k0 = 128 * q;
#pragma unroll
            for (int jj = 0; jj < 4; ++jj) { const int n = (lane >> 3) + 8 * jj; const LAS float* sp = scr + (16 * c) * 33 + n;
                u32x4 o;
#pragma unroll
                for (int t = 0; t < 4; ++t) { const int b0 = __float2int_rn(sp[(4 * t) * 33]), b1 = __float2int_rn(sp[(4 * t + 1) * 33]), b2 = __float2int_rn(sp[(4 * t + 2) * 33]), b3 = __float2int_rn(sp[(4 * t + 3) * 33]);
                    o[t] = (unsigned)(b0 & 0xff) | ((unsigned)(b1 & 0xff) << 8) | ((unsigned)(b2 & 0xff) << 16) | ((unsigned)(b3 & 0xff) << 24); }
                *(u32x4*)(J.W8 + (size_t)(drow + n) * D + k0 + 16 * c) = o; }
            if (q == 0 && lane < 32) SB[srow + lane] = cm * (1.f / 127.f);
            LDS_BAR();
        }
    }
}

DI void load_row(const float* p, int lane, f32x4 (&v)[4]) {
    const f32x4* xr = (const f32x4*)p + lane;
#pragma unroll
    for (int j = 0; j < 4; ++j) v[j] = __builtin_nontemporal_load(xr + 64 * j);
}
DI float sumsq16(const f32x4 (&v)[4]) { float s = 0.f;
#pragma unroll
    for (int j = 0; j < 4; ++j) s += (v[j].x * v[j].x + v[j].y * v[j].y) + (v[j].z * v[j].z + v[j].w * v[j].w);
    return s; }
DI void store_bf16_row(bf16* orow, int lane, const f32x4 (&v)[4]) {
    u32x2* o8 = (u32x2*)orow + lane;
#pragma unroll
    for (int j = 0; j < 4; ++j) { u32x2 w; w.x = pk2(v[j].x, v[j].y); w.y = pk2(v[j].z, v[j].w); o8[64 * j] = w; }
}
DI float quant_row_store(signed char* drow, int lane, const f32x4 (&v)[4]) {
    float am = 0.f;
#pragma unroll
    for (int j = 0; j < 4; ++j) am = fmaxf(fmaxf(am, fmaxf(fabsf(v[j].x), fabsf(v[j].y))), fmaxf(fabsf(v[j].z), fabsf(v[j].w)));
    am = wave_max(am);
    const float qinv = am > 0.f ? 127.f / am : 0.f;
    unsigned* o4 = (unsigned*)drow + lane;
#pragma unroll
    for (int j = 0; j < 4; ++j) { const int b0 = __float2int_rn(v[j].x * qinv), b1 = __float2int_rn(v[j].y * qinv), b2 = __float2int_rn(v[j].z * qinv), b3 = __float2int_rn(v[j].w * qinv);
        o4[64 * j] = (unsigned)(b0 & 0xff) | ((unsigned)(b1 & 0xff) << 8) | ((unsigned)(b2 & 0xff) << 16) | ((unsigned)(b3 & 0xff) << 24); }
    return am * (1.f / 127.f);
}
DI void load_rowB(const bf16* p, int lane, u32x4 (&r)[2]) { const u32x4* xr = (const u32x4*)p + lane; r[0] = __builtin_nontemporal_load(xr); r[1] = __builtin_nontemporal_load(xr + 64); }
DI void load_gB(const float* g, int lane, f32x4 (&v)[4]) {
#pragma unroll
    for (int i = 0; i < 4; ++i) v[i] = *(const f32x4*)(g + 512 * (i >> 1) + 8 * lane + 4 * (i & 1));
}
DI void unpackB(const u32x4 (&r)[2], f32x4 (&v)[4]) {
#pragma unroll
    for (int j = 0; j < 2; ++j) { v[2 * j].x = bflo(r[j].x); v[2 * j].y = bfhi(r[j].x); v[2 * j].z = bflo(r[j].y); v[2 * j].w = bfhi(r[j].y);
        v[2 * j + 1].x = bflo(r[j].z); v[2 * j + 1].y = bfhi(r[j].z); v[2 * j + 1].z = bflo(r[j].w); v[2 * j + 1].w = bfhi(r[j].w); }
}
DI void addB(const u32x4 (&r)[2], f32x4 (&v)[4]) {
#pragma unroll
    for (int j = 0; j < 2; ++j) { v[2 * j].x += bflo(r[j].x); v[2 * j].y += bfhi(r[j].x); v[2 * j].z += bflo(r[j].y); v[2 * j].w += bfhi(r[j].y);
        v[2 * j + 1].x += bflo(r[j].z); v[2 * j + 1].y += bfhi(r[j].z); v[2 * j + 1].z += bflo(r[j].w); v[2 * j + 1].w += bfhi(r[j].w); }
}
DI void store_rowB(bf16* orow, int lane, const f32x4 (&v)[4]) { u32x4* o = (u32x4*)orow + lane; __builtin_nontemporal_store(pg8::pack8(v[0], v[1]), o); __builtin_nontemporal_store(pg8::pack8(v[2], v[3]), o + 64); }
DI unsigned q4(const f32x4& v, float qinv) { const int b0 = __float2int_rn(v.x * qinv), b1 = __float2int_rn(v.y * qinv), b2 = __float2int_rn(v.z * qinv), b3 = __float2int_rn(v.w * qinv);
    return (unsigned)(b0 & 0xff) | ((unsigned)(b1 & 0xff) << 8) | ((unsigned)(b2 & 0xff) << 16) | ((unsigned)(b3 & 0xff) << 24); }
DI float row_absmax(const f32x4 (&v)[4]) { float am = 0.f;
#pragma unroll
    for (int j = 0; j < 4; ++j) am = fmaxf(fmaxf(am, fmaxf(fabsf(v[j].x), fabsf(v[j].y))), fmaxf(fabsf(v[j].z), fabsf(v[j].w)));
    return wave_max(am); }
DI void store_q8B(signed char* drow, int lane, const f32x4 (&v)[4], float qinv) { u32x2* o8 = (u32x2*)drow + lane;
#pragma unroll
    for (int j = 0; j < 2; ++j) { u32x2 w; w.x = q4(v[2 * j], qinv); w.y = q4(v[2 * j + 1], qinv); o8[64 * j] = w; } }
DI float quant_row_storeB(signed char* drow, int lane, const f32x4 (&v)[4]) {
    const float am = row_absmax(v); const float qinv = am > 0.f ? 127.f / am : 0.f;
    store_q8B(drow, lane, v, qinv);
    return am * (1.f / 127.f);
}
DI void norm_plain(const Frame& F, const bf16* src, const float* g, signed char* dst, float* SA) {
    f32x4 gv[4]; load_gB(g, F.lane, gv);
    const int gw = F.vcu * 8 + F.wave, NGW = F.G * 8;
    u32x4 nr[2], n2[2]; load_rowB(src + (size_t)gw * D, F.lane, nr); load_rowB(src + (size_t)(gw + NGW) * D, F.lane, n2);
    for (int m = gw; m < T; m += NGW) {
        f32x4 v[4]; unpackB(nr, v);
        nr[0] = n2[0]; nr[1] = n2[1];
        if (m + 2 * NGW < T) load_rowB(src + (size_t)(m + 2 * NGW) * D, F.lane, n2);
        const float rstd = rsqrtf(wave_sum(sumsq16(v)) * (1.f / D) + EPS);
#pragma unroll
        for (int j = 0; j < 4; ++j) v[j] = v[j] * rstd * gv[j];
        const float sc = quant_row_storeB(dst + (size_t)m * D, F.lane, v);
        if (F.lane == 0) SA[m] = sc;
    }
}
DI void norm_mix0(const Frame& F, const Args& a) {
    const float* x = a.in[0]; const float* g = a.in[2]; const float* win = a.in[6];
    signed char* dst = (signed char*)(F.ws + WS_HN); float* SA = (float*)(F.ws + WS_SA); float* GA = (float*)(F.ws + WS_GA); float* BT = (float*)(F.ws + WS_BETA);
    f32x4 gv[4]; load_row(g, F.lane, gv);
    float w8[16][8];
#pragma unroll
    for (int j = 0; j < 4; ++j)
#pragma unroll
        for (int e = 0; e < 4; ++e) { const int k = 256 * j + 4 * F.lane + e; const f32x4 lo = *(const f32x4*)(win + (size_t)k * EV_IN + EV_N), hi = *(const f32x4*)(win + (size_t)k * EV_IN + EV_N + 4);
#pragma unroll
            for (int c = 0; c < 4; ++c) { w8[4 * j + e][c] = lo[c]; w8[4 * j + e][4 + c] = hi[c]; } }
    const int h4 = F.lane & 3;
    const float negA = -__expf(a.in[9][h4]), dtb = a.in[10][h4];
    const int gw = F.vcu * 8 + F.wave, NGW = F.G * 8;
    f32x4 nv[4]; load_row(x + (size_t)gw * D, F.lane, nv);
    for (int m = gw; m < T; m += NGW) {
        f32x4 v[4];
#pragma unroll
        for (int j = 0; j < 4; ++j) v[j] = nv[j];
        if (m + NGW < T) load_row(x + (size_t)(m + NGW) * D, F.lane, nv);
        const float rstd = rsqrtf(wave_sum(sumsq16(v)) * (1.f / D) + EPS);
#pragma unroll
        for (int j = 0; j < 4; ++j) v[j] = v[j] * rstd * gv[j];
        { const float sc = quant_row_store(dst + (size_t)m * D, F.lane, v); if (F.lane == 0) SA[m] = sc; }
        float dsum[8];
#pragma unroll
        for (int c = 0; c < 8; ++c) { float s = 0.f;
#pragma unroll
            for (int j = 0; j < 4; ++j)
#pragma unroll
                for (int e = 0; e < 4; ++e) s += v[j][e] * w8[4 * j + e][c];
            dsum[c] = s; }
        wave_sum8(dsum, F.lane);
        float af = dsum[0], bfv = dsum[4];
        if (h4 == 1) { af = dsum[1]; bfv = dsum[5]; } else if (h4 == 2) { af = dsum[2]; bfv = dsum[6]; } else if (h4 == 3) { af = dsum[3]; bfv = dsum[7]; }
        const float z = af + dtb; const float sp = (z > 20.f) ? z : log1pf(__expf(z));
        if (F.lane < 4) { GA[(size_t)m * 4 + h4] = negA * sp; BT[(size_t)m * 4 + h4] = sigmoid_f(bfv); }
    }
}
DI void convert_p(const Frame& F, const float* p, bf16* dst) {
    const size_t n8 = (size_t)T * 256 / 8;
    for (size_t i = (size_t)F.vcu * 512 + F.tid; i < n8; i += (size_t)F.G * 512) {
        const f32x4 a = *(const f32x4*)(p + i * 8), b = *(const f32x4*)(p + i * 8 + 4);
        *(u32x4*)(dst + i * 8) = pg8::pack8(a, b);
    }
}
DI void norm_router(const Frame& F, const Args& a) {
    const bf16* h = (const bf16*)(F.ws + WS_XB); const float* g = a.in[3] + D; const float* wr_ = a.in[24];
    signed char* dst = (signed char*)(F.ws + WS_HN); int* row_ts = (int*)(F.ws + WS_ROWTS); float* row_gate = (float*)(F.ws + WS_ROWGATE); float* row_sa = (float*)(F.ws + WS_ROWSA); unsigned* ctl = (unsigned*)(F.ws + WS_CTL);
    f32x4 gv[4]; load_gB(g, F.lane, gv);
    float w8[16][8];
#pragma unroll
    for (int j = 0; j < 4; ++j)
#pragma unroll
        for (int e = 0; e < 4; ++e) { const int k = 512 * (j >> 1) + 8 * F.lane + 4 * (j & 1) + e; const f32x4 lo = *(const f32x4*)(wr_ + (size_t)k * 8), hi = *(const f32x4*)(wr_ + (size_t)k * 8 + 4);
#pragma unroll
            for (int c = 0; c < 4; ++c) { w8[4 * j + e][c] = lo[c]; w8[4 * j + e][4 + c] = hi[c]; } }
    const int gw = F.vcu * 8 + F.wave, NGW = F.G * 8;
    if (gw == 0) { unsigned* z = (unsigned*)(dst + (size_t)T * D) + F.lane;
#pragma unroll
        for (int j = 0; j < 4; ++j) z[64 * j] = 0u; }
    for (int grp = gw; grp < T / 32; grp += NGW) {
        int e0 = 0, e1 = 1; float g0 = 0.f, g1 = 0.f, sav = 0.f;
        u32x4 nr[2], n2[2]; load_rowB(h + (size_t)(grp * 32) * D, F.lane, nr); load_rowB(h + (size_t)(grp * 32 + 1) * D, F.lane, n2);
        for (int rr = 0; rr < 32; ++rr) {
            const int m = grp * 32 + rr;
            f32x4 v[4]; unpackB(nr, v);
            nr[0] = n2[0]; nr[1] = n2[1];
            if (rr + 2 < 32) load_rowB(h + (size_t)(m + 2) * D, F.lane, n2);
            const float rstd = rsqrtf(wave_sum(sumsq16(v)) * (1.f / D) + EPS);
#pragma unroll
            for (int j = 0; j < 4; ++j) v[j] = v[j] * rstd * gv[j];
            const float am = row_absmax(v);
            const float qinv = am > 0.f ? 127.f / am : 0.f;
            store_q8B(dst + (size_t)m * D, F.lane, v, qinv);
            float lg[8];
#pragma unroll
            for (int c = 0; c < 8; ++c) { float s = 0.f;
#pragma unroll
                for (int j = 0; j < 4; ++j)
#pragma unroll
                    for (int e = 0; e < 4; ++e) s += v[j][e] * w8[4 * j + e][c];
                lg[c] = s; }
            wave_sum8(lg, F.lane);
            int b0 = 0; float v0 = lg[0];
#pragma unroll
            for (int c = 1; c < 8; ++c) if (lg[c] > v0) { v0 = lg[c]; b0 = c; }
            int b1 = -1; float v1 = -INFINITY;
#pragma unroll
            for (int c = 0; c < 8; ++c) if (c != b0 && lg[c] > v1) { v1 = lg[c]; b1 = c; }
            const float ga = 1.f / (1.f + __expf(v1 - v0));
            if (F.lane == rr) { e0 = b0; e1 = b1; g0 = ga; g1 = 1.f - ga; sav = am * (1.f / 127.f); }
        }
        const bool act = F.lane < 32;
#pragma unroll
        for (int e = 0; e < 8; ++e) {
            const unsigned long long m0 = __ballot(act && e0 == e), m1 = __ballot(act && e1 == e);
            const int n0 = __popcll(m0), n1 = __popcll(m1);
            if (n0 + n1 == 0) continue;
            unsigned base = 0;
            if (F.lane == 0) base = __hip_atomic_fetch_add(ctl + CW_CNT + 64 * e, (unsigned)(n0 + n1), __ATOMIC_RELAXED, __HIP_MEMORY_SCOPE_AGENT);
            base = (unsigned)__builtin_amdgcn_readfirstlane((int)base);
            const unsigned long long below = (1ull << F.lane) - 1ull;
            const int tok = grp * 32 + F.lane;
            if (act && e0 == e) { const unsigned off = base + (unsigned)__popcll(m0 & below); row_ts[(size_t)e * CAP + off] = tok * 2; row_gate[(size_t)e * CAP + off] = g0; row_sa[(size_t)e * CAP + off] = sav; }
            if (act && e1 == e) { const unsigned off = base + (unsigned)n0 + (unsigned)__popcll(m1 & below); row_ts[(size_t)e * CAP + off] = tok * 2 + 1; row_gate[(size_t)e * CAP + off] = g1; row_sa[(size_t)e * CAP + off] = sav; }
        }
    }
}
DI void combine_norm(const Frame& F, const Args& a) {
    bf16* h = (bf16*)(F.ws + WS_XB); const float* g = a.in[4] + D; const bf16* ym = (const bf16*)a.out; signed char* dst = (signed char*)(F.ws + WS_HN); float* SA = (float*)(F.ws + WS_SA);
    f32x4 gv[4]; load_gB(g, F.lane, gv);
    const int gw = F.vcu * 8 + F.wave, NGW = F.G * 8;
    u32x4 nh[2], np[2], nq[2];
    load_rowB(h + (size_t)gw * D, F.lane, nh); load_rowB(ym + (size_t)gw * 2 * D, F.lane, np); load_rowB(ym + (size_t)gw * 2 * D + D, F.lane, nq);
    for (int m = gw; m < T; m += NGW) {
        f32x4 v[4]; unpackB(nh, v); addB(np, v); addB(nq, v);
        if (m + NGW < T) { const int mn = m + NGW; load_rowB(h + (size_t)mn * D, F.lane, nh); load_rowB(ym + (size_t)mn * 2 * D, F.lane, np); load_rowB(ym + (size_t)mn * 2 * D + D, F.lane, nq); }
        store_rowB(h + (size_t)m * D, F.lane, v);
        const float rstd = rsqrtf(wave_sum(sumsq16(v)) * (1.f / D) + EPS);
#pragma unroll
        for (int j = 0; j < 4; ++j) v[j] = v[j] * rstd * gv[j];
        { const float sc = quant_row_storeB(dst + (size_t)m * D, F.lane, v); if (F.lane == 0) SA[m] = sc; }
    }
}
DI void final_norm(const Frame& F, const Args& a) {
    const bf16* h = (const bf16*)(F.ws + WS_XB); float* o = a.out; const float* g = a.in[5];
    f32x4 gv[4]; load_gB(g, F.lane, gv);
    const int gw = F.vcu * 8 + F.wave, NGW = F.G * 8;
    u32x4 nr[2], n2[2]; load_rowB(h + (size_t)gw * D, F.lane, nr); load_rowB(h + (size_t)(gw + NGW) * D, F.lane, n2);
    for (int m = gw; m < T; m += NGW) {
        f32x4 v[4]; unpackB(nr, v);
        nr[0] = n2[0]; nr[1] = n2[1];
        if (m + 2 * NGW < T) load_rowB(h + (size_t)(m + 2 * NGW) * D, F.lane, n2);
        const float rstd = rsqrtf(wave_sum(sumsq16(v)) * (1.f / D) + EPS);
        float* orow = o + (size_t)m * D + 8 * F.lane;
#pragma unroll
        for (int i = 0; i < 4; ++i) __builtin_nontemporal_store(v[i] * rstd * gv[i], (f32x4*)(orow + 512 * (i >> 1) + 4 * (i & 1)));
    }
}

DI void mixer_a(const Frame& F, const Args& a, int worker, int nworkers) {
    const bf16* U = (const bf16*)(F.ws + WS_U0); bf16* Y = (bf16*)(F.ws + WS_Y); const float* cw = a.in[7];
    const int c8 = (F.tid & 63) * 8;
    float w0[8], w1[8], w2[8];
#pragma unroll
    for (int e = 0; e < 8; ++e) { w0[e] = cw[c8 + e]; w1[e] = cw[512 + c8 + e]; w2[e] = cw[1024 + c8 + e]; }
    const int rstride = 8 * nworkers;
    for (int run = worker * 8 + (F.tid >> 6); run < T / 8; run += rstride) {
        const int r0 = run * 8; const bool first = (r0 & (SEQ - 1)) == 0;
        const bf16* up = U + (size_t)r0 * EVU + c8;
        u32x4 z[10], bg[8];
        z[0] = (u32x4){0u, 0u, 0u, 0u}; z[1] = z[0];
        if (!first) { z[0] = __builtin_nontemporal_load((const u32x4*)(up - 2 * (size_t)EVU + 512)); z[1] = __builtin_nontemporal_load((const u32x4*)(up - (size_t)EVU + 512)); }
#pragma unroll
        for (int i = 0; i < 8; ++i) { z[2 + i] = __builtin_nontemporal_load((const u32x4*)(up + (size_t)i * EVU + 512)); bg[i] = __builtin_nontemporal_load((const u32x4*)(up + (size_t)i * EVU)); }
#pragma unroll
        for (int i = 0; i < 8; ++i) {
            float o[8];
#pragma unroll
            for (int p = 0; p < 4; ++p) {
                const float a0 = w0[2 * p] * bflo(z[i][p]) + w1[2 * p] * bflo(z[i + 1][p]) + w2[2 * p] * bflo(z[i + 2][p]);
                const float a1 = w0[2 * p + 1] * bfhi(z[i][p]) + w1[2 * p + 1] * bfhi(z[i + 1][p]) + w2[2 * p + 1] * bfhi(z[i + 2][p]);
                o[2 * p] = bflo(bg[i][p]) * a0; o[2 * p + 1] = bfhi(bg[i][p]) * a1;
            }
            u32x4 wv; wv.x = pk2(o[0], o[1]); wv.y = pk2(o[2], o[3]); wv.z = pk2(o[4], o[5]); wv.w = pk2(o[6], o[7]);
            *(u32x4*)(Y + (size_t)(r0 + i) * D + c8) = wv;
        }
    }
}

constexpr int GA_GCS = 0, GA_BTS = 256, GA_KN = 1024, GA_KB = GA_KN + 17408, GA_QN = GA_KB + 17408, GA_VBT = GA_QN + 17408, GA_KGT = GA_VBT + 18432,
              GA_AM = GA_KGT + 18432, GA_TB = GA_AM + 17408, GA_QKS = GA_TB + 9216, GA_CW = GA_QKS + 9216, GA_END = GA_CW + 6144;
static_assert(GA_END <= 155648, "gdn-a lds");
template <int I0, int I1> DI void subst_rows(const LAS float* Ab, float (&Tr)[32], int col) {
    typedef float f32x3_t __attribute__((ext_vector_type(3)));
    f32x4 av[I1 - I0][8]; float at[I1 - I0][3];
#pragma unroll
    for (int i = I0; i < I1; ++i) {
#pragma unroll
        for (int v = 0; v < i / 4; ++v) av[i - I0][v] = *(const LAS f32x4*)(Ab + i * 68 + 4 * v);
        const LAS float* tp = Ab + i * 68 + 4 * (i / 4);
        if ((i & 3) == 1) at[i - I0][0] = tp[0];
        else if ((i & 3) == 2) { const f32x2_t t = *(const LAS f32x2_t*)tp; at[i - I0][0] = t.x; at[i - I0][1] = t.y; }
        else if ((i & 3) == 3) { const f32x3_t t = *(const LAS f32x3_t*)tp; at[i - I0][0] = t.x; at[i - I0][1] = t.y; at[i - I0][2] = t.z; }
    }
    asm volatile("s_waitcnt lgkmcnt(0)" ::: "memory");
#pragma unroll
    for (int i = I0; i < I1; ++i) {
        float acc = (i == col) ? 1.f : 0.f;
#pragma unroll
        for (int j = 0; j < i; ++j) { const float aij = (j < 4 * (i / 4)) ? av[i - I0][j >> 2][j & 3] : at[i - I0][j & 3]; acc = __builtin_fmaf(-aij, Tr[j], acc); }
        Tr[i] = acc;
    }
    asm volatile("" ::: "memory");
}
DI void gdn_a(const Frame& F, const Args& a) {
    LAS unsigned char* L = F.lds;
    LAS float* gcs = (LAS float*)(L + GA_GCS); LAS float* bts = (LAS float*)(L + GA_BTS);
    LAS float* Am = (LAS float*)(L + GA_AM);
    const bf16* U = (const bf16*)(F.ws + WS_U0); const float* GA = (const float*)(F.ws + WS_GA); const float* BT = (const float*)(F.ws + WS_BETA);
    float* EG = (float*)(F.ws + WS_EG); const float* cw = a.in[8];
    const int lane = F.lane, w = F.wave, r = lane & 31, hh = lane >> 5;
    for (int item = F.vcu; item < 4096; item += F.G) {
        const int bh = item >> 5, n = item & 31, b = bh >> 2, h = bh & 3, t0 = b * SEQ + n * 64;
        unsigned char* Gp = F.ws + WS_G + (size_t)item * G_ITEM;
        if (w == 0) {
            float gc = GA[(size_t)(t0 + lane) * 4 + h];
#pragma unroll
            for (int o = 1; o < 64; o <<= 1) { const float up = __shfl_up(gc, o); if (lane >= o) gc += up; }
            gcs[lane] = gc; bts[lane] = BT[(size_t)(t0 + lane) * 4 + h];
            if (lane == 63) EG[item] = __expf(gc);
        }
        for (int i = F.tid; i < 1536; i += 512) { const int part = i >> 9, rem = i & 511, j = rem >> 7, c = rem & 127; *(LAS float*)(L + GA_CW + i * 4) = cw[j * 1536 + part * 512 + h * 128 + c]; }
        const int g2 = (F.tid >> 4) * 2, c8 = (F.tid & 15) * 8;
        u32x4 xr[3][5];
        {
            const bf16* ub = U + (size_t)t0 * EVU + 1024 + h * 128 + c8;
#pragma unroll
            for (int q = 0; q < 5; ++q) {
                const bool ok = (q >= 3) || (n * 64 + g2 - 3 + q >= 0);
                const bf16* rp = ub + (ptrdiff_t)(ok ? g2 - 3 + q : 0) * EVU;
#pragma unroll
                for (int part = 0; part < 3; ++part) { const u32x4 ld = *(const u32x4*)(rp + part * 512); xr[part][q] = ok ? ld : (u32x4){0u, 0u, 0u, 0u}; }
            }
        }
        WG_BAR();
        const float glast = gcs[63];
#pragma unroll
        for (int part = 0; part < 3; ++part) {
            float tp[2][8];
#pragma unroll
            for (int tk = 0; tk < 2; ++tk) {
                const int tok = g2 + tk;
                float acc[8];
#pragma unroll
                for (int e = 0; e < 8; ++e) acc[e] = 0.f;
#pragma unroll
                for (int j = 0; j < 4; ++j) {
                    const u32x4 xv = xr[part][tk + j];
                    const f32x4 w0 = *(const LAS f32x4*)(L + GA_CW + ((part * 4 + j) * 128 + c8) * 4), w1 = *(const LAS f32x4*)(L + GA_CW + ((part * 4 + j) * 128 + c8 + 4) * 4);
                    acc[0] += w0[0] * bflo(xv[0]); acc[1] += w0[1] * bfhi(xv[0]); acc[2] += w0[2] * bflo(xv[1]); acc[3] += w0[3] * bfhi(xv[1]);
                    acc[4] += w1[0] * bflo(xv[2]); acc[5] += w1[1] * bfhi(xv[2]); acc[6] += w1[2] * bflo(xv[3]); acc[7] += w1[3] * bfhi(xv[3]);
                }
                float ss = 0.f;
#pragma unroll
                for (int e = 0; e < 8; ++e) { acc[e] = silu_f(acc[e]); ss += acc[e] * acc[e]; }
                ss = row16_sum(ss);
                const float beta = bts[tok], gc = gcs[tok];
                if (part == 0) {
                    const float sc = rsqrtf(ss + EPS) * 0.08838834764831845f, eg = __expf(gc);
                    u32x4 o; o.x = pk2(acc[0] * sc, acc[1] * sc); o.y = pk2(acc[2] * sc, acc[3] * sc); o.z = pk2(acc[4] * sc, acc[5] * sc); o.w = pk2(acc[6] * sc, acc[7] * sc);
                    *(LAS u32x4*)(L + GA_QN + tok * 272 + c8 * 2) = o;
                    const float s2 = sc * eg;
                    u32x4 g; g.x = pk2(acc[0] * s2, acc[1] * s2); g.y = pk2(acc[2] * s2, acc[3] * s2); g.z = pk2(acc[4] * s2, acc[5] * s2); g.w = pk2(acc[6] * s2, acc[7] * s2);
                    *(u32x4*)(Gp + G_QG + tok * 256 + c8 * 2) = g;
                } else if (part == 1) {
                    const float sc = rsqrtf(ss + EPS), sb = sc * beta, sg = sb * __expf(gc), sd = sc * __expf(glast - gc);
                    u32x4 o; o.x = pk2(acc[0] * sc, acc[1] * sc); o.y = pk2(acc[2] * sc, acc[3] * sc); o.z = pk2(acc[4] * sc, acc[5] * sc); o.w = pk2(acc[6] * sc, acc[7] * sc);
                    *(LAS u32x4*)(L + GA_KN + tok * 272 + c8 * 2) = o;
                    u32x4 p; p.x = pk2(acc[0] * sb, acc[1] * sb); p.y = pk2(acc[2] * sb, acc[3] * sb); p.z = pk2(acc[4] * sb, acc[5] * sb); p.w = pk2(acc[6] * sb, acc[7] * sb);
                    *(LAS u32x4*)(L + GA_KB + tok * 272 + c8 * 2) = p;
                    u32x4 d; d.x = pk2(acc[0] * sd, acc[1] * sd); d.y = pk2(acc[2] * sd, acc[3] * sd); d.z = pk2(acc[4] * sd, acc[5] * sd); d.w = pk2(acc[6] * sd, acc[7] * sd);
                    *(u32x4*)(Gp + G_KD + tok * 256 + c8 * 2) = d;
#pragma unroll
                    for (int e = 0; e < 8; ++e) tp[tk][e] = acc[e] * sg;
                } else {
#pragma unroll
                    for (int e = 0; e < 8; ++e) tp[tk][e] = acc[e] * beta;
                }
            }
            if (part == 1) {
#pragma unroll
                for (int e = 0; e < 8; ++e) *(LAS unsigned*)(L + GA_KGT + (c8 + e) * 144 + g2 * 2) = pk2(tp[0][e], tp[1][e]);
            } else if (part == 2) {
#pragma unroll
                for (int e = 0; e < 8; ++e) *(LAS unsigned*)(L + GA_VBT + (c8 + e) * 144 + g2 * 2) = pk2(tp[0][e], tp[1][e]);
            }
        }
        WG_BAR();
        {
            const int mat = w >> 2, ti = (w >> 1) & 1, tj = w & 1;
            f32x16 x = zero16();
            if (ti >= tj) {
                const LAS unsigned char* ap = L + (mat ? GA_QN : GA_KB) + (32 * ti + r) * 272 + hh * 16;
                const LAS unsigned char* bp = L + GA_KN + (32 * tj + r) * 272 + hh * 16;
#pragma unroll
                for (int s = 0; s < 8; ++s) x = MFMA32(*(const LAS bf16x8*)(ap + 32 * s), *(const LAS bf16x8*)(bp + 32 * s), x);
            }
            const int j = 32 * tj + r; const float gj = gcs[j];
            if (mat == 0) {
#pragma unroll
                for (int reg = 0; reg < 16; ++reg) { const int i = 32 * ti + crow(reg, hh); const float dec = __expf(gcs[i] - gj); Am[i * 68 + j] = (i > j) ? x[reg] * dec : 0.f; }
            } else {
#pragma unroll
                for (int reg = 0; reg < 16; ++reg) { const int i = 32 * ti + crow(reg, hh); const float dec = __expf(gcs[i] - gj);
                    *(LAS bf16*)(L + GA_QKS + i * 144 + j * 2) = (bf16)(pk2((i >= j) ? x[reg] * dec : 0.f, 0.f) & 0xffffu); }
            }
        }
        WG_BAR();
        if (w == 0) {
            const int blk = hh, col = r;
            float Tr[32];
            const LAS float* Ab = Am + (blk * 32) * 68 + blk * 32;
            subst_rows<0, 8>(Ab, Tr, col); subst_rows<8, 12>(Ab, Tr, col); subst_rows<12, 16>(Ab, Tr, col);
            subst_rows<16, 18>(Ab, Tr, col); subst_rows<18, 20>(Ab, Tr, col); subst_rows<20, 22>(Ab, Tr, col); subst_rows<22, 24>(Ab, Tr, col);
            subst_rows<24, 26>(Ab, Tr, col); subst_rows<26, 28>(Ab, Tr, col); subst_rows<28, 30>(Ab, Tr, col); subst_rows<30, 32>(Ab, Tr, col);
#pragma unroll
            for (int i = 0; i < 32; ++i) *(LAS bf16*)(L + GA_TB + (blk * 32 + i) * 144 + (blk * 32 + col) * 2) = (bf16)(pk2(Tr[i], 0.f) & 0xffffu);
            f32x16 P = zero16();
#pragma unroll
            for (int s = 0; s < 2; ++s) {
                const LAS float* arow = Am + (32 + r) * 68 + 16 * s + 8 * hh;
                const f32x4 a0 = *(const LAS f32x4*)arow, a1 = *(const LAS f32x4*)(arow + 4);
                const bf16x8 af = __builtin_bit_cast(bf16x8, pg8::pack8(a0, a1));
                float tv[8];
#pragma unroll
                for (int jj = 0; jj < 8; ++jj) { const float lo = Tr[16 * s + jj]; const float hi = __shfl(Tr[16 * s + 8 + jj], r); tv[jj] = hh ? hi : lo; }
                u32x4 tb; tb.x = pk2(tv[0], tv[1]); tb.y = pk2(tv[2], tv[3]); tb.z = pk2(tv[4], tv[5]); tb.w = pk2(tv[6], tv[7]);
                P = MFMA32(af, __builtin_bit_cast(bf16x8, tb), P);
            }
            f32x16 R = zero16();
#pragma unroll
            for (int s = 0; s < 2; ++s) {
                const LAS unsigned char* tp = L + GA_TB + (32 + r) * 144 + (32 + 16 * s + 4 * hh) * 2;
                const s16x4 lo = *(const LAS s16x4*)tp, hi = *(const LAS s16x4*)(tp + 16);
                R = MFMA32(cat8(lo, hi), pack_step(P, s), R);
            }
#pragma unroll
            for (int reg = 0; reg < 16; ++reg) *(LAS bf16*)(L + GA_TB + (32 + crow(reg, hh)) * 144 + r * 2) = (bf16)(pk2(-R[reg], 0.f) & 0xffffu);
        } else {
            for (int p = F.tid - 64; p < 512; p += 448) { const int row = p >> 3, c = p & 7; *(u32x4*)(Gp + G_QK + row * 128 + c * 16) = *(const LAS u32x4*)(L + GA_QKS + row * 144 + c * 16); }
            if (w == 1) {
#pragma unroll
                for (int i = 0; i < 16; ++i) *(LAS bf16*)(L + GA_TB + (2 * i + hh) * 144 + (32 + r) * 2) = (bf16)0; }
        }
        WG_BAR();
        if (w < 4) {
#pragma unroll
            for (int q = 0; q < 2; ++q) {
                const int idx = w * 2 + q, ib = idx >> 2, db = idx & 3;
                f32x16 x = zero16();
                const LAS unsigned char* ap = L + GA_TB + (32 * ib + r) * 144 + hh * 16;
                const LAS unsigned char* bp = L + GA_VBT + (32 * db + r) * 144 + hh * 16;
#pragma unroll
                for (int s = 0; s < 4; ++s) if (ib || s < 2) x = MFMA32(*(const LAS bf16x8*)(ap + 32 * s), *(const LAS bf16x8*)(bp + 32 * s), x);
#pragma unroll
                for (int g = 0; g < 4; ++g) { u32x2 o; o.x = pk2(x[4 * g], x[4 * g + 1]); o.y = pk2(x[4 * g + 2], x[4 * g + 3]);
                    *(u32x2*)(Gp + G_UT + ((32 * db + r) * 64 + 32 * ib + 8 * g + 4 * hh) * 2) = o; }
            }
        } else {
#pragma unroll
            for (int q = 0; q < 2; ++q) {
                const int idx = (w - 4) * 2 + q, dkb = idx >> 1, ib = idx & 1;
                f32x16 x = zero16();
                const LAS unsigned char* ap = L + GA_KGT + (32 * dkb + r) * 144 + hh * 16;
                const LAS unsigned char* bp = L + GA_TB + (32 * ib + r) * 144 + hh * 16;
#pragma unroll
                for (int s = 0; s < 4; ++s) if (ib || s < 2) x = MFMA32(*(const LAS bf16x8*)(ap + 32 * s), *(const LAS bf16x8*)(bp + 32 * s), x);
#pragma unroll
                for (int g = 0; g < 4; ++g) { u32x2 o; o.x = pk2(x[4 * g], x[4 * g + 1]); o.y = pk2(x[4 * g + 2], x[4 * g + 3]);
                    *(u32x2*)(Gp + G_W + ((32 * ib + r) * 128 + 32 * dkb + 8 * g + 4 * hh) * 2) = o; }
            }
        }
        WG_BAR();
    }
}

constexpr int GB_ST = 0, GB_W = 34816, GB_QG = GB_W + 17408, GB_KD = GB_QG + 17408, GB_QK = GB_KD + 20480, GB_O = GB_QK + 9216, GB_END = GB_O + 33792;
static_assert(GB_END <= 140000, "gdn-b lds");
DI void gdn_b(const Frame& F, const Args& a, int worker, int nworkers) {
    LAS unsigned char* L = F.lds;
    const bf16* U = (const bf16*)(F.ws + WS_U0); bf16* Y = (bf16*)(F.ws + WS_Y); const float* EG = (const float*)(F.ws + WS_EG); const float* gn = a.in[11];
    const int lane = F.lane, w = F.wave, r = lane & 31, hh = lane >> 5, dvb = w & 3, hf = w >> 2;
    const int q4 = (lane & 15) >> 2, p4 = lane & 3, g1 = (lane >> 4) & 1;
    f32x4 gnv[4];
#pragma unroll
    for (int i = 0; i < 4; ++i) gnv[i] = *(const f32x4*)(gn + (F.tid & 7) * 16 + 4 * i);
    const unsigned src_t = (unsigned)F.tid * 16u;
    const unsigned dst_w = (unsigned)((F.tid >> 4) * 272 + (F.tid & 15) * 16);
    const unsigned dst_k = (unsigned)((F.tid >> 4) * 320 + (F.tid & 15) * 16);
    const unsigned dst_q = (unsigned)((F.tid >> 3) * 144 + (F.tid & 7) * 16);
    const unsigned ut_t = (unsigned)(((32 * dvb + r) * 64 + 4 * hh) * 2);
    for (int bh = worker; bh < 128; bh += nworkers) {
        const int b = bh >> 2, h = bh & 3;
        f32x16 Sacc[2] = {zero16(), zero16()};
        for (int p = F.tid; p < 34816 / 16; p += 512) *(LAS u32x4*)(L + GB_ST + p * 16) = (u32x4){0u, 0u, 0u, 0u};
        u32x4 nop[7]; u32x2 nui[2][4]; float neg; u32x4 nog[2];
#define GB_PREFETCH(nn) do { const int _item = bh * 32 + (nn); const unsigned char* _Gp = F.ws + WS_G + (size_t)_item * G_ITEM; \
            unsigned _so = src_t, _uo = ut_t; asm volatile("" : "+v"(_so), "+v"(_uo)); \
            _Pragma("unroll") for (int k = 0; k < 7; ++k) { const unsigned char* _bk = _Gp + (8192 * k + (k >= 2 ? 16384 : 0)); nop[k] = *(const u32x4*)(_bk + _so); } \
            _Pragma("unroll") for (int tb = 0; tb < 2; ++tb) _Pragma("unroll") for (int g = 0; g < 4; ++g) { const unsigned char* _bu = _Gp + G_UT + (64 * tb + 16 * g); nui[tb][g] = *(const u32x2*)(_bu + _uo); } \
            neg = EG[_item]; \
            const unsigned char* _og = (const unsigned char*)(U + (size_t)(b * SEQ + (nn) * 64) * EVU + 2560 + h * 128); \
            unsigned _lo = (unsigned)((F.tid >> 3) * EVU + (F.tid & 7) * 16) * 2u; asm volatile("" : "+v"(_lo)); \
            nog[0] = *(const u32x4*)(_og + _lo); nog[1] = *(const u32x4*)(_og + 16 + _lo); } while (0)
        GB_PREFETCH(0);
        for (int n = 0; n < 32; ++n) {
            const int t0 = b * SEQ + n * 64;
            *(LAS u32x4*)(L + GB_W + dst_w) = nop[0]; *(LAS u32x4*)(L + GB_W + dst_w + 32 * 272) = nop[1];
            *(LAS u32x4*)(L + GB_QG + dst_w) = nop[2]; *(LAS u32x4*)(L + GB_QG + dst_w + 32 * 272) = nop[3];
            *(LAS u32x4*)(L + GB_KD + dst_k) = nop[4]; *(LAS u32x4*)(L + GB_KD + dst_k + 32 * 320) = nop[5];
            *(LAS u32x4*)(L + GB_QK + dst_q) = nop[6];
            u32x2 ui[2][4]; u32x4 og[2];
#pragma unroll
            for (int tb = 0; tb < 2; ++tb)
#pragma unroll
                for (int g = 0; g < 4; ++g) ui[tb][g] = nui[tb][g];
            og[0] = nog[0]; og[1] = nog[1];
            const float eg = neg;
            LDS_BAR();
            if (n + 1 < 32) GB_PREFETCH(n + 1);
            f32x16 x0 = zero16(), x1 = zero16(), o = zero16();
            {
                const LAS unsigned char* sp = L + GB_ST + (32 * dvb + r) * 272 + hh * 16;
                const LAS unsigned char* wp = L + GB_W + r * 272 + hh * 16;
                const LAS unsigned char* qp = L + GB_QG + (32 * hf + r) * 272 + hh * 16;
#pragma unroll
                for (int s = 0; s < 8; ++s) {
                    const bf16x8 sf = *(const LAS bf16x8*)(sp + 32 * s);
                    x0 = MFMA32(*(const LAS bf16x8*)(wp + 32 * s), sf, x0);
                    x1 = MFMA32(*(const LAS bf16x8*)(wp + 32 * 272 + 32 * s), sf, x1);
                    o = MFMA32(*(const LAS bf16x8*)(qp + 32 * s), sf, o);
                }
            }
            bf16x8 pv[2][2];
#pragma unroll
            for (int g = 0; g < 4; ++g) {
                x0[4 * g] = bflo(ui[0][g].x) - x0[4 * g]; x0[4 * g + 1] = bfhi(ui[0][g].x) - x0[4 * g + 1]; x0[4 * g + 2] = bflo(ui[0][g].y) - x0[4 * g + 2]; x0[4 * g + 3] = bfhi(ui[0][g].y) - x0[4 * g + 3];
                x1[4 * g] = bflo(ui[1][g].x) - x1[4 * g]; x1[4 * g + 1] = bfhi(ui[1][g].x) - x1[4 * g + 1]; x1[4 * g + 2] = bflo(ui[1][g].y) - x1[4 * g + 2]; x1[4 * g + 3] = bfhi(ui[1][g].y) - x1[4 * g + 3];
            }
            pv[0][0] = pack_step(x0, 0); pv[0][1] = pack_step(x0, 1); pv[1][0] = pack_step(x1, 0); pv[1][1] = pack_step(x1, 1);
#pragma unroll
            for (int tb = 0; tb < 2; ++tb) {
                if (tb <= hf) {
#pragma unroll
                    for (int s = 0; s < 2; ++s) {
                        const LAS unsigned char* kp = L + GB_QK + (32 * hf + r) * 144 + (32 * tb + 16 * s + 4 * hh) * 2;
                        o = MFMA32(cat8(*(const LAS s16x4*)kp, *(const LAS s16x4*)(kp + 16)), pv[tb][s], o);
                    }
                }
            }
            {
                LAS float* Ol = (LAS float*)(L + GB_O) + (32 * hf + 4 * hh) * 132 + 32 * dvb + r;
#pragma unroll
                for (int reg = 0; reg < 16; ++reg) Ol[((reg & 3) + 8 * (reg >> 2)) * 132] = o[reg];
            }
#pragma unroll
            for (int d2 = 0; d2 < 2; ++d2) {
                const int db = 2 * hf + d2;
                f32x16 x = Sacc[d2] * eg;
                const LAS unsigned char* kb = L + GB_KD + (4 * hh + q4) * 320 + (32 * db + 16 * g1 + 4 * p4) * 2;
#pragma unroll
                for (int tb = 0; tb < 2; ++tb)
#pragma unroll
                    for (int s = 0; s < 2; ++s) {
                        const LAS unsigned char* kp = kb + (32 * tb + 16 * s) * 320;
                        x = MFMA32(cat8(vtr(kp), vtr(kp + 8 * 320)), pv[tb][s], x);
                    }
                Sacc[d2] = x;
            }
            LDS_BAR();
#pragma unroll
            for (int d2 = 0; d2 < 2; ++d2) {
                const int db = 2 * hf + d2;
#pragma unroll
                for (int g = 0; g < 4; ++g) { u32x2 ov; ov.x = pk2(Sacc[d2][4 * g], Sacc[d2][4 * g + 1]); ov.y = pk2(Sacc[d2][4 * g + 2], Sacc[d2][4 * g + 3]);
                    *(LAS u32x2*)(L + GB_ST + (32 * dvb + r) * 272 + (32 * db + 8 * g + 4 * hh) * 2) = ov; }
            }
            {
                const int row = F.tid >> 3, cg = (F.tid & 7) * 16;
                const LAS float* Ol = (const LAS float*)(L + GB_O) + row * 132 + cg;
                f32x4 ov[4]; float ss = 0.f;
#pragma unroll
                for (int i = 0; i < 4; ++i) { ov[i] = *(const LAS f32x4*)(Ol + 4 * i); ss += (ov[i].x * ov[i].x + ov[i].y * ov[i].y) + (ov[i].z * ov[i].z + ov[i].w * ov[i].w); }
                ss += dppf(ss, 0); ss += dppf(ss, 1); ss += dppf(ss, 2);
                const float rstd = rsqrtf(ss * (1.f / 128.f) + EPS);
                bf16* yp = Y + (size_t)(t0 + row) * D + 512 + h * 128 + cg;
#pragma unroll
                for (int hv = 0; hv < 2; ++hv) {
                    const u32x4 gq = og[hv]; const f32x4 a0 = ov[2 * hv] * rstd * gnv[2 * hv], a1 = ov[2 * hv + 1] * rstd * gnv[2 * hv + 1];
                    u32x4 o4; o4.x = pk2(a0.x * silu_f(bflo(gq.x)), a0.y * silu_f(bfhi(gq.x))); o4.y = pk2(a0.z * silu_f(bflo(gq.y)), a0.w * silu_f(bfhi(gq.y)));
                    o4.z = pk2(a1.x * silu_f(bflo(gq.z)), a1.y * silu_f(bfhi(gq.z))); o4.w = pk2(a1.z * silu_f(bflo(gq.w)), a1.w * silu_f(bfhi(gq.w)));
                    *(u32x4*)(yp + 8 * hv) = o4;
                }
            }
        }
        WG_BAR();
    }
#undef GB_PREFETCH
}

constexpr int AT_STAGE = 38912, AT_K = 0, AT_V = 18432, AT_NST = 4, AT_BIAS = LDS_MISC + 1024;
DI void attn_dma_offs(int w, int lane, int h, unsigned (&go)[5]) {
#pragma unroll
    for (int k = 0; k < 5; ++k) {
        int ii = w + 8 * k; if (ii >= 38) ii -= 2; unsigned o;
        if (ii < 18) { const int i = ii * 64 + lane, m = i / 576, rem = i - m * 576, rr = rem / 9, c0 = rem - rr * 9, c = c0 > 7 ? 7 : c0; o = (unsigned)(rr * OD_N + 512 + h * 128 + m * 64 + c * 8) * 2u; }
        else { const int i = (ii - 18) * 64 + lane, rr = i / 20, c0 = i - rr * 20, c = c0 > 15 ? 15 : c0; o = (unsigned)(rr * OD_N + 1024 + h * 128 + c * 8) * 2u; }
        go[k] = o;
    }
}
DI void glds16(const void* gsrc, unsigned lds_dst) { unsigned keep;
    asm volatile("s_mov_b32 %0, m0\n\ts_mov_b32 m0, %2\n\ts_nop 0\n\tglobal_load_lds_dwordx4 %1, off\n\ts_mov_b32 m0, %0" : "=&s"(keep) : "v"(gsrc), "s"(lds_dst) : "memory"); }
DI void attn_dma(const bf16* U1, int trow, LAS unsigned char* stage, int w, const unsigned (&go)[5]) {
    const char* g = (const char*)(U1 + (size_t)trow * OD_N);
    const unsigned sbase = (unsigned)(uintptr_t)stage;
#pragma unroll
    for (int k = 0; k < 5; ++k) {
        int ii = w + 8 * k; if (ii >= 38) ii -= 2;
        const unsigned dst = sbase + ((ii < 18) ? (unsigned)(AT_K + ii * 1024) : (unsigned)(AT_V + (ii - 18) * 1024));
        glds16(g + go[k], (unsigned)__builtin_amdgcn_readfirstlane((int)dst));
    }
}
DI void attn_phase(const Frame& F, const Args& a) {
    LAS unsigned char* L = F.lds;
    const bf16* U1 = (const bf16*)(F.ws + WS_U); bf16* Y = (bf16*)(F.ws + WS_Y);
    const float* lamp = a.in[14]; const float* dng = a.in[15]; const float* relb = a.in[21];
    const int lane = F.lane, w = F.wave, r = lane & 31, hh = lane >> 5, mp = w >> 2, qs = w & 3;
    const int q4 = (lane & 15) >> 2, p4 = lane & 3, g1 = (lane >> 4) & 1;
    const float lam = __expf(wave_sum(lamp[lane] * lamp[64 + lane])) - __expf(wave_sum(lamp[128 + lane] * lamp[192 + lane])) + LAMBDA_INIT;
    const float c1 = 0.125f * LOG2E;
    LAS float* btab = (LAS float*)(L + AT_BIAS);
    LAS float* exch = (LAS float*)L;
    for (int item = F.vcu; item < 256; item += F.G) {
        const int bh = item >> 1, par = item & 1, b = bh >> 2, h = bh & 3, trow0 = b * SEQ;
        WG_BAR();
        if (F.tid < 128) { const int n = F.tid; int bucket = n;
            if (n >= 16) { const int lg = 16 + (int)(__logf((float)n / 16.f) / 2.0794415416798357f * 16.f); bucket = lg < 31 ? lg : 31; }
            btab[n] = relb[bucket * 4 + h] * LOG2E; }
        const float bias_far = relb[31 * 4 + h] * LOG2E;
        unsigned go[5]; attn_dma_offs(w, lane, h, go);
        for (int ui = 0; ui < 8; ++ui) {
            const int qblk = 2 * ui + ((ui ^ par) & 1);
            const int q0 = qblk * 128 + qs * 32, qpos = q0 + r, ntiles = 2 * (qblk + 1);
            bf16x8 qf[4];
            { const bf16* qp = U1 + (size_t)(trow0 + qpos) * OD_N + h * 128 + mp * 64 + 8 * hh;
#pragma unroll
              for (int s = 0; s < 4; ++s) qf[s] = *(const bf16x8*)(qp + 16 * s); }
            asm volatile("s_waitcnt vmcnt(0)" ::: "memory");
            f32x16 O[4] = {zero16(), zero16(), zero16(), zero16()};
            float mrun = -INFINITY, lrun = 0.f;
            attn_dma(U1, trow0, L, w, go);
            attn_dma(U1, trow0 + 64, L + AT_STAGE, w, go);
            bf16x8 pf[2][2]; bool pend = false;
            const LAS unsigned char* vlane = L + AT_V + (4 * hh + q4) * 320 + (16 * g1 + 4 * p4) * 2;
#define ATT_PV(stage_) do { const LAS unsigned char* vb_ = vlane + (stage_) * AT_STAGE; \
                _Pragma("unroll") for (int db = 0; db < 4; ++db) _Pragma("unroll") for (int kh = 0; kh < 2; ++kh) _Pragma("unroll") for (int s_ = 0; s_ < 2; ++s_) { \
                    const LAS unsigned char* vp = vb_ + (32 * kh + 16 * s_) * 320 + 64 * db; O[db] = MFMA32(cat8(vtr(vp), vtr(vp + 8 * 320)), pf[kh][s_], O[db]); } } while (0)
            for (int kt = 0; kt < ntiles; ++kt) {
                if (kt + 1 < ntiles) asm volatile("s_waitcnt vmcnt(5)" ::: "memory"); else asm volatile("s_waitcnt vmcnt(0)" ::: "memory");
                __builtin_amdgcn_s_barrier(); asm volatile("" ::: "memory");
                if (kt + 2 < ntiles) attn_dma(U1, trow0 + (kt + 2) * 64, L + ((kt + 2) & 3) * AT_STAGE, w, go);
                if (mp == 1 && pend) { ATT_PV((kt - 1) & 3); pend = false; }
                const int key0 = kt * 64;
                if (key0 <= q0 + 31) {
                    const LAS unsigned char* sb = L + (kt & 3) * AT_STAGE;
                    const LAS unsigned char* kb = sb + AT_K + mp * 9216 + r * 144 + hh * 16;
                    f32x16 x0 = zero16(), x1 = zero16();
#pragma unroll
                    for (int s = 0; s < 4; ++s) { x0 = MFMA32(*(const LAS bf16x8*)(kb + 32 * s), qf[s], x0); x1 = MFMA32(*(const LAS bf16x8*)(kb + 32 * 144 + 32 * s), qf[s], x1); }
                    const bool far = q0 - (key0 + 63) >= 128;
                    if (!far) {
#pragma unroll
                        for (int reg = 0; reg < 16; ++reg) {
                            const int d0 = qpos - (key0 + crow(reg, hh)), d1 = d0 - 32;
                            const float b0 = btab[d0 < 0 ? 0 : (d0 > 127 ? 127 : d0)], b1 = btab[d1 < 0 ? 0 : (d1 > 127 ? 127 : d1)];
                            x0[reg] = (d0 >= 0) ? x0[reg] * c1 + b0 : -INFINITY; x1[reg] = (d1 >= 0) ? x1[reg] * c1 + b1 : -INFINITY;
                        }
                    }
                    float mx = x0[0];
#pragma unroll
                    for (int reg = 1; reg < 16; ++reg) mx = fmaxf(mx, x0[reg]);
#pragma unroll
                    for (int reg = 0; reg < 16; ++reg) mx = fmaxf(mx, x1[reg]);
                    if (far) mx = mx * c1 + bias_far;
                    mx = fmaxf(mx, __shfl_xor(mx, 32));
                    if (__any(mx - mrun > 6.f)) {
                        const float mnew = fmaxf(mrun, mx), alpha = __builtin_amdgcn_exp2f(mrun - mnew); mrun = mnew;
                        lrun *= alpha;
#pragma unroll
                        for (int db = 0; db < 4; ++db) O[db] = O[db] * alpha;
                    }
                    float rs = 0.f;
                    if (far) { const float off = bias_far - mrun;
#pragma unroll
                        for (int reg = 0; reg < 16; ++reg) { x0[reg] = __builtin_amdgcn_exp2f(x0[reg] * c1 + off); x1[reg] = __builtin_amdgcn_exp2f(x1[reg] * c1 + off); rs += x0[reg] + x1[reg]; }
                    } else {
#pragma unroll
                        for (int reg = 0; reg < 16; ++reg) { x0[reg] = __builtin_amdgcn_exp2f(x0[reg] - mrun); x1[reg] = __builtin_amdgcn_exp2f(x1[reg] - mrun); rs += x0[reg] + x1[reg]; }
                    }
                    lrun += rs;
                    pf[0][0] = pack_step(x0, 0); pf[0][1] = pack_step(x0, 1); pf[1][0] = pack_step(x1, 0); pf[1][1] = pack_step(x1, 1);
                    if (mp == 0) ATT_PV(kt & 3); else pend = true;
                }
            }
            if (mp == 1 && pend) ATT_PV((ntiles - 1) & 3);
#undef ATT_PV
            const float ltot = lrun + __shfl_xor(lrun, 32);
            const float inv = 1.f / ltot;
            LDS_BAR();
            if (mp == 1) {
                const float sc = inv * lam;
#pragma unroll
                for (int db = 0; db < 4; ++db)
#pragma unroll
                    for (int reg = 0; reg < 16; ++reg) exch[(qs * 64 + db * 16 + reg) * 64 + lane] = O[db][reg] * sc;
            }
            LDS_BAR();
            if (mp == 0) {
                float ss = 0.f;
#pragma unroll
                for (int db = 0; db < 4; ++db)
#pragma unroll
                    for (int reg = 0; reg < 16; ++reg) { const float o = O[db][reg] * inv - exch[(qs * 64 + db * 16 + reg) * 64 + lane]; O[db][reg] = o; ss += o * o; }
                ss += __shfl_xor(ss, 32);
                const float rstd = rsqrtf(ss * (1.f / 128.f) + EPS) * (1.f - LAMBDA_INIT);
                bf16* yp = Y + (size_t)(trow0 + qpos) * D + h * 128;
#pragma unroll
                for (int db = 0; db < 4; ++db)
#pragma unroll
                    for (int g = 0; g < 4; ++g) { const int d = 32 * db + 8 * g + 4 * hh; const f32x4 gv = *(const f32x4*)(dng + d);
                        u32x2 o; o.x = pk2(O[db][4 * g] * rstd * gv[0], O[db][4 * g + 1] * rstd * gv[1]); o.y = pk2(O[db][4 * g + 2] * rstd * gv[2], O[db][4 * g + 3] * rstd * gv[3]);
                        *(u32x2*)(yp + d) = o; }
            }
            LDS_BAR();
        }
    }
}

constexpr int CF_GLU = 0, CF_RED = 96256, CF_STAT = CF_RED + 16384, CF_END = CF_STAT + 512;
DI void conformer_phase(const Frame& F, const Args& a) {
    LAS unsigned char* L = F.lds;
    const bf16* U1 = (const bf16*)(F.ws + WS_U); bf16* Y = (bf16*)(F.ws + WS_Y);
    const float* cw = a.in[16]; const float* cb = a.in[17]; const float* lg = a.in[18]; const float* lb = a.in[19];
    const int c = F.tid;
    float wv[31];
#pragma unroll
    for (int j = 0; j < 31; ++j) wv[j] = cw[j * 512 + c];
    const float bias = cb[c], lng = lg[c], lnb = lb[c];
    LAS float* red = (LAS float*)(L + CF_RED); LAS float* stat = (LAS float*)(L + CF_STAT);
    const int tpw = (T / 64 + F.G - 1) / F.G;
    for (int kt = 0; kt < tpw; ++kt) {
        const int tile = F.vcu * tpw + kt; if (tile >= T / 64) break;
        const int t0 = tile * 64, s0 = t0 & (SEQ - 1);
        const bool reuse = (kt > 0) && (s0 != 0);
        LDS_BAR();
        if (reuse) {
            u32x4 cp[4];
#pragma unroll
            for (int j = 0; j < 4; ++j) { const int idx = F.tid + 512 * j; if (idx < 1920) cp[j] = *(const LAS u32x4*)(L + CF_GLU + 64 * 1024 + idx * 16); }
#pragma unroll
            for (int j = 0; j < 4; ++j) { const int idx = F.tid + 512 * j; if (idx < 1920) *(LAS u32x4*)(L + CF_GLU + idx * 16) = cp[j]; }
            LDS_BAR();
        }
        const int it0 = reuse ? 30 * 64 : 0, nb4 = reuse ? 3 : 4;
#pragma unroll 1
        for (int b4 = 0; b4 < nb4; ++b4) {
            u32x4 ga[3], gb[3];
#pragma unroll
            for (int k = 0; k < 3; ++k) {
                const int it = it0 + F.tid + 512 * (3 * b4 + k), row = it >> 6, c8 = (it & 63) * 8;
                ga[k] = (u32x4){0u, 0u, 0u, 0u}; gb[k] = ga[k];
                if (it < 94 * 64 && s0 + row - 30 >= 0) { const bf16* up = U1 + (size_t)(t0 + row - 30) * OD_N + 1536 + c8; ga[k] = *(const u32x4*)up; gb[k] = *(const u32x4*)(up + 512); }
            }
#pragma unroll
            for (int k = 0; k < 3; ++k) {
                const int it = it0 + F.tid + 512 * (3 * b4 + k), row = it >> 6, c8 = (it & 63) * 8;
                u32x4 o;
#pragma unroll
                for (int q = 0; q < 4; ++q) o[q] = pk2(bflo(ga[k][q]) * sigmoid_f(bflo(gb[k][q])), bfhi(ga[k][q]) * sigmoid_f(bfhi(gb[k][q])));
                if (it < 94 * 64) *(LAS u32x4*)(L + CF_GLU + row * 1024 + c8 * 2) = o;
            }
            asm volatile("" ::: "memory");
        }
        LDS_BAR();
        float out[64];
        float xs[94];
#pragma unroll
        for (int q = 0; q < 46; ++q) xs[q] = bf2f(*(const LAS bf16*)(L + CF_GLU + q * 1024 + c * 2));
#pragma unroll
        for (int hb = 0; hb < 4; ++hb) {
#pragma unroll
            for (int t2 = 0; t2 < 16; ++t2) {
                float acc = bias;
#pragma unroll
                for (int j = 0; j < 31; ++j) acc = __builtin_fmaf(wv[j], xs[16 * hb + t2 + j], acc);
                out[16 * hb + t2] = acc;
            }
            asm volatile("" ::: "memory");
            if (hb < 3) {
#pragma unroll
                for (int q = 0; q < 16; ++q) xs[46 + 16 * hb + q] = bf2f(*(const LAS bf16*)(L + CF_GLU + (46 + 16 * hb + q) * 1024 + c * 2));
            }
        }
        {
            const int part = F.wave * 4 + (F.lane >> 4), tk = (F.lane & 1) * 4 + (F.lane & 2) * 4 + (F.lane & 4) * 4 + (F.lane & 8) * 4;
            float p1[4];
            { float q[64];
#pragma unroll
              for (int tt = 0; tt < 64; ++tt) q[tt] = out[tt];
              transpose_sum_row(q, F.lane);
#pragma unroll
              for (int t = 0; t < 4; ++t) p1[t] = q[t]; }
            __builtin_amdgcn_sched_barrier(0);
            { float q[64];
#pragma unroll
              for (int tt = 0; tt < 64; ++tt) q[tt] = out[tt] * out[tt];
              transpose_sum_row(q, F.lane);
#pragma unroll
              for (int t = 0; t < 4; ++t) *(LAS f32x2_t*)(red + (part * 64 + tk + t) * 2) = (f32x2_t){p1[t], q[t]}; }
        }
        LDS_BAR();
        if (F.tid < 64) { float s1 = 0.f, s2 = 0.f;
#pragma unroll
            for (int q = 0; q < 32; ++q) { const f32x2_t pr = *(const LAS f32x2_t*)(red + (q * 64 + F.tid) * 2); s1 += pr.x; s2 += pr.y; }
            const float mean = s1 * (1.f / 512.f); const float var = fmaxf(s2 * (1.f / 512.f) - mean * mean, 0.f);
            stat[F.tid * 2] = mean; stat[F.tid * 2 + 1] = rsqrtf(var + EPS); }
        LDS_BAR();
#pragma unroll
        for (int tt = 0; tt < 64; ++tt) {
            const float v = (out[tt] - stat[tt * 2]) * stat[tt * 2 + 1] * lng + lnb;
            Y[(size_t)(t0 + tt) * D + 512 + c] = (bf16)(pk2(silu_f(v), 0.f) & 0xffffu);
        }
    }
}

DI void stagger_us(int us) { const unsigned long long t0 = __builtin_amdgcn_s_memrealtime(); while (__builtin_amdgcn_s_memrealtime() - t0 < (unsigned long long)us * 100ull) __builtin_amdgcn_s_sleep(32); }
constexpr int NPH = 26;
__global__ void __launch_bounds__(512, 2) fwd_kernel(Args args) {
    extern __shared__ __attribute__((aligned(16))) unsigned char lds_raw[];
    Frame F;
    F.lds = (LAS unsigned char*)lds_raw; F.ws = args.ws;
    F.wave = __builtin_amdgcn_readfirstlane((int)threadIdx.x >> 6); F.tid = threadIdx.x; F.lane = F.tid & 63;
    F.G = gridDim.x; { const int bx = blockIdx.x; F.vcu = (F.G % 8 == 0) ? (bx % 8) * (F.G / 8) + bx / 8 : bx; }
    volatile LAS unsigned* MISC = (volatile LAS unsigned*)(F.lds + LDS_MISC);
    if (F.tid < 64) MISC[F.tid] = 0u;
    __syncthreads();
    unsigned* ctl = (unsigned*)(F.ws + WS_CTL);
    const bool multi = (args.ph_hi - args.ph_lo) > 1;
    XcdBarrier bar; bar.bar = ctl + CW_BAR; bar.x = 0; bar.st = MISC + 8; bar.wave = F.wave;
    if (multi) bar = xcd_barrier_post(ctl + CW_BAR, MISC + 8, F.wave);
    const int lo = args.ph_lo, hi = args.ph_hi;
#define IN(k) (lo <= (k) && (k) < hi)
#define SEAM(k) do { if (IN(k) && IN((k) + 1)) xcd_barrier(bar); } while (0)
    unsigned char* ws = F.ws;
    bf16* HN = (bf16*)(ws + WS_HN); signed char* HN8 = (signed char*)(ws + WS_HN); bf16* UB = (bf16*)(ws + WS_U); bf16* UB0 = (bf16*)(ws + WS_U0); bf16* YB = (bf16*)(ws + WS_Y); bf16* XB = (bf16*)(ws + WS_XB); float* SAp = (float*)(ws + WS_SA); const float* SBp = (const float*)(ws + WS_SB);
    const int bx = (int)blockIdx.x;

    if (IN(0)) { quant_k1024(phase_frame(F), args, 0, 4, F.vcu, F.G); absmax_jobs(phase_frame(F), args, 10, N_QJOBS, F.vcu, F.G); convert_weights(phase_frame(F), args); norm_mix0(phase_frame(F), args); } SEAM(0);
    if (IN(1)) { pg8::SchedDense S; S.init(HN, ws + W_EVIN, T, EV_N, D / 2, F.G, bx); pg8::EpiEvInI8 E{UB0, SAp, SBp + SBO_EVIN}; pg8::gemm_phase(F.lds, S, E, F.wave); } SEAM(1);
    if (IN(2)) { gdn_a(phase_frame(F), args); } SEAM(2);
    if (IN(3)) { if ((bx & 1) == 0) { gdn_b(phase_frame(F), args, bx >> 1, (F.G + 1) >> 1); quant_k1024(phase_frame(F), args, 4, 8, bx >> 1, (F.G + 1) >> 1); }     else { mixer_a(phase_frame(F), args, bx >> 1, F.G >> 1); quant_k1024(phase_frame(F), args, 8, 10, bx >> 1, F.G >> 1); quant_jobs(phase_frame(F), args, 10, N_QJOBS, bx >> 1, F.G >> 1); } } SEAM(3);
    if (IN(4)) { pg8::SchedDense S; S.init(YB, ws + W_EVOUT, T, D, D, F.G, bx); pg8::EpiResid E{args.in[0], XB}; pg8::gemm_phase(F.lds, S, E, F.wave); } SEAM(4);
    if (IN(5)) { norm_plain(phase_frame(F), XB, args.in[3], HN8, SAp); } SEAM(5);
    if (IN(6)) { pg8::SchedDense S; S.init(HN, ws + W_FFGU, T, 2 * DFF, D / 2, F.G, bx); pg8::EpiSwiGLUI8 E{UB, DFF, SAp, SBp + SBO_FFGU}; pg8::gemm_phase(F.lds, S, E, F.wave); } SEAM(6);
    if (IN(7)) { pg8::SchedDense S; S.init(UB, ws + W_FFD, T, D, DFF, F.G, bx); pg8::EpiResidB E{XB}; pg8::gemm_phase(F.lds, S, E, F.wave); } SEAM(7);
    if (IN(8)) { norm_plain(phase_frame(F), XB, args.in[4], HN8, SAp); convert_p(phase_frame(F), args.in[1], (bf16*)(ws + WS_GX)); convert_p(phase_frame(F), args.in[1] + (size_t)T * 256, (bf16*)(ws + WS_PB2)); } SEAM(8);
    if (IN(9)) { pg8::SchedDense S; S.init(ws + WS_GX, ws + W_PPROJ, T, D, 256, F.G, bx); pg8::EpiStoreBf16 E{UB, D}; pg8::gemm_phase(F.lds, S, E, F.wave); }
    if (IN(10)) { pg8::SchedDense S; S.init(HN, ws + W_PGATE, T, D, D / 2, F.G, bx); pg8::EpiPleGateI8 E{XB, UB, SAp, SBp + SBO_PGATE}; pg8::gemm_phase(F.lds, S, E, F.wave); } SEAM(10);
    if (IN(11)) { norm_plain(phase_frame(F), XB, args.in[2] + D, HN8, SAp); } SEAM(11);
    if (IN(12)) { pg8::SchedDense S; S.init(HN, ws + W_ODIN, T, OD_N, D / 2, F.G, bx); pg8::EpiStoreBf16I8 E{UB, OD_N, SAp, SBp + SBO_ODIN}; pg8::gemm_phase(F.lds, S, E, F.wave); } SEAM(12);
    if (IN(13)) { attn_phase(phase_frame(F), args); conformer_phase(phase_frame(F), args); } SEAM(13);
    if (IN(14)) { pg8::SchedDense S; S.init(YB, ws + W_ODOUT, T, D, D, F.G, bx); pg8::EpiResidB E{XB}; pg8::gemm_phase(F.lds, S, E, F.wave); } SEAM(14);
    if (IN(15)) { norm_router(phase_frame(F), args); } SEAM(15);
#define MOE_PART(part, phg, phd) \
    if (IN(phg) || IN(phd)) { \
        LAS int* tab = (LAS int*)(F.lds + LDS_MISC + 256); \
        if (is_thread0(F.wave)) { int pb = 0; for (int e = 0; e < 8; ++e) { const int c = (int)__hip_atomic_load(ctl + CW_CNT + 64 * e, __ATOMIC_RELAXED, __HIP_MEMORY_SCOPE_AGENT); tab[e] = c; tab[8 + e] = pb; pb += (c + 255) >> 8; } tab[16] = pb; } \
        __syncthreads(); \
        const int nbt = tab[16]; int nMp = nbt - (part) * MOE_NBP; nMp = nMp < 0 ? 0 : (nMp > MOE_NBP ? MOE_NBP : nMp); \
        if (IN(phg)) { pg8::SchedMoeGU S; S.A = (const char*)HN; S.Bt = (const char*)(ws + W_MGU); S.K = D / 2; S.nM = nMp; S.nN = 2 * DFE / 256; S.G = F.G; S.c = bx; S.blk0 = (part) * MOE_NBP; S.bstride = (size_t)2 * DFE * D; \
            S.row_ts = (const int*)(ws + WS_ROWTS); S.tab = tab; S.gather = true; pg8::EpiSwiGLUI8F8 E{(bf16*)(ws + WS_ACT8), DFE, (const float*)(ws + WS_ROWSA), (const float*)(ws + WS_SB)}; pg8::gemm_phase(F.lds, S, E, F.wave); \
              \
            { const int remg = (nMp * (2 * DFE / 256)) % F.G; if (remg != 0 && bx >= remg) { pg8::SchedDense S2; S2.init(ws + WS_PB2, ws + W_PPROJ + (size_t)D * 256 * 2, T, D, 256, F.G - remg, bx - remg, 0, 1); pg8::EpiStoreBf16 E2{YB, D}; pg8::gemm_phase(F.lds, S2, E2, F.wave); } } } \
        SEAM(phg); \
        if (IN(phd)) { pg8::SchedMoeDown S; S.A = (const char*)(ws + WS_ACT8); S.Bt = (const char*)(ws + W_MD); S.K = DFE / 2; S.nM = nMp; S.nN = D / 256; S.G = F.G; S.c = bx; S.blk0 = (part) * MOE_NBP; S.bstride = (size_t)D * DFE; \
            S.row_ts = (const int*)(ws + WS_ROWTS); S.tab = tab; S.gather = false; pg8::EpiMoeDown E{(bf16*)args.out, (const int*)(ws + WS_ROWTS), (const float*)(ws + WS_ROWGATE), (const float*)(ws + WS_SB) + SBO_MD}; pg8::gemm_phase(F.lds, S, E, F.wave); \
              \
            { const int rem = (nMp * (D / 256)) % F.G, remg = (nMp * (2 * DFE / 256)) % F.G, done = remg ? F.G - remg : 0;     \
              if (rem == 0 || bx >= rem) { pg8::SchedDense S2; S2.init(ws + WS_PB2, ws + W_PPROJ + (size_t)D * 256 * 2, T, D, 256, rem ? F.G - rem : F.G, rem ? bx - rem : bx, done); pg8::EpiStoreBf16 E2{YB, D}; pg8::gemm_phase(F.lds, S2, E2, F.wave); } } } \
        SEAM(phd); \
    }
    MOE_PART(0, 16, 17)
    if (IN(22)) { combine_norm(phase_frame(F), args); } SEAM(22);
    if (IN(24)) { pg8::SchedDense S; S.init(HN, ws + W_PGATE + (size_t)D * D, T, D, D / 2, F.G, bx); pg8::EpiPleGateI8 E{XB, YB, SAp, SBp + SBO_PGATE + D}; pg8::gemm_phase(F.lds, S, E, F.wave); } SEAM(24);
    if (IN(25)) { final_norm(phase_frame(F), args); }
#undef IN
#undef SEAM
}

#ifndef MK_MULTI_LAUNCH
#define MK_MULTI_LAUNCH 0
#endif
extern "C" void kernel_launch(void* const* d_in, const int* in_sizes, int n_in, void* d_out, int out_size, void* d_ws, size_t ws_size, hipStream_t stream) {
    static int grid = 0;
    if (grid == 0) {
        if (n_in != 29 || out_size != T * D || ws_size < WS_END) { fprintf(stderr, "kernel_launch: unexpected shapes (n_in %d out %d ws %zu)\n", n_in, out_size, ws_size); grid = -1; return; }
        int dev = 0, cus = 0, per_cu = 0;
        if (hipGetDevice(&dev) != hipSuccess || hipDeviceGetAttribute(&cus, hipDeviceAttributeMultiprocessorCount, dev) != hipSuccess) { grid = -1; return; }
        if (hipFuncSetAttribute((const void*)fwd_kernel, hipFuncAttributeMaxDynamicSharedMemorySize, LDS_BYTES) != hipSuccess) { fprintf(stderr, "kernel_launch: LDS attribute failed\n"); grid = -1; return; }
        if (hipOccupancyMaxActiveBlocksPerMultiprocessor(&per_cu, (const void*)fwd_kernel, 512, LDS_BYTES) != hipSuccess || per_cu < 1) { fprintf(stderr, "kernel_launch: occupancy query says %d\n", per_cu); }
        (void)hipGetLastError();
        grid = cus;
    }
    if (grid < 0) return;
    (void)hipMemsetAsync((char*)d_ws + WS_CTL, 0, CTL_BYTES, stream);
    Args a{};
    for (int i = 0; i < 29; ++i) a.in[i] = (const float*)d_in[i];
    a.out = (float*)d_out; a.ws = (unsigned char*)d_ws;
#if MK_MULTI_LAUNCH
    for (int ph = 0; ph < NPH; ++ph) { a.ph_lo = ph; a.ph_hi = ph + 1; hipLaunchKernelGGL(fwd_kernel, dim3(grid), dim3(512), LDS_BYTES, stream, a); }
#else
    a.ph_lo = 0; a.ph_hi = NPH;
    hipLaunchKernelGGL(fwd_kernel, dim3(grid), dim3(512), LDS_BYTES, stream, a);
#endif
}
```

```cpp
#include <hip/hip_runtime.h>
#include <stdint.h>
#include <stdio.h>

#define DI __device__ __forceinline__
#define LAS __attribute__((address_space(3)))
#define GAS __attribute__((address_space(1)))
typedef unsigned short bf16;
typedef short bf16x8 __attribute__((ext_vector_type(8)));
typedef short s16x4 __attribute__((ext_vector_type(4)));
typedef short v4i16_t __attribute__((ext_vector_type(4)));
typedef float f32x4 __attribute__((ext_vector_type(4)));
typedef float f32x16 __attribute__((ext_vector_type(16)));
typedef float f32x2_t __attribute__((ext_vector_type(2)));
typedef __bf16 bf16x2_t __attribute__((ext_vector_type(2)));
typedef unsigned u32x4 __attribute__((ext_vector_type(4)));
typedef unsigned u32x2 __attribute__((ext_vector_type(2)));
typedef int i32x4 __attribute__((ext_vector_type(4)));
typedef GAS unsigned gu32;

constexpr int T = 65536, D = 1024, SEQ = 2048, NBATCH = 32;
constexpr int EV_IN = 3592, EV_N = 3584, EVU = 3072;
constexpr int OD_N = 2560;
constexpr int DFF = 2816, DFE = 3584, NE = 8, CAP = 65536;
constexpr int MOE_NBP = 520, MOE_NPART = 1;
constexpr float ACT8_SCALE = 16.f;
constexpr float EPS = 1e-6f;
constexpr float LOG2E = 1.4426950408889634f;
constexpr float LAMBDA_INIT = 0.35550906f;

constexpr size_t MiB = 1u << 20;
constexpr size_t WS_CTL = 0, CTL_BYTES = 1 * MiB;
constexpr size_t WS_GA = 1 * MiB, WS_BETA = 2 * MiB, WS_ROWTS = 3 * MiB, WS_ROWGATE = 5 * MiB, WS_EG = 7 * MiB, WS_ROWSA = 8 * MiB, WS_SB = 10 * MiB, WS_SA = 11 * MiB;
constexpr size_t WS_W = 16 * MiB;
constexpr size_t W_EVIN = WS_W;
constexpr size_t W_EVOUT = W_EVIN + (size_t)EV_N * D;
constexpr size_t W_FFGU = W_EVOUT + (size_t)D * D * 2;
constexpr size_t W_FFD = W_FFGU + (size_t)2 * DFF * D;
constexpr size_t W_ODIN = W_FFD + (size_t)D * DFF * 2;
constexpr size_t W_ODOUT = W_ODIN + (size_t)OD_N * D;
constexpr size_t W_MGU = W_ODOUT + (size_t)D * D * 2;
constexpr size_t W_MD = W_MGU + (size_t)NE * 2 * DFE * D;
constexpr size_t W_PPROJ = W_MD + (size_t)NE * D * DFE;
constexpr size_t W_PGATE = W_PPROJ + (size_t)2 * D * 256 * 2;
constexpr size_t W_END = W_PGATE + (size_t)2 * D * D;
constexpr int SBO_MOE = 0, SBO_EVIN = NE * 2 * DFE, SBO_FFGU = SBO_EVIN + EV_N, SBO_ODIN = SBO_FFGU + 2 * DFF, SBO_PGATE = SBO_ODIN + OD_N, SBO_MD = SBO_PGATE + 2 * D, SBO_END = SBO_MD + NE * D;
constexpr size_t WS_XS = 125 * MiB;
constexpr size_t WS_PB2 = 128 * MiB;
constexpr size_t WS_HN = 222 * MiB;
constexpr size_t WS_G = 222 * MiB;
constexpr size_t WS_GX = 352 * MiB;
constexpr size_t WS_ACT8 = 288 * MiB;
constexpr size_t WS_U0 = 512 * MiB;
constexpr size_t WS_U = 384 * MiB;
constexpr size_t WS_XB = 768 * MiB;
constexpr size_t WS_Y = 896 * MiB;
constexpr size_t WS_END = 1024 * MiB;
static_assert(W_END <= WS_XS && WS_XS + (size_t)T * 16 <= WS_PB2 && W_END <= WS_PB2 && WS_PB2 + (size_t)T * 256 * 2 <= WS_HN, "weights fit");
static_assert(WS_G + (size_t)4096 * 73728 <= WS_U0, "gdn intermediates fit");
static_assert(WS_ACT8 + (size_t)MOE_NBP * 256 * DFE <= WS_XB && WS_HN + (size_t)(T + 1) * D <= WS_ACT8 && WS_U + (size_t)T * DFF * 2 <= WS_XB && WS_GX + (size_t)T * 256 * 2 <= WS_U, "moe act / ffn act fit");
constexpr size_t G_ITEM = 73728;
constexpr size_t G_W = 0, G_UT = 16384, G_QG = 32768, G_KD = 49152, G_QK = 65536;

constexpr int CW_CNT = 64;
constexpr int CW_BAR = 4096;
constexpr int CW_PCNT = 32768;
constexpr int CW_CMAX = 65536;

constexpr int LDS_BYTES = 160 * 1024;
constexpr int LDS_MISC = 131072 + 24576;
DI float bf2f(unsigned short b) { return __uint_as_float(((unsigned)b) << 16); }
DI float bflo(unsigned u) { return __uint_as_float(u << 16); }
DI float bfhi(unsigned u) { return __uint_as_float(u & 0xffff0000u); }
DI unsigned pk2(float lo, float hi) { f32x2_t v = {lo, hi}; bf16x2_t b = __builtin_convertvector(v, bf16x2_t); return __builtin_bit_cast(unsigned, b); }
DI float dppf(float v, const int ctrl_sel) {
    int r;
    switch (ctrl_sel) {
        case 0: r = __builtin_amdgcn_update_dpp(0, __builtin_bit_cast(int, v), 0xB1, 0xF, 0xF, true); break;
        case 1: r = __builtin_amdgcn_update_dpp(0, __builtin_bit_cast(int, v), 0x4E, 0xF, 0xF, true); break;
        case 2: r = __builtin_amdgcn_update_dpp(0, __builtin_bit_cast(int, v), 0x141, 0xF, 0xF, true); break;
        default: r = __builtin_amdgcn_update_dpp(0, __builtin_bit_cast(int, v), 0x140, 0xF, 0xF, true); break;
    }
    return __builtin_bit_cast(float, r);
}
DI float row16_sum(float v) { v += dppf(v, 0); v += dppf(v, 1); v += dppf(v, 2); v += dppf(v, 3); return v; }
DI float rlane(float v, int l) { return __builtin_bit_cast(float, __builtin_amdgcn_readlane(__builtin_bit_cast(int, v), l)); }
DI float wave_sum(float v) { v = row16_sum(v); return (rlane(v, 0) + rlane(v, 16)) + (rlane(v, 32) + rlane(v, 48)); }
DI float wave_max(float v) { v = fmaxf(v, dppf(v, 0)); v = fmaxf(v, dppf(v, 1)); v = fmaxf(v, dppf(v, 2)); v = fmaxf(v, dppf(v, 3)); return fmaxf(fmaxf(rlane(v, 0), rlane(v, 16)), fmaxf(rlane(v, 32), rlane(v, 48))); }
DI float dpp_ror8(float v) { return __builtin_bit_cast(float, __builtin_amdgcn_update_dpp(0, __builtin_bit_cast(int, v), 0x128, 0xF, 0xF, true)); }
DI void transpose_sum_row(float (&v)[64], int lane) {
    const bool b3 = (lane & 8) != 0, b2 = (lane & 4) != 0, b1 = (lane & 2) != 0, b0 = (lane & 1) != 0;
#pragma unroll
    for (int t = 0; t < 32; ++t) { const float keep = b3 ? v[t + 32] : v[t], send = b3 ? v[t] : v[t + 32]; v[t] = keep + dpp_ror8(send); }
#pragma unroll
    for (int t = 0; t < 16; ++t) { const float keep = b2 ? v[t + 16] : v[t], send = b2 ? v[t] : v[t + 16]; v[t] = keep + dppf(send, 2); }
#pragma unroll
    for (int t = 0; t < 8; ++t) { const float keep = b1 ? v[t + 8] : v[t], send = b1 ? v[t] : v[t + 8]; v[t] = keep + dppf(send, 1); }
#pragma unroll
    for (int t = 0; t < 4; ++t) { const float keep = b0 ? v[t + 4] : v[t], send = b0 ? v[t] : v[t + 4]; v[t] = keep + dppf(send, 0); }
}
DI void wave_sum8(float (&v)[8], int lane) {
    const bool b3 = (lane & 8) != 0, b2 = (lane & 4) != 0, b1 = (lane & 2) != 0;
#pragma unroll
    for (int t = 0; t < 4; ++t) { const float keep = b3 ? v[t + 4] : v[t], send = b3 ? v[t] : v[t + 4]; v[t] = keep + dpp_ror8(send); }
#pragma unroll
    for (int t = 0; t < 2; ++t) { const float keep = b2 ? v[t + 2] : v[t], send = b2 ? v[t] : v[t + 2]; v[t] = keep + dppf(send, 2); }
    float x; { const float keep = b1 ? v[1] : v[0], send = b1 ? v[0] : v[1]; x = keep + dppf(send, 1); }
    x += dppf(x, 0);
    x += __shfl_xor(x, 16); x += __shfl_xor(x, 32);
#pragma unroll
    for (int k = 0; k < 8; ++k) v[k] = rlane(x, 2 * k);
}
DI float sigmoid_f(float x) { return __builtin_amdgcn_rcpf(1.f + __builtin_amdgcn_exp2f(x * -1.4426950408889634f)); }
DI float silu_f(float x) { return x * sigmoid_f(x); }
DI int crow(int reg, int hh) { return (reg & 3) + 8 * (reg >> 2) + 4 * hh; }
DI bf16x8 pack_step(const f32x16& x, int s) {
    u32x4 p;
    p[0] = pk2(x[8 * s + 0], x[8 * s + 1]); p[1] = pk2(x[8 * s + 2], x[8 * s + 3]); p[2] = pk2(x[8 * s + 4], x[8 * s + 5]); p[3] = pk2(x[8 * s + 6], x[8 * s + 7]);
    return __builtin_bit_cast(bf16x8, p);
}
DI s16x4 vtr(const LAS unsigned char* p) { return __builtin_bit_cast(s16x4, __builtin_amdgcn_ds_read_tr16_b64_v4i16((LAS v4i16_t*)p)); }
DI bf16x8 cat8(s16x4 lo, s16x4 hi) { return __builtin_shufflevector(lo, hi, 0, 1, 2, 3, 4, 5, 6, 7); }
#define MFMA32(a, b, c) __builtin_amdgcn_mfma_f32_32x32x16_bf16((a), (b), (c), 0, 0, 0)
DI f32x16 zero16() { f32x16 z; for (int i = 0; i < 16; ++i) z[i] = 0.f; return z; }
#define WG_BAR() __syncthreads()
#define LDS_BAR() do { asm volatile("s_waitcnt lgkmcnt(0)" ::: "memory"); __builtin_amdgcn_s_barrier(); asm volatile("" ::: "memory"); } while (0)

#define XB_TMO      128
#define XB_XCNT(j)  (256  + 64 * (j))
#define XB_XSUB(j)  (1280 + 64 * (j))
#define XB_XGEN(j)  (2304 + 64 * (j))
#define XB_TOP      3328
#define XB_TOPGEN   3392
#define XCD_BAR_WORDS 3456
#define XB_SPIN_CAP (1u << 22)
DI unsigned xb_ld(unsigned* p)              { return __hip_atomic_load(p, __ATOMIC_RELAXED, __HIP_MEMORY_SCOPE_AGENT); }
DI unsigned xb_add(unsigned* p, unsigned v) { return __hip_atomic_fetch_add(p, v, __ATOMIC_RELAXED, __HIP_MEMORY_SCOPE_AGENT); }
DI unsigned xb_xcc_id() { return (unsigned)__builtin_amdgcn_s_getreg((3 << 11) | 20) & 0xFu; }
#define XB_SPIN(cond, bar) do { unsigned _sp = 0; while (cond) { __builtin_amdgcn_s_sleep(1); \
    if ((++_sp & 255u) == 0u) { if (xb_ld(&(bar)[XB_TMO])) break; if (_sp > XB_SPIN_CAP) { atomicAdd(&(bar)[XB_TMO], 1u); break; } } } } while (0)
struct XcdBarrier { unsigned* bar; unsigned x; volatile LAS unsigned* st; int wave; };
DI bool is_thread0(int wave) { int lane; asm volatile("v_mbcnt_lo_u32_b32 %0, -1, 0\n\tv_mbcnt_hi_u32_b32 %0, -1, %0" : "=v"(lane)); return wave == 0 && lane == 0; }
DI XcdBarrier xcd_barrier_post(unsigned* bar, volatile LAS unsigned* st, int wave) {
    XcdBarrier b; b.bar = bar; b.x = xb_xcc_id(); b.st = st; b.wave = wave;
    if (is_thread0(wave)) (void)xb_add(&bar[XB_XCNT(b.x)], 1u);
    return b;
}
DI void xcd_barrier_complete(unsigned* bar, unsigned x, unsigned& nloc, unsigned& nx) {
    const unsigned G = gridDim.x * gridDim.y * gridDim.z;
    unsigned sum, cnt, mine, sp = 0u;
    for (;;) {
        sum = 0u; cnt = 0u; mine = 0u;
#pragma unroll
        for (unsigned j = 0; j < 16; ++j) { const unsigned c = xb_ld(&bar[XB_XCNT(j)]); sum += c; cnt += (c > 0u) ? 1u : 0u; mine = (j == x) ? c : mine; }
        if (sum == G) break;
        __builtin_amdgcn_s_sleep(1);
        if ((++sp & 255u) == 0u) { if (xb_ld(&bar[XB_TMO])) break; if (sp > XB_SPIN_CAP) { atomicAdd(&bar[XB_TMO], 1u); break; } }
    }
    nloc = mine > 0u ? mine : 1u; nx = cnt > 0u ? cnt : 1u;
}
DI void xcd_barrier(const XcdBarrier& b) {
    asm volatile("s_waitcnt vmcnt(0)" ::: "memory");
    __syncthreads();
    if (is_thread0(b.wave)) {
        unsigned* bar = b.bar;
        __builtin_amdgcn_s_waitcnt(0);
        unsigned nloc = b.st[0], nx = b.st[1];
        if (nloc == 0u) { xcd_barrier_complete(bar, b.x, nloc, nx); b.st[0] = nloc; b.st[1] = nx; }
        const unsigned old = xb_add(&bar[XB_XSUB(b.x)], 1u);
        const unsigned gen = old / nloc;
        if (old + 1u == (gen + 1u) * nloc) {
            __builtin_amdgcn_fence(__ATOMIC_RELEASE, "agent");
            asm volatile("s_waitcnt vmcnt(0)" ::: "memory");
            const unsigned og = xb_add(&bar[XB_TOP], 1u);
            const unsigned tg = og / nx;
            if (og + 1u == (tg + 1u) * nx) xb_add(&bar[XB_TOPGEN], 1u);
            else XB_SPIN(xb_ld(&bar[XB_TOPGEN]) == tg, bar);
            __builtin_amdgcn_fence(__ATOMIC_ACQUIRE, "agent");
            xb_add(&bar[XB_XGEN(b.x)], 1u);
            asm volatile("s_waitcnt vmcnt(0)" ::: "memory");
        } else {
            XB_SPIN(xb_ld(&bar[XB_XGEN(b.x)]) == gen, bar);
            __builtin_amdgcn_fence(__ATOMIC_ACQUIRE, "agent");
            asm volatile("s_waitcnt vmcnt(0)" ::: "memory");
        }
    }
    __syncthreads();
}

struct Args { const float* in[29]; float* out; unsigned char* ws; int ph_lo, ph_hi; };
struct Frame {
    LAS unsigned char* lds;
    unsigned char* ws;
    int tid, lane, wave, G, vcu;
};

DI Frame phase_frame(const Frame& F0) {
    Frame F = F0; int lane;
    asm volatile("v_mbcnt_lo_u32_b32 %0, -1, 0\n\tv_mbcnt_hi_u32_b32 %0, -1, %0" : "=v"(lane));
    F.lane = lane; F.tid = F0.wave * 64 + lane; return F;
}
namespace pg8 {
constexpr int BM = 256, BK = 64, HALF = 128, HTB = HALF * BK * 2, STAGE_BYTES = 8 * HTB, NXCD = 8, WGM = 8;
__host__ __device__ __forceinline__ int lds_byte(int r, int c) { const int st = (r >> 4) * 2 + (c >> 5), rr = r & 15, cc = c & 31, ob = rr * 64 + cc * 2; return st * 1024 + (ob ^ (((ob >> 9) & 1) << 5)); }
__host__ __device__ __forceinline__ void stage_rc(int b, int& R, int& C) { const int st = b / 1024, sb = b % 1024, swz = sb ^ (((sb >> 9) & 1) << 5); R = (st >> 1) * 16 + swz / 64; C = (st & 1) * 32 + (swz % 64) / 2; }
__host__ __device__ __forceinline__ int perm32(int rho) { const int n = rho >> 4, i = rho & 15; return 8 * (i >> 2) + 4 * n + (i & 3); }

struct Unit { int pm, pn, e, lb, rows; };

DI bool static_unit(int i, int G, int c, int nM, int nN, int& pm, int& pn, int off = 0) {
    const int nwg = nM * nN; const long L = (long)i * G + c + off; if (L >= nwg) return false;
    int wgid = (int)L; { const int q = nwg / NXCD, r = nwg % NXCD, xcd = wgid % NXCD, off = wgid / NXCD; wgid = (xcd < r ? xcd * (q + 1) : r * (q + 1) + (xcd - r) * q) + off; }
    const int nig = WGM * nN, gid = wgid / nig, fm = gid * WGM, gsz = (nM - fm) < WGM ? (nM - fm) : WGM;
    pm = fm + ((wgid % nig) % gsz); pn = (wgid % nig) / gsz; return true;
}
struct SchedDense {
    static constexpr bool GATHER = false;
    const char* A; const char* Bt; int K, nM, nN, G, c, off, maxi;
    DI void init(const void* A_, const void* Bt_, int M, int N, int K_, int G_, int c_, int off_ = 0, int maxi_ = 1 << 30) { A = (const char*)A_; Bt = (const char*)Bt_; K = K_; nM = M / BM; nN = N / BM; G = G_; c = c_; off = off_; maxi = maxi_; }
    DI bool next(int i, Unit& u) const { u.e = 0; u.rows = 256; if (i >= maxi) return false; const bool ok = static_unit(i, G, c, nM, nN, u.pm, u.pn, off); u.lb = u.pm; return ok; }
    DI const char* a_base(const Unit& u) const { return A + (size_t)u.pm * BM * K * 2; }
    DI const char* b_base(const Unit& u) const { return Bt + (size_t)u.pn * BM * K * 2; }
    DI void ts_load(const Unit&, const int (&)[2], int (&)[2][2]) const {}
    DI void a_offs(const Unit&, const int (&R)[2], const int (&C)[2], const int (&)[2][2], unsigned (&o)[2][2]) const {
#pragma unroll
        for (int h = 0; h < 2; ++h)
#pragma unroll
            for (int i = 0; i < 2; ++i) o[h][i] = (unsigned)((h * HALF + R[i]) * K + C[i]) * 2u;
    }
};
struct SchedMoe {
    const char* A; const char* Bt; int K, nM, nN, G, c, blk0; size_t bstride; const int* row_ts; const LAS int* tab; bool gather;
    DI bool next(int i, Unit& u) const {
        int pm, pn; if (!static_unit(i, G, c, nM, nN, pm, pn)) return false;
        const int gb = blk0 + pm; int e = 0;
#pragma unroll
        for (int j = 1; j < 8; ++j) e += (gb >= tab[8 + j]) ? 1 : 0;
        e = __builtin_amdgcn_readfirstlane(e);
        const int lb = gb - __builtin_amdgcn_readfirstlane(tab[8 + e]); const int rem = __builtin_amdgcn_readfirstlane(tab[e]) - lb * 256;
        u.pm = pm; u.pn = pn; u.e = e; u.lb = lb; u.rows = rem < 256 ? rem : 256; return true;
    }
    DI const char* b_base(const Unit& u) const { return Bt + (size_t)u.e * bstride + (size_t)u.pn * BM * K * 2; }
};
struct SchedMoeGU : SchedMoe {
    static constexpr bool GATHER = true;
    DI const char* a_base(const Unit&) const { return A; }
    DI void ts_load(const Unit& u, const int (&R)[2], int (&ts)[2][2]) const {
#pragma unroll
        for (int h = 0; h < 2; ++h)
#pragma unroll
            for (int i = 0; i < 2; ++i) { const int lr = h * HALF + R[i]; ts[h][i] = (lr < u.rows) ? row_ts[(size_t)u.e * CAP + u.lb * 256 + lr] : (T << 1); }
    }
    DI void a_offs(const Unit&, const int (&)[2], const int (&C)[2], const int (&ts)[2][2], unsigned (&o)[2][2]) const {
#pragma unroll
        for (int h = 0; h < 2; ++h)
#pragma unroll
            for (int i = 0; i < 2; ++i) o[h][i] = ((unsigned)(ts[h][i] >> 1) * (unsigned)K + (unsigned)C[i]) * 2u;
    }
};
struct SchedMoeDown : SchedMoe {
    static constexpr bool GATHER = false;
    DI const char* a_base(const Unit& u) const { return A + (size_t)u.pm * BM * K * 2; }
    DI void ts_load(const Unit&, const int (&)[2], int (&)[2][2]) const {}
    DI void a_offs(const Unit&, const int (&R)[2], const int (&C)[2], const int (&)[2][2], unsigned (&o)[2][2]) const {
#pragma unroll
        for (int h = 0; h < 2; ++h)
#pragma unroll
            for (int i = 0; i < 2; ++i) o[h][i] = (unsigned)((h * HALF + R[i]) * K + C[i]) * 2u;
    }
};

typedef f32x4 Acc[2][2][4][2];
typedef i32x4 AccI[2][2][4][2];
template <bool I8> struct AccSel { typedef f32x4 type; };
template <> struct AccSel<true> { typedef i32x4 type; };
DI u32x4 pack8(const f32x4& v0, const f32x4& v1) { u32x4 w; w.x = pk2(v0[0], v0[1]); w.y = pk2(v0[2], v0[3]); w.z = pk2(v1[0], v1[1]); w.w = pk2(v1[2], v1[3]); return w; }

struct EpiStoreBf16 {
    static constexpr bool PERM = true; static constexpr int MODE = 0; static constexpr bool ALIGN = true;
    bf16* O; int ldc;
    struct Pre {}; DI void prefetch(Pre&, const Unit&, int, int, int, int) const {}
    DI void operator()(const Acc& acc, const Unit& u, int wr, int wc, int fr, int fq, const Pre&) const {
        const int row0 = u.pm * BM + wr * 64 + fr, col0 = u.pn * BM + wc * 32 + 8 * fq;
#pragma unroll
        for (int ai = 0; ai < 2; ++ai)
#pragma unroll
            for (int m = 0; m < 4; ++m) { bf16* rowp = O + (size_t)(row0 + ai * HALF + m * 16) * ldc + col0;
#pragma unroll
                for (int bj = 0; bj < 2; ++bj) *(u32x4*)(rowp + bj * HALF) = pack8(acc[ai][bj][m][0], acc[ai][bj][m][1]); }
    }
};
struct EpiEvIn {
    static constexpr bool PERM = true; static constexpr int MODE = 0; static constexpr bool ALIGN = true;
    bf16* O;
    struct Pre {}; DI void prefetch(Pre&, const Unit&, int, int, int, int) const {}
    DI void operator()(const Acc& acc, const Unit& u, int wr, int wc, int fr, int fq, const Pre&) const {
        const int row0 = u.pm * BM + wr * 64 + fr;
        if (u.pn >= 2 && u.pn < 6) {
            const int col0 = 512 + (u.pn - 2) * HALF + wc * 32 + 8 * fq;
#pragma unroll
            for (int ai = 0; ai < 2; ++ai)
#pragma unroll
                for (int m = 0; m < 4; ++m) { bf16* rowp = O + (size_t)(row0 + ai * HALF + m * 16) * EVU + col0;
                    *(u32x4*)rowp = pack8(acc[ai][0][m][0] * acc[ai][1][m][0], acc[ai][0][m][1] * acc[ai][1][m][1]); }
        } else {
            const int col0 = u.pn * BM - (u.pn >= 6 ? 512 : 0) + wc * 32 + 8 * fq;
#pragma unroll
            for (int ai = 0; ai < 2; ++ai)
#pragma unroll
                for (int m = 0; m < 4; ++m) { bf16* rowp = O + (size_t)(row0 + ai * HALF + m * 16) * EVU + col0;
#pragma unroll
                    for (int bj = 0; bj < 2; ++bj) *(u32x4*)(rowp + bj * HALF) = pack8(acc[ai][bj][m][0], acc[ai][bj][m][1]); }
        }
    }
};
struct EpiSwiGLU {
    static constexpr bool PERM = true; static constexpr int MODE = 0; static constexpr bool ALIGN = true;
    bf16* O; int ldc;
    struct Pre {}; DI void prefetch(Pre&, const Unit&, int, int, int, int) const {}
    DI void operator()(const Acc& acc, const Unit& u, int wr, int wc, int fr, int fq, const Pre&) const {
        const int row0 = u.pm * BM + wr * 64 + fr, col0 = u.pn * HALF + wc * 32 + 8 * fq;
#pragma unroll
        for (int ai = 0; ai < 2; ++ai)
#pragma unroll
            for (int m = 0; m < 4; ++m) { bf16* rowp = O + (size_t)(row0 + ai * HALF + m * 16) * ldc + col0;
                f32x4 v0, v1;
#pragma unroll
                for (int j = 0; j < 4; ++j) { v0[j] = silu_f(acc[ai][0][m][0][j]) * acc[ai][1][m][0][j]; v1[j] = silu_f(acc[ai][0][m][1][j]) * acc[ai][1][m][1][j]; }
                *(u32x4*)rowp = pack8(v0, v1); }
    }
};
template <bool OUT8> struct EpiSwiGLUI8T {
    static constexpr bool PERM = true; static constexpr int MODE = 1; static constexpr bool ALIGN = true;
    bf16* O; int ldc; const float* row_sa; const float* sb;
    struct Pre { f32x4 sl0, sl1, sp0, sp1; float ra[2][4]; };
    DI void prefetch(Pre& p, const Unit& u, int wr, int wc, int fr, int fq) const {
        const size_t rbase = (size_t)u.e * CAP + u.lb * 256;
        const float* sbp = sb + (size_t)u.e * (2 * DFE) + u.pn * BM + wc * 32 + 8 * fq;
        const f32x4 sg0 = *(const f32x4*)sbp, sg1 = *(const f32x4*)(sbp + 4), su0 = *(const f32x4*)(sbp + HALF), su1 = *(const f32x4*)(sbp + HALF + 4);
        p.sl0 = sg0 * (-LOG2E); p.sl1 = sg1 * (-LOG2E); p.sp0 = sg0 * su0 * (OUT8 ? ACT8_SCALE : 1.f); p.sp1 = sg1 * su1 * (OUT8 ? ACT8_SCALE : 1.f);
#pragma unroll
        for (int ai = 0; ai < 2; ++ai)
#pragma unroll
            for (int m = 0; m < 4; ++m) { const int lr = ai * HALF + wr * 64 + m * 16 + fr; p.ra[ai][m] = (lr < u.rows) ? row_sa[rbase + lr] : 0.f; }
    }
    DI f32x2_t pair(const i32x4& g, const i32x4& u, int h2, f32x2_t t1, f32x2_t t2) const {
        const f32x2_t gf = {(float)g[2 * h2], (float)g[2 * h2 + 1]}, uf = {(float)u[2 * h2], (float)u[2 * h2 + 1]};
        const f32x2_t ea = gf * t1;
        f32x2_t e = {__builtin_amdgcn_exp2f(ea.x), __builtin_amdgcn_exp2f(ea.y)};
        e = e + 1.f;
        const f32x2_t r = {__builtin_amdgcn_rcpf(e.x), __builtin_amdgcn_rcpf(e.y)};
        f32x2_t o = (gf * uf) * t2; o = o * r;
        if constexpr (OUT8) { o.x = __builtin_amdgcn_fmed3f(o.x, -448.f, 448.f); o.y = __builtin_amdgcn_fmed3f(o.y, -448.f, 448.f); }
        return o;
    }
    DI void operator()(const AccI& acc, const Unit& u, int wr, int wc, int fr, int fq, const Pre& p) const {
        const int row0 = u.pm * BM + wr * 64 + fr, col0 = u.pn * HALF + wc * 32 + 8 * fq;
#pragma unroll
        for (int ai = 0; ai < 2; ++ai)
#pragma unroll
            for (int m = 0; m < 4; ++m) {
                const float ra = p.ra[ai][m], ra2 = ra * ra;
                const f32x4 t1a = p.sl0 * ra, t1b = p.sl1 * ra, t2a = p.sp0 * ra2, t2b = p.sp1 * ra2;
                const f32x2_t o0 = pair(acc[ai][0][m][0], acc[ai][1][m][0], 0, (f32x2_t){t1a[0], t1a[1]}, (f32x2_t){t2a[0], t2a[1]});
                const f32x2_t o1 = pair(acc[ai][0][m][0], acc[ai][1][m][0], 1, (f32x2_t){t1a[2], t1a[3]}, (f32x2_t){t2a[2], t2a[3]});
                const f32x2_t o2 = pair(acc[ai][0][m][1], acc[ai][1][m][1], 0, (f32x2_t){t1b[0], t1b[1]}, (f32x2_t){t2b[0], t2b[1]});
                const f32x2_t o3 = pair(acc[ai][0][m][1], acc[ai][1][m][1], 1, (f32x2_t){t1b[2], t1b[3]}, (f32x2_t){t2b[2], t2b[3]});
                if constexpr (OUT8) {
                    unsigned char* p8 = (unsigned char*)O + (size_t)(row0 + ai * HALF + m * 16) * ldc + col0;
                    int p0 = 0, p1 = 0; p0 = __builtin_amdgcn_cvt_pk_fp8_f32(o0.x, o0.y, p0, false); p0 = __builtin_amdgcn_cvt_pk_fp8_f32(o1.x, o1.y, p0, true);
                    p1 = __builtin_amdgcn_cvt_pk_fp8_f32(o2.x, o2.y, p1, false); p1 = __builtin_amdgcn_cvt_pk_fp8_f32(o3.x, o3.y, p1, true);
                    *(u32x2*)p8 = (u32x2){(unsigned)p0, (unsigned)p1};
                } else {
                    bf16* rowp = O + (size_t)(row0 + ai * HALF + m * 16) * ldc + col0;
                    u32x4 w; w.x = pk2(o0.x, o0.y); w.y = pk2(o1.x, o1.y); w.z = pk2(o2.x, o2.y); w.w = pk2(o3.x, o3.y);
                    *(u32x4*)rowp = w;
                }
            }
    }
};
typedef EpiSwiGLUI8T<false> EpiSwiGLUI8;
typedef EpiSwiGLUI8T<true> EpiSwiGLUI8F8;
struct EpiEvInI8 {
    static constexpr bool PERM = true; static constexpr int MODE = 1; static constexpr bool ALIGN = true;
    bf16* O; const float* sa; const float* sb;
    struct Pre { f32x4 s00, s01, s10, s11; float ra[2][4]; };
    DI void prefetch(Pre& p, const Unit& u, int wr, int wc, int fr, int fq) const {
        const float* sbp = sb + u.pn * BM + wc * 32 + 8 * fq; const int row0 = u.pm * BM + wr * 64 + fr;
        p.s00 = *(const f32x4*)sbp; p.s01 = *(const f32x4*)(sbp + 4); p.s10 = *(const f32x4*)(sbp + HALF); p.s11 = *(const f32x4*)(sbp + HALF + 4);
#pragma unroll
        for (int ai = 0; ai < 2; ++ai)
#pragma unroll
            for (int m = 0; m < 4; ++m) p.ra[ai][m] = sa[row0 + ai * HALF + m * 16];
    }
    DI void operator()(const AccI& acc, const Unit& u, int wr, int wc, int fr, int fq, const Pre& p) const {
        const int row0 = u.pm * BM + wr * 64 + fr;
        const f32x4 s00 = p.s00, s01 = p.s01, s10 = p.s10, s11 = p.s11;
        if (u.pn >= 2 && u.pn < 6) {
            const int col0 = 512 + (u.pn - 2) * HALF + wc * 32 + 8 * fq;
#pragma unroll
            for (int ai = 0; ai < 2; ++ai)
#pragma unroll
                for (int m = 0; m < 4; ++m) { const int row = row0 + ai * HALF + m * 16; const float ra = p.ra[ai][m]; bf16* rowp = O + (size_t)row * EVU + col0;
                    f32x4 v0, v1;
#pragma unroll
                    for (int j = 0; j < 4; ++j) { v0[j] = ((float)acc[ai][0][m][0][j] * (ra * s00[j])) * ((float)acc[ai][1][m][0][j] * (ra * s10[j])); v1[j] = ((float)acc[ai][0][m][1][j] * (ra * s01[j])) * ((float)acc[ai][1][m][1][j] * (ra * s11[j])); }
                    *(u32x4*)rowp = pack8(v0, v1); }
        } else {
            const int col0 = u.pn * BM - (u.pn >= 6 ? 512 : 0) + wc * 32 + 8 * fq;
#pragma unroll
            for (int ai = 0; ai < 2; ++ai)
#pragma unroll
                for (int m = 0; m < 4; ++m) { const int row = row0 + ai * HALF + m * 16; const float ra = p.ra[ai][m]; bf16* rowp = O + (size_t)row * EVU + col0;
                    f32x4 v0, v1, v2, v3;
#pragma unroll
                    for (int j = 0; j < 4; ++j) { v0[j] = (float)acc[ai][0][m][0][j] * (ra * s00[j]); v1[j] = (float)acc[ai][0][m][1][j] * (ra * s01[j]); v2[j] = (float)acc[ai][1][m][0][j] * (ra * s10[j]); v3[j] = (float)acc[ai][1][m][1][j] * (ra * s11[j]); }
                    *(u32x4*)rowp = pack8(v0, v1); *(u32x4*)(rowp + HALF) = pack8(v2, v3); }
        }
    }
};
struct EpiStoreBf16I8 {
    static constexpr bool PERM = true; static constexpr int MODE = 1; static constexpr bool ALIGN = true;
    bf16* O; int ldc; const float* sa; const float* sb;
    struct Pre { f32x4 s00, s01, s10, s11; float ra[2][4]; };
    DI void prefetch(Pre& p, const Unit& u, int wr, int wc, int fr, int fq) const {
        const float* sbp = sb + u.pn * BM + wc * 32 + 8 * fq; const int row0 = u.pm * BM + wr * 64 + fr;
        p.s00 = *(const f32x4*)sbp; p.s01 = *(const f32x4*)(sbp + 4); p.s10 = *(const f32x4*)(sbp + HALF); p.s11 = *(const f32x4*)(sbp + HALF + 4);
#pragma unroll
        for (int ai = 0; ai < 2; ++ai)
#pragma unroll
            for (int m = 0; m < 4; ++m) p.ra[ai][m] = sa[row0 + ai * HALF + m * 16];
    }
    DI void operator()(const AccI& acc, const Unit& u, int wr, int wc, int fr, int fq, const Pre& p) const {
        const int row0 = u.pm * BM + wr * 64 + fr, col0 = u.pn * BM + wc * 32 + 8 * fq;
        const f32x4 s00 = p.s00, s01 = p.s01, s10 = p.s10, s11 = p.s11;
#pragma unroll
        for (int ai = 0; ai < 2; ++ai)
#pragma unroll
            for (int m = 0; m < 4; ++m) { const int row = row0 + ai * HALF + m * 16; const float ra = p.ra[ai][m]; bf16* rowp = O + (size_t)row * ldc + col0;
                f32x4 v0, v1, v2, v3;
#pragma unroll
                for (int j = 0; j < 4; ++j) { v0[j] = (float)acc[ai][0][m][0][j] * (ra * s00[j]); v1[j] = (float)acc[ai][0][m][1][j] * (ra * s01[j]); v2[j] = (float)acc[ai][1][m][0][j] * (ra * s10[j]); v3[j] = (float)acc[ai][1][m][1][j] * (ra * s11[j]); }
                *(u32x4*)rowp = pack8(v0, v1); *(u32x4*)(rowp + HALF) = pack8(v2, v3); }
    }
};
struct EpiPleGateI8 {
    static constexpr bool PERM = true; static constexpr int MODE = 1; static constexpr bool ALIGN = true;
    bf16* h; const bf16* tmp; const float* sa; const float* sb;
    struct Pre { f32x4 sv[2][2]; u32x4 bv[2][2]; u32x4 tv[2][2]; float ra[2]; };
    DI void load_batch(u32x4 (&bv)[2][2], u32x4 (&tv)[2][2], float (&ra)[2], const Unit& u, int wr, int wc, int fr, int fq, int ai, int mp) const {
        const int row0 = u.pm * BM + wr * 64 + fr, col0 = u.pn * BM + wc * 32 + 8 * fq;
#pragma unroll
        for (int mm = 0; mm < 2; ++mm) { const int row = row0 + ai * HALF + (2 * mp + mm) * 16; ra[mm] = sa[row]; const size_t off = (size_t)row * D + col0;
#pragma unroll
            for (int bj = 0; bj < 2; ++bj) { tv[mm][bj] = *(const u32x4*)(tmp + off + bj * HALF); bv[mm][bj] = *(const u32x4*)(h + off + bj * HALF); } }
    }
    DI void prefetch(Pre& p, const Unit& u, int wr, int wc, int fr, int fq) const {
        const int col0 = u.pn * BM + wc * 32 + 8 * fq;
#pragma unroll
        for (int bj = 0; bj < 2; ++bj)
#pragma unroll
            for (int n = 0; n < 2; ++n) p.sv[bj][n] = *(const f32x4*)(sb + col0 + bj * HALF + n * 4) * (-LOG2E);
        load_batch(p.bv, p.tv, p.ra, u, wr, wc, fr, fq, 0, 0);
    }
    DI void operator()(const AccI& acc, const Unit& u, int wr, int wc, int fr, int fq, const Pre& p) const {
        const int row0 = u.pm * BM + wr * 64 + fr, col0 = u.pn * BM + wc * 32 + 8 * fq;
#pragma unroll
        for (int ai = 0; ai < 2; ++ai)
#pragma unroll
            for (int mp = 0; mp < 2; ++mp) {
                u32x4 bv[2][2]; u32x4 tv[2][2]; float ra[2];
                if (ai == 0 && mp == 0) {
#pragma unroll
                    for (int mm = 0; mm < 2; ++mm) { ra[mm] = p.ra[mm];
#pragma unroll
                        for (int bj = 0; bj < 2; ++bj) { tv[mm][bj] = p.tv[mm][bj]; bv[mm][bj] = p.bv[mm][bj]; } }
                } else load_batch(bv, tv, ra, u, wr, wc, fr, fq, ai, mp);
                asm volatile("" ::: "memory");
#pragma unroll
                for (int mm = 0; mm < 2; ++mm) { const int m = 2 * mp + mm; const size_t off = (size_t)(row0 + ai * HALF + m * 16) * D + col0;
#pragma unroll
                    for (int bj = 0; bj < 2; ++bj) { f32x4 r[2];
#pragma unroll
                        for (int n = 0; n < 2; ++n) { const i32x4 a = acc[ai][bj][m][n]; const f32x4 sc = p.sv[bj][n] * ra[mm];
                            const unsigned t0 = n ? tv[mm][bj].z : tv[mm][bj].x, t1 = n ? tv[mm][bj].w : tv[mm][bj].y;
                            const unsigned b0 = n ? bv[mm][bj].z : bv[mm][bj].x, b1 = n ? bv[mm][bj].w : bv[mm][bj].y;
                            const f32x2_t e0 = (f32x2_t){(float)a[0], (float)a[1]} * (f32x2_t){sc[0], sc[1]}, e1 = (f32x2_t){(float)a[2], (float)a[3]} * (f32x2_t){sc[2], sc[3]};
                            const f32x2_t d0 = (f32x2_t){__builtin_amdgcn_exp2f(e0.x), __builtin_amdgcn_exp2f(e0.y)} + 1.f, d1 = (f32x2_t){__builtin_amdgcn_exp2f(e1.x), __builtin_amdgcn_exp2f(e1.y)} + 1.f;
                            const f32x2_t s0 = {__builtin_amdgcn_rcpf(d0.x), __builtin_amdgcn_rcpf(d0.y)}, s1 = {__builtin_amdgcn_rcpf(d1.x), __builtin_amdgcn_rcpf(d1.y)};
                            const f32x2_t q0 = (f32x2_t){bflo(t0), bfhi(t0)} * s0 + (f32x2_t){bflo(b0), bfhi(b0)}, q1 = (f32x2_t){bflo(t1), bfhi(t1)} * s1 + (f32x2_t){bflo(b1), bfhi(b1)};
                            r[n][0] = q0.x; r[n][1] = q0.y; r[n][2] = q1.x; r[n][3] = q1.y; }
                        *(u32x4*)(h + off + bj * HALF) = pack8(r[0], r[1]); } }
                asm volatile("" ::: "memory");
            }
    }
};
struct EpiPleGateFinal {
    static constexpr bool PERM = true; static constexpr int MODE = 1; static constexpr bool ALIGN = true;
    unsigned char* ws; const float* gfin; float* out; LAS unsigned char* lds;
    struct Pre { f32x4 sv[2][2]; };
    DI void load_group(u32x4 (&bv)[2], u32x4 (&tv)[2], float& ra, const Unit& u, int wr, int wc, int fr, int fq, int ai, int m) const {
        const bf16* h = (const bf16*)(ws + WS_XB); const bf16* tmp = (const bf16*)(ws + WS_Y); const float* sa = (const float*)(ws + WS_SA);
        const int row = u.pm * BM + wr * 64 + fr + ai * HALF + m * 16, col0 = u.pn * BM + wc * 32 + 8 * fq; ra = sa[row]; const size_t off = (size_t)row * D + col0;
#pragma unroll
        for (int bj = 0; bj < 2; ++bj) { tv[bj] = *(const u32x4*)(tmp + off + bj * HALF); bv[bj] = *(const u32x4*)(h + off + bj * HALF); }
    }
    DI void prefetch(Pre& p, const Unit& u, int wr, int wc, int fr, int fq) const {
        const int col0 = u.pn * BM + wc * 32 + 8 * fq;
#pragma unroll
        for (int bj = 0; bj < 2; ++bj)
#pragma unroll
            for (int n = 0; n < 2; ++n) p.sv[bj][n] = *(const f32x4*)((const float*)(ws + WS_SB) + SBO_PGATE + D + col0 + bj * HALF + n * 4) * (-LOG2E);
    }
    DI void operator()(AccI& acc, const Unit& u, int wr, int wc, int fr, int fq, const Pre& p) const {
        const int row0 = u.pm * BM + wr * 64 + fr, col0 = u.pn * BM + wc * 32 + 8 * fq;
        float ssq[2][4];
#pragma unroll
        for (int ai = 0; ai < 2; ++ai)
#pragma unroll
            for (int m = 0; m < 4; ++m) {
                u32x4 bv[2], tv[2]; float ra; load_group(bv, tv, ra, u, wr, wc, fr, fq, ai, m);
                asm volatile("" ::: "memory");
                float sq = 0.f;
#pragma unroll
                for (int bj = 0; bj < 2; ++bj)
#pragma unroll
                    for (int n = 0; n < 2; ++n) { const i32x4 a = acc[ai][bj][m][n]; const f32x4 sc = p.sv[bj][n] * ra;
                        const unsigned t0 = n ? tv[bj].z : tv[bj].x, t1 = n ? tv[bj].w : tv[bj].y;
                        const unsigned b0 = n ? bv[bj].z : bv[bj].x, b1 = n ? bv[bj].w : bv[bj].y;
                        const f32x2_t e0 = (f32x2_t){(float)a[0], (float)a[1]} * (f32x2_t){sc[0], sc[1]}, e1 = (f32x2_t){(float)a[2], (float)a[3]} * (f32x2_t){sc[2], sc[3]};
                        const f32x2_t d0 = (f32x2_t){__builtin_amdgcn_exp2f(e0.x), __builtin_amdgcn_exp2f(e0.y)} + 1.f, d1 = (f32x2_t){__builtin_amdgcn_exp2f(e1.x), __builtin_amdgcn_exp2f(e1.y)} + 1.f;
                        const f32x2_t s0 = {__builtin_amdgcn_rcpf(d0.x), __builtin_amdgcn_rcpf(d0.y)}, s1 = {__builtin_amdgcn_rcpf(d1.x), __builtin_amdgcn_rcpf(d1.y)};
                        const f32x2_t q0 = (f32x2_t){bflo(t0), bfhi(t0)} * s0 + (f32x2_t){bflo(b0), bfhi(b0)}, q1 = (f32x2_t){bflo(t1), bfhi(t1)} * s1 + (f32x2_t){bflo(b1), bfhi(b1)};
                        const f32x4 r = {q0.x, q0.y, q1.x, q1.y};
                        sq += (r[0] * r[0] + r[1] * r[1]) + (r[2] * r[2] + r[3] * r[3]);
                        acc[ai][bj][m][n] = __builtin_bit_cast(i32x4, r); }
                ssq[ai][m] = sq;
                asm volatile("" ::: "memory");
            }
        LAS float* P = (LAS float*)(lds + 131072); LAS float* S = P + 4096;
#pragma unroll
        for (int ai = 0; ai < 2; ++ai)
#pragma unroll
            for (int m = 0; m < 4; ++m) P[(ai * HALF + wr * 64 + m * 16 + fr) * 16 + wc * 4 + fq] = ssq[ai][m];
        asm volatile("s_waitcnt lgkmcnt(0)" ::: "memory"); __builtin_amdgcn_s_barrier(); asm volatile("" ::: "memory");
        const int wid = wr * 4 + wc, lane = fq * 16 + fr, row = wid * 32 + (lane & 31);
        unsigned* slot = (unsigned*)(ws + WS_XS) + ((size_t)(u.pm * BM + row)) * 4;
        if (lane < 32) { const f32x4 p0 = *(const LAS f32x4*)(P + row * 16), p1 = *(const LAS f32x4*)(P + row * 16 + 4), p2 = *(const LAS f32x4*)(P + row * 16 + 8), p3 = *(const LAS f32x4*)(P + row * 16 + 12);
            const f32x4 pp = (p0 + p1) + (p2 + p3); const float tsum = (pp[0] + pp[1]) + (pp[2] + pp[3]);
            __hip_atomic_store(slot + u.pn, __float_as_uint(tsum), __ATOMIC_RELAXED, __HIP_MEMORY_SCOPE_AGENT); }
        asm volatile("s_waitcnt vmcnt(0)" ::: "memory");
        unsigned* pc = (unsigned*)(ws + WS_CTL) + CW_PCNT + 64 * u.pm;
        if (lane == 0) __hip_atomic_fetch_add(pc, 1u, __ATOMIC_RELAXED, __HIP_MEMORY_SCOPE_AGENT);
        if (wid == 0) {
            for (unsigned spin = 0; spin < 400000u; ++spin) {
                if ((unsigned)__builtin_amdgcn_readfirstlane((int)__hip_atomic_load(pc, __ATOMIC_RELAXED, __HIP_MEMORY_SCOPE_AGENT)) >= 32u) break;
                __builtin_amdgcn_s_sleep(2);
            }
            __builtin_amdgcn_fence(__ATOMIC_ACQUIRE, "agent");
        }
        asm volatile("s_waitcnt vmcnt(0) lgkmcnt(0)" ::: "memory"); __builtin_amdgcn_s_barrier(); asm volatile("" ::: "memory");
        if (lane < 32) {
            const float x0 = __uint_as_float(__hip_atomic_load(slot + 0, __ATOMIC_RELAXED, __HIP_MEMORY_SCOPE_AGENT)), x1 = __uint_as_float(__hip_atomic_load(slot + 1, __ATOMIC_RELAXED, __HIP_MEMORY_SCOPE_AGENT));
            const float x2 = __uint_as_float(__hip_atomic_load(slot + 2, __ATOMIC_RELAXED, __HIP_MEMORY_SCOPE_AGENT)), x3 = __uint_as_float(__hip_atomic_load(slot + 3, __ATOMIC_RELAXED, __HIP_MEMORY_SCOPE_AGENT));
            S[row] = rsqrtf(((x0 + x1) + (x2 + x3)) * (1.f / D) + EPS);
        }
        asm volatile("s_waitcnt vmcnt(0) lgkmcnt(0)" ::: "memory"); __builtin_amdgcn_s_barrier(); asm volatile("" ::: "memory");
        f32x4 gv[2][2];
#pragma unroll
        for (int bj = 0; bj < 2; ++bj)
#pragma unroll
            for (int n = 0; n < 2; ++n) gv[bj][n] = *(const f32x4*)(gfin + col0 + bj * HALF + n * 4);
#pragma unroll
        for (int ai = 0; ai < 2; ++ai)
#pragma unroll
            for (int m = 0; m < 4; ++m) { const float rs = S[ai * HALF + wr * 64 + m * 16 + fr]; float* orow = out + (size_t)(row0 + ai * HALF + m * 16) * D + col0;
#pragma unroll
                for (int bj = 0; bj < 2; ++bj)
#pragma unroll
                    for (int n = 0; n < 2; ++n) *(f32x4*)(orow + bj * HALF + n * 4) = __builtin_bit_cast(f32x4, acc[ai][bj][m][n]) * rs * gv[bj][n]; }
    }
};
struct EpiResid {
    static constexpr bool PERM = true; static constexpr int MODE = 0; static constexpr bool ALIGN = true;
    const float* base; bf16* out;
    struct Pre { f32x4 bv[2][2][2]; };
    DI void load_batch(f32x4 (&bv)[2][2][2], const Unit& u, int wr, int wc, int fr, int fq, int ai, int mp) const {
        const int row0 = u.pm * BM + wr * 64 + fr, col0 = u.pn * BM + wc * 32 + 8 * fq;
#pragma unroll
        for (int mm = 0; mm < 2; ++mm) { const size_t off = (size_t)(row0 + ai * HALF + (2 * mp + mm) * 16) * D + col0;
#pragma unroll
            for (int bj = 0; bj < 2; ++bj)
#pragma unroll
                for (int n = 0; n < 2; ++n) bv[mm][bj][n] = __builtin_nontemporal_load((const f32x4*)(base + off + bj * HALF + n * 4)); }
    }
    DI void prefetch(Pre& p, const Unit& u, int wr, int wc, int fr, int fq) const { load_batch(p.bv, u, wr, wc, fr, fq, 0, 0); }
    DI void operator()(const Acc& acc, const Unit& u, int wr, int wc, int fr, int fq, const Pre& p) const {
        const int row0 = u.pm * BM + wr * 64 + fr, col0 = u.pn * BM + wc * 32 + 8 * fq;
#pragma unroll
        for (int ai = 0; ai < 2; ++ai)
#pragma unroll
            for (int mp = 0; mp < 2; ++mp) {
                f32x4 bv[2][2][2];
                if (ai == 0 && mp == 0) {
#pragma unroll
                    for (int mm = 0; mm < 2; ++mm)
#pragma unroll
                        for (int bj = 0; bj < 2; ++bj)
#pragma unroll
                            for (int n = 0; n < 2; ++n) bv[mm][bj][n] = p.bv[mm][bj][n];
                } else load_batch(bv, u, wr, wc, fr, fq, ai, mp);
                asm volatile("" ::: "memory");
#pragma unroll
                for (int mm = 0; mm < 2; ++mm) { const int m = 2 * mp + mm; const size_t off = (size_t)(row0 + ai * HALF + m * 16) * D + col0;
#pragma unroll
                    for (int bj = 0; bj < 2; ++bj) *(u32x4*)(out + off + bj * HALF) = pack8(bv[mm][bj][0] + acc[ai][bj][m][0], bv[mm][bj][1] + acc[ai][bj][m][1]); }
                asm volatile("" ::: "memory");
            }
    }
};
struct EpiResidB {
    static constexpr bool PERM = true; static constexpr int MODE = 0; static constexpr bool ALIGN = true;
    bf16* h;
    struct Pre { u32x4 bv[4][2]; };
    DI void load_batch(u32x4 (&bv)[4][2], const Unit& u, int wr, int wc, int fr, int fq, int ai) const {
        const int row0 = u.pm * BM + wr * 64 + fr, col0 = u.pn * BM + wc * 32 + 8 * fq;
#pragma unroll
        for (int m = 0; m < 4; ++m) { const size_t off = (size_t)(row0 + ai * HALF + m * 16) * D + col0;
#pragma unroll
            for (int bj = 0; bj < 2; ++bj) bv[m][bj] = *(const u32x4*)(h + off + bj * HALF); }
    }
    DI void prefetch(Pre& p, const Unit& u, int wr, int wc, int fr, int fq) const { load_batch(p.bv, u, wr, wc, fr, fq, 0); }
    DI void operator()(const Acc& acc, const Unit& u, int wr, int wc, int fr, int fq, const Pre& p) const {
        const int row0 = u.pm * BM + wr * 64 + fr, col0 = u.pn * BM + wc * 32 + 8 * fq;
        u32x4 b1[4][2]; load_batch(b1, u, wr, wc, fr, fq, 1);
        asm volatile("" ::: "memory");
#pragma unroll
        for (int ai = 0; ai < 2; ++ai) {
#pragma unroll
            for (int m = 0; m < 4; ++m) { const size_t off = (size_t)(row0 + ai * HALF + m * 16) * D + col0;
#pragma unroll
                for (int bj = 0; bj < 2; ++bj) { const u32x4 b = ai ? b1[m][bj] : p.bv[m][bj]; const f32x4 a0 = acc[ai][bj][m][0], a1 = acc[ai][bj][m][1];
                    f32x4 r0, r1; r0[0] = bflo(b.x) + a0[0]; r0[1] = bfhi(b.x) + a0[1]; r0[2] = bflo(b.y) + a0[2]; r0[3] = bfhi(b.y) + a0[3];
                    r1[0] = bflo(b.z) + a1[0]; r1[1] = bfhi(b.z) + a1[1]; r1[2] = bflo(b.w) + a1[2]; r1[3] = bfhi(b.w) + a1[3];
                    *(u32x4*)(h + off + bj * HALF) = pack8(r0, r1); } }
            asm volatile("" ::: "memory");
        }
    }
};
struct EpiPleGate {
    static constexpr bool PERM = false; static constexpr int MODE = 0; static constexpr bool ALIGN = true;
    float* h; const bf16* tmp;
    struct Pre {}; DI void prefetch(Pre&, const Unit&, int, int, int, int) const {}
    DI void operator()(const Acc& acc, const Unit& u, int wr, int wc, int fr, int fq, const Pre&) const {
        const int row0 = u.pm * BM + wr * 64 + fr, col0 = u.pn * BM + wc * 32 + 4 * fq;
#pragma unroll
        for (int ai = 0; ai < 2; ++ai)
#pragma unroll
            for (int m = 0; m < 4; ++m) { const size_t off = (size_t)(row0 + ai * HALF + m * 16) * D + col0;
#pragma unroll
                for (int bj = 0; bj < 2; ++bj)
#pragma unroll
                    for (int n = 0; n < 2; ++n) { const size_t o = off + bj * HALF + n * 16; const f32x4 b = *(const f32x4*)(h + o); const u32x2 t = *(const u32x2*)(tmp + o); const f32x4 a = acc[ai][bj][m][n];
                        f32x4 r; r[0] = b[0] + bflo(t.x) * sigmoid_f(a[0]); r[1] = b[1] + bfhi(t.x) * sigmoid_f(a[1]); r[2] = b[2] + bflo(t.y) * sigmoid_f(a[2]); r[3] = b[3] + bfhi(t.y) * sigmoid_f(a[3]);
                        *(f32x4*)(h + o) = r; } }
    }
};
struct EpiMoeDown {
    static constexpr bool PERM = true; static constexpr int MODE = 2; static constexpr bool ALIGN = true;
    bf16* Y; const int* row_ts; const float* row_gate; const float* sb;
    struct Pre { f32x4 sc[2][2]; int ts[2][4]; float g[2][4]; };
    DI void prefetch(Pre& p, const Unit& u, int wr, int wc, int fr, int fq) const {
        const int col0 = u.pn * BM + wc * 32 + 8 * fq; const size_t rbase = (size_t)u.e * CAP + u.lb * 256;
        const float* sbp = sb + (size_t)u.e * D + col0;
        p.sc[0][0] = *(const f32x4*)sbp; p.sc[0][1] = *(const f32x4*)(sbp + 4); p.sc[1][0] = *(const f32x4*)(sbp + HALF); p.sc[1][1] = *(const f32x4*)(sbp + HALF + 4);
#pragma unroll
        for (int ai = 0; ai < 2; ++ai)
#pragma unroll
            for (int m = 0; m < 4; ++m) { const int lr = ai * HALF + wr * 64 + m * 16 + fr; const bool ok = lr < u.rows; p.ts[ai][m] = ok ? row_ts[rbase + lr] : -1; p.g[ai][m] = ok ? row_gate[rbase + lr] : 0.f; }
    }
    DI void operator()(const Acc& acc, const Unit& u, int wr, int wc, int fr, int fq, const Pre& p) const {
        const int col0 = u.pn * BM + wc * 32 + 8 * fq;
#pragma unroll
        for (int ai = 0; ai < 2; ++ai)
#pragma unroll
            for (int m = 0; m < 4; ++m) {
                if (p.ts[ai][m] >= 0) { const float g = p.g[ai][m] * (1.f / ACT8_SCALE); bf16* rowp = Y + (size_t)p.ts[ai][m] * D + col0;
#pragma unroll
                    for (int bj = 0; bj < 2; ++bj) *(u32x4*)(rowp + bj * HALF) = pack8(acc[ai][bj][m][0] * (p.sc[bj][0] * g), acc[ai][bj][m][1] * (p.sc[bj][1] * g)); } }
    }
};

DI f32x4 mma16(const bf16x8& a, const bf16x8& b, const f32x4& c) { return __builtin_amdgcn_mfma_f32_16x16x32_bf16(a, b, c, 0, 0, 0); }
DI i32x4 mma16(const bf16x8& a, const bf16x8& b, const i32x4& c) { return __builtin_amdgcn_mfma_i32_16x16x64_i8(__builtin_bit_cast(i32x4, a), __builtin_bit_cast(i32x4, b), c, 0, 0, 0); }
typedef int i32x8 __attribute__((ext_vector_type(8)));
DI f32x4 mma_fp8(const bf16x8& a0, const bf16x8& a1, const bf16x8& b0, const bf16x8& b1, const f32x4& c) {
    const i32x4 x0 = __builtin_bit_cast(i32x4, a0), x1 = __builtin_bit_cast(i32x4, a1), y0 = __builtin_bit_cast(i32x4, b0), y1 = __builtin_bit_cast(i32x4, b1);
    const i32x8 a = __builtin_shufflevector(x0, x1, 0, 1, 2, 3, 4, 5, 6, 7), b = __builtin_shufflevector(y0, y1, 0, 1, 2, 3, 4, 5, 6, 7);
    f32x4 d = c; const int sc = 0x7f7f7f7f;
    asm("v_mfma_scale_f32_16x16x128_f8f6f4 %0, %1, %2, %0, %3, %3 op_sel_hi:[0,0,0]" : "+v"(d) : "v"(a), "v"(b), "v"(sc));
    return d;
}
template <class Epi, class Sched>
DI void gemm_phase(LAS unsigned char* lds, const Sched& S, const Epi& E, int wave_id) {
    constexpr bool GATHER = Sched::GATHER; constexpr int MODE = Epi::MODE; constexpr bool ALIGN = Epi::ALIGN; typedef typename AccSel<MODE == 1>::type acc_t;
    int lane_; asm volatile("v_mbcnt_lo_u32_b32 %0, -1, 0\n\tv_mbcnt_hi_u32_b32 %0, -1, %0" : "=v"(lane_));
    const int wid = wave_id, lane = lane_, tid = wid * 64 + lane, wr = wid >> 2, wc = wid & 3, fq = lane >> 4; int fr = lane & 15;
    const int K = S.K, nt = K / BK;
    int Rr[2], Cc[2]; unsigned voffB[2];
#pragma unroll
    for (int i = 0; i < 2; ++i) { int R, C; stage_rc(tid * 16 + i * 8192, R, C); Rr[i] = R; Cc[i] = C; const int Rb = Epi::PERM ? ((R & ~31) + perm32(R & 31)) : R; voffB[i] = (unsigned)(Rb * K + C) * 2u; }
    const size_t kstep = (size_t)(BK * 2);
    const size_t hstep = (size_t)HALF * K * 2;
    const unsigned ldsw = (unsigned)wid * 1024u;
    const int aoff = lds_byte(wr * 64 + fr, fq * 8), boff = lds_byte(wc * 32 + fr, fq * 8);
#define PG8_SA(b, h) (((b) * 2 + (h)) * HTB)
#define PG8_SB(b, h) ((4 + (b) * 2 + (h)) * HTB)
#define PG8_STAGE(bufoff, gbase, voff) do { _Pragma("unroll") for (int _i = 0; _i < 2; ++_i) \
        __builtin_amdgcn_global_load_lds((const unsigned*)((const char*)(gbase) + (voff)[_i]), (LAS unsigned*)(lds + (bufoff) + ldsw + _i * 8192), 16, 0, 0); } while (0)
#define PG8_LDA(dst, b, h) do { _Pragma("unroll") for (int m = 0; m < 4; ++m) _Pragma("unroll") for (int k = 0; k < 2; ++k) dst[m][k] = *(const LAS bf16x8*)(lds + PG8_SA(b, h) + aoff + m * 2048 + k * 1024); } while (0)
#define PG8_LDB(dst, b, h) do { _Pragma("unroll") for (int n = 0; n < 2; ++n) _Pragma("unroll") for (int k = 0; k < 2; ++k) dst[n][k] = *(const LAS bf16x8*)(lds + PG8_SB(b, h) + boff + n * 2048 + k * 1024); } while (0)
#define PG8_MMA(ai, bj, At, Bt) do { __builtin_amdgcn_s_setprio(1); _Pragma("unroll") for (int m = 0; m < 4; ++m) _Pragma("unroll") for (int n = 0; n < 2; ++n) { \
        if constexpr (MODE == 2) acc[ai][bj][m][n] = mma_fp8(Bt[n][0], Bt[n][1], At[m][0], At[m][1], acc[ai][bj][m][n]); \
        else { _Pragma("unroll") for (int k = 0; k < 2; ++k) acc[ai][bj][m][n] = mma16(Bt[n][k], At[m][k], acc[ai][bj][m][n]); } } __builtin_amdgcn_s_setprio(0); } while (0)
#define PG8_WAIT_V(n) asm volatile("s_waitcnt vmcnt(" #n ")" ::: "memory")
#define PG8_WAIT_L(n) asm volatile("s_waitcnt lgkmcnt(" #n ")" ::: "memory")
#define PG8_BAR __builtin_amdgcn_s_barrier()
#define PG8_SCHED __builtin_amdgcn_sched_barrier(0)
    Unit cur, nxt, nn; int ui = 0;
    if (!S.next(0, cur)) return;
    acc_t acc[2][2][4][2];
#pragma unroll
    for (int a = 0; a < 2; ++a)
#pragma unroll
        for (int b = 0; b < 2; ++b)
#pragma unroll
            for (int m = 0; m < 4; ++m)
#pragma unroll
                for (int n = 0; n < 2; ++n) acc[a][b][m][n] = (acc_t){0, 0, 0, 0};
    bf16x8 At[4][2], B0[2][2], B1[2][2];
    unsigned vA[2][2], nvA[2][2]; int pts[2][2] = {{0, 0}, {0, 0}};
    { int ts0[2][2] = {{0, 0}, {0, 0}}; S.ts_load(cur, Rr, ts0); S.a_offs(cur, Rr, Cc, ts0, vA); }
    bool has_next = S.next(1, nxt);
    if (GATHER && has_next) S.ts_load(nxt, Rr, pts);
    const char* cA = S.a_base(cur); const char* cB = S.b_base(cur);
    PG8_STAGE(PG8_SB(0, 0), cB, voffB); PG8_STAGE(PG8_SB(0, 1), cB + hstep, voffB); PG8_STAGE(PG8_SA(0, 0), cA, vA[0]); PG8_STAGE(PG8_SA(0, 1), cA, vA[1]);
    if (wr == 1) PG8_BAR;
    PG8_WAIT_V(2); PG8_BAR;
    PG8_STAGE(PG8_SB(1, 0), cB + kstep, voffB); PG8_STAGE(PG8_SA(1, 0), cA + kstep, vA[0]); PG8_STAGE(PG8_SB(1, 1), cB + hstep + kstep, voffB);
    PG8_WAIT_V(6); PG8_BAR;
    for (;;) {
        const char* nA = has_next ? S.a_base(nxt) : cA; const char* nB = has_next ? S.b_base(nxt) : cB;
        if constexpr (GATHER) {
            if (has_next) S.a_offs(nxt, Rr, Cc, pts, nvA);
            else {
#pragma unroll
                for (int h = 0; h < 2; ++h)
#pragma unroll
                    for (int i = 0; i < 2; ++i) nvA[h][i] = vA[h][i];
            }
        }
        const bool has_nn = has_next && S.next(ui + 2, nn);
        if (GATHER && has_nn) S.ts_load(nn, Rr, pts);
        for (int t = 0; t < nt; t += 2) {
            const bool last = (t == nt - 2);
            const char* a1 = cA + (size_t)(t + 1) * kstep;
            const char* a2 = last ? nA : cA + (size_t)(t + 2) * kstep; const char* b2 = last ? nB : cB + (size_t)(t + 2) * kstep;
            const char* a3 = a2 + kstep; const char* b3 = b2 + kstep;
            unsigned w0[2], w1[2];
            if (GATHER) { w0[0] = last ? nvA[0][0] : vA[0][0]; w0[1] = last ? nvA[0][1] : vA[0][1]; w1[0] = last ? nvA[1][0] : vA[1][0]; w1[1] = last ? nvA[1][1] : vA[1][1]; }
            else { w0[0] = vA[0][0]; w0[1] = vA[0][1]; w1[0] = vA[1][0]; w1[1] = vA[1][1]; }
            PG8_LDB(B0, 0, 0); PG8_LDB(B1, 0, 1); PG8_SCHED; PG8_LDA(At, 0, 0); PG8_STAGE(PG8_SA(1, 1), a1, vA[1]);
            PG8_WAIT_V(8); PG8_WAIT_L(0); PG8_BAR; PG8_MMA(0, 0, At, B0); PG8_MMA(0, 1, At, B1); PG8_BAR; PG8_SCHED;
            PG8_LDA(At, 0, 1); PG8_STAGE(PG8_SA(0, 0), a2, w0); PG8_STAGE(PG8_SB(0, 0), b2, voffB); PG8_STAGE(PG8_SB(0, 1), b2 + hstep, voffB);
            PG8_WAIT_V(8); PG8_WAIT_L(0); PG8_BAR; PG8_MMA(1, 0, At, B0); PG8_MMA(1, 1, At, B1); PG8_BAR; PG8_SCHED;
            PG8_LDB(B0, 1, 0); PG8_LDB(B1, 1, 1); PG8_SCHED; PG8_LDA(At, 1, 0); PG8_STAGE(PG8_SA(0, 1), a2, w1);
            PG8_WAIT_V(8); PG8_WAIT_L(0); PG8_BAR; PG8_MMA(0, 0, At, B0); PG8_MMA(0, 1, At, B1); PG8_BAR; PG8_SCHED;
            PG8_LDA(At, 1, 1); PG8_STAGE(PG8_SA(1, 0), a3, w0); PG8_STAGE(PG8_SB(1, 0), b3, voffB); PG8_STAGE(PG8_SB(1, 1), b3 + hstep, voffB);
            PG8_WAIT_V(8); PG8_WAIT_L(0); PG8_BAR; PG8_MMA(1, 0, At, B0); PG8_MMA(1, 1, At, B1); PG8_BAR; PG8_SCHED;
        }
        typename Epi::Pre pre; E.prefetch(pre, cur, wr, wc, fr, fq);
        if constexpr (ALIGN) { if (wr == 0) PG8_BAR; }
        if constexpr (MODE == 2) asm volatile("s_nop 15\n\ts_nop 7" ::: "memory");
        E(acc, cur, wr, wc, fr, fq, pre);
        if (!has_next) break;
#pragma unroll
        for (int a = 0; a < 2; ++a)
#pragma unroll
            for (int b = 0; b < 2; ++b)
#pragma unroll
                for (int m = 0; m < 4; ++m)
#pragma unroll
                    for (int n = 0; n < 2; ++n) acc[a][b][m][n] = (acc_t){0, 0, 0, 0};
        cur = nxt; cA = nA; cB = nB; ++ui;
        if constexpr (GATHER) {
#pragma unroll
            for (int h = 0; h < 2; ++h)
#pragma unroll
                for (int i = 0; i < 2; ++i) vA[h][i] = nvA[h][i];
        }
        nxt = nn; has_next = has_nn;
        if constexpr (ALIGN) { if (wr == 1) PG8_BAR; }
    }
    PG8_WAIT_V(0);
    if constexpr (!ALIGN) { if (wr == 0) PG8_BAR; }
    PG8_BAR;
#undef PG8_SA
#undef PG8_SB
#undef PG8_STAGE
#undef PG8_LDA
#undef PG8_LDB
#undef PG8_MMA
#undef PG8_WAIT_V
#undef PG8_WAIT_L
#undef PG8_BAR
#undef PG8_SCHED
}
}

struct ConvJob { const float* W; bf16* WT; int K, ldn, col0, ncols, drow0, mode, nbatch; size_t sstride, dstride; };
DI void transpose_item(const ConvJob& J, int item, LAS float* scr, int lane) {
    const int per = (J.K / 64) * (J.ncols / 32); const int bi = item / per; int r = item - bi * per;
    const int nblk = J.ncols / 32, kb = r / nblk, nb = r % nblk, k0 = 64 * kb, j0 = 32 * nb;
    const float* W = J.W + (size_t)bi * J.sstride; bf16* WT = J.WT + (size_t)bi * J.dstride;
    float tv[32];
#pragma unroll
    for (int i = 0; i < 32; ++i) { const int kk = 2 * i + (lane >> 5); tv[i] = __builtin_nontemporal_load(W + (size_t)(k0 + kk) * J.ldn + J.col0 + j0 + (lane & 31)); }
#pragma unroll
    for (int i = 0; i < 32; ++i) { const int kk = 2 * i + (lane >> 5); scr[kk * 33 + (lane & 31)] = tv[i]; }
    asm volatile("s_waitcnt lgkmcnt(0)" ::: "memory");
    const int c = lane & 7;
    const int drow = J.drow0 + (J.mode ? ((j0 >> 7) * 256 + (j0 & 127)) : j0);
#pragma unroll
    for (int j = 0; j < 4; ++j) { const int n = (lane >> 3) + 8 * j; const LAS float* s = scr + (8 * c) * 33 + n;
        u32x4 o; o.x = pk2(s[0 * 33], s[1 * 33]); o.y = pk2(s[2 * 33], s[3 * 33]); o.z = pk2(s[4 * 33], s[5 * 33]); o.w = pk2(s[6 * 33], s[7 * 33]);
        *(u32x4*)(WT + (size_t)(drow + n) * J.K + k0 + 8 * c) = o; }
    asm volatile("s_waitcnt lgkmcnt(0)" ::: "memory");
}
constexpr int N_JOBS = 15;
DI ConvJob get_job(const Args& a, int j) {
    unsigned char* ws = a.ws; ConvJob J; J.nbatch = 1; J.sstride = 0; J.dstride = 0; J.mode = 0;
    switch (j) {
        case 0: J.W = a.in[6]; J.WT = (bf16*)(ws + W_EVIN); J.K = D; J.ldn = EV_IN; J.col0 = 0; J.ncols = 512; J.drow0 = 0; break;
        case 1: J.W = a.in[6]; J.WT = (bf16*)(ws + W_EVIN); J.K = D; J.ldn = EV_IN; J.col0 = 512; J.ncols = 512; J.drow0 = 512; J.mode = 1; break;
        case 2: J.W = a.in[6]; J.WT = (bf16*)(ws + W_EVIN); J.K = D; J.ldn = EV_IN; J.col0 = 1024; J.ncols = 512; J.drow0 = 640; J.mode = 1; break;
        case 3: J.W = a.in[6]; J.WT = (bf16*)(ws + W_EVIN); J.K = D; J.ldn = EV_IN; J.col0 = 1536; J.ncols = 2048; J.drow0 = 1536; break;
        case 4: J.W = a.in[12]; J.WT = (bf16*)(ws + W_EVOUT); J.K = D; J.ldn = D; J.col0 = 0; J.ncols = D; J.drow0 = 0; break;
        case 5: J.W = a.in[22]; J.WT = (bf16*)(ws + W_FFGU); J.K = D; J.ldn = 2 * DFF; J.col0 = 0; J.ncols = DFF; J.drow0 = 0; J.mode = 1; break;
        case 6: J.W = a.in[22]; J.WT = (bf16*)(ws + W_FFGU); J.K = D; J.ldn = 2 * DFF; J.col0 = DFF; J.ncols = DFF; J.drow0 = 128; J.mode = 1; break;
        case 7: J.W = a.in[23]; J.WT = (bf16*)(ws + W_FFD); J.K = DFF; J.ldn = D; J.col0 = 0; J.ncols = D; J.drow0 = 0; break;
        case 8: J.W = a.in[13]; J.WT = (bf16*)(ws + W_ODIN); J.K = D; J.ldn = OD_N; J.col0 = 0; J.ncols = OD_N; J.drow0 = 0; break;
        case 9: J.W = a.in[20]; J.WT = (bf16*)(ws + W_ODOUT); J.K = D; J.ldn = D; J.col0 = 0; J.ncols = D; J.drow0 = 0; break;
        case 10: J.W = a.in[25]; J.WT = (bf16*)(ws + W_MGU); J.K = D; J.ldn = 2 * DFE; J.col0 = 0; J.ncols = DFE; J.drow0 = 0; J.mode = 1; J.nbatch = NE; J.sstride = (size_t)D * 2 * DFE; J.dstride = (size_t)2 * DFE * D; break;
        case 11: J.W = a.in[25]; J.WT = (bf16*)(ws + W_MGU); J.K = D; J.ldn = 2 * DFE; J.col0 = DFE; J.ncols = DFE; J.drow0 = 128; J.mode = 1; J.nbatch = NE; J.sstride = (size_t)D * 2 * DFE; J.dstride = (size_t)2 * DFE * D; break;
        case 12: J.W = a.in[26]; J.WT = (bf16*)(ws + W_MD); J.K = DFE; J.ldn = D; J.col0 = 0; J.ncols = D; J.drow0 = 0; J.nbatch = NE; J.sstride = (size_t)DFE * D; J.dstride = (size_t)D * DFE; break;
        case 13: J.W = a.in[27]; J.WT = (bf16*)(ws + W_PPROJ); J.K = 256; J.ldn = D; J.col0 = 0; J.ncols = D; J.drow0 = 0; J.nbatch = 2; J.sstride = (size_t)256 * D; J.dstride = (size_t)D * 256; break;
        default: J.W = a.in[28]; J.WT = (bf16*)(ws + W_PGATE); J.K = D; J.ldn = D; J.col0 = 0; J.ncols = D; J.drow0 = 0; J.nbatch = 2; J.sstride = (size_t)D * D; J.dstride = (size_t)D * D; break;
    }
    return J;
}
DI void convert_weights(const Frame& F, const Args& a) {
    LAS float* scr = (LAS float*)(F.lds + F.wave * 16384);
    const int gw = F.vcu * 8 + F.wave, NGW = F.G * 8;
    for (int jj = 0; jj < 4; ++jj) {
        const int j = jj == 0 ? 4 : jj == 1 ? 7 : jj == 2 ? 9 : 13;
        const ConvJob J = get_job(a, j);
        const int nitems = J.nbatch * (J.K / 64) * (J.ncols / 32);
        for (int it = gw; it < nitems; it += NGW) transpose_item(J, it, scr, F.lane);
    }
}

struct QJob { const float* W; signed char* W8; int ldn, col0, ncols, drow0, mode, nbatch, rows_pb, sbo, K, fp8; size_t sstride; };
constexpr int N_QJOBS = 11;
DI QJob get_qjob(const Args& a, int j) {
    unsigned char* ws = a.ws; QJob J; J.nbatch = 1; J.sstride = 0; J.mode = 0; J.rows_pb = 0; J.K = D; J.fp8 = 0;
    switch (j) {
        case 10: J.W = a.in[26]; J.W8 = (signed char*)(ws + W_MD); J.ldn = D; J.col0 = 0; J.ncols = D; J.drow0 = 0; J.sbo = SBO_MD; J.nbatch = NE; J.rows_pb = D; J.sstride = (size_t)DFE * D; J.K = DFE; J.fp8 = 1; break;
        case 0: J.W = a.in[6]; J.W8 = (signed char*)(ws + W_EVIN); J.ldn = EV_IN; J.col0 = 0; J.ncols = 512; J.drow0 = 0; J.sbo = SBO_EVIN; break;
        case 1: J.W = a.in[6]; J.W8 = (signed char*)(ws + W_EVIN); J.ldn = EV_IN; J.col0 = 512; J.ncols = 512; J.drow0 = 512; J.mode = 1; J.sbo = SBO_EVIN; break;
        case 2: J.W = a.in[6]; J.W8 = (signed char*)(ws + W_EVIN); J.ldn = EV_IN; J.col0 = 1024; J.ncols = 512; J.drow0 = 640; J.mode = 1; J.sbo = SBO_EVIN; break;
        case 3: J.W = a.in[6]; J.W8 = (signed char*)(ws + W_EVIN); J.ldn = EV_IN; J.col0 = 1536; J.ncols = 2048; J.drow0 = 1536; J.sbo = SBO_EVIN; break;
        case 4: J.W = a.in[22]; J.W8 = (signed char*)(ws + W_FFGU); J.ldn = 2 * DFF; J.col0 = 0; J.ncols = DFF; J.drow0 = 0; J.mode = 1; J.sbo = SBO_FFGU; break;
        case 5: J.W = a.in[22]; J.W8 = (signed char*)(ws + W_FFGU); J.ldn = 2 * DFF; J.col0 = DFF; J.ncols = DFF; J.drow0 = 128; J.mode = 1; J.sbo = SBO_FFGU; break;
        case 6: J.W = a.in[13]; J.W8 = (signed char*)(ws + W_ODIN); J.ldn = OD_N; J.col0 = 0; J.ncols = OD_N; J.drow0 = 0; J.sbo = SBO_ODIN; break;
        case 7: J.W = a.in[28]; J.W8 = (signed char*)(ws + W_PGATE); J.ldn = D; J.col0 = 0; J.ncols = D; J.drow0 = 0; J.sbo = SBO_PGATE; J.nbatch = 2; J.rows_pb = D; J.sstride = (size_t)D * D; break;
        case 8: J.W = a.in[25]; J.W8 = (signed char*)(ws + W_MGU); J.ldn = 2 * DFE; J.col0 = 0; J.ncols = DFE; J.drow0 = 0; J.mode = 1; J.sbo = SBO_MOE; J.nbatch = NE; J.rows_pb = 2 * DFE; J.sstride = (size_t)D * 2 * DFE; break;
        default: J.W = a.in[25]; J.W8 = (signed char*)(ws + W_MGU); J.ldn = 2 * DFE; J.col0 = DFE; J.ncols = DFE; J.drow0 = 128; J.mode = 1; J.sbo = SBO_MOE; J.nbatch = NE; J.rows_pb = 2 * DFE; J.sstride = (size_t)D * 2 * DFE; break;
    }
    return J;
}
DI int q_drow(const QJob& J, int j0) { return J.drow0 + (J.mode ? ((j0 >> 7) * 256 + (j0 & 127)) : j0); }
DI void absmax_jobs(const Frame& F, const Args& a, int jlo, int jhi, int worker, int nworkers) {
    unsigned* cmax = (unsigned*)(F.ws + WS_CTL) + CW_CMAX;
    const int gw = worker * 8 + F.wave, NGW = nworkers * 8, lane = F.lane;
    for (int j = jlo; j < jhi; ++j) {
        const QJob J = get_qjob(a, j);
        const int nblk = J.ncols / 256, per = (J.K / 64) * nblk, nitems = J.nbatch * per;
        for (int it = gw; it < nitems; it += NGW) {
            const int bi = it / per, r = it - bi * per, kb = r / nblk, nb = r - kb * nblk;
            if (J.fp8 && (kb % 14) != 0) continue;
            const float* p = J.W + (size_t)bi * J.sstride + (size_t)(kb * 64) * J.ldn + J.col0 + nb * 256 + 4 * lane;
            f32x4 m = (f32x4){0.f, 0.f, 0.f, 0.f};
#pragma unroll 1
            for (int i0 = 0; i0 < 64; i0 += 16) {
                f32x4 tv[16];
#pragma unroll
                for (int i = 0; i < 16; ++i) tv[i] = __builtin_nontemporal_load((const f32x4*)(p + (size_t)(i0 + i) * J.ldn));
#pragma unroll
                for (int i = 0; i < 16; ++i) { m[0] = fmaxf(m[0], fabsf(tv[i][0])); m[1] = fmaxf(m[1], fabsf(tv[i][1])); m[2] = fmaxf(m[2], fabsf(tv[i][2])); m[3] = fmaxf(m[3], fabsf(tv[i][3])); }
            }
            unsigned* cp = cmax + J.sbo + bi * J.rows_pb + q_drow(J, nb * 256 + 4 * lane);
#pragma unroll
            for (int e = 0; e < 4; ++e) __hip_atomic_fetch_max(cp + e, __float_as_uint(m[e]), __ATOMIC_RELAXED, __HIP_MEMORY_SCOPE_AGENT);
        }
    }
}
DI void quant_jobs(const Frame& F, const Args& a, int jlo, int jhi, int worker, int nworkers) {
    const unsigned* cmax = (const unsigned*)(F.ws + WS_CTL) + CW_CMAX; float* SB = (float*)(F.ws + WS_SB);
    LAS float* scr = (LAS float*)(F.lds + F.wave * 17408);
    const int gw = worker * 8 + F.wave, NGW = nworkers * 8, lane = F.lane;
    for (int j = jlo; j < jhi; ++j) {
        const QJob J = get_qjob(a, j);
        const int nblk = J.ncols / 32, per = (J.K / 128) * nblk, nitems = J.nbatch * per;
        const float qmax = J.fp8 ? 448.f : 127.f;
        for (int it = gw; it < nitems; it += NGW) {
            const int bi = it / per, r = it - bi * per, kb = r / nblk, nb = r - kb * nblk, k0 = kb * 128, j0 = nb * 32;
            const int srow = J.sbo + bi * J.rows_pb + q_drow(J, j0);
            float cm = __uint_as_float(__hip_atomic_load(cmax + srow + (lane & 31), __ATOMIC_RELAXED, __HIP_MEMORY_SCOPE_AGENT));
            if (J.fp8) cm *= 4.f;
            const float inv = cm > 0.f ? qmax / cm : 0.f;
            const char* pb = (const char*)(J.W + (size_t)bi * J.sstride + (size_t)k0 * J.ldn + J.col0 + j0);
            const unsigned lo = (unsigned)((lane >> 5) * J.ldn + (lane & 31)) * 4u;
            {
                float tv[64];
#pragma unroll
                for (int i = 0; i < 64; ++i) tv[i] = __builtin_nontemporal_load((const float*)(pb + (lo + (unsigned)(2 * i * J.ldn) * 4u)));
#pragma unroll
                for (int i = 0; i < 64; ++i) scr[(2 * i + (lane >> 5)) * 33 + (lane & 31)] = tv[i] * inv;
            }
            asm volatile("s_waitcnt lgkmcnt(0)" ::: "memory");
            const int drow = bi * J.rows_pb + q_drow(J, j0);
            const int c = lane & 7;
#pragma unroll
            for (int jj = 0; jj < 4; ++jj) { const int n = (lane >> 3) + 8 * jj; const LAS float* sp = scr + (16 * c) * 33 + n;
                u32x4 o;
#pragma unroll
                for (int q = 0; q < 4; ++q) { float f0 = sp[(4 * q) * 33], f1 = sp[(4 * q + 1) * 33], f2 = sp[(4 * q + 2) * 33], f3 = sp[(4 * q + 3) * 33];
                    if (J.fp8) { int pk = 0; f0 = __builtin_amdgcn_fmed3f(f0, -448.f, 448.f); f1 = __builtin_amdgcn_fmed3f(f1, -448.f, 448.f); f2 = __builtin_amdgcn_fmed3f(f2, -448.f, 448.f); f3 = __builtin_amdgcn_fmed3f(f3, -448.f, 448.f);
                        pk = __builtin_amdgcn_cvt_pk_fp8_f32(f0, f1, pk, false); pk = __builtin_amdgcn_cvt_pk_fp8_f32(f2, f3, pk, true); o[q] = (unsigned)pk; }
                    else { const int b0 = __float2int_rn(f0), b1 = __float2int_rn(f1), b2 = __float2int_rn(f2), b3 = __float2int_rn(f3);
                        o[q] = (unsigned)(b0 & 0xff) | ((unsigned)(b1 & 0xff) << 8) | ((unsigned)(b2 & 0xff) << 16) | ((unsigned)(b3 & 0xff) << 24); } }
                *(u32x4*)(J.W8 + (size_t)(drow + n) * J.K + k0 + 16 * c) = o; }
            if (k0 == 0 && lane < 32) SB[srow + lane] = cm / qmax;
            asm volatile("s_waitcnt lgkmcnt(0)" ::: "memory");
        }
    }
}

DI void quant_k1024(const Frame& F, const Args& a, int jlo, int jhi, int worker, int nworkers) {
    float* SB = (float*)(F.ws + WS_SB);
    LAS float* scr = (LAS float*)(F.lds + F.wave * 17408);
    LAS float* cmx = (LAS float*)(F.lds + 8 * 17408);
    const int lane = F.lane, q = F.wave; int rot = 0;
#pragma unroll
    for (int j = jlo; j < jhi; ++j) {
        const QJob J = get_qjob(a, j);
        const int nblk = J.ncols / 32, nitems = J.nbatch * nblk;
        const int w0 = (worker + nworkers - (rot % nworkers)) % nworkers; rot += nitems;
        for (int it = w0; it < nitems; it += nworkers) {
            const int bi = it / nblk, nb = it - bi * nblk, j0 = nb * 32;
            const char* pb = (const char*)(J.W + (size_t)bi * J.sstride + (size_t)(128 * q) * J.ldn + J.col0 + j0);
            const unsigned lo = (unsigned)((lane >> 5) * J.ldn + (lane & 31)) * 4u;
            float v[64]; float m = 0.f;
#pragma unroll
            for (int i = 0; i < 64; ++i) v[i] = __builtin_nontemporal_load((const float*)(pb + (lo + (unsigned)(2 * i * J.ldn) * 4u)));
#pragma unroll
            for (int i = 0; i < 64; ++i) m = fmaxf(m, fabsf(v[i]));
            m = fmaxf(m, __shfl_xor(m, 32));
            if (lane < 32) cmx[q * 32 + lane] = m;
            LDS_BAR();
            float cm = cmx[lane & 31];
#pragma unroll
            for (int t = 1; t < 8; ++t) cm = fmaxf(cm, cmx[t * 32 + (lane & 31)]);
            const float inv = cm > 0.f ? 127.f / cm : 0.f;
            const int srow = J.sbo + bi * J.rows_pb + q_drow(J, j0), drow = bi * J.rows_pb + q_drow(J, j0);
#pragma unroll
            for (int i = 0; i < 64; ++i) scr[(2 * i + (lane >> 5)) * 33 + (lane & 31)] = v[i] * inv;
            asm volatile("s_waitcnt lgkmcnt(0)" ::: "memory");
            const int c = lane & 7, k0 = 128 * q;
#pragma unroll
            for (int jj = 0; jj < 4; ++jj) { const int n = (lane >> 3) + 8 * jj; const LAS float* sp = scr + (16 * c) * 33 + n;
                u32x4 o;
#pragma unroll
                for (int t = 0; t < 4; ++t) { const int b0 = __float2int_rn(sp[(4 * t) * 33]), b1 = __float2int_rn(sp[(4 * t + 1) * 33]), b2 = __float2int_rn(sp[(4 * t + 2) * 33]), b3 = __float2int_rn(sp[(4 * t + 3) * 33]);
                    o[t] = (unsigned)(b0 & 0xff) | ((unsigned)(b1 & 0xff) << 8) | ((unsigned)(b2 & 0xff) << 16) | ((unsigned)(b3 & 0xff) << 24); }
                *(u32x4*)(J.W8 + (size_t)(drow + n) * D + k0 + 16 * c) = o; }
            if (q == 0 && lane < 32) SB[srow + lane] = cm * (1.f / 127.f);
            LDS_BAR();
        }
    }
}

DI void load_row(const float* p, int lane, f32x4 (&v)[4]) {
    const f32x4* xr = (const f32x4*)p + lane;
#pragma unroll
    for (int j = 0; j < 4; ++j) v[j] = __builtin_nontemporal_load(xr + 64 * j);
}
DI float sumsq16(const f32x4 (&v)[4]) { float s = 0.f;
#pragma unroll
    for (int j = 0; j < 4; ++j) s += (v[j].x * v[j].x + v[j].y * v[j].y) + (v[j].z * v[j].z + v[j].w * v[j].w);
    return s; }
DI void store_bf16_row(bf16* orow, int lane, const f32x4 (&v)[4]) {
    u32x2* o8 = (u32x2*)orow + lane;
#pragma unroll
    for (int j = 0; j < 4; ++j) { u32x2 w; w.x = pk2(v[j].x, v[j].y); w.y = pk2(v[j].z, v[j].w); o8[64 * j] = w; }
}
DI float quant_row_store(signed char* drow, int lane, const f32x4 (&v)[4]) {
    float am = 0.f;
#pragma unroll
    for (int j = 0; j < 4; ++j) am = fmaxf(fmaxf(am, fmaxf(fabsf(v[j].x), fabsf(v[j].y))), fmaxf(fabsf(v[j].z), fabsf(v[j].w)));
    am = wave_max(am);
    const float qinv = am > 0.f ? 127.f / am : 0.f;
    unsigned* o4 = (unsigned*)drow + lane;
#pragma unroll
    for (int j = 0; j < 4; ++j) { const int b0 = __float2int_rn(v[j].x * qinv), b1 = __float2int_rn(v[j].y * qinv), b2 = __float2int_rn(v[j].z * qinv), b3 = __float2int_rn(v[j].w * qinv);
        o4[64 * j] = (unsigned)(b0 & 0xff) | ((unsigned)(b1 & 0xff) << 8) | ((unsigned)(b2 & 0xff) << 16) | ((unsigned)(b3 & 0xff) << 24); }
    return am * (1.f / 127.f);
}
DI void load_rowB(const bf16* p, int lane, u32x4 (&r)[2]) { const u32x4* xr = (const u32x4*)p + lane; r[0] = __builtin_nontemporal_load(xr); r[1] = __builtin_nontemporal_load(xr + 64); }
DI void load_gB(const float* g, int lane, f32x4 (&v)[4]) {
#pragma unroll
    for (int i = 0; i < 4; ++i) v[i] = *(const f32x4*)(g + 512 * (i >> 1) + 8 * lane + 4 * (i & 1));
}
DI void unpackB(const u32x4 (&r)[2], f32x4 (&v)[4]) {
#pragma unroll
    for (int j = 0; j < 2; ++j) { v[2 * j].x = bflo(r[j].x); v[2 * j].y = bfhi(r[j].x); v[2 * j].z = bflo(r[j].y); v[2 * j].w = bfhi(r[j].y);
        v[2 * j + 1].x = bflo(r[j].z); v[2 * j + 1].y = bfhi(r[j].z); v[2 * j + 1].z = bflo(r[j].w); v[2 * j + 1].w = bfhi(r[j].w); }
}
DI void addB(const u32x4 (&r)[2], f32x4 (&v)[4]) {
#pragma unroll
    for (int j = 0; j < 2; ++j) { v[2 * j].x += bflo(r[j].x); v[2 * j].y += bfhi(r[j].x); v[2 * j].z += bflo(r[j].y); v[2 * j].w += bfhi(r[j].y);
        v[2 * j + 1].x += bflo(r[j].z); v[2 * j + 1].y += bfhi(r[j].z); v[2 * j + 1].z += bflo(r[j].w); v[2 * j + 1].w += bfhi(r[j].w); }
}
DI void store_rowB(bf16* orow, int lane, const f32x4 (&v)[4]) { u32x4* o = (u32x4*)orow + lane; __builtin_nontemporal_store(pg8::pack8(v[0], v[1]), o); __builtin_nontemporal_store(pg8::pack8(v[2], v[3]), o + 64); }
DI unsigned q4(const f32x4& v, float qinv) { const int b0 = __float2int_rn(v.x * qinv), b1 = __float2int_rn(v.y * qinv), b2 = __float2int_rn(v.z * qinv), b3 = __float2int_rn(v.w * qinv);
    return (unsigned)(b0 & 0xff) | ((unsigned)(b1 & 0xff) << 8) | ((unsigned)(b2 & 0xff) << 16) | ((unsigned)(b3 & 0xff) << 24); }
DI float row_absmax(const f32x4 (&v)[4]) { float am = 0.f;
#pragma unroll
    for (int j = 0; j < 4; ++j) am = fmaxf(fmaxf(am, fmaxf(fabsf(v[j].x), fabsf(v[j].y))), fmaxf(fabsf(v[j].z), fabsf(v[j].w)));
    return wave_max(am); }
DI void store_q8B(signed char* drow, int lane, const f32x4 (&v)[4], float qinv) { u32x2* o8 = (u32x2*)drow + lane;
#pragma unroll
    for (int j = 0; j < 2; ++j) { u32x2 w; w.x = q4(v[2 * j], qinv); w.y = q4(v[2 * j + 1], qinv); o8[64 * j] = w; } }
DI float quant_row_storeB(signed char* drow, int lane, const f32x4 (&v)[4]) {
    const float am = row_absmax(v); const float qinv = am > 0.f ? 127.f / am : 0.f;
    store_q8B(drow, lane, v, qinv);
    return am * (1.f / 127.f);
}
DI void norm_plain(const Frame& F, const bf16* src, const float* g, signed char* dst, float* SA) {
    f32x4 gv[4]; load_gB(g, F.lane, gv);
    const int gw = F.vcu * 8 + F.wave, NGW = F.G * 8;
    u32x4 nr[2], n2[2]; load_rowB(src + (size_t)gw * D, F.lane, nr); load_rowB(src + (size_t)(gw + NGW) * D, F.lane, n2);
    for (int m = gw; m < T; m += NGW) {
        f32x4 v[4]; unpackB(nr, v);
        nr[0] = n2[0]; nr[1] = n2[1];
        if (m + 2 * NGW < T) load_rowB(src + (size_t)(m + 2 * NGW) * D, F.lane, n2);
        const float rstd = rsqrtf(wave_sum(sumsq16(v)) * (1.f / D) + EPS);
#pragma unroll
        for (int j = 0; j < 4; ++j) v[j] = v[j] * rstd * gv[j];
        const float sc = quant_row_storeB(dst + (size_t)m * D, F.lane, v);
        if (F.lane == 0) SA[m] = sc;
    }
}
DI void norm_mix0(const Frame& F, const Args& a) {
    const float* x = a.in[0]; const float* g = a.in[2]; const float* win = a.in[6];
    signed char* dst = (signed char*)(F.ws + WS_HN); float* SA = (float*)(F.ws + WS_SA); float* GA = (float*)(F.ws + WS_GA); float* BT = (float*)(F.ws + WS_BETA);
    f32x4 gv[4]; load_row(g, F.lane, gv);
    float w8[16][8];
#pragma unroll
    for (int j = 0; j < 4; ++j)
#pragma unroll
        for (int e = 0; e < 4; ++e) { const int k = 256 * j + 4 * F.lane + e; const f32x4 lo = *(const f32x4*)(win + (size_t)k * EV_IN + EV_N), hi = *(const f32x4*)(win + (size_t)k * EV_IN + EV_N + 4);
#pragma unroll
            for (int c = 0; c < 4; ++c) { w8[4 * j + e][c] = lo[c]; w8[4 * j + e][4 + c] = hi[c]; } }
    const int h4 = F.lane & 3;
    const float negA = -__expf(a.in[9][h4]), dtb = a.in[10][h4];
    const int gw = F.vcu * 8 + F.wave, NGW = F.G * 8;
    f32x4 nv[4]; load_row(x + (size_t)gw * D, F.lane, nv);
    for (int m = gw; m < T; m += NGW) {
        f32x4 v[4];
#pragma unroll
        for (int j = 0; j < 4; ++j) v[j] = nv[j];
        if (m + NGW < T) load_row(x + (size_t)(m + NGW) * D, F.lane, nv);
        const float rstd = rsqrtf(wave_sum(sumsq16(v)) * (1.f / D) + EPS);
#pragma unroll
        for (int j = 0; j < 4; ++j) v[j] = v[j] * rstd * gv[j];
        { const float sc = quant_row_store(dst + (size_t)m * D, F.lane, v); if (F.lane == 0) SA[m] = sc; }
        float dsum[8];
#pragma unroll
        for (int c = 0; c < 8; ++c) { float s = 0.f;
#pragma unroll
            for (int j = 0; j < 4; ++j)
#pragma unroll
                for (int e = 0; e < 4; ++e) s += v[j][e] * w8[4 * j + e][c];
            dsum[c] = s; }
        wave_sum8(dsum, F.lane);
        float af = dsum[0], bfv = dsum[4];
        if (h4 == 1) { af = dsum[1]; bfv = dsum[5]; } else if (h4 == 2) { af = dsum[2]; bfv = dsum[6]; } else if (h4 == 3) { af = dsum[3]; bfv = dsum[7]; }
        const float z = af + dtb; const float sp = (z > 20.f) ? z : log1pf(__expf(z));
        if (F.lane < 4) { GA[(size_t)m * 4 + h4] = negA * sp; BT[(size_t)m * 4 + h4] = sigmoid_f(bfv); }
    }
}
DI void convert_p(const Frame& F, const float* p, bf16* dst) {
    const size_t n8 = (size_t)T * 256 / 8;
    for (size_t i = (size_t)F.vcu * 512 + F.tid; i < n8; i += (size_t)F.G * 512) {
        const f32x4 a = *(const f32x4*)(p + i * 8), b = *(const f32x4*)(p + i * 8 + 4);
        *(u32x4*)(dst + i * 8) = pg8::pack8(a, b);
    }
}
DI void norm_router(const Frame& F, const Args& a) {
    const bf16* h = (const bf16*)(F.ws + WS_XB); const float* g = a.in[3] + D; const float* wr_ = a.in[24];
    signed char* dst = (signed char*)(F.ws + WS_HN); int* row_ts = (int*)(F.ws + WS_ROWTS); float* row_gate = (float*)(F.ws + WS_ROWGATE); float* row_sa = (float*)(F.ws + WS_ROWSA); unsigned* ctl = (unsigned*)(F.ws + WS_CTL);
    f32x4 gv[4]; load_gB(g, F.lane, gv);
    float w8[16][8];
#pragma unroll
    for (int j = 0; j < 4; ++j)
#pragma unroll
        for (int e = 0; e < 4; ++e) { const int k = 512 * (j >> 1) + 8 * F.lane + 4 * (j & 1) + e; const f32x4 lo = *(const f32x4*)(wr_ + (size_t)k * 8), hi = *(const f32x4*)(wr_ + (size_t)k * 8 + 4);
#pragma unroll
            for (int c = 0; c < 4; ++c) { w8[4 * j + e][c] = lo[c]; w8[4 * j + e][4 + c] = hi[c]; } }
    const int gw = F.vcu * 8 + F.wave, NGW = F.G * 8;
    if (gw == 0) { unsigned* z = (unsigned*)(dst + (size_t)T * D) + F.lane;
#pragma unroll
        for (int j = 0; j < 4; ++j) z[64 * j] = 0u; }
    for (int grp = gw; grp < T / 32; grp += NGW) {
        int e0 = 0, e1 = 1; float g0 = 0.f, g1 = 0.f, sav = 0.f;
        u32x4 nr[2], n2[2]; load_rowB(h + (size_t)(grp * 32) * D, F.lane, nr); load_rowB(h + (size_t)(grp * 32 + 1) * D, F.lane, n2);
        for (int rr = 0; rr < 32; ++rr) {
            const int m = grp * 32 + rr;
            f32x4 v[4]; unpackB(nr, v);
            nr[0] = n2[0]; nr[1] = n2[1];
            if (rr + 2 < 32) load_rowB(h + (size_t)(m + 2) * D, F.lane, n2);
            const float rstd = rsqrtf(wave_sum(sumsq16(v)) * (1.f / D) + EPS);
#pragma unroll
            for (int j = 0; j < 4; ++j) v[j] = v[j] * rstd * gv[j];
            const float am = row_absmax(v);
            const float qinv = am > 0.f ? 127.f / am : 0.f;
            store_q8B(dst + (size_t)m * D, F.lane, v, qinv);
            float lg[8];
#pragma unroll
            for (int c = 0; c < 8; ++c) { float s = 0.f;
#pragma unroll
                for (int j = 0; j < 4; ++j)
#pragma unroll
                    for (int e = 0; e < 4; ++e) s += v[j][e] * w8[4 * j + e][c];
                lg[c] = s; }
            wave_sum8(lg, F.lane);
            int b0 = 0; float v0 = lg[0];
#pragma unroll
            for (int c = 1; c < 8; ++c) if (lg[c] > v0) { v0 = lg[c]; b0 = c; }
            int b1 = -1; float v1 = -INFINITY;
#pragma unroll
            for (int c = 0; c < 8; ++c) if (c != b0 && lg[c] > v1) { v1 = lg[c]; b1 = c; }
            const float ga = 1.f / (1.f + __expf(v1 - v0));
            if (F.lane == rr) { e0 = b0; e1 = b1; g0 = ga; g1 = 1.f - ga; sav = am * (1.f / 127.f); }
        }
        const bool act = F.lane < 32;
#pragma unroll
        for (int e = 0; e < 8; ++e) {
            const unsigned long long m0 = __ballot(act && e0 == e), m1 = __ballot(act && e1 == e);
            const int n0 = __popcll(m0), n1 = __popcll(m1);
            if (n0 + n1 == 0) continue;
            unsigned base = 0;
            if (F.lane == 0) base = __hip_atomic_fetch_add(ctl + CW_CNT + 64 * e, (unsigned)(n0 + n1), __ATOMIC_RELAXED, __HIP_MEMORY_SCOPE_AGENT);
            base = (unsigned)__builtin_amdgcn_readfirstlane((int)base);
            const unsigned long long below = (1ull << F.lane) - 1ull;
            const int tok = grp * 32 + F.lane;
            if (act && e0 == e) { const unsigned off = base + (unsigned)__popcll(m0 & below); row_ts[(size_t)e * CAP + off] = tok * 2; row_gate[(size_t)e * CAP + off] = g0; row_sa[(size_t)e * CAP + off] = sav; }
            if (act && e1 == e) { const unsigned off = base + (unsigned)n0 + (unsigned)__popcll(m1 & below); row_ts[(size_t)e * CAP + off] = tok * 2 + 1; row_gate[(size_t)e * CAP + off] = g1; row_sa[(size_t)e * CAP + off] = sav; }
        }
    }
}
DI void combine_norm(const Frame& F, const Args& a) {
    bf16* h = (bf16*)(F.ws + WS_XB); const float* g = a.in[4] + D; const bf16* ym = (const bf16*)a.out; signed char* dst = (signed char*)(F.ws + WS_HN); float* SA = (float*)(F.ws + WS_SA);
    f32x4 gv[4]; load_gB(g, F.lane, gv);
    const int gw = F.vcu * 8 + F.wave, NGW = F.G * 8;
    u32x4 nh[2], np[2], nq[2];
    load_rowB(h + (size_t)gw * D, F.lane, nh); load_rowB(ym + (size_t)gw * 2 * D, F.lane, np); load_rowB(ym + (size_t)gw * 2 * D + D, F.lane, nq);
    for (int m = gw; m < T; m += NGW) {
        f32x4 v[4]; unpackB(nh, v); addB(np, v); addB(nq, v);
        if (m + NGW < T) { const int mn = m + NGW; load_rowB(h + (size_t)mn * D, F.lane, nh); load_rowB(ym + (size_t)mn * 2 * D, F.lane, np); load_rowB(ym + (size_t)mn * 2 * D + D, F.lane, nq); }
        store_rowB(h + (size_t)m * D, F.lane, v);
        const float rstd = rsqrtf(wave_sum(sumsq16(v)) * (1.f / D) + EPS);
#pragma unroll
        for (int j = 0; j < 4; ++j) v[j] = v[j] * rstd * gv[j];
        { const float sc = quant_row_storeB(dst + (size_t)m * D, F.lane, v); if (F.lane == 0) SA[m] = sc; }
    }
}
DI void final_norm(const Frame& F, const Args& a) {
    const bf16* h = (const bf16*)(F.ws + WS_XB); float* o = a.out; const float* g = a.in[5];
    f32x4 gv[4]; load_gB(g, F.lane, gv);
    const int gw = F.vcu * 8 + F.wave, NGW = F.G * 8;
    u32x4 nr[2], n2[2]; load_rowB(h + (size_t)gw * D, F.lane, nr); load_rowB(h + (size_t)(gw + NGW) * D, F.lane, n2);
    for (int m = gw; m < T; m += NGW) {
        f32x4 v[4]; unpackB(nr, v);
        nr[0] = n2[0]; nr[1] = n2[1];
        if (m + 2 * NGW < T) load_rowB(h + (size_t)(m + 2 * NGW) * D, F.lane, n2);
        const float rstd = rsqrtf(wave_sum(sumsq16(v)) * (1.f / D) + EPS);
        float* orow = o + (size_t)m * D + 8 * F.lane;
#pragma unroll
        for (int i = 0; i < 4; ++i) __builtin_nontemporal_store(v[i] * rstd * gv[i], (f32x4*)(orow + 512 * (i >> 1) + 4 * (i & 1)));
    }
}

DI void mixer_a(const Frame& F, const Args& a, int worker, int nworkers) {
    const bf16* U = (const bf16*)(F.ws + WS_U0); bf16* Y = (bf16*)(F.ws + WS_Y); const float* cw = a.in[7];
    const int c8 = (F.tid & 63) * 8;
    float w0[8], w1[8], w2[8];
#pragma unroll
    for (int e = 0; e < 8; ++e) { w0[e] = cw[c8 + e]; w1[e] = cw[512 + c8 + e]; w2[e] = cw[1024 + c8 + e]; }
    const int rstride = 8 * nworkers;
    for (int run = worker * 8 + (F.tid >> 6); run < T / 8; run += rstride) {
        const int r0 = run * 8; const bool first = (r0 & (SEQ - 1)) == 0;
        const bf16* up = U + (size_t)r0 * EVU + c8;
        u32x4 z[10], bg[8];
        z[0] = (u32x4){0u, 0u, 0u, 0u}; z[1] = z[0];
        if (!first) { z[0] = __builtin_nontemporal_load((const u32x4*)(up - 2 * (size_t)EVU + 512)); z[1] = __builtin_nontemporal_load((const u32x4*)(up - (size_t)EVU + 512)); }
#pragma unroll
        for (int i = 0; i < 8; ++i) { z[2 + i] = __builtin_nontemporal_load((const u32x4*)(up + (size_t)i * EVU + 512)); bg[i] = __builtin_nontemporal_load((const u32x4*)(up + (size_t)i * EVU)); }
#pragma unroll
        for (int i = 0; i < 8; ++i) {
            float o[8];
#pragma unroll
            for (int p = 0; p < 4; ++p) {
                const float a0 = w0[2 * p] * bflo(z[i][p]) + w1[2 * p] * bflo(z[i + 1][p]) + w2[2 * p] * bflo(z[i + 2][p]);
                const float a1 = w0[2 * p + 1] * bfhi(z[i][p]) + w1[2 * p + 1] * bfhi(z[i + 1][p]) + w2[2 * p + 1] * bfhi(z[i + 2][p]);
                o[2 * p] = bflo(bg[i][p]) * a0; o[2 * p + 1] = bfhi(bg[i][p]) * a1;
            }
            u32x4 wv; wv.x = pk2(o[0], o[1]); wv.y = pk2(o[2], o[3]); wv.z = pk2(o[4], o[5]); wv.w = pk2(o[6], o[7]);
            *(u32x4*)(Y + (size_t)(r0 + i) * D + c8) = wv;
        }
    }
}

constexpr int GA_GCS = 0, GA_BTS = 256, GA_KN = 1024, GA_KB = GA_KN + 17408, GA_QN = GA_KB + 17408, GA_VBT = GA_QN + 17408, GA_KGT = GA_VBT + 18432,
              GA_AM = GA_KGT + 18432, GA_TB = GA_AM + 17408, GA_QKS = GA_TB + 9216, GA_CW = GA_QKS + 9216, GA_END = GA_CW + 6144;
static_assert(GA_END <= 155648, "gdn-a lds");
template <int I0, int I1> DI void subst_rows(const LAS float* Ab, float (&Tr)[32], int col) {
    typedef float f32x3_t __attribute__((ext_vector_type(3)));
    f32x4 av[I1 - I0][8]; float at[I1 - I0][3];
#pragma unroll
    for (int i = I0; i < I1; ++i) {
#pragma unroll
        for (int v = 0; v < i / 4; ++v) av[i - I0][v] = *(const LAS f32x4*)(Ab + i * 68 + 4 * v);
        const LAS float* tp = Ab + i * 68 + 4 * (i / 4);
        if ((i & 3) == 1) at[i - I0][0] = tp[0];
        else if ((i & 3) == 2) { const f32x2_t t = *(const LAS f32x2_t*)tp; at[i - I0][0] = t.x; at[i - I0][1] = t.y; }
        else if ((i & 3) == 3) { const f32x3_t t = *(const LAS f32x3_t*)tp; at[i - I0][0] = t.x; at[i - I0][1] = t.y; at[i - I0][2] = t.z; }
    }
    asm volatile("s_waitcnt lgkmcnt(0)" ::: "memory");
#pragma unroll
    for (int i = I0; i < I1; ++i) {
        float acc = (i == col) ? 1.f : 0.f;
#pragma unroll
        for (int j = 0; j < i; ++j) { const float aij = (j < 4 * (i / 4)) ? av[i - I0][j >> 2][j & 3] : at[i - I0][j & 3]; acc = __builtin_fmaf(-aij, Tr[j], acc); }
        Tr[i] = acc;
    }
    asm volatile("" ::: "memory");
}
DI void gdn_a(const Frame& F, const Args& a) {
    LAS unsigned char* L = F.lds;
    LAS float* gcs = (LAS float*)(L + GA_GCS); LAS float* bts = (LAS float*)(L + GA_BTS);
    LAS float* Am = (LAS float*)(L + GA_AM);
    const bf16* U = (const bf16*)(F.ws + WS_U0); const float* GA = (const float*)(F.ws + WS_GA); const float* BT = (const float*)(F.ws + WS_BETA);
    float* EG = (float*)(F.ws + WS_EG); const float* cw = a.in[8];
    const int lane = F.lane, w = F.wave, r = lane & 31, hh = lane >> 5;
    for (int item = F.vcu; item < 4096; item += F.G) {
        const int bh = item >> 5, n = item & 31, b = bh >> 2, h = bh & 3, t0 = b * SEQ + n * 64;
        unsigned char* Gp = F.ws + WS_G + (size_t)item * G_ITEM;
        if (w == 0) {
            float gc = GA[(size_t)(t0 + lane) * 4 + h];
#pragma unroll
            for (int o = 1; o < 64; o <<= 1) { const float up = __shfl_up(gc, o); if (lane >= o) gc += up; }
            gcs[lane] = gc; bts[lane] = BT[(size_t)(t0 + lane) * 4 + h];
            if (lane == 63) EG[item] = __expf(gc);
        }
        for (int i = F.tid; i < 1536; i += 512) { const int part = i >> 9, rem = i & 511, j = rem >> 7, c = rem & 127; *(LAS float*)(L + GA_CW + i * 4) = cw[j * 1536 + part * 512 + h * 128 + c]; }
        const int g2 = (F.tid >> 4) * 2, c8 = (F.tid & 15) * 8;
        u32x4 xr[3][5];
        {
            const bf16* ub = U + (size_t)t0 * EVU + 1024 + h * 128 + c8;
#pragma unroll
            for (int q = 0; q < 5; ++q) {
                const bool ok = (q >= 3) || (n * 64 + g2 - 3 + q >= 0);
                const bf16* rp = ub + (ptrdiff_t)(ok ? g2 - 3 + q : 0) * EVU;
#pragma unroll
                for (int part = 0; part < 3; ++part) { const u32x4 ld = *(const u32x4*)(rp + part * 512); xr[part][q] = ok ? ld : (u32x4){0u, 0u, 0u, 0u}; }
            }
        }
        WG_BAR();
        const float glast = gcs[63];
#pragma unroll
        for (int part = 0; part < 3; ++part) {
            float tp[2][8];
#pragma unroll
            for (int tk = 0; tk < 2; ++tk) {
                const int tok = g2 + tk;
                float acc[8];
#pragma unroll
                for (int e = 0; e < 8; ++e) acc[e] = 0.f;
#pragma unroll
                for (int j = 0; j < 4; ++j) {
                    const u32x4 xv = xr[part][tk + j];
                    const f32x4 w0 = *(const LAS f32x4*)(L + GA_CW + ((part * 4 + j) * 128 + c8) * 4), w1 = *(const LAS f32x4*)(L + GA_CW + ((part * 4 + j) * 128 + c8 + 4) * 4);
                    acc[0] += w0[0] * bflo(xv[0]); acc[1] += w0[1] * bfhi(xv[0]); acc[2] += w0[2] * bflo(xv[1]); acc[3] += w0[3] * bfhi(xv[1]);
                    acc[4] += w1[0] * bflo(xv[2]); acc[5] += w1[1] * bfhi(xv[2]); acc[6] += w1[2] * bflo(xv[3]); acc[7] += w1[3] * bfhi(xv[3]);
                }
                float ss = 0.f;
#pragma unroll
                for (int e = 0; e < 8; ++e) { acc[e] = silu_f(acc[e]); ss += acc[e] * acc[e]; }
                ss = row16_sum(ss);
                const float beta = bts[tok], gc = gcs[tok];
                if (part == 0) {
                    const float sc = rsqrtf(ss + EPS) * 0.08838834764831845f, eg = __expf(gc);
                    u32x4 o; o.x = pk2(acc[0] * sc, acc[1] * sc); o.y = pk2(acc[2] * sc, acc[3] * sc); o.z = pk2(acc[4] * sc, acc[5] * sc); o.w = pk2(acc[6] * sc, acc[7] * sc);
                    *(LAS u32x4*)(L + GA_QN + tok * 272 + c8 * 2) = o;
                    const float s2 = sc * eg;
                    u32x4 g; g.x = pk2(acc[0] * s2, acc[1] * s2); g.y = pk2(acc[2] * s2, acc[3] * s2); g.z = pk2(acc[4] * s2, acc[5] * s2); g.w = pk2(acc[6] * s2, acc[7] * s2);
                    *(u32x4*)(Gp + G_QG + tok * 256 + c8 * 2) = g;
                } else if (part == 1) {
                    const float sc = rsqrtf(ss + EPS), sb = sc * beta, sg = sb * __expf(gc), sd = sc * __expf(glast - gc);
                    u32x4 o; o.x = pk2(acc[0] * sc, acc[1] * sc); o.y = pk2(acc[2] * sc, acc[3] * sc); o.z = pk2(acc[4] * sc, acc[5] * sc); o.w = pk2(acc[6] * sc, acc[7] * sc);
                    *(LAS u32x4*)(L + GA_KN + tok * 272 + c8 * 2) = o;
                    u32x4 p; p.x = pk2(acc[0] * sb, acc[1] * sb); p.y = pk2(acc[2] * sb, acc[3] * sb); p.z = pk2(acc[4] * sb, acc[5] * sb); p.w = pk2(acc[6] * sb, acc[7] * sb);
                    *(LAS u32x4*)(L + GA_KB + tok * 272 + c8 * 2) = p;
                    u32x4 d; d.x = pk2(acc[0] * sd, acc[1] * sd); d.y = pk2(acc[2] * sd, acc[3] * sd); d.z = pk2(acc[4] * sd, acc[5] * sd); d.w = pk2(acc[6] * sd, acc[7] * sd);
                    *(u32x4*)(Gp + G_KD + tok * 256 + c8 * 2) = d;
#pragma unroll
                    for (int e = 0; e < 8; ++e) tp[tk][e] = acc[e] * sg;
                } else {
#pragma unroll
                    for (int e = 0; e < 8; ++e) tp[tk][e] = acc[e] * beta;
                }
            }
            if (part == 1) {
#pragma unroll
                for (int e = 0; e < 8; ++e) *(LAS unsigned*)(L + GA_KGT + (c8 + e) * 144 + g2 * 2) = pk2(tp[0][e], tp[1][e]);
            } else if (part == 2) {
#pragma unroll
                for (int e = 0; e < 8; ++e) *(LAS unsigned*)(L + GA_VBT + (c8 + e) * 144 + g2 * 2) = pk2(tp[0][e], tp[1][e]);
            }
        }
        WG_BAR();
        {
            const int mat = w >> 2, ti = (w >> 1) & 1, tj = w & 1;
            f32x16 x = zero16();
            if (ti >= tj) {
                const LAS unsigned char* ap = L + (mat ? GA_QN : GA_KB) + (32 * ti + r) * 272 + hh * 16;
                const LAS unsigned char* bp = L + GA_KN + (32 * tj + r) * 272 + hh * 16;
#pragma unroll
                for (int s = 0; s < 8; ++s) x = MFMA32(*(const LAS bf16x8*)(ap + 32 * s), *(const LAS bf16x8*)(bp + 32 * s), x);
            }
            const int j = 32 * tj + r; const float gj = gcs[j];
            if (mat == 0) {
#pragma unroll
                for (int reg = 0; reg < 16; ++reg) { const int i = 32 * ti + crow(reg, hh); const float dec = __expf(gcs[i] - gj); Am[i * 68 + j] = (i > j) ? x[reg] * dec : 0.f; }
            } else {
#pragma unroll
                for (int reg = 0; reg < 16; ++reg) { const int i = 32 * ti + crow(reg, hh); const float dec = __expf(gcs[i] - gj);
                    *(LAS bf16*)(L + GA_QKS + i * 144 + j * 2) = (bf16)(pk2((i >= j) ? x[reg] * dec : 0.f, 0.f) & 0xffffu); }
            }
        }
        WG_BAR();
        if (w == 0) {
            const int blk = hh, col = r;
            float Tr[32];
            const LAS float* Ab = Am + (blk * 32) * 68 + blk * 32;
            subst_rows<0, 8>(Ab, Tr, col); subst_rows<8, 12>(Ab, Tr, col); subst_rows<12, 16>(Ab, Tr, col);
            subst_rows<16, 18>(Ab, Tr, col); subst_rows<18, 20>(Ab, Tr, col); subst_rows<20, 22>(Ab, Tr, col); subst_rows<22, 24>(Ab, Tr, col);
            subst_rows<24, 26>(Ab, Tr, col); subst_rows<26, 28>(Ab, Tr, col); subst_rows<28, 30>(Ab, Tr, col); subst_rows<30, 32>(Ab, Tr, col);
#pragma unroll
            for (int i = 0; i < 32; ++i) *(LAS bf16*)(L + GA_TB + (blk * 32 + i) * 144 + (blk * 32 + col) * 2) = (bf16)(pk2(Tr[i], 0.f) & 0xffffu);
            f32x16 P = zero16();
#pragma unroll
            for (int s = 0; s < 2; ++s) {
                const LAS float* arow = Am + (32 + r) * 68 + 16 * s + 8 * hh;
                const f32x4 a0 = *(const LAS f32x4*)arow, a1 = *(const LAS f32x4*)(arow + 4);
                const bf16x8 af = __builtin_bit_cast(bf16x8, pg8::pack8(a0, a1));
                float tv[8];
#pragma unroll
                for (int jj = 0; jj < 8; ++jj) { const float lo = Tr[16 * s + jj]; const float hi = __shfl(Tr[16 * s + 8 + jj], r); tv[jj] = hh ? hi : lo; }
                u32x4 tb; tb.x = pk2(tv[0], tv[1]); tb.y = pk2(tv[2], tv[3]); tb.z = pk2(tv[4], tv[5]); tb.w = pk2(tv[6], tv[7]);
                P = MFMA32(af, __builtin_bit_cast(bf16x8, tb), P);
            }
            f32x16 R = zero16();
#pragma unroll
            for (int s = 0; s < 2; ++s) {
                const LAS unsigned char* tp = L + GA_TB + (32 + r) * 144 + (32 + 16 * s + 4 * hh) * 2;
                const s16x4 lo = *(const LAS s16x4*)tp, hi = *(const LAS s16x4*)(tp + 16);
                R = MFMA32(cat8(lo, hi), pack_step(P, s), R);
            }
#pragma unroll
            for (int reg = 0; reg < 16; ++reg) *(LAS bf16*)(L + GA_TB + (32 + crow(reg, hh)) * 144 + r * 2) = (bf16)(pk2(-R[reg], 0.f) & 0xffffu);
        } else {
            for (int p = F.tid - 64; p < 512; p += 448) { const int row = p >> 3, c = p & 7; *(u32x4*)(Gp + G_QK + row * 128 + c * 16) = *(const LAS u32x4*)(L + GA_QKS + row * 144 + c * 16); }
            if (w == 1) {
#pragma unroll
                for (int i = 0; i < 16; ++i) *(LAS bf16*)(L + GA_TB + (2 * i + hh) * 144 + (32 + r) * 2) = (bf16)0; }
        }
        WG_BAR();
        if (w < 4) {
#pragma unroll
            for (int q = 0; q < 2; ++q) {
                const int idx = w * 2 + q, ib = idx >> 2, db = idx & 3;
                f32x16 x = zero16();
                const LAS unsigned char* ap = L + GA_TB + (32 * ib + r) * 144 + hh * 16;
                const LAS unsigned char* bp = L + GA_VBT + (32 * db + r) * 144 + hh * 16;
#pragma unroll
                for (int s = 0; s < 4; ++s) if (ib || s < 2) x = MFMA32(*(const LAS bf16x8*)(ap + 32 * s), *(const LAS bf16x8*)(bp + 32 * s), x);
#pragma unroll
                for (int g = 0; g < 4; ++g) { u32x2 o; o.x = pk2(x[4 * g], x[4 * g + 1]); o.y = pk2(x[4 * g + 2], x[4 * g + 3]);
                    *(u32x2*)(Gp + G_UT + ((32 * db + r) * 64 + 32 * ib + 8 * g + 4 * hh) * 2) = o; }
            }
        } else {
#pragma unroll
            for (int q = 0; q < 2; ++q) {
                const int idx = (w - 4) * 2 + q, dkb = idx >> 1, ib = idx & 1;
                f32x16 x = zero16();
                const LAS unsigned char* ap = L + GA_KGT + (32 * dkb + r) * 144 + hh * 16;
                const LAS unsigned char* bp = L + GA_TB + (32 * ib + r) * 144 + hh * 16;
#pragma unroll
                for (int s = 0; s < 4; ++s) if (ib || s < 2) x = MFMA32(*(const LAS bf16x8*)(ap + 32 * s), *(const LAS bf16x8*)(bp + 32 * s), x);
#pragma unroll
                for (int g = 0; g < 4; ++g) { u32x2 o; o.x = pk2(x[4 * g], x[4 * g + 1]); o.y = pk2(x[4 * g + 2], x[4 * g + 3]);
                    *(u32x2*)(Gp + G_W + ((32 * ib + r) * 128 + 32 * dkb + 8 * g + 4 * hh) * 2) = o; }
            }
        }
        WG_BAR();
    }
}

constexpr int GB_ST = 0, GB_W = 34816, GB_QG = GB_W + 17408, GB_KD = GB_QG + 17408, GB_QK = GB_KD + 20480, GB_O = GB_QK + 9216, GB_END = GB_O + 33792;
static_assert(GB_END <= 140000, "gdn-b lds");
DI void gdn_b(const Frame& F, const Args& a, int worker, int nworkers) {
    LAS unsigned char* L = F.lds;
    const bf16* U = (const bf16*)(F.ws + WS_U0); bf16* Y = (bf16*)(F.ws + WS_Y); const float* EG = (const float*)(F.ws + WS_EG); const float* gn = a.in[11];
    const int lane = F.lane, w = F.wave, r = lane & 31, hh = lane >> 5, dvb = w & 3, hf = w >> 2;
    const int q4 = (lane & 15) >> 2, p4 = lane & 3, g1 = (lane >> 4) & 1;
    f32x4 gnv[4];
#pragma unroll
    for (int i = 0; i < 4; ++i) gnv[i] = *(const f32x4*)(gn + (F.tid & 7) * 16 + 4 * i);
    const unsigned src_t = (unsigned)F.tid * 16u;
    const unsigned dst_w = (unsigned)((F.tid >> 4) * 272 + (F.tid & 15) * 16);
    const unsigned dst_k = (unsigned)((F.tid >> 4) * 320 + (F.tid & 15) * 16);
    const unsigned dst_q = (unsigned)((F.tid >> 3) * 144 + (F.tid & 7) * 16);
    const unsigned ut_t = (unsigned)(((32 * dvb + r) * 64 + 4 * hh) * 2);
    for (int bh = worker; bh < 128; bh += nworkers) {
        const int b = bh >> 2, h = bh & 3;
        f32x16 Sacc[2] = {zero16(), zero16()};
        for (int p = F.tid; p < 34816 / 16; p += 512) *(LAS u32x4*)(L + GB_ST + p * 16) = (u32x4){0u, 0u, 0u, 0u};
        u32x4 nop[7]; u32x2 nui[2][4]; float neg; u32x4 nog[2];
#define GB_PREFETCH(nn) do { const int _item = bh * 32 + (nn); const unsigned char* _Gp = F.ws + WS_G + (size_t)_item * G_ITEM; \
            unsigned _so = src_t, _uo = ut_t; asm volatile("" : "+v"(_so), "+v"(_uo)); \
            _Pragma("unroll") for (int k = 0; k < 7; ++k) { const unsigned char* _bk = _Gp + (8192 * k + (k >= 2 ? 16384 : 0)); nop[k] = *(const u32x4*)(_bk + _so); } \
            _Pragma("unroll") for (int tb = 0; tb < 2; ++tb) _Pragma("unroll") for (int g = 0; g < 4; ++g) { const unsigned char* _bu = _Gp + G_UT + (64 * tb + 16 * g); nui[tb][g] = *(const u32x2*)(_bu + _uo); } \
            neg = EG[_item]; \
            const unsigned char* _og = (const unsigned char*)(U + (size_t)(b * SEQ + (nn) * 64) * EVU + 2560 + h * 128); \
            unsigned _lo = (unsigned)((F.tid >> 3) * EVU + (F.tid & 7) * 16) * 2u; asm volatile("" : "+v"(_lo)); \
            nog[0] = *(const u32x4*)(_og + _lo); nog[1] = *(const u32x4*)(_og + 16 + _lo); } while (0)
        GB_PREFETCH(0);
        for (int n = 0; n < 32; ++n) {
            const int t0 = b * SEQ + n * 64;
            *(LAS u32x4*)(L + GB_W + dst_w) = nop[0]; *(LAS u32x4*)(L + GB_W + dst_w + 32 * 272) = nop[1];
            *(LAS u32x4*)(L + GB_QG + dst_w) = nop[2]; *(LAS u32x4*)(L + GB_QG + dst_w + 32 * 272) = nop[3];
            *(LAS u32x4*)(L + GB_KD + dst_k) = nop[4]; *(LAS u32x4*)(L + GB_KD + dst_k + 32 * 320) = nop[5];
            *(LAS u32x4*)(L + GB_QK + dst_q) = nop[6];
            u32x2 ui[2][4]; u32x4 og[2];
#pragma unroll
            for (int tb = 0; tb < 2; ++tb)
#pragma unroll
                for (int g = 0; g < 4; ++g) ui[tb][g] = nui[tb][g];
            og[0] = nog[0]; og[1] = nog[1];
            const float eg = neg;
            LDS_BAR();
            if (n + 1 < 32) GB_PREFETCH(n + 1);
            f32x16 x0 = zero16(), x1 = zero16(), o = zero16();
            {
                const LAS unsigned char* sp = L + GB_ST + (32 * dvb + r) * 272 + hh * 16;
                const LAS unsigned char* wp = L + GB_W + r * 272 + hh * 16;
                const LAS unsigned char* qp = L + GB_QG + (32 * hf + r) * 272 + hh * 16;
#pragma unroll
                for (int s = 0; s < 8; ++s) {
                    const bf16x8 sf = *(const LAS bf16x8*)(sp + 32 * s);
                    x0 = MFMA32(*(const LAS bf16x8*)(wp + 32 * s), sf, x0);
                    x1 = MFMA32(*(const LAS bf16x8*)(wp + 32 * 272 + 32 * s), sf, x1);
                    o = MFMA32(*(const LAS bf16x8*)(qp + 32 * s), sf, o);
                }
            }
            bf16x8 pv[2][2];
#pragma unroll
            for (int g = 0; g < 4; ++g) {
                x0[4 * g] = bflo(ui[0][g].x) - x0[4 * g]; x0[4 * g + 1] = bfhi(ui[0][g].x) - x0[4 * g + 1]; x0[4 * g + 2] = bflo(ui[0][g].y) - x0[4 * g + 2]; x0[4 * g + 3] = bfhi(ui[0][g].y) - x0[4 * g + 3];
                x1[4 * g] = bflo(ui[1][g].x) - x1[4 * g]; x1[4 * g + 1] = bfhi(ui[1][g].x) - x1[4 * g + 1]; x1[4 * g + 2] = bflo(ui[1][g].y) - x1[4 * g + 2]; x1[4 * g + 3] = bfhi(ui[1][g].y) - x1[4 * g + 3];
            }
            pv[0][0] = pack_step(x0, 0); pv[0][1] = pack_step(x0, 1); pv[1][0] = pack_step(x1, 0); pv[1][1] = pack_step(x1, 1);
#pragma unroll
            for (int tb = 0; tb < 2; ++tb) {
                if (tb <= hf) {
#pragma unroll
                    for (int s = 0; s < 2; ++s) {
                        const LAS unsigned char* kp = L + GB_QK + (32 * hf + r) * 144 + (32 * tb + 16 * s + 4 * hh) * 2;
                        o = MFMA32(cat8(*(const LAS s16x4*)kp, *(const LAS s16x4*)(kp + 16)), pv[tb][s], o);
                    }
                }
            }
            {
                LAS float* Ol = (LAS float*)(L + GB_O) + (32 * hf + 4 * hh) * 132 + 32 * dvb + r;
#pragma unroll
                for (int reg = 0; reg < 16; ++reg) Ol[((reg & 3) + 8 * (reg >> 2)) * 132] = o[reg];
            }
#pragma unroll
            for (int d2 = 0; d2 < 2; ++d2) {
                const int db = 2 * hf + d2;
                f32x16 x = Sacc[d2] * eg;
                const LAS unsigned char* kb = L + GB_KD + (4 * hh + q4) * 320 + (32 * db + 16 * g1 + 4 * p4) * 2;
#pragma unroll
                for (int tb = 0; tb < 2; ++tb)
#pragma unroll
                    for (int s = 0; s < 2; ++s) {
                        const LAS unsigned char* kp = kb + (32 * tb + 16 * s) * 320;
                        x = MFMA32(cat8(vtr(kp), vtr(kp + 8 * 320)), pv[tb][s], x);
                    }
                Sacc[d2] = x;
            }
            LDS_BAR();
#pragma unroll
            for (int d2 = 0; d2 < 2; ++d2) {
                const int db = 2 * hf + d2;
#pragma unroll
                for (int g = 0; g < 4; ++g) { u32x2 ov; ov.x = pk2(Sacc[d2][4 * g], Sacc[d2][4 * g + 1]); ov.y = pk2(Sacc[d2][4 * g + 2], Sacc[d2][4 * g + 3]);
                    *(LAS u32x2*)(L + GB_ST + (32 * dvb + r) * 272 + (32 * db + 8 * g + 4 * hh) * 2) = ov; }
            }
            {
                const int row = F.tid >> 3, cg = (F.tid & 7) * 16;
                const LAS float* Ol = (const LAS float*)(L + GB_O) + row * 132 + cg;
                f32x4 ov[4]; float ss = 0.f;
#pragma unroll
                for (int i = 0; i < 4; ++i) { ov[i] = *(const LAS f32x4*)(Ol + 4 * i); ss += (ov[i].x * ov[i].x + ov[i].y * ov[i].y) + (ov[i].z * ov[i].z + ov[i].w * ov[i].w); }
                ss += dppf(ss, 0); ss += dppf(ss, 1); ss += dppf(ss, 2);
                const float rstd = rsqrtf(ss * (1.f / 128.f) + EPS);
                bf16* yp = Y + (size_t)(t0 + row) * D + 512 + h * 128 + cg;
#pragma unroll
                for (int hv = 0; hv < 2; ++hv) {
                    const u32x4 gq = og[hv]; const f32x4 a0 = ov[2 * hv] * rstd * gnv[2 * hv], a1 = ov[2 * hv + 1] * rstd * gnv[2 * hv + 1];
                    u32x4 o4; o4.x = pk2(a0.x * silu_f(bflo(gq.x)), a0.y * silu_f(bfhi(gq.x))); o4.y = pk2(a0.z * silu_f(bflo(gq.y)), a0.w * silu_f(bfhi(gq.y)));
                    o4.z = pk2(a1.x * silu_f(bflo(gq.z)), a1.y * silu_f(bfhi(gq.z))); o4.w = pk2(a1.z * silu_f(bflo(gq.w)), a1.w * silu_f(bfhi(gq.w)));
                    *(u32x4*)(yp + 8 * hv) = o4;
                }
            }
        }
        WG_BAR();
    }
#undef GB_PREFETCH
}

constexpr int AT_STAGE = 38912, AT_K = 0, AT_V = 18432, AT_NST = 4, AT_BIAS = LDS_MISC + 1024;
DI void attn_dma_offs(int w, int lane, int h, unsigned (&go)[5]) {
#pragma unroll
    for (int k = 0; k < 5; ++k) {
        int ii = w + 8 * k; if (ii >= 38) ii -= 2; unsigned o;
        if (ii < 18) { const int i = ii * 64 + lane, m = i / 576, rem = i - m * 576, rr = rem / 9, c0 = rem - rr * 9, c = c0 > 7 ? 7 : c0; o = (unsigned)(rr * OD_N + 512 + h * 128 + m * 64 + c * 8) * 2u; }
        else { const int i = (ii - 18) * 64 + lane, rr = i / 20, c0 = i - rr * 20, c = c0 > 15 ? 15 : c0; o = (unsigned)(rr * OD_N + 1024 + h * 128 + c * 8) * 2u; }
        go[k] = o;
    }
}
DI void glds16(const void* gsrc, unsigned lds_dst) { unsigned keep;
    asm volatile("s_mov_b32 %0, m0\n\ts_mov_b32 m0, %2\n\ts_nop 0\n\tglobal_load_lds_dwordx4 %1, off\n\ts_mov_b32 m0, %0" : "=&s"(keep) : "v"(gsrc), "s"(lds_dst) : "memory"); }
DI void attn_dma(const bf16* U1, int trow, LAS unsigned char* stage, int w, const unsigned (&go)[5]) {
    const char* g = (const char*)(U1 + (size_t)trow * OD_N);
    const unsigned sbase = (unsigned)(uintptr_t)stage;
#pragma unroll
    for (int k = 0; k < 5; ++k) {
        int ii = w + 8 * k; if (ii >= 38) ii -= 2;
        const unsigned dst = sbase + ((ii < 18) ? (unsigned)(AT_K + ii * 1024) : (unsigned)(AT_V + (ii - 18) * 1024));
        glds16(g + go[k], (unsigned)__builtin_amdgcn_readfirstlane((int)dst));
    }
}
DI void attn_phase(const Frame& F, const Args& a) {
    LAS unsigned char* L = F.lds;
    const bf16* U1 = (const bf16*)(F.ws + WS_U); bf16* Y = (bf16*)(F.ws + WS_Y);
    const float* lamp = a.in[14]; const float* dng = a.in[15]; const float* relb = a.in[21];
    const int lane = F.lane, w = F.wave, r = lane & 31, hh = lane >> 5, mp = w >> 2, qs = w & 3;
    const int q4 = (lane & 15) >> 2, p4 = lane & 3, g1 = (lane >> 4) & 1;
    const float lam = __expf(wave_sum(lamp[lane] * lamp[64 + lane])) - __expf(wave_sum(lamp[128 + lane] * lamp[192 + lane])) + LAMBDA_INIT;
    const float c1 = 0.125f * LOG2E;
    LAS float* btab = (LAS float*)(L + AT_BIAS);
    LAS float* exch = (LAS float*)L;
    for (int item = F.vcu; item < 256; item += F.G) {
        const int bh = item >> 1, par = item & 1, b = bh >> 2, h = bh & 3, trow0 = b * SEQ;
        WG_BAR();
        if (F.tid < 128) { const int n = F.tid; int bucket = n;
            if (n >= 16) { const int lg = 16 + (int)(__logf((float)n / 16.f) / 2.0794415416798357f * 16.f); bucket = lg < 31 ? lg : 31; }
            btab[n] = relb[bucket * 4 + h] * LOG2E; }
        const float bias_far = relb[31 * 4 + h] * LOG2E;
        unsigned go[5]; attn_dma_offs(w, lane, h, go);
        for (int ui = 0; ui < 8; ++ui) {
            const int qblk = 2 * ui + ((ui ^ par) & 1);
            const int q0 = qblk * 128 + qs * 32, qpos = q0 + r, ntiles = 2 * (qblk + 1);
            bf16x8 qf[4];
            { const bf16* qp = U1 + (size_t)(trow0 + qpos) * OD_N + h * 128 + mp * 64 + 8 * hh;
#pragma unroll
              for (int s = 0; s < 4; ++s) qf[s] = *(const bf16x8*)(qp + 16 * s); }
            asm volatile("s_waitcnt vmcnt(0)" ::: "memory");
            f32x16 O[4] = {zero16(), zero16(), zero16(), zero16()};
            float mrun = -INFINITY, lrun = 0.f;
            attn_dma(U1, trow0, L, w, go);
            attn_dma(U1, trow0 + 64, L + AT_STAGE, w, go);
            bf16x8 pf[2][2]; bool pend = false;
            const LAS unsigned char* vlane = L + AT_V + (4 * hh + q4) * 320 + (16 * g1 + 4 * p4) * 2;
#define ATT_PV(stage_) do { const LAS unsigned char* vb_ = vlane + (stage_) * AT_STAGE; \
                _Pragma("unroll") for (int db = 0; db < 4; ++db) _Pragma("unroll") for (int kh = 0; kh < 2; ++kh) _Pragma("unroll") for (int s_ = 0; s_ < 2; ++s_) { \
                    const LAS unsigned char* vp = vb_ + (32 * kh + 16 * s_) * 320 + 64 * db; O[db] = MFMA32(cat8(vtr(vp), vtr(vp + 8 * 320)), pf[kh][s_], O[db]); } } while (0)
            for (int kt = 0; kt < ntiles; ++kt) {
                if (kt + 1 < ntiles) asm volatile("s_waitcnt vmcnt(5)" ::: "memory"); else asm volatile("s_waitcnt vmcnt(0)" ::: "memory");
                __builtin_amdgcn_s_barrier(); asm volatile("" ::: "memory");
                if (kt + 2 < ntiles) attn_dma(U1, trow0 + (kt + 2) * 64, L + ((kt + 2) & 3) * AT_STAGE, w, go);
                if (mp == 1 && pend) { ATT_PV((kt - 1) & 3); pend = false; }
                const int key0 = kt * 64;
                if (key0 <= q0 + 31) {
                    const LAS unsigned char* sb = L + (kt & 3) * AT_STAGE;
                    const LAS unsigned char* kb = sb + AT_K + mp * 9216 + r * 144 + hh * 16;
                    f32x16 x0 = zero16(), x1 = zero16();
#pragma unroll
                    for (int s = 0; s < 4; ++s) { x0 = MFMA32(*(const LAS bf16x8*)(kb + 32 * s), qf[s], x0); x1 = MFMA32(*(const LAS bf16x8*)(kb + 32 * 144 + 32 * s), qf[s], x1); }
                    const bool far = q0 - (key0 + 63) >= 128;
                    if (!far) {
#pragma unroll
                        for (int reg = 0; reg < 16; ++reg) {
                            const int d0 = qpos - (key0 + crow(reg, hh)), d1 = d0 - 32;
                            const float b0 = btab[d0 < 0 ? 0 : (d0 > 127 ? 127 : d0)], b1 = btab[d1 < 0 ? 0 : (d1 > 127 ? 127 : d1)];
                            x0[reg] = (d0 >= 0) ? x0[reg] * c1 + b0 : -INFINITY; x1[reg] = (d1 >= 0) ? x1[reg] * c1 + b1 : -INFINITY;
                        }
                    }
                    float mx = x0[0];
#pragma unroll
                    for (int reg = 1; reg < 16; ++reg) mx = fmaxf(mx, x0[reg]);
#pragma unroll
                    for (int reg = 0; reg < 16; ++reg) mx = fmaxf(mx, x1[reg]);
                    if (far) mx = mx * c1 + bias_far;
                    mx = fmaxf(mx, __shfl_xor(mx, 32));
                    if (__any(mx - mrun > 6.f)) {
                        const float mnew = fmaxf(mrun, mx), alpha = __builtin_amdgcn_exp2f(mrun - mnew); mrun = mnew;
                        lrun *= alpha;
#pragma unroll
                        for (int db = 0; db < 4; ++db) O[db] = O[db] * alpha;
                    }
                    float rs = 0.f;
                    if (far) { const float off = bias_far - mrun;
#pragma unroll
                        for (int reg = 0; reg < 16; ++reg) { x0[reg] = __builtin_amdgcn_exp2f(x0[reg] * c1 + off); x1[reg] = __builtin_amdgcn_exp2f(x1[reg] * c1 + off); rs += x0[reg] + x1[reg]; }
                    } else {
#pragma unroll
                        for (int reg = 0; reg < 16; ++reg) { x0[reg] = __builtin_amdgcn_exp2f(x0[reg] - mrun); x1[reg] = __builtin_amdgcn_exp2f(x1[reg] - mrun); rs += x0[reg] + x1[reg]; }
                    }
                    lrun += rs;
                    pf[0][0] = pack_step(x0, 0); pf[0][1] = pack_step(x0, 1); pf[1][0] = pack_step(x1, 0); pf[1][1] = pack_step(x1, 1);
                    if (mp == 0) ATT_PV(kt & 3); else pend = true;
                }
            }
            if (mp == 1 && pend) ATT_PV((ntiles - 1) & 3);
#undef ATT_PV
            const float ltot = lrun + __shfl_xor(lrun, 32);
            const float inv = 1.f / ltot;
            LDS_BAR();
            if (mp == 1) {
                const float sc = inv * lam;
#pragma unroll
                for (int db = 0; db < 4; ++db)
#pragma unroll
                    for (int reg = 0; reg < 16; ++reg) exch[(qs * 64 + db * 16 + reg) * 64 + lane] = O[db][reg] * sc;
            }
            LDS_BAR();
            if (mp == 0) {
                float ss = 0.f;
#pragma unroll
                for (int db = 0; db < 4; ++db)
#pragma unroll
                    for (int reg = 0; reg < 16; ++reg) { const float o = O[db][reg] * inv - exch[(qs * 64 + db * 16 + reg) * 64 + lane]; O[db][reg] = o; ss += o * o; }
                ss += __shfl_xor(ss, 32);
                const float rstd = rsqrtf(ss * (1.f / 128.f) + EPS) * (1.f - LAMBDA_INIT);
                bf16* yp = Y + (size_t)(trow0 + qpos) * D + h * 128;
#pragma unroll
                for (int db = 0; db < 4; ++db)
#pragma unroll
                    for (int g = 0; g < 4; ++g) { const int d = 32 * db + 8 * g + 4 * hh; const f32x4 gv = *(const f32x4*)(dng + d);
                        u32x2 o; o.x = pk2(O[db][4 * g] * rstd * gv[0], O[db][4 * g + 1] * rstd * gv[1]); o.y = pk2(O[db][4 * g + 2] * rstd * gv[2], O[db][4 * g + 3] * rstd * gv[3]);
                        *(u32x2*)(yp + d) = o; }
            }
            LDS_BAR();
        }
    }
}

constexpr int CF_GLU = 0, CF_RED = 96256, CF_STAT = CF_RED + 16384, CF_END = CF_STAT + 512;
DI void conformer_phase(const Frame& F, const Args& a) {
    LAS unsigned char* L = F.lds;
    const bf16* U1 = (const bf16*)(F.ws + WS_U); bf16* Y = (bf16*)(F.ws + WS_Y);
    const float* cw = a.in[16]; const float* cb = a.in[17]; const float* lg = a.in[18]; const float* lb = a.in[19];
    const int c = F.tid;
    float wv[31];
#pragma unroll
    for (int j = 0; j < 31; ++j) wv[j] = cw[j * 512 + c];
    const float bias = cb[c], lng = lg[c], lnb = lb[c];
    LAS float* red = (LAS float*)(L + CF_RED); LAS float* stat = (LAS float*)(L + CF_STAT);
    const int tpw = (T / 64 + F.G - 1) / F.G;
    for (int kt = 0; kt < tpw; ++kt) {
        const int tile = F.vcu * tpw + kt; if (tile >= T / 64) break;
        const int t0 = tile * 64, s0 = t0 & (SEQ - 1);
        const bool reuse = (kt > 0) && (s0 != 0);
        WG_BAR();
        if (reuse) {
            u32x4 cp[4];
#pragma unroll
            for (int j = 0; j < 4; ++j) { const int idx = F.tid + 512 * j; if (idx < 1920) cp[j] = *(const LAS u32x4*)(L + CF_GLU + 64 * 1024 + idx * 16); }
#pragma unroll
            for (int j = 0; j < 4; ++j) { const int idx = F.tid + 512 * j; if (idx < 1920) *(LAS u32x4*)(L + CF_GLU + idx * 16) = cp[j]; }
            LDS_BAR();
        }
        const int it0 = reuse ? 30 * 64 : 0, nb4 = reuse ? 3 : 4;
#pragma unroll 1
        for (int b4 = 0; b4 < nb4; ++b4) {
            u32x4 ga[3], gb[3];
#pragma unroll
            for (int k = 0; k < 3; ++k) {
                const int it = it0 + F.tid + 512 * (3 * b4 + k), row = it >> 6, c8 = (it & 63) * 8;
                ga[k] = (u32x4){0u, 0u, 0u, 0u}; gb[k] = ga[k];
                if (it < 94 * 64 && s0 + row - 30 >= 0) { const bf16* up = U1 + (size_t)(t0 + row - 30) * OD_N + 1536 + c8; ga[k] = *(const u32x4*)up; gb[k] = *(const u32x4*)(up + 512); }
            }
#pragma unroll
            for (int k = 0; k < 3; ++k) {
                const int it = it0 + F.tid + 512 * (3 * b4 + k), row = it >> 6, c8 = (it & 63) * 8;
                u32x4 o;
#pragma unroll
                for (int q = 0; q < 4; ++q) o[q] = pk2(bflo(ga[k][q]) * sigmoid_f(bflo(gb[k][q])), bfhi(ga[k][q]) * sigmoid_f(bfhi(gb[k][q])));
                if (it < 94 * 64) *(LAS u32x4*)(L + CF_GLU + row * 1024 + c8 * 2) = o;
            }
            asm volatile("" ::: "memory");
        }
        WG_BAR();
        float out[64];
        float xs[94];
#pragma unroll
        for (int q = 0; q < 46; ++q) xs[q] = bf2f(*(const LAS bf16*)(L + CF_GLU + q * 1024 + c * 2));
#pragma unroll
        for (int hb = 0; hb < 4; ++hb) {
#pragma unroll
            for (int t2 = 0; t2 < 16; ++t2) {
                float acc = bias;
#pragma unroll
                for (int j = 0; j < 31; ++j) acc = __builtin_fmaf(wv[j], xs[16 * hb + t2 + j], acc);
                out[16 * hb + t2] = acc;
            }
            asm volatile("" ::: "memory");
            if (hb < 3) {
#pragma unroll
                for (int q = 0; q < 16; ++q) xs[46 + 16 * hb + q] = bf2f(*(const LAS bf16*)(L + CF_GLU + (46 + 16 * hb + q) * 1024 + c * 2));
            }
        }
        {
            const int part = F.wave * 4 + (F.lane >> 4), tk = (F.lane & 1) * 4 + (F.lane & 2) * 4 + (F.lane & 4) * 4 + (F.lane & 8) * 4;
            float p1[4];
            { float q[64];
#pragma unroll
              for (int tt = 0; tt < 64; ++tt) q[tt] = out[tt];
              transpose_sum_row(q, F.lane);
#pragma unroll
              for (int t = 0; t < 4; ++t) p1[t] = q[t]; }
            __builtin_amdgcn_sched_barrier(0);
            { float q[64];
#pragma unroll
              for (int tt = 0; tt < 64; ++tt) q[tt] = out[tt] * out[tt];
              transpose_sum_row(q, F.lane);
#pragma unroll
              for (int t = 0; t < 4; ++t) *(LAS f32x2_t*)(red + (part * 64 + tk + t) * 2) = (f32x2_t){p1[t], q[t]}; }
        }
        WG_BAR();
        if (F.tid < 64) { float s1 = 0.f, s2 = 0.f;
#pragma unroll
            for (int q = 0; q < 32; ++q) { const f32x2_t pr = *(const LAS f32x2_t*)(red + (q * 64 + F.tid) * 2); s1 += pr.x; s2 += pr.y; }
            const float mean = s1 * (1.f / 512.f); const float var = fmaxf(s2 * (1.f / 512.f) - mean * mean, 0.f);
            stat[F.tid * 2] = mean; stat[F.tid * 2 + 1] = rsqrtf(var + EPS); }
        WG_BAR();
#pragma unroll
        for (int tt = 0; tt < 64; ++tt) {
            const float v = (out[tt] - stat[tt * 2]) * stat[tt * 2 + 1] * lng + lnb;
            Y[(size_t)(t0 + tt) * D + 512 + c] = (bf16)(pk2(silu_f(v), 0.f) & 0xffffu);
        }
    }
}

DI void stagger_us(int us) { const unsigned long long t0 = __builtin_amdgcn_s_memrealtime(); while (__builtin_amdgcn_s_memrealtime() - t0 < (unsigned long long)us * 100ull) __builtin_amdgcn_s_sleep(32); }
constexpr int NPH = 26;
__global__ void __launch_bounds__(512, 2) fwd_kernel(Args args) {
    extern __shared__ __attribute__((aligned(16))) unsigned char lds_raw[];
    Frame F;
    F.lds = (LAS unsigned char*)lds_raw; F.ws = args.ws;
    F.wave = __builtin_amdgcn_readfirstlane((int)threadIdx.x >> 6); F.tid = threadIdx.x; F.lane = F.tid & 63;
    F.G = gridDim.x; { const int bx = blockIdx.x; F.vcu = (F.G % 8 == 0) ? (bx % 8) * (F.G / 8) + bx / 8 : bx; }
    volatile LAS unsigned* MISC = (volatile LAS unsigned*)(F.lds + LDS_MISC);
    if (F.tid < 64) MISC[F.tid] = 0u;
    __syncthreads();
    unsigned* ctl = (unsigned*)(F.ws + WS_CTL);
    const bool multi = (args.ph_hi - args.ph_lo) > 1;
    XcdBarrier bar; bar.bar = ctl + CW_BAR; bar.x = 0; bar.st = MISC + 8; bar.wave = F.wave;
    if (multi) bar = xcd_barrier_post(ctl + CW_BAR, MISC + 8, F.wave);
    const int lo = args.ph_lo, hi = args.ph_hi;
#define IN(k) (lo <= (k) && (k) < hi)
#define SEAM(k) do { if (IN(k) && IN((k) + 1)) xcd_barrier(bar); } while (0)
    unsigned char* ws = F.ws;
    bf16* HN = (bf16*)(ws + WS_HN); signed char* HN8 = (signed char*)(ws + WS_HN); bf16* UB = (bf16*)(ws + WS_U); bf16* UB0 = (bf16*)(ws + WS_U0); bf16* YB = (bf16*)(ws + WS_Y); bf16* XB = (bf16*)(ws + WS_XB); float* SAp = (float*)(ws + WS_SA); const float* SBp = (const float*)(ws + WS_SB);
    const int bx = (int)blockIdx.x;

    if (IN(0)) { quant_k1024(phase_frame(F), args, 0, 4, F.vcu, F.G); absmax_jobs(phase_frame(F), args, 10, N_QJOBS, F.vcu, F.G); convert_weights(phase_frame(F), args); norm_mix0(phase_frame(F), args); } SEAM(0);
    if (IN(1)) { pg8::SchedDense S; S.init(HN, ws + W_EVIN, T, EV_N, D / 2, F.G, bx); pg8::EpiEvInI8 E{UB0, SAp, SBp + SBO_EVIN}; pg8::gemm_phase(F.lds, S, E, F.wave); } SEAM(1);
    if (IN(2)) { gdn_a(phase_frame(F), args); } SEAM(2);
    if (IN(3)) { if ((bx & 1) == 0) { gdn_b(phase_frame(F), args, bx >> 1, (F.G + 1) >> 1); quant_k1024(phase_frame(F), args, 4, 8, bx >> 1, (F.G + 1) >> 1); }     else { mixer_a(phase_frame(F), args, bx >> 1, F.G >> 1); quant_k1024(phase_frame(F), args, 8, 10, bx >> 1, F.G >> 1); quant_jobs(phase_frame(F), args, 10, N_QJOBS, bx >> 1, F.G >> 1); } } SEAM(3);
    if (IN(4)) { pg8::SchedDense S; S.init(YB, ws + W_EVOUT, T, D, D, F.G, bx); pg8::EpiResid E{args.in[0], XB}; pg8::gemm_phase(F.lds, S, E, F.wave); } SEAM(4);
    if (IN(5)) { norm_plain(phase_frame(F), XB, args.in[3], HN8, SAp); } SEAM(5);
    if (IN(6)) { pg8::SchedDense S; S.init(HN, ws + W_FFGU, T, 2 * DFF, D / 2, F.G, bx); pg8::EpiSwiGLUI8 E{UB, DFF, SAp, SBp + SBO_FFGU}; pg8::gemm_phase(F.lds, S, E, F.wave); } SEAM(6);
    if (IN(7)) { pg8::SchedDense S; S.init(UB, ws + W_FFD, T, D, DFF, F.G, bx); pg8::EpiResidB E{XB}; pg8::gemm_phase(F.lds, S, E, F.wave); } SEAM(7);
    if (IN(8)) { norm_plain(phase_frame(F), XB, args.in[4], HN8, SAp); convert_p(phase_frame(F), args.in[1], (bf16*)(ws + WS_GX)); convert_p(phase_frame(F), args.in[1] + (size_t)T * 256, (bf16*)(ws + WS_PB2)); } SEAM(8);
    if (IN(9)) { pg8::SchedDense S; S.init(ws + WS_GX, ws + W_PPROJ, T, D, 256, F.G, bx); pg8::EpiStoreBf16 E{UB, D}; pg8::gemm_phase(F.lds, S, E, F.wave); }
    if (IN(10)) { pg8::SchedDense S; S.init(HN, ws + W_PGATE, T, D, D / 2, F.G, bx); pg8::EpiPleGateI8 E{XB, UB, SAp, SBp + SBO_PGATE}; pg8::gemm_phase(F.lds, S, E, F.wave); } SEAM(10);
    if (IN(11)) { norm_plain(phase_frame(F), XB, args.in[2] + D, HN8, SAp); } SEAM(11);
    if (IN(12)) { pg8::SchedDense S; S.init(HN, ws + W_ODIN, T, OD_N, D / 2, F.G, bx); pg8::EpiStoreBf16I8 E{UB, OD_N, SAp, SBp + SBO_ODIN}; pg8::gemm_phase(F.lds, S, E, F.wave); } SEAM(12);
    if (IN(13)) { attn_phase(phase_frame(F), args); conformer_phase(phase_frame(F), args); } SEAM(13);
    if (IN(14)) { pg8::SchedDense S; S.init(YB, ws + W_ODOUT, T, D, D, F.G, bx); pg8::EpiResidB E{XB}; pg8::gemm_phase(F.lds, S, E, F.wave); } SEAM(14);
    if (IN(15)) { norm_router(phase_frame(F), args); } SEAM(15);
#define MOE_PART(part, phg, phd) \
    if (IN(phg) || IN(phd)) { \
        LAS int* tab = (LAS int*)(F.lds + LDS_MISC + 256); \
        if (is_thread0(F.wave)) { int pb = 0; for (int e = 0; e < 8; ++e) { const int c = (int)__hip_atomic_load(ctl + CW_CNT + 64 * e, __ATOMIC_RELAXED, __HIP_MEMORY_SCOPE_AGENT); tab[e] = c; tab[8 + e] = pb; pb += (c + 255) >> 8; } tab[16] = pb; } \
        __syncthreads(); \
        const int nbt = tab[16]; int nMp = nbt - (part) * MOE_NBP; nMp = nMp < 0 ? 0 : (nMp > MOE_NBP ? MOE_NBP : nMp); \
        if (IN(phg)) { pg8::SchedMoeGU S; S.A = (const char*)HN; S.Bt = (const char*)(ws + W_MGU); S.K = D / 2; S.nM = nMp; S.nN = 2 * DFE / 256; S.G = F.G; S.c = bx; S.blk0 = (part) * MOE_NBP; S.bstride = (size_t)2 * DFE * D; \
            S.row_ts = (const int*)(ws + WS_ROWTS); S.tab = tab; S.gather = true; pg8::EpiSwiGLUI8F8 E{(bf16*)(ws + WS_ACT8), DFE, (const float*)(ws + WS_ROWSA), (const float*)(ws + WS_SB)}; pg8::gemm_phase(F.lds, S, E, F.wave); \
              \
            { const int remg = (nMp * (2 * DFE / 256)) % F.G; if (remg != 0 && bx >= remg) { pg8::SchedDense S2; S2.init(ws + WS_PB2, ws + W_PPROJ + (size_t)D * 256 * 2, T, D, 256, F.G - remg, bx - remg, 0, 1); pg8::EpiStoreBf16 E2{YB, D}; pg8::gemm_phase(F.lds, S2, E2, F.wave); } } } \
        SEAM(phg); \
        if (IN(phd)) { pg8::SchedMoeDown S; S.A = (const char*)(ws + WS_ACT8); S.Bt = (const char*)(ws + W_MD); S.K = DFE / 2; S.nM = nMp; S.nN = D / 256; S.G = F.G; S.c = bx; S.blk0 = (part) * MOE_NBP; S.bstride = (size_t)D * DFE; \
            S.row_ts = (const int*)(ws + WS_ROWTS); S.tab = tab; S.gather = false; pg8::EpiMoeDown E{(bf16*)args.out, (const int*)(ws + WS_ROWTS), (const float*)(ws + WS_ROWGATE), (const float*)(ws + WS_SB) + SBO_MD}; pg8::gemm_phase(F.lds, S, E, F.wave); \
              \
            { const int rem = (nMp * (D / 256)) % F.G, remg = (nMp * (2 * DFE / 256)) % F.G, done = remg ? F.G - remg : 0;     \
              if (rem == 0 || bx >= rem) { pg8::SchedDense S2; S2.init(ws + WS_PB2, ws + W_PPROJ + (size_t)D * 256 * 2, T, D, 256, rem ? F.G - rem : F.G, rem ? bx - rem : bx, done); pg8::EpiStoreBf16 E2{YB, D}; pg8::gemm_phase(F.lds, S2, E2, F.wave); } } } \
        SEAM(phd); \
    }
    MOE_PART(0, 16, 17)
    if (IN(22)) { combine_norm(phase_frame(F), args); } SEAM(22);
    const bool fuse_final = (F.G == 256);
    if (IN(24)) { pg8::SchedDense S; S.init(HN, ws + W_PGATE + (size_t)D * D, T, D, D / 2, F.G, bx);
        if (fuse_final) { pg8::EpiPleGateFinal E{ws, args.in[5], args.out, F.lds}; pg8::gemm_phase(F.lds, S, E, F.wave); }
        else { pg8::EpiPleGateI8 E{XB, YB, SAp, SBp + SBO_PGATE + D}; pg8::gemm_phase(F.lds, S, E, F.wave); } }
    if (!fuse_final) { SEAM(24); if (IN(25)) final_norm(phase_frame(F), args); }

#undef IN
#undef SEAM
}

#ifndef MK_MULTI_LAUNCH
#define MK_MULTI_LAUNCH 0
#endif
extern "C" void kernel_launch(void* const* d_in, const int* in_sizes, int n_in, void* d_out, int out_size, void* d_ws, size_t ws_size, hipStream_t stream) {
    static int grid = 0;
    if (grid == 0) {
        if (n_in != 29 || out_size != T * D || ws_size < WS_END) { fprintf(stderr, "kernel_launch: unexpected shapes (n_in %d out %d ws %zu)\n", n_in, out_size, ws_size); grid = -1; return; }
        int dev = 0, cus = 0, per_cu = 0;
        if (hipGetDevice(&dev) != hipSuccess || hipDeviceGetAttribute(&cus, hipDeviceAttributeMultiprocessorCount, dev) != hipSuccess) { grid = -1; return; }
        if (hipFuncSetAttribute((const void*)fwd_kernel, hipFuncAttributeMaxDynamicSharedMemorySize, LDS_BYTES) != hipSuccess) { fprintf(stderr, "kernel_launch: LDS attribute failed\n"); grid = -1; return; }
        if (hipOccupancyMaxActiveBlocksPerMultiprocessor(&per_cu, (const void*)fwd_kernel, 512, LDS_BYTES) != hipSuccess || per_cu < 1) { fprintf(stderr, "kernel_launch: occupancy query says %d\n", per_cu); }
        (void)hipGetLastError();
        grid = cus;
    }
    if (grid < 0) return;
    (void)hipMemsetAsync((char*)d_ws + WS_CTL, 0, CTL_BYTES, stream);
    Args a{};
    for (int i = 0; i < 29; ++i) a.in[i] = (const float*)d_in[i];
    a.out = (float*)d_out; a.ws = (unsigned char*)d_ws;
#if MK_MULTI_LAUNCH
    for (int ph = 0; ph < NPH; ++ph) { a.ph_lo = ph; a.ph_hi = ph + 1; hipLaunchKernelGGL(fwd_kernel, dim3(grid), dim3(512), LDS_BYTES, stream, a); }
#else
    a.ph_lo = 0; a.ph_hi = NPH;
    hipLaunchKernelGGL(fwd_kernel, dim3(grid), dim3(512), LDS_BYTES, stream, a);
#endif
}
```

```cpp
#include <hip/hip_runtime.h>
#include <stdint.h>
#include <stdio.h>

#define DI __device__ __forceinline__
#define LAS __attribute__((address_space(3)))
#define GAS __attribute__((address_space(1)))
typedef unsigned short bf16;
typedef short bf16x8 __attribute__((ext_vector_type(8)));
typedef short s16x4 __attribute__((ext_vector_type(4)));
typedef short v4i16_t __attribute__((ext_vector_type(4)));
typedef float f32x4 __attribute__((ext_vector_type(4)));
typedef float f32x16 __attribute__((ext_vector_type(16)));
typedef float f32x2_t __attribute__((ext_vector_type(2)));
typedef __bf16 bf16x2_t __attribute__((ext_vector_type(2)));
typedef unsigned u32x4 __attribute__((ext_vector_type(4)));
typedef unsigned u32x2 __attribute__((ext_vector_type(2)));
typedef int i32x4 __attribute__((ext_vector_type(4)));
typedef GAS unsigned gu32;

constexpr int T = 65536, D = 1024, SEQ = 2048, NBATCH = 32;
constexpr int EV_IN = 3592, EV_N = 3584, EVU = 3072;
constexpr int OD_N = 2560;
constexpr int DFF = 2816, DFE = 3584, NE = 8, CAP = 65536;
constexpr int MOE_NBP = 520, MOE_NPART = 1;
constexpr float ACT8_SCALE = 16.f;
constexpr float EPS = 1e-6f;
constexpr float LOG2E = 1.4426950408889634f;
constexpr float LAMBDA_INIT = 0.35550906f;

constexpr size_t MiB = 1u << 20;
constexpr size_t WS_CTL = 0, CTL_BYTES = 1 * MiB;
constexpr size_t WS_GA = 1 * MiB, WS_BETA = 2 * MiB, WS_ROWTS = 3 * MiB, WS_ROWGATE = 5 * MiB, WS_EG = 7 * MiB, WS_ROWSA = 8 * MiB, WS_SB = 10 * MiB, WS_SA = 11 * MiB;
constexpr size_t WS_W = 16 * MiB;
constexpr size_t W_EVIN = WS_W;
constexpr size_t W_EVOUT = W_EVIN + (size_t)EV_N * D;
constexpr size_t W_FFGU = W_EVOUT + (size_t)D * D * 2;
constexpr size_t W_FFD = W_FFGU + (size_t)2 * DFF * D;
constexpr size_t W_ODIN = W_FFD + (size_t)D * DFF * 2;
constexpr size_t W_ODOUT = W_ODIN + (size_t)OD_N * D;
constexpr size_t W_MGU = W_ODOUT + (size_t)D * D * 2;
constexpr size_t W_MD = W_MGU + (size_t)NE * 2 * DFE * D;
constexpr size_t W_PPROJ = W_MD + (size_t)NE * D * DFE;
constexpr size_t W_PGATE = W_PPROJ + (size_t)2 * D * 256 * 2;
constexpr size_t W_END = W_PGATE + (size_t)2 * D * D;
constexpr int SBO_MOE = 0, SBO_EVIN = NE * 2 * DFE, SBO_FFGU = SBO_EVIN + EV_N, SBO_ODIN = SBO_FFGU + 2 * DFF, SBO_PGATE = SBO_ODIN + OD_N, SBO_MD = SBO_PGATE + 2 * D, SBO_END = SBO_MD + NE * D;
constexpr size_t WS_XS = 125 * MiB;
constexpr size_t WS_PB2 = 128 * MiB;
constexpr size_t WS_HN = 222 * MiB;
constexpr size_t WS_G = 222 * MiB;
constexpr size_t WS_GX = 352 * MiB;
constexpr size_t WS_ACT8 = 288 * MiB;
constexpr size_t WS_U0 = 512 * MiB;
constexpr size_t WS_U = 384 * MiB;
constexpr size_t WS_XB = 768 * MiB;
constexpr size_t WS_Y = 896 * MiB;
constexpr size_t WS_END = 1024 * MiB;
static_assert(W_END <= WS_XS && WS_XS + (size_t)T * 16 <= WS_PB2 && W_END <= WS_PB2 && WS_PB2 + (size_t)T * 256 * 2 <= WS_HN, "weights fit");
static_assert(WS_G + (size_t)4096 * 73728 <= WS_U0, "gdn intermediates fit");
static_assert(WS_ACT8 + (size_t)MOE_NBP * 256 * DFE <= WS_XB && WS_HN + (size_t)(T + 1) * D <= WS_ACT8 && WS_U + (size_t)T * DFF * 2 <= WS_XB && WS_GX + (size_t)T * 256 * 2 <= WS_U, "moe act / ffn act fit");
constexpr size_t G_ITEM = 73728;
constexpr size_t G_W = 0, G_UT = 16384, G_QG = 32768, G_KD = 49152, G_QK = 65536;

constexpr int CW_CNT = 64;
constexpr int CW_BAR = 4096;
constexpr int CW_PCNT = 32768;
constexpr int CW_CMAX = 65536;

constexpr int LDS_BYTES = 160 * 1024;
constexpr int LDS_MISC = 131072 + 24576;
DI float bf2f(unsigned short b) { return __uint_as_float(((unsigned)b) << 16); }
DI float bflo(unsigned u) { return __uint_as_float(u << 16); }
DI float bfhi(unsigned u) { return __uint_as_float(u & 0xffff0000u); }
DI unsigned pk2(float lo, float hi) { f32x2_t v = {lo, hi}; bf16x2_t b = __builtin_convertvector(v, bf16x2_t); return __builtin_bit_cast(unsigned, b); }
DI float dppf(float v, const int ctrl_sel) {
    int r;
    switch (ctrl_sel) {
        case 0: r = __builtin_amdgcn_update_dpp(0, __builtin_bit_cast(int, v), 0xB1, 0xF, 0xF, true); break;
        case 1: r = __builtin_amdgcn_update_dpp(0, __builtin_bit_cast(int, v), 0x4E, 0xF, 0xF, true); break;
        case 2: r = __builtin_amdgcn_update_dpp(0, __builtin_bit_cast(int, v), 0x141, 0xF, 0xF, true); break;
        default: r = __builtin_amdgcn_update_dpp(0, __builtin_bit_cast(int, v), 0x140, 0xF, 0xF, true); break;
    }
    return __builtin_bit_cast(float, r);
}
DI float row16_sum(float v) { v += dppf(v, 0); v += dppf(v, 1); v += dppf(v, 2); v += dppf(v, 3); return v; }
DI float rlane(float v, int l) { return __builtin_bit_cast(float, __builtin_amdgcn_readlane(__builtin_bit_cast(int, v), l)); }
DI float wave_sum(float v) { v = row16_sum(v); return (rlane(v, 0) + rlane(v, 16)) + (rlane(v, 32) + rlane(v, 48)); }
DI float wave_max(float v) { v = fmaxf(v, dppf(v, 0)); v = fmaxf(v, dppf(v, 1)); v = fmaxf(v, dppf(v, 2)); v = fmaxf(v, dppf(v, 3)); return fmaxf(fmaxf(rlane(v, 0), rlane(v, 16)), fmaxf(rlane(v, 32), rlane(v, 48))); }
DI float dpp_ror8(float v) { return __builtin_bit_cast(float, __builtin_amdgcn_update_dpp(0, __builtin_bit_cast(int, v), 0x128, 0xF, 0xF, true)); }
DI void transpose_sum_row(float (&v)[64], int lane) {
    const bool b3 = (lane & 8) != 0, b2 = (lane & 4) != 0, b1 = (lane & 2) != 0, b0 = (lane & 1) != 0;
#pragma unroll
    for (int t = 0; t < 32; ++t) { const float keep = b3 ? v[t + 32] : v[t], send = b3 ? v[t] : v[t + 32]; v[t] = keep + dpp_ror8(send); }
#pragma unroll
    for (int t = 0; t < 16; ++t) { const float keep = b2 ? v[t + 16] : v[t], send = b2 ? v[t] : v[t + 16]; v[t] = keep + dppf(send, 2); }
#pragma unroll
    for (int t = 0; t < 8; ++t) { const float keep = b1 ? v[t + 8] : v[t], send = b1 ? v[t] : v[t + 8]; v[t] = keep + dppf(send, 1); }
#pragma unroll
    for (int t = 0; t < 4; ++t) { const float keep = b0 ? v[t + 4] : v[t], send = b0 ? v[t] : v[t + 4]; v[t] = keep + dppf(send, 0); }
}
DI void wave_sum8(float (&v)[8], int lane) {
    const bool b3 = (lane & 8) != 0, b2 = (lane & 4) != 0, b1 = (lane & 2) != 0;
#pragma unroll
    for (int t = 0; t < 4; ++t) { const float keep = b3 ? v[t + 4] : v[t], send = b3 ? v[t] : v[t + 4]; v[t] = keep + dpp_ror8(send); }
#pragma unroll
    for (int t = 0; t < 2; ++t) { const float keep = b2 ? v[t + 2] : v[t], send = b2 ? v[t] : v[t + 2]; v[t] = keep + dppf(send, 2); }
    float x; { const float keep = b1 ? v[1] : v[0], send = b1 ? v[0] : v[1]; x = keep + dppf(send, 1); }
    x += dppf(x, 0);
    x += __shfl_xor(x, 16); x += __shfl_xor(x, 32);
#pragma unroll
    for (int k = 0; k < 8; ++k) v[k] = rlane(x, 2 * k);
}
DI float sigmoid_f(float x) { return __builtin_amdgcn_rcpf(1.f + __builtin_amdgcn_exp2f(x * -1.4426950408889634f)); }
DI float silu_f(float x) { return x * sigmoid_f(x); }
DI int crow(int reg, int hh) { return (reg & 3) + 8 * (reg >> 2) + 4 * hh; }
DI bf16x8 pack_step(const f32x16& x, int s) {
    u32x4 p;
    p[0] = pk2(x[8 * s + 0], x[8 * s + 1]); p[1] = pk2(x[8 * s + 2], x[8 * s + 3]); p[2] = pk2(x[8 * s + 4], x[8 * s + 5]); p[3] = pk2(x[8 * s + 6], x[8 * s + 7]);
    return __builtin_bit_cast(bf16x8, p);
}
DI s16x4 vtr(const LAS unsigned char* p) { return __builtin_bit_cast(s16x4, __builtin_amdgcn_ds_read_tr16_b64_v4i16((LAS v4i16_t*)p)); }
DI bf16x8 cat8(s16x4 lo, s16x4 hi) { return __builtin_shufflevector(lo, hi, 0, 1, 2, 3, 4, 5, 6, 7); }
#define MFMA32(a, b, c) __builtin_amdgcn_mfma_f32_32x32x16_bf16((a), (b), (c), 0, 0, 0)
DI f32x16 zero16() { f32x16 z; for (int i = 0; i < 16; ++i) z[i] = 0.f; return z; }
#define WG_BAR() __syncthreads()
#define LDS_BAR() do { asm volatile("s_waitcnt lgkmcnt(0)" ::: "memory"); __builtin_amdgcn_s_barrier(); asm volatile("" ::: "memory"); } while (0)

#define XB_TMO      128
#define XB_XCNT(j)  (256  + 64 * (j))
#define XB_XSUB(j)  (1280 + 64 * (j))
#define XB_XGEN(j)  (2304 + 64 * (j))
#define XB_TOP      3328
#define XB_TOPGEN   3392
#define XCD_BAR_WORDS 3456
#define XB_SPIN_CAP (1u << 22)
DI unsigned xb_ld(unsigned* p)              { return __hip_atomic_load(p, __ATOMIC_RELAXED, __HIP_MEMORY_SCOPE_AGENT); }
DI unsigned xb_add(unsigned* p, unsigned v) { return __hip_atomic_fetch_add(p, v, __ATOMIC_RELAXED, __HIP_MEMORY_SCOPE_AGENT); }
DI unsigned xb_xcc_id() { return (unsigned)__builtin_amdgcn_s_getreg((3 << 11) | 20) & 0xFu; }
#define XB_SPIN(cond, bar) do { unsigned _sp = 0; while (cond) { __builtin_amdgcn_s_sleep(1); \
    if ((++_sp & 255u) == 0u) { if (xb_ld(&(bar)[XB_TMO])) break; if (_sp > XB_SPIN_CAP) { atomicAdd(&(bar)[XB_TMO], 1u); break; } } } } while (0)
struct XcdBarrier { unsigned* bar; unsigned x; volatile LAS unsigned* st; int wave; };
DI bool is_thread0(int wave) { int lane; asm volatile("v_mbcnt_lo_u32_b32 %0, -1, 0\n\tv_mbcnt_hi_u32_b32 %0, -1, %0" : "=v"(lane)); return wave == 0 && lane == 0; }
DI XcdBarrier xcd_barrier_post(unsigned* bar, volatile LAS unsigned* st, int wave) {
    XcdBarrier b; b.bar = bar; b.x = xb_xcc_id(); b.st = st; b.wave = wave;
    if (is_thread0(wave)) (void)xb_add(&bar[XB_XCNT(b.x)], 1u);
    return b;
}
DI void xcd_barrier_complete(unsigned* bar, unsigned x, unsigned& nloc, unsigned& nx) {
    const unsigned G = gridDim.x * gridDim.y * gridDim.z;
    unsigned sum, cnt, mine, sp = 0u;
    for (;;) {
        sum = 0u; cnt = 0u; mine = 0u;
#pragma unroll
        for (unsigned j = 0; j < 16; ++j) { const unsigned c = xb_ld(&bar[XB_XCNT(j)]); sum += c; cnt += (c > 0u) ? 1u : 0u; mine = (j == x) ? c : mine; }
        if (sum == G) break;
        __builtin_amdgcn_s_sleep(1);
        if ((++sp & 255u) == 0u) { if (xb_ld(&bar[XB_TMO])) break; if (sp > XB_SPIN_CAP) { atomicAdd(&bar[XB_TMO], 1u); break; } }
    }
    nloc = mine > 0u ? mine : 1u; nx = cnt > 0u ? cnt : 1u;
}
DI void xcd_barrier(const XcdBarrier& b) {
    asm volatile("s_waitcnt vmcnt(0)" ::: "memory");
    __syncthreads();
    if (is_thread0(b.wave)) {
        unsigned* bar = b.bar;
        __builtin_amdgcn_s_waitcnt(0);
        unsigned nloc = b.st[0], nx = b.st[1];
        if (nloc == 0u) { xcd_barrier_complete(bar, b.x, nloc, nx); b.st[0] = nloc; b.st[1] = nx; }
        const unsigned old = xb_add(&bar[XB_XSUB(b.x)], 1u);
        const unsigned gen = old / nloc;
        if (old + 1u == (gen + 1u) * nloc) {
            __builtin_amdgcn_fence(__ATOMIC_RELEASE, "agent");
            asm volatile("s_waitcnt vmcnt(0)" ::: "memory");
            const unsigned og = xb_add(&bar[XB_TOP], 1u);
            const unsigned tg = og / nx;
            if (og + 1u == (tg + 1u) * nx) xb_add(&bar[XB_TOPGEN], 1u);
            else XB_SPIN(xb_ld(&bar[XB_TOPGEN]) == tg, bar);
            __builtin_amdgcn_fence(__ATOMIC_ACQUIRE, "agent");
            xb_add(&bar[XB_XGEN(b.x)], 1u);
            asm volatile("s_waitcnt vmcnt(0)" ::: "memory");
        } else {
            XB_SPIN(xb_ld(&bar[XB_XGEN(b.x)]) == gen, bar);
            __builtin_amdgcn_fence(__ATOMIC_ACQUIRE, "agent");
            asm volatile("s_waitcnt vmcnt(0)" ::: "memory");
        }
    }
    __syncthreads();
}

struct Args { const float* in[29]; float* out; unsigned char* ws; int ph_lo, ph_hi; };
struct Frame {
    LAS unsigned char* lds;
    unsigned char* ws;
    int tid, lane, wave, G, vcu;
};

DI Frame phase_frame(const Frame& F0) {
    Frame F = F0; int lane;
    asm volatile("v_mbcnt_lo_u32_b32 %0, -1, 0\n\tv_mbcnt_hi_u32_b32 %0, -1, %0" : "=v"(lane));
    F.lane = lane; F.tid = F0.wave * 64 + lane; return F;
}
namespace pg8 {
constexpr int BM = 256, BK = 64, HALF = 128, HTB = HALF * BK * 2, STAGE_BYTES = 8 * HTB, NXCD = 8, WGM = 8;
__host__ __device__ __forceinline__ int lds_byte(int r, int c) { const int st = (r >> 4) * 2 + (c >> 5), rr = r & 15, cc = c & 31, ob = rr * 64 + cc * 2; return st * 1024 + (ob ^ (((ob >> 9) & 1) << 5)); }
__host__ __device__ __forceinline__ void stage_rc(int b, int& R, int& C) { const int st = b / 1024, sb = b % 1024, swz = sb ^ (((sb >> 9) & 1) << 5); R = (st >> 1) * 16 + swz / 64; C = (st & 1) * 32 + (swz % 64) / 2; }
__host__ __device__ __forceinline__ int perm32(int rho) { const int n = rho >> 4, i = rho & 15; return 8 * (i >> 2) + 4 * n + (i & 3); }

struct Unit { int pm, pn, e, lb, rows; };

DI bool static_unit(int i, int G, int c, int nM, int nN, int& pm, int& pn, int off = 0) {
    const int nwg = nM * nN; const long L = (long)i * G + c + off; if (L >= nwg) return false;
    int wgid = (int)L; { const int q = nwg / NXCD, r = nwg % NXCD, xcd = wgid % NXCD, off = wgid / NXCD; wgid = (xcd < r ? xcd * (q + 1) : r * (q + 1) + (xcd - r) * q) + off; }
    const int nig = WGM * nN, gid = wgid / nig, fm = gid * WGM, gsz = (nM - fm) < WGM ? (nM - fm) : WGM;
    pm = fm + ((wgid % nig) % gsz); pn = (wgid % nig) / gsz; return true;
}
struct SchedDense {
    static constexpr bool GATHER = false;
    const char* A; const char* Bt; int K, nM, nN, G, c, off, maxi;
    DI void init(const void* A_, const void* Bt_, int M, int N, int K_, int G_, int c_, int off_ = 0, int maxi_ = 1 << 30) { A = (const char*)A_; Bt = (const char*)Bt_; K = K_; nM = M / BM; nN = N / BM; G = G_; c = c_; off = off_; maxi = maxi_; }
    DI bool next(int i, Unit& u) const { u.e = 0; u.rows = 256; if (i >= maxi) return false; const bool ok = static_unit(i, G, c, nM, nN, u.pm, u.pn, off); u.lb = u.pm; return ok; }
    DI const char* a_base(const Unit& u) const { return A + (size_t)u.pm * BM * K * 2; }
    DI const char* b_base(const Unit& u) const { return Bt + (size_t)u.pn * BM * K * 2; }
    DI void ts_load(const Unit&, const int (&)[2], int (&)[2][2]) const {}
    DI void a_offs(const Unit&, const int (&R)[2], const int (&C)[2], const int (&)[2][2], unsigned (&o)[2][2]) const {
#pragma unroll
        for (int h = 0; h < 2; ++h)
#pragma unroll
            for (int i = 0; i < 2; ++i) o[h][i] = (unsigned)((h * HALF + R[i]) * K + C[i]) * 2u;
    }
};
struct SchedMoe {
    const char* A; const char* Bt; int K, nM, nN, G, c, blk0; size_t bstride; const int* row_ts; const LAS int* tab; bool gather;
    DI bool next(int i, Unit& u) const {
        int pm, pn; if (!static_unit(i, G, c, nM, nN, pm, pn)) return false;
        const int gb = blk0 + pm; int e = 0;
#pragma unroll
        for (int j = 1; j < 8; ++j) e += (gb >= tab[8 + j]) ? 1 : 0;
        e = __builtin_amdgcn_readfirstlane(e);
        const int lb = gb - __builtin_amdgcn_readfirstlane(tab[8 + e]); const int rem = __builtin_amdgcn_readfirstlane(tab[e]) - lb * 256;
        u.pm = pm; u.pn = pn; u.e = e; u.lb = lb; u.rows = rem < 256 ? rem : 256; return true;
    }
    DI const char* b_base(const Unit& u) const { return Bt + (size_t)u.e * bstride + (size_t)u.pn * BM * K * 2; }
};
struct SchedMoeGU : SchedMoe {
    static constexpr bool GATHER = true;
    DI const char* a_base(const Unit&) const { return A; }
    DI void ts_load(const Unit& u, const int (&R)[2], int (&ts)[2][2]) const {
#pragma unroll
        for (int h = 0; h < 2; ++h)
#pragma unroll
            for (int i = 0; i < 2; ++i) { const int lr = h * HALF + R[i]; ts[h][i] = (lr < u.rows) ? row_ts[(size_t)u.e * CAP + u.lb * 256 + lr] : (T << 1); }
    }
    DI void a_offs(const Unit&, const int (&)[2], const int (&C)[2], const int (&ts)[2][2], unsigned (&o)[2][2]) const {
#pragma unroll
        for (int h = 0; h < 2; ++h)
#pragma unroll
            for (int i = 0; i < 2; ++i) o[h][i] = ((unsigned)(ts[h][i] >> 1) * (unsigned)K + (unsigned)C[i]) * 2u;
    }
};
struct SchedMoeDown : SchedMoe {
    static constexpr bool GATHER = false;
    DI const char* a_base(const Unit& u) const { return A + (size_t)u.pm * BM * K * 2; }
    DI void ts_load(const Unit&, const int (&)[2], int (&)[2][2]) const {}
    DI void a_offs(const Unit&, const int (&R)[2], const int (&C)[2], const int (&)[2][2], unsigned (&o)[2][2]) const {
#pragma unroll
        for (int h = 0; h < 2; ++h)
#pragma unroll
            for (int i = 0; i < 2; ++i) o[h][i] = (unsigned)((h * HALF + R[i]) * K + C[i]) * 2u;
    }
};

typedef f32x4 Acc[2][2][4][2];
typedef i32x4 AccI[2][2][4][2];
template <bool I8> struct AccSel { typedef f32x4 type; };
template <> struct AccSel<true> { typedef i32x4 type; };
DI u32x4 pack8(const f32x4& v0, const f32x4& v1) { u32x4 w; w.x = pk2(v0[0], v0[1]); w.y = pk2(v0[2], v0[3]); w.z = pk2(v1[0], v1[1]); w.w = pk2(v1[2], v1[3]); return w; }

struct EpiStoreBf16 {
    static constexpr bool PERM = true; static constexpr int MODE = 0; static constexpr bool ALIGN = true;
    bf16* O; int ldc;
    struct Pre {}; DI void prefetch(Pre&, const Unit&, int, int, int, int) const {}
    DI void operator()(const Acc& acc, const Unit& u, int wr, int wc, int fr, int fq, const Pre&) const {
        const int row0 = u.pm * BM + wr * 64 + fr, col0 = u.pn * BM + wc * 32 + 8 * fq;
#pragma unroll
        for (int ai = 0; ai < 2; ++ai)
#pragma unroll
            for (int m = 0; m < 4; ++m) { bf16* rowp = O + (size_t)(row0 + ai * HALF + m * 16) * ldc + col0;
#pragma unroll
                for (int bj = 0; bj < 2; ++bj) *(u32x4*)(rowp + bj * HALF) = pack8(acc[ai][bj][m][0], acc[ai][bj][m][1]); }
    }
};
struct EpiEvIn {
    static constexpr bool PERM = true; static constexpr int MODE = 0; static constexpr bool ALIGN = true;
    bf16* O;
    struct Pre {}; DI void prefetch(Pre&, const Unit&, int, int, int, int) const {}
    DI void operator()(const Acc& acc, const Unit& u, int wr, int wc, int fr, int fq, const Pre&) const {
        const int row0 = u.pm * BM + wr * 64 + fr;
        if (u.pn >= 2 && u.pn < 6) {
            const int col0 = 512 + (u.pn - 2) * HALF + wc * 32 + 8 * fq;
#pragma unroll
            for (int ai = 0; ai < 2; ++ai)
#pragma unroll
                for (int m = 0; m < 4; ++m) { bf16* rowp = O + (size_t)(row0 + ai * HALF + m * 16) * EVU + col0;
                    *(u32x4*)rowp = pack8(acc[ai][0][m][0] * acc[ai][1][m][0], acc[ai][0][m][1] * acc[ai][1][m][1]); }
        } else {
            const int col0 = u.pn * BM - (u.pn >= 6 ? 512 : 0) + wc * 32 + 8 * fq;
#pragma unroll
            for (int ai = 0; ai < 2; ++ai)
#pragma unroll
                for (int m = 0; m < 4; ++m) { bf16* rowp = O + (size_t)(row0 + ai * HALF + m * 16) * EVU + col0;
#pragma unroll
                    for (int bj = 0; bj < 2; ++bj) *(u32x4*)(rowp + bj * HALF) = pack8(acc[ai][bj][m][0], acc[ai][bj][m][1]); }
        }
    }
};
struct EpiSwiGLU {
    static constexpr bool PERM = true; static constexpr int MODE = 0; static constexpr bool ALIGN = true;
    bf16* O; int ldc;
    struct Pre {}; DI void prefetch(Pre&, const Unit&, int, int, int, int) const {}
    DI void operator()(const Acc& acc, const Unit& u, int wr, int wc, int fr, int fq, const Pre&) const {
        const int row0 = u.pm * BM + wr * 64 + fr, col0 = u.pn * HALF + wc * 32 + 8 * fq;
#pragma unroll
        for (int ai = 0; ai < 2; ++ai)
#pragma unroll
            for (int m = 0; m < 4; ++m) { bf16* rowp = O + (size_t)(row0 + ai * HALF + m * 16) * ldc + col0;
                f32x4 v0, v1;
#pragma unroll
                for (int j = 0; j < 4; ++j) { v0[j] = silu_f(acc[ai][0][m][0][j]) * acc[ai][1][m][0][j]; v1[j] = silu_f(acc[ai][0][m][1][j]) * acc[ai][1][m][1][j]; }
                *(u32x4*)rowp = pack8(v0, v1); }
    }
};
template <bool OUT8> struct EpiSwiGLUI8T {
    static constexpr bool PERM = true; static constexpr int MODE = 1; static constexpr bool ALIGN = true;
    bf16* O; int ldc; const float* row_sa; const float* sb;
    struct Pre { f32x4 sl0, sl1, sp0, sp1; float ra[2][4]; };
    DI void prefetch(Pre& p, const Unit& u, int wr, int wc, int fr, int fq) const {
        const size_t rbase = (size_t)u.e * CAP + u.lb * 256;
        const float* sbp = sb + (size_t)u.e * (2 * DFE) + u.pn * BM + wc * 32 + 8 * fq;
        const f32x4 sg0 = *(const f32x4*)sbp, sg1 = *(const f32x4*)(sbp + 4), su0 = *(const f32x4*)(sbp + HALF), su1 = *(const f32x4*)(sbp + HALF + 4);
        p.sl0 = sg0 * (-LOG2E); p.sl1 = sg1 * (-LOG2E); p.sp0 = sg0 * su0 * (OUT8 ? ACT8_SCALE : 1.f); p.sp1 = sg1 * su1 * (OUT8 ? ACT8_SCALE : 1.f);
#pragma unroll
        for (int ai = 0; ai < 2; ++ai)
#pragma unroll
            for (int m = 0; m < 4; ++m) { const int lr = ai * HALF + wr * 64 + m * 16 + fr; const float rv = row_sa[rbase + (lr < u.rows ? lr : 0)]; p.ra[ai][m] = (lr < u.rows) ? rv : 0.f; }
    }
    DI f32x2_t pair(const i32x4& g, const i32x4& u, int h2, f32x2_t t1, f32x2_t t2) const {
        const f32x2_t gf = {(float)g[2 * h2], (float)g[2 * h2 + 1]}, uf = {(float)u[2 * h2], (float)u[2 * h2 + 1]};
        const f32x2_t ea = gf * t1;
        f32x2_t e = {__builtin_amdgcn_exp2f(ea.x), __builtin_amdgcn_exp2f(ea.y)};
        e = e + 1.f;
        const f32x2_t r = {__builtin_amdgcn_rcpf(e.x), __builtin_amdgcn_rcpf(e.y)};
        f32x2_t o = (gf * uf) * t2; o = o * r;
        if constexpr (OUT8) { o.x = __builtin_amdgcn_fmed3f(o.x, -448.f, 448.f); o.y = __builtin_amdgcn_fmed3f(o.y, -448.f, 448.f); }
        return o;
    }
    DI void operator()(const AccI& acc, const Unit& u, int wr, int wc, int fr, int fq, const Pre& p) const {
        const int row0 = u.pm * BM + wr * 64 + fr, col0 = u.pn * HALF + wc * 32 + 8 * fq;
#pragma unroll
        for (int ai = 0; ai < 2; ++ai)
#pragma unroll
            for (int m = 0; m < 4; ++m) {
                const float ra = p.ra[ai][m], ra2 = ra * ra;
                const f32x4 t1a = p.sl0 * ra, t1b = p.sl1 * ra, t2a = p.sp0 * ra2, t2b = p.sp1 * ra2;
                const f32x2_t o0 = pair(acc[ai][0][m][0], acc[ai][1][m][0], 0, (f32x2_t){t1a[0], t1a[1]}, (f32x2_t){t2a[0], t2a[1]});
                const f32x2_t o1 = pair(acc[ai][0][m][0], acc[ai][1][m][0], 1, (f32x2_t){t1a[2], t1a[3]}, (f32x2_t){t2a[2], t2a[3]});
                const f32x2_t o2 = pair(acc[ai][0][m][1], acc[ai][1][m][1], 0, (f32x2_t){t1b[0], t1b[1]}, (f32x2_t){t2b[0], t2b[1]});
                const f32x2_t o3 = pair(acc[ai][0][m][1], acc[ai][1][m][1], 1, (f32x2_t){t1b[2], t1b[3]}, (f32x2_t){t2b[2], t2b[3]});
                if constexpr (OUT8) {
                    unsigned char* p8 = (unsigned char*)O + (size_t)(row0 + ai * HALF + m * 16) * ldc + col0;
                    int p0 = 0, p1 = 0; p0 = __builtin_amdgcn_cvt_pk_fp8_f32(o0.x, o0.y, p0, false); p0 = __builtin_amdgcn_cvt_pk_fp8_f32(o1.x, o1.y, p0, true);
                    p1 = __builtin_amdgcn_cvt_pk_fp8_f32(o2.x, o2.y, p1, false); p1 = __builtin_amdgcn_cvt_pk_fp8_f32(o3.x, o3.y, p1, true);
                    *(u32x2*)p8 = (u32x2){(unsigned)p0, (unsigned)p1};
                } else {
                    bf16* rowp = O + (size_t)(row0 + ai * HALF + m * 16) * ldc + col0;
                    u32x4 w; w.x = pk2(o0.x, o0.y); w.y = pk2(o1.x, o1.y); w.z = pk2(o2.x, o2.y); w.w = pk2(o3.x, o3.y);
                    *(u32x4*)rowp = w;
                }
            }
    }
};
typedef EpiSwiGLUI8T<false> EpiSwiGLUI8;
typedef EpiSwiGLUI8T<true> EpiSwiGLUI8F8;
struct EpiEvInI8 {
    static constexpr bool PERM = true; static constexpr int MODE = 1; static constexpr bool ALIGN = true;
    bf16* O; const float* sa; const float* sb;
    struct Pre { f32x4 s00, s01, s10, s11; float ra[2][4]; };
    DI void prefetch(Pre& p, const Unit& u, int wr, int wc, int fr, int fq) const {
        const float* sbp = sb + u.pn * BM + wc * 32 + 8 * fq; const int row0 = u.pm * BM + wr * 64 + fr;
        p.s00 = *(const f32x4*)sbp; p.s01 = *(const f32x4*)(sbp + 4); p.s10 = *(const f32x4*)(sbp + HALF); p.s11 = *(const f32x4*)(sbp + HALF + 4);
#pragma unroll
        for (int ai = 0; ai < 2; ++ai)
#pragma unroll
            for (int m = 0; m < 4; ++m) p.ra[ai][m] = sa[row0 + ai * HALF + m * 16];
    }
    DI void operator()(const AccI& acc, const Unit& u, int wr, int wc, int fr, int fq, const Pre& p) const {
        const int row0 = u.pm * BM + wr * 64 + fr;
        const f32x4 s00 = p.s00, s01 = p.s01, s10 = p.s10, s11 = p.s11;
        if (u.pn >= 2 && u.pn < 6) {
            const int col0 = 512 + (u.pn - 2) * HALF + wc * 32 + 8 * fq;
#pragma unroll
            for (int ai = 0; ai < 2; ++ai)
#pragma unroll
                for (int m = 0; m < 4; ++m) { const int row = row0 + ai * HALF + m * 16; const float ra = p.ra[ai][m]; bf16* rowp = O + (size_t)row * EVU + col0;
                    f32x4 v0, v1;
#pragma unroll
                    for (int j = 0; j < 4; ++j) { v0[j] = ((float)acc[ai][0][m][0][j] * (ra * s00[j])) * ((float)acc[ai][1][m][0][j] * (ra * s10[j])); v1[j] = ((float)acc[ai][0][m][1][j] * (ra * s01[j])) * ((float)acc[ai][1][m][1][j] * (ra * s11[j])); }
                    *(u32x4*)rowp = pack8(v0, v1); }
        } else {
            const int col0 = u.pn * BM - (u.pn >= 6 ? 512 : 0) + wc * 32 + 8 * fq;
#pragma unroll
            for (int ai = 0; ai < 2; ++ai)
#pragma unroll
                for (int m = 0; m < 4; ++m) { const int row = row0 + ai * HALF + m * 16; const float ra = p.ra[ai][m]; bf16* rowp = O + (size_t)row * EVU + col0;
                    f32x4 v0, v1, v2, v3;
#pragma unroll
                    for (int j = 0; j < 4; ++j) { v0[j] = (float)acc[ai][0][m][0][j] * (ra * s00[j]); v1[j] = (float)acc[ai][0][m][1][j] * (ra * s01[j]); v2[j] = (float)acc[ai][1][m][0][j] * (ra * s10[j]); v3[j] = (float)acc[ai][1][m][1][j] * (ra * s11[j]); }
                    *(u32x4*)rowp = pack8(v0, v1); *(u32x4*)(rowp + HALF) = pack8(v2, v3); }
        }
    }
};
struct EpiStoreBf16I8 {
    static constexpr bool PERM = true; static constexpr int MODE = 1; static constexpr bool ALIGN = true;
    bf16* O; int ldc; const float* sa; const float* sb;
    struct Pre { f32x4 s00, s01, s10, s11; float ra[2][4]; };
    DI void prefetch(Pre& p, const Unit& u, int wr, int wc, int fr, int fq) const {
        const float* sbp = sb + u.pn * BM + wc * 32 + 8 * fq; const int row0 = u.pm * BM + wr * 64 + fr;
        p.s00 = *(const f32x4*)sbp; p.s01 = *(const f32x4*)(sbp + 4); p.s10 = *(const f32x4*)(sbp + HALF); p.s11 = *(const f32x4*)(sbp + HALF + 4);
#pragma unroll
        for (int ai = 0; ai < 2; ++ai)
#pragma unroll
            for (int m = 0; m < 4; ++m) p.ra[ai][m] = sa[row0 + ai * HALF + m * 16];
    }
    DI void operator()(const AccI& acc, const Unit& u, int wr, int wc, int fr, int fq, const Pre& p) const {
        const int row0 = u.pm * BM + wr * 64 + fr, col0 = u.pn * BM + wc * 32 + 8 * fq;
        const f32x4 s00 = p.s00, s01 = p.s01, s10 = p.s10, s11 = p.s11;
#pragma unroll
        for (int ai = 0; ai < 2; ++ai)
#pragma unroll
            for (int m = 0; m < 4; ++m) { const int row = row0 + ai * HALF + m * 16; const float ra = p.ra[ai][m]; bf16* rowp = O + (size_t)row * ldc + col0;
                f32x4 v0, v1, v2, v3;
#pragma unroll
                for (int j = 0; j < 4; ++j) { v0[j] = (float)acc[ai][0][m][0][j] * (ra * s00[j]); v1[j] = (float)acc[ai][0][m][1][j] * (ra * s01[j]); v2[j] = (float)acc[ai][1][m][0][j] * (ra * s10[j]); v3[j] = (float)acc[ai][1][m][1][j] * (ra * s11[j]); }
                *(u32x4*)rowp = pack8(v0, v1); *(u32x4*)(rowp + HALF) = pack8(v2, v3); }
    }
};
struct EpiPleGateI8 {
    static constexpr bool PERM = true; static constexpr int MODE = 1; static constexpr bool ALIGN = true;
    bf16* h; const bf16* tmp; const float* sa; const float* sb;
    struct Pre { f32x4 sv[2][2]; u32x4 bv[2][2]; u32x4 tv[2][2]; float ra[2]; };
    DI void load_batch(u32x4 (&bv)[2][2], u32x4 (&tv)[2][2], float (&ra)[2], const Unit& u, int wr, int wc, int fr, int fq, int ai, int mp) const {
        const int row0 = u.pm * BM + wr * 64 + fr, col0 = u.pn * BM + wc * 32 + 8 * fq;
#pragma unroll
        for (int mm = 0; mm < 2; ++mm) { const int row = row0 + ai * HALF + (2 * mp + mm) * 16; ra[mm] = sa[row]; const size_t off = (size_t)row * D + col0;
#pragma unroll
            for (int bj = 0; bj < 2; ++bj) { tv[mm][bj] = *(const u32x4*)(tmp + off + bj * HALF); bv[mm][bj] = *(const u32x4*)(h + off + bj * HALF); } }
    }
    DI void prefetch(Pre& p, const Unit& u, int wr, int wc, int fr, int fq) const {
        const int col0 = u.pn * BM + wc * 32 + 8 * fq;
#pragma unroll
        for (int bj = 0; bj < 2; ++bj)
#pragma unroll
            for (int n = 0; n < 2; ++n) p.sv[bj][n] = *(const f32x4*)(sb + col0 + bj * HALF + n * 4) * (-LOG2E);
        load_batch(p.bv, p.tv, p.ra, u, wr, wc, fr, fq, 0, 0);
    }
    DI void operator()(const AccI& acc, const Unit& u, int wr, int wc, int fr, int fq, const Pre& p) const {
        const int row0 = u.pm * BM + wr * 64 + fr, col0 = u.pn * BM + wc * 32 + 8 * fq;
#pragma unroll
        for (int ai = 0; ai < 2; ++ai)
#pragma unroll
            for (int mp = 0; mp < 2; ++mp) {
                u32x4 bv[2][2]; u32x4 tv[2][2]; float ra[2];
                if (ai == 0 && mp == 0) {
#pragma unroll
                    for (int mm = 0; mm < 2; ++mm) { ra[mm] = p.ra[mm];
#pragma unroll
                        for (int bj = 0; bj < 2; ++bj) { tv[mm][bj] = p.tv[mm][bj]; bv[mm][bj] = p.bv[mm][bj]; } }
                } else load_batch(bv, tv, ra, u, wr, wc, fr, fq, ai, mp);
                asm volatile("" ::: "memory");
#pragma unroll
                for (int mm = 0; mm < 2; ++mm) { const int m = 2 * mp + mm; const size_t off = (size_t)(row0 + ai * HALF + m * 16) * D + col0;
#pragma unroll
                    for (int bj = 0; bj < 2; ++bj) { f32x4 r[2];
#pragma unroll
                        for (int n = 0; n < 2; ++n) { const i32x4 a = acc[ai][bj][m][n]; const f32x4 sc = p.sv[bj][n] * ra[mm];
                            const unsigned t0 = n ? tv[mm][bj].z : tv[mm][bj].x, t1 = n ? tv[mm][bj].w : tv[mm][bj].y;
                            const unsigned b0 = n ? bv[mm][bj].z : bv[mm][bj].x, b1 = n ? bv[mm][bj].w : bv[mm][bj].y;
                            const f32x2_t e0 = (f32x2_t){(float)a[0], (float)a[1]} * (f32x2_t){sc[0], sc[1]}, e1 = (f32x2_t){(float)a[2], (float)a[3]} * (f32x2_t){sc[2], sc[3]};
                            const f32x2_t d0 = (f32x2_t){__builtin_amdgcn_exp2f(e0.x), __builtin_amdgcn_exp2f(e0.y)} + 1.f, d1 = (f32x2_t){__builtin_amdgcn_exp2f(e1.x), __builtin_amdgcn_exp2f(e1.y)} + 1.f;
                            const f32x2_t s0 = {__builtin_amdgcn_rcpf(d0.x), __builtin_amdgcn_rcpf(d0.y)}, s1 = {__builtin_amdgcn_rcpf(d1.x), __builtin_amdgcn_rcpf(d1.y)};
                            const f32x2_t q0 = (f32x2_t){bflo(t0), bfhi(t0)} * s0 + (f32x2_t){bflo(b0), bfhi(b0)}, q1 = (f32x2_t){bflo(t1), bfhi(t1)} * s1 + (f32x2_t){bflo(b1), bfhi(b1)};
                            r[n][0] = q0.x; r[n][1] = q0.y; r[n][2] = q1.x; r[n][3] = q1.y; }
                        *(u32x4*)(h + off + bj * HALF) = pack8(r[0], r[1]); } }
                asm volatile("" ::: "memory");
            }
    }
};
struct EpiPleGateFinal {
    static constexpr bool PERM = true; static constexpr int MODE = 1; static constexpr bool ALIGN = true;
    unsigned char* ws; const float* gfin; float* out; LAS unsigned char* lds;
    struct Pre { f32x4 sv[2][2]; };
    DI void load_group(u32x4 (&bv)[2], u32x4 (&tv)[2], float& ra, const Unit& u, int wr, int wc, int fr, int fq, int ai, int m) const {
        const bf16* h = (const bf16*)(ws + WS_XB); const bf16* tmp = (const bf16*)(ws + WS_Y); const float* sa = (const float*)(ws + WS_SA);
        const int row = u.pm * BM + wr * 64 + fr + ai * HALF + m * 16, col0 = u.pn * BM + wc * 32 + 8 * fq; ra = sa[row]; const size_t off = (size_t)row * D + col0;
#pragma unroll
        for (int bj = 0; bj < 2; ++bj) { tv[bj] = *(const u32x4*)(tmp + off + bj * HALF); bv[bj] = *(const u32x4*)(h + off + bj * HALF); }
    }
    DI void prefetch(Pre& p, const Unit& u, int wr, int wc, int fr, int fq) const {
        const int col0 = u.pn * BM + wc * 32 + 8 * fq;
#pragma unroll
        for (int bj = 0; bj < 2; ++bj)
#pragma unroll
            for (int n = 0; n < 2; ++n) p.sv[bj][n] = *(const f32x4*)((const float*)(ws + WS_SB) + SBO_PGATE + D + col0 + bj * HALF + n * 4) * (-LOG2E);
    }
    DI void operator()(AccI& acc, const Unit& u, int wr, int wc, int fr, int fq, const Pre& p) const {
        const int row0 = u.pm * BM + wr * 64 + fr, col0 = u.pn * BM + wc * 32 + 8 * fq;
        float ssq[2][4];
#pragma unroll
        for (int ai = 0; ai < 2; ++ai)
#pragma unroll
            for (int m = 0; m < 4; ++m) {
                u32x4 bv[2], tv[2]; float ra; load_group(bv, tv, ra, u, wr, wc, fr, fq, ai, m);
                asm volatile("" ::: "memory");
                float sq = 0.f;
#pragma unroll
                for (int bj = 0; bj < 2; ++bj)
#pragma unroll
                    for (int n = 0; n < 2; ++n) { const i32x4 a = acc[ai][bj][m][n]; const f32x4 sc = p.sv[bj][n] * ra;
                        const unsigned t0 = n ? tv[bj].z : tv[bj].x, t1 = n ? tv[bj].w : tv[bj].y;
                        const unsigned b0 = n ? bv[bj].z : bv[bj].x, b1 = n ? bv[bj].w : bv[bj].y;
                        const f32x2_t e0 = (f32x2_t){(float)a[0], (float)a[1]} * (f32x2_t){sc[0], sc[1]}, e1 = (f32x2_t){(float)a[2], (float)a[3]} * (f32x2_t){sc[2], sc[3]};
                        const f32x2_t d0 = (f32x2_t){__builtin_amdgcn_exp2f(e0.x), __builtin_amdgcn_exp2f(e0.y)} + 1.f, d1 = (f32x2_t){__builtin_amdgcn_exp2f(e1.x), __builtin_amdgcn_exp2f(e1.y)} + 1.f;
                        const f32x2_t s0 = {__builtin_amdgcn_rcpf(d0.x), __builtin_amdgcn_rcpf(d0.y)}, s1 = {__builtin_amdgcn_rcpf(d1.x), __builtin_amdgcn_rcpf(d1.y)};
                        const f32x2_t q0 = (f32x2_t){bflo(t0), bfhi(t0)} * s0 + (f32x2_t){bflo(b0), bfhi(b0)}, q1 = (f32x2_t){bflo(t1), bfhi(t1)} * s1 + (f32x2_t){bflo(b1), bfhi(b1)};
                        const f32x4 r = {q0.x, q0.y, q1.x, q1.y};
                        sq += (r[0] * r[0] + r[1] * r[1]) + (r[2] * r[2] + r[3] * r[3]);
                        acc[ai][bj][m][n] = __builtin_bit_cast(i32x4, r); }
                ssq[ai][m] = sq;
                asm volatile("" ::: "memory");
            }
        LAS float* P = (LAS float*)(lds + 131072); LAS float* S = P + 4096;
#pragma unroll
        for (int ai = 0; ai < 2; ++ai)
#pragma unroll
            for (int m = 0; m < 4; ++m) P[(ai * HALF + wr * 64 + m * 16 + fr) * 16 + wc * 4 + fq] = ssq[ai][m];
        asm volatile("s_waitcnt lgkmcnt(0)" ::: "memory"); __builtin_amdgcn_s_barrier(); asm volatile("" ::: "memory");
        const int wid = wr * 4 + wc, lane = fq * 16 + fr, row = wid * 32 + (lane & 31);
        unsigned* slot = (unsigned*)(ws + WS_XS) + ((size_t)(u.pm * BM + row)) * 4;
        if (lane < 32) { const f32x4 p0 = *(const LAS f32x4*)(P + row * 16), p1 = *(const LAS f32x4*)(P + row * 16 + 4), p2 = *(const LAS f32x4*)(P + row * 16 + 8), p3 = *(const LAS f32x4*)(P + row * 16 + 12);
            const f32x4 pp = (p0 + p1) + (p2 + p3); const float tsum = (pp[0] + pp[1]) + (pp[2] + pp[3]);
            __hip_atomic_store(slot + u.pn, __float_as_uint(tsum), __ATOMIC_RELAXED, __HIP_MEMORY_SCOPE_AGENT); }
        asm volatile("s_waitcnt vmcnt(0)" ::: "memory");
        unsigned* pc = (unsigned*)(ws + WS_CTL) + CW_PCNT + 64 * u.pm;
        if (lane == 0) __hip_atomic_fetch_add(pc, 1u, __ATOMIC_RELAXED, __HIP_MEMORY_SCOPE_AGENT);
        if (wid == 0) {
            for (unsigned spin = 0; spin < 400000u; ++spin) {
                if ((unsigned)__builtin_amdgcn_readfirstlane((int)__hip_atomic_load(pc, __ATOMIC_RELAXED, __HIP_MEMORY_SCOPE_AGENT)) >= 32u) break;
                __builtin_amdgcn_s_sleep(2);
            }
            __builtin_amdgcn_fence(__ATOMIC_ACQUIRE, "agent");
        }
        asm volatile("s_waitcnt vmcnt(0) lgkmcnt(0)" ::: "memory"); __builtin_amdgcn_s_barrier(); asm volatile("" ::: "memory");
        if (lane < 32) {
            const float x0 = __uint_as_float(__hip_atomic_load(slot + 0, __ATOMIC_RELAXED, __HIP_MEMORY_SCOPE_AGENT)), x1 = __uint_as_float(__hip_atomic_load(slot + 1, __ATOMIC_RELAXED, __HIP_MEMORY_SCOPE_AGENT));
            const float x2 = __uint_as_float(__hip_atomic_load(slot + 2, __ATOMIC_RELAXED, __HIP_MEMORY_SCOPE_AGENT)), x3 = __uint_as_float(__hip_atomic_load(slot + 3, __ATOMIC_RELAXED, __HIP_MEMORY_SCOPE_AGENT));
            S[row] = rsqrtf(((x0 + x1) + (x2 + x3)) * (1.f / D) + EPS);
        }
        asm volatile("s_waitcnt vmcnt(0) lgkmcnt(0)" ::: "memory"); __builtin_amdgcn_s_barrier(); asm volatile("" ::: "memory");
        f32x4 gv[2][2];
#pragma unroll
        for (int bj = 0; bj < 2; ++bj)
#pragma unroll
            for (int n = 0; n < 2; ++n) gv[bj][n] = *(const f32x4*)(gfin + col0 + bj * HALF + n * 4);
#pragma unroll
        for (int ai = 0; ai < 2; ++ai)
#pragma unroll
            for (int m = 0; m < 4; ++m) { const float rs = S[ai * HALF + wr * 64 + m * 16 + fr]; float* orow = out + (size_t)(row0 + ai * HALF + m * 16) * D + col0;
#pragma unroll
                for (int bj = 0; bj < 2; ++bj)
#pragma unroll
                    for (int n = 0; n < 2; ++n) *(f32x4*)(orow + bj * HALF + n * 4) = __builtin_bit_cast(f32x4, acc[ai][bj][m][n]) * rs * gv[bj][n]; }
    }
};
struct EpiResid {
    static constexpr bool PERM = true; static constexpr int MODE = 0; static constexpr bool ALIGN = true;
    const float* base; bf16* out;
    struct Pre { f32x4 bv[2][2][2]; };
    DI void load_batch(f32x4 (&bv)[2][2][2], const Unit& u, int wr, int wc, int fr, int fq, int ai, int mp) const {
        const int row0 = u.pm * BM + wr * 64 + fr, col0 = u.pn * BM + wc * 32 + 8 * fq;
#pragma unroll
        for (int mm = 0; mm < 2; ++mm) { const size_t off = (size_t)(row0 + ai * HALF + (2 * mp + mm) * 16) * D + col0;
#pragma unroll
            for (int bj = 0; bj < 2; ++bj)
#pragma unroll
                for (int n = 0; n < 2; ++n) bv[mm][bj][n] = __builtin_nontemporal_load((const f32x4*)(base + off + bj * HALF + n * 4)); }
    }
    DI void prefetch(Pre& p, const Unit& u, int wr, int wc, int fr, int fq) const { load_batch(p.bv, u, wr, wc, fr, fq, 0, 0); }
    DI void operator()(const Acc& acc, const Unit& u, int wr, int wc, int fr, int fq, const Pre& p) const {
        const int row0 = u.pm * BM + wr * 64 + fr, col0 = u.pn * BM + wc * 32 + 8 * fq;
#pragma unroll
        for (int ai = 0; ai < 2; ++ai)
#pragma unroll
            for (int mp = 0; mp < 2; ++mp) {
                f32x4 bv[2][2][2];
                if (ai == 0 && mp == 0) {
#pragma unroll
                    for (int mm = 0; mm < 2; ++mm)
#pragma unroll
                        for (int bj = 0; bj < 2; ++bj)
#pragma unroll
                            for (int n = 0; n < 2; ++n) bv[mm][bj][n] = p.bv[mm][bj][n];
                } else load_batch(bv, u, wr, wc, fr, fq, ai, mp);
                asm volatile("" ::: "memory");
#pragma unroll
                for (int mm = 0; mm < 2; ++mm) { const int m = 2 * mp + mm; const size_t off = (size_t)(row0 + ai * HALF + m * 16) * D + col0;
#pragma unroll
                    for (int bj = 0; bj < 2; ++bj) *(u32x4*)(out + off + bj * HALF) = pack8(bv[mm][bj][0] + acc[ai][bj][m][0], bv[mm][bj][1] + acc[ai][bj][m][1]); }
                asm volatile("" ::: "memory");
            }
    }
};
struct EpiResidB {
    static constexpr bool PERM = true; static constexpr int MODE = 0; static constexpr bool ALIGN = true;
    bf16* h;
    struct Pre { u32x4 bv[4][2]; };
    DI void load_batch(u32x4 (&bv)[4][2], const Unit& u, int wr, int wc, int fr, int fq, int ai) const {
        const int row0 = u.pm * BM + wr * 64 + fr, col0 = u.pn * BM + wc * 32 + 8 * fq;
#pragma unroll
        for (int m = 0; m < 4; ++m) { const size_t off = (size_t)(row0 + ai * HALF + m * 16) * D + col0;
#pragma unroll
            for (int bj = 0; bj < 2; ++bj) bv[m][bj] = *(const u32x4*)(h + off + bj * HALF); }
    }
    DI void prefetch(Pre& p, const Unit& u, int wr, int wc, int fr, int fq) const { load_batch(p.bv, u, wr, wc, fr, fq, 0); }
    DI void operator()(const Acc& acc, const Unit& u, int wr, int wc, int fr, int fq, const Pre& p) const {
        const int row0 = u.pm * BM + wr * 64 + fr, col0 = u.pn * BM + wc * 32 + 8 * fq;
        u32x4 b1[4][2]; load_batch(b1, u, wr, wc, fr, fq, 1);
        asm volatile("" ::: "memory");
#pragma unroll
        for (int ai = 0; ai < 2; ++ai) {
#pragma unroll
            for (int m = 0; m < 4; ++m) { const size_t off = (size_t)(row0 + ai * HALF + m * 16) * D + col0;
#pragma unroll
                for (int bj = 0; bj < 2; ++bj) { const u32x4 b = ai ? b1[m][bj] : p.bv[m][bj]; const f32x4 a0 = acc[ai][bj][m][0], a1 = acc[ai][bj][m][1];
                    f32x4 r0, r1; r0[0] = bflo(b.x) + a0[0]; r0[1] = bfhi(b.x) + a0[1]; r0[2] = bflo(b.y) + a0[2]; r0[3] = bfhi(b.y) + a0[3];
                    r1[0] = bflo(b.z) + a1[0]; r1[1] = bfhi(b.z) + a1[1]; r1[2] = bflo(b.w) + a1[2]; r1[3] = bfhi(b.w) + a1[3];
                    *(u32x4*)(h + off + bj * HALF) = pack8(r0, r1); } }
            asm volatile("" ::: "memory");
        }
    }
};
struct EpiPleGate {
    static constexpr bool PERM = false; static constexpr int MODE = 0; static constexpr bool ALIGN = true;
    float* h; const bf16* tmp;
    struct Pre {}; DI void prefetch(Pre&, const Unit&, int, int, int, int) const {}
    DI void operator()(const Acc& acc, const Unit& u, int wr, int wc, int fr, int fq, const Pre&) const {
        const int row0 = u.pm * BM + wr * 64 + fr, col0 = u.pn * BM + wc * 32 + 4 * fq;
#pragma unroll
        for (int ai = 0; ai < 2; ++ai)
#pragma unroll
            for (int m = 0; m < 4; ++m) { const size_t off = (size_t)(row0 + ai * HALF + m * 16) * D + col0;
#pragma unroll
                for (int bj = 0; bj < 2; ++bj)
#pragma unroll
                    for (int n = 0; n < 2; ++n) { const size_t o = off + bj * HALF + n * 16; const f32x4 b = *(const f32x4*)(h + o); const u32x2 t = *(const u32x2*)(tmp + o); const f32x4 a = acc[ai][bj][m][n];
                        f32x4 r; r[0] = b[0] + bflo(t.x) * sigmoid_f(a[0]); r[1] = b[1] + bfhi(t.x) * sigmoid_f(a[1]); r[2] = b[2] + bflo(t.y) * sigmoid_f(a[2]); r[3] = b[3] + bfhi(t.y) * sigmoid_f(a[3]);
                        *(f32x4*)(h + o) = r; } }
    }
};
struct EpiMoeDown {
    static constexpr bool PERM = true; static constexpr int MODE = 2; static constexpr bool ALIGN = true;
    bf16* Y; const int* row_ts; const float* row_gate; const float* sb;
    struct Pre { f32x4 sc[2][2]; int ts[2][4]; float g[2][4]; };
    DI void prefetch(Pre& p, const Unit& u, int wr, int wc, int fr, int fq) const {
        const int col0 = u.pn * BM + wc * 32 + 8 * fq; const size_t rbase = (size_t)u.e * CAP + u.lb * 256;
        const float* sbp = sb + (size_t)u.e * D + col0;
        p.sc[0][0] = *(const f32x4*)sbp; p.sc[0][1] = *(const f32x4*)(sbp + 4); p.sc[1][0] = *(const f32x4*)(sbp + HALF); p.sc[1][1] = *(const f32x4*)(sbp + HALF + 4);
#pragma unroll
        for (int ai = 0; ai < 2; ++ai)
#pragma unroll
            for (int m = 0; m < 4; ++m) { const int lr = ai * HALF + wr * 64 + m * 16 + fr; const bool ok = lr < u.rows; const int lrc = ok ? lr : 0; const int tv_ = row_ts[rbase + lrc]; const float gv_ = row_gate[rbase + lrc]; p.ts[ai][m] = ok ? tv_ : -1; p.g[ai][m] = ok ? gv_ : 0.f; }
    }
    DI void operator()(const Acc& acc, const Unit& u, int wr, int wc, int fr, int fq, const Pre& p) const {
        const int col0 = u.pn * BM + wc * 32 + 8 * fq;
#pragma unroll
        for (int ai = 0; ai < 2; ++ai)
#pragma unroll
            for (int m = 0; m < 4; ++m) {
                if (p.ts[ai][m] >= 0) { const float g = p.g[ai][m] * (1.f / ACT8_SCALE); bf16* rowp = Y + (size_t)p.ts[ai][m] * D + col0;
#pragma unroll
                    for (int bj = 0; bj < 2; ++bj) *(u32x4*)(rowp + bj * HALF) = pack8(acc[ai][bj][m][0] * (p.sc[bj][0] * g), acc[ai][bj][m][1] * (p.sc[bj][1] * g)); } }
    }
};

DI f32x4 mma16(const bf16x8& a, const bf16x8& b, const f32x4& c) { return __builtin_amdgcn_mfma_f32_16x16x32_bf16(a, b, c, 0, 0, 0); }
DI i32x4 mma16(const bf16x8& a, const bf16x8& b, const i32x4& c) { return __builtin_amdgcn_mfma_i32_16x16x64_i8(__builtin_bit_cast(i32x4, a), __builtin_bit_cast(i32x4, b), c, 0, 0, 0); }
typedef int i32x8 __attribute__((ext_vector_type(8)));
DI f32x4 mma_fp8(const bf16x8& a0, const bf16x8& a1, const bf16x8& b0, const bf16x8& b1, const f32x4& c) {
    const i32x4 x0 = __builtin_bit_cast(i32x4, a0), x1 = __builtin_bit_cast(i32x4, a1), y0 = __builtin_bit_cast(i32x4, b0), y1 = __builtin_bit_cast(i32x4, b1);
    const i32x8 a = __builtin_shufflevector(x0, x1, 0, 1, 2, 3, 4, 5, 6, 7), b = __builtin_shufflevector(y0, y1, 0, 1, 2, 3, 4, 5, 6, 7);
    f32x4 d = c; const int sc = 0x7f7f7f7f;
    asm("v_mfma_scale_f32_16x16x128_f8f6f4 %0, %1, %2, %0, %3, %3 op_sel_hi:[0,0,0]" : "+v"(d) : "v"(a), "v"(b), "v"(sc));
    return d;
}
template <class Epi, class Sched>
DI void gemm_phase(LAS unsigned char* lds, const Sched& S, const Epi& E, int wave_id) {
    constexpr bool GATHER = Sched::GATHER; constexpr int MODE = Epi::MODE; constexpr bool ALIGN = Epi::ALIGN; typedef typename AccSel<MODE == 1>::type acc_t;
    int lane_; asm volatile("v_mbcnt_lo_u32_b32 %0, -1, 0\n\tv_mbcnt_hi_u32_b32 %0, -1, %0" : "=v"(lane_));
    const int wid = wave_id, lane = lane_, tid = wid * 64 + lane, wr = wid >> 2, wc = wid & 3, fq = lane >> 4; int fr = lane & 15;
    const int K = S.K, nt = K / BK;
    int Rr[2], Cc[2]; unsigned voffB[2];
#pragma unroll
    for (int i = 0; i < 2; ++i) { int R, C; stage_rc(tid * 16 + i * 8192, R, C); Rr[i] = R; Cc[i] = C; const int Rb = Epi::PERM ? ((R & ~31) + perm32(R & 31)) : R; voffB[i] = (unsigned)(Rb * K + C) * 2u; }
    const size_t kstep = (size_t)(BK * 2);
    const size_t hstep = (size_t)HALF * K * 2;
    const unsigned ldsw = (unsigned)wid * 1024u;
    const int aoff = lds_byte(wr * 64 + fr, fq * 8), boff = lds_byte(wc * 32 + fr, fq * 8);
#define PG8_SA(b, h) (((b) * 2 + (h)) * HTB)
#define PG8_SB(b, h) ((4 + (b) * 2 + (h)) * HTB)
#define PG8_STAGE(bufoff, gbase, voff) do { _Pragma("unroll") for (int _i = 0; _i < 2; ++_i) \
        __builtin_amdgcn_global_load_lds((const unsigned*)((const char*)(gbase) + (voff)[_i]), (LAS unsigned*)(lds + (bufoff) + ldsw + _i * 8192), 16, 0, 0); } while (0)
#define PG8_LDA(dst, b, h) do { _Pragma("unroll") for (int m = 0; m < 4; ++m) _Pragma("unroll") for (int k = 0; k < 2; ++k) dst[m][k] = *(const LAS bf16x8*)(lds + PG8_SA(b, h) + aoff + m * 2048 + k * 1024); } while (0)
#define PG8_LDB(dst, b, h) do { _Pragma("unroll") for (int n = 0; n < 2; ++n) _Pragma("unroll") for (int k = 0; k < 2; ++k) dst[n][k] = *(const LAS bf16x8*)(lds + PG8_SB(b, h) + boff + n * 2048 + k * 1024); } while (0)
#define PG8_MMA(ai, bj, At, Bt) do { __builtin_amdgcn_s_setprio(1); _Pragma("unroll") for (int m = 0; m < 4; ++m) _Pragma("unroll") for (int n = 0; n < 2; ++n) { \
        if constexpr (MODE == 2) acc[ai][bj][m][n] = mma_fp8(Bt[n][0], Bt[n][1], At[m][0], At[m][1], acc[ai][bj][m][n]); \
        else { _Pragma("unroll") for (int k = 0; k < 2; ++k) acc[ai][bj][m][n] = mma16(Bt[n][k], At[m][k], acc[ai][bj][m][n]); } } __builtin_amdgcn_s_setprio(0); } while (0)
#define PG8_WAIT_V(n) asm volatile("s_waitcnt vmcnt(" #n ")" ::: "memory")
#define PG8_WAIT_L(n) asm volatile("s_waitcnt lgkmcnt(" #n ")" ::: "memory")
#define PG8_BAR __builtin_amdgcn_s_barrier()
#define PG8_SCHED __builtin_amdgcn_sched_barrier(0)
    Unit cur, nxt, nn; int ui = 0;
    if (!S.next(0, cur)) return;
    acc_t acc[2][2][4][2];
#pragma unroll
    for (int a = 0; a < 2; ++a)
#pragma unroll
        for (int b = 0; b < 2; ++b)
#pragma unroll
            for (int m = 0; m < 4; ++m)
#pragma unroll
                for (int n = 0; n < 2; ++n) acc[a][b][m][n] = (acc_t){0, 0, 0, 0};
    bf16x8 At[4][2], B0[2][2], B1[2][2];
    unsigned vA[2][2], nvA[2][2]; int pts[2][2] = {{0, 0}, {0, 0}};
    { int ts0[2][2] = {{0, 0}, {0, 0}}; S.ts_load(cur, Rr, ts0); S.a_offs(cur, Rr, Cc, ts0, vA); }
    bool has_next = S.next(1, nxt);
    if (GATHER && has_next) S.ts_load(nxt, Rr, pts);
    const char* cA = S.a_base(cur); const char* cB = S.b_base(cur);
    PG8_STAGE(PG8_SB(0, 0), cB, voffB); PG8_STAGE(PG8_SB(0, 1), cB + hstep, voffB); PG8_STAGE(PG8_SA(0, 0), cA, vA[0]); PG8_STAGE(PG8_SA(0, 1), cA, vA[1]);
    if (wr == 1) PG8_BAR;
    PG8_WAIT_V(2); PG8_BAR;
    PG8_STAGE(PG8_SB(1, 0), cB + kstep, voffB); PG8_STAGE(PG8_SA(1, 0), cA + kstep, vA[0]); PG8_STAGE(PG8_SB(1, 1), cB + hstep + kstep, voffB);
    PG8_WAIT_V(6); PG8_BAR;
    for (;;) {
        const char* nA = has_next ? S.a_base(nxt) : cA; const char* nB = has_next ? S.b_base(nxt) : cB;
        if constexpr (GATHER) {
            if (has_next) S.a_offs(nxt, Rr, Cc, pts, nvA);
            else {
#pragma unroll
                for (int h = 0; h < 2; ++h)
#pragma unroll
                    for (int i = 0; i < 2; ++i) nvA[h][i] = vA[h][i];
            }
        }
        const bool has_nn = has_next && S.next(ui + 2, nn);
        if (GATHER && has_nn) S.ts_load(nn, Rr, pts);
        for (int t = 0; t < nt; t += 2) {
            const bool last = (t == nt - 2);
            const char* a1 = cA + (size_t)(t + 1) * kstep;
            const char* a2 = last ? nA : cA + (size_t)(t + 2) * kstep; const char* b2 = last ? nB : cB + (size_t)(t + 2) * kstep;
            const char* a3 = a2 + kstep; const char* b3 = b2 + kstep;
            unsigned w0[2], w1[2];
            if (GATHER) { w0[0] = last ? nvA[0][0] : vA[0][0]; w0[1] = last ? nvA[0][1] : vA[0][1]; w1[0] = last ? nvA[1][0] : vA[1][0]; w1[1] = last ? nvA[1][1] : vA[1][1]; }
            else { w0[0] = vA[0][0]; w0[1] = vA[0][1]; w1[0] = vA[1][0]; w1[1] = vA[1][1]; }
            PG8_LDB(B0, 0, 0); PG8_LDB(B1, 0, 1); PG8_SCHED; PG8_LDA(At, 0, 0); PG8_STAGE(PG8_SA(1, 1), a1, vA[1]);
            PG8_WAIT_V(8); PG8_WAIT_L(0); PG8_BAR; PG8_MMA(0, 0, At, B0); PG8_MMA(0, 1, At, B1); PG8_BAR; PG8_SCHED;
            PG8_LDA(At, 0, 1); PG8_STAGE(PG8_SA(0, 0), a2, w0); PG8_STAGE(PG8_SB(0, 0), b2, voffB); PG8_STAGE(PG8_SB(0, 1), b2 + hstep, voffB);
            PG8_WAIT_V(8); PG8_WAIT_L(0); PG8_BAR; PG8_MMA(1, 0, At, B0); PG8_MMA(1, 1, At, B1); PG8_BAR; PG8_SCHED;
            PG8_LDB(B0, 1, 0); PG8_LDB(B1, 1, 1); PG8_SCHED; PG8_LDA(At, 1, 0); PG8_STAGE(PG8_SA(0, 1), a2, w1);
            PG8_WAIT_V(8); PG8_WAIT_L(0); PG8_BAR; PG8_MMA(0, 0, At, B0); PG8_MMA(0, 1, At, B1); PG8_BAR; PG8_SCHED;
            PG8_LDA(At, 1, 1); PG8_STAGE(PG8_SA(1, 0), a3, w0); PG8_STAGE(PG8_SB(1, 0), b3, voffB); PG8_STAGE(PG8_SB(1, 1), b3 + hstep, voffB);
            PG8_WAIT_V(8); PG8_WAIT_L(0); PG8_BAR; PG8_MMA(1, 0, At, B0); PG8_MMA(1, 1, At, B1); PG8_BAR; PG8_SCHED;
        }
        typename Epi::Pre pre; E.prefetch(pre, cur, wr, wc, fr, fq);
        if constexpr (ALIGN) { if (wr == 0) PG8_BAR; }
        if constexpr (MODE == 2) asm volatile("s_nop 15\n\ts_nop 7" ::: "memory");
        E(acc, cur, wr, wc, fr, fq, pre);
        if (!has_next) break;
#pragma unroll
        for (int a = 0; a < 2; ++a)
#pragma unroll
            for (int b = 0; b < 2; ++b)
#pragma unroll
                for (int m = 0; m < 4; ++m)
#pragma unroll
                    for (int n = 0; n < 2; ++n) acc[a][b][m][n] = (acc_t){0, 0, 0, 0};
        cur = nxt; cA = nA; cB = nB; ++ui;
        if constexpr (GATHER) {
#pragma unroll
            for (int h = 0; h < 2; ++h)
#pragma unroll
                for (int i = 0; i < 2; ++i) vA[h][i] = nvA[h][i];
        }
        nxt = nn; has_next = has_nn;
        if constexpr (ALIGN) { if (wr == 1) PG8_BAR; }
    }
    PG8_WAIT_V(0);
    if constexpr (!ALIGN) { if (wr == 0) PG8_BAR; }
    PG8_BAR;
#undef PG8_SA
#undef PG8_SB
#undef PG8_STAGE
#undef PG8_LDA
#undef PG8_LDB
#undef PG8_MMA
#undef PG8_WAIT_V
#undef PG8_WAIT_L
#undef PG8_BAR
#undef PG8_SCHED
}
}

struct ConvJob { const float* W; bf16* WT; int K, ldn, col0, ncols, drow0, mode, nbatch; size_t sstride, dstride; };
DI void transpose_item(const ConvJob& J, int item, LAS float* scr, int lane) {
    const int per = (J.K / 64) * (J.ncols / 32); const int bi = item / per; int r = item - bi * per;
    const int nblk = J.ncols / 32, kb = r / nblk, nb = r % nblk, k0 = 64 * kb, j0 = 32 * nb;
    const float* W = J.W + (size_t)bi * J.sstride; bf16* WT = J.WT + (size_t)bi * J.dstride;
    float tv[32];
#pragma unroll
    for (int i = 0; i < 32; ++i) { const int kk = 2 * i + (lane >> 5); tv[i] = __builtin_nontemporal_load(W + (size_t)(k0 + kk) * J.ldn + J.col0 + j0 + (lane & 31)); }
#pragma unroll
    for (int i = 0; i < 32; ++i) { const int kk = 2 * i + (lane >> 5); scr[kk * 33 + (lane & 31)] = tv[i]; }
    asm volatile("s_waitcnt lgkmcnt(0)" ::: "memory");
    const int c = lane & 7;
    const int drow = J.drow0 + (J.mode ? ((j0 >> 7) * 256 + (j0 & 127)) : j0);
#pragma unroll
    for (int j = 0; j < 4; ++j) { const int n = (lane >> 3) + 8 * j; const LAS float* s = scr + (8 * c) * 33 + n;
        u32x4 o; o.x = pk2(s[0 * 33], s[1 * 33]); o.y = pk2(s[2 * 33], s[3 * 33]); o.z = pk2(s[4 * 33], s[5 * 33]); o.w = pk2(s[6 * 33], s[7 * 33]);
        *(u32x4*)(WT + (size_t)(drow + n) * J.K + k0 + 8 * c) = o; }
    asm volatile("s_waitcnt lgkmcnt(0)" ::: "memory");
}
constexpr int N_JOBS = 15;
DI ConvJob get_job(const Args& a, int j) {
    unsigned char* ws = a.ws; ConvJob J; J.nbatch = 1; J.sstride = 0; J.dstride = 0; J.mode = 0;
    switch (j) {
        case 0: J.W = a.in[6]; J.WT = (bf16*)(ws + W_EVIN); J.K = D; J.ldn = EV_IN; J.col0 = 0; J.ncols = 512; J.drow0 = 0; break;
        case 1: J.W = a.in[6]; J.WT = (bf16*)(ws + W_EVIN); J.K = D; J.ldn = EV_IN; J.col0 = 512; J.ncols = 512; J.drow0 = 512; J.mode = 1; break;
        case 2: J.W = a.in[6]; J.WT = (bf16*)(ws + W_EVIN); J.K = D; J.ldn = EV_IN; J.col0 = 1024; J.ncols = 512; J.drow0 = 640; J.mode = 1; break;
        case 3: J.W = a.in[6]; J.WT = (bf16*)(ws + W_EVIN); J.K = D; J.ldn = EV_IN; J.col0 = 1536; J.ncols = 2048; J.drow0 = 1536; break;
        case 4: J.W = a.in[12]; J.WT = (bf16*)(ws + W_EVOUT); J.K = D; J.ldn = D; J.col0 = 0; J.ncols = D; J.drow0 = 0; break;
        case 5: J.W = a.in[22]; J.WT = (bf16*)(ws + W_FFGU); J.K = D; J.ldn = 2 * DFF; J.col0 = 0; J.ncols = DFF; J.drow0 = 0; J.mode = 1; break;
        case 6: J.W = a.in[22]; J.WT = (bf16*)(ws + W_FFGU); J.K = D; J.ldn = 2 * DFF; J.col0 = DFF; J.ncols = DFF; J.drow0 = 128; J.mode = 1; break;
        case 7: J.W = a.in[23]; J.WT = (bf16*)(ws + W_FFD); J.K = DFF; J.ldn = D; J.col0 = 0; J.ncols = D; J.drow0 = 0; break;
        case 8: J.W = a.in[13]; J.WT = (bf16*)(ws + W_ODIN); J.K = D; J.ldn = OD_N; J.col0 = 0; J.ncols = OD_N; J.drow0 = 0; break;
        case 9: J.W = a.in[20]; J.WT = (bf16*)(ws + W_ODOUT); J.K = D; J.ldn = D; J.col0 = 0; J.ncols = D; J.drow0 = 0; break;
        case 10: J.W = a.in[25]; J.WT = (bf16*)(ws + W_MGU); J.K = D; J.ldn = 2 * DFE; J.col0 = 0; J.ncols = DFE; J.drow0 = 0; J.mode = 1; J.nbatch = NE; J.sstride = (size_t)D * 2 * DFE; J.dstride = (size_t)2 * DFE * D; break;
        case 11: J.W = a.in[25]; J.WT = (bf16*)(ws + W_MGU); J.K = D; J.ldn = 2 * DFE; J.col0 = DFE; J.ncols = DFE; J.drow0 = 128; J.mode = 1; J.nbatch = NE; J.sstride = (size_t)D * 2 * DFE; J.dstride = (size_t)2 * DFE * D; break;
        case 12: J.W = a.in[26]; J.WT = (bf16*)(ws + W_MD); J.K = DFE; J.ldn = D; J.col0 = 0; J.ncols = D; J.drow0 = 0; J.nbatch = NE; J.sstride = (size_t)DFE * D; J.dstride = (size_t)D * DFE; break;
        case 13: J.W = a.in[27]; J.WT = (bf16*)(ws + W_PPROJ); J.K = 256; J.ldn = D; J.col0 = 0; J.ncols = D; J.drow0 = 0; J.nbatch = 2; J.sstride = (size_t)256 * D; J.dstride = (size_t)D * 256; break;
        default: J.W = a.in[28]; J.WT = (bf16*)(ws + W_PGATE); J.K = D; J.ldn = D; J.col0 = 0; J.ncols = D; J.drow0 = 0; J.nbatch = 2; J.sstride = (size_t)D * D; J.dstride = (size_t)D * D; break;
    }
    return J;
}
DI void convert_weights(const Frame& F, const Args& a) {
    LAS float* scr = (LAS float*)(F.lds + F.wave * 16384);
    const int gw = F.vcu * 8 + F.wave, NGW = F.G * 8;
    for (int jj = 0; jj < 4; ++jj) {
        const int j = jj == 0 ? 4 : jj == 1 ? 7 : jj == 2 ? 9 : 13;
        const ConvJob J = get_job(a, j);
        const int nitems = J.nbatch * (J.K / 64) * (J.ncols / 32);
        for (int it = gw; it < nitems; it += NGW) transpose_item(J, it, scr, F.lane);
    }
}

struct QJob { const float* W; signed char* W8; int ldn, col0, ncols, drow0, mode, nbatch, rows_pb, sbo, K, fp8; size_t sstride; };
constexpr int N_QJOBS = 11;
DI QJob get_qjob(const Args& a, int j) {
    unsigned char* ws = a.ws; QJob J; J.nbatch = 1; J.sstride = 0; J.mode = 0; J.rows_pb = 0; J.K = D; J.fp8 = 0;
    switch (j) {
        case 10: J.W = a.in[26]; J.W8 = (signed char*)(ws + W_MD); J.ldn = D; J.col0 = 0; J.ncols = D; J.drow0 = 0; J.sbo = SBO_MD; J.nbatch = NE; J.rows_pb = D; J.sstride = (size_t)DFE * D; J.K = DFE; J.fp8 = 1; break;
        case 0: J.W = a.in[6]; J.W8 = (signed char*)(ws + W_EVIN); J.ldn = EV_IN; J.col0 = 0; J.ncols = 512; J.drow0 = 0; J.sbo = SBO_EVIN; break;
        case 1: J.W = a.in[6]; J.W8 = (signed char*)(ws + W_EVIN); J.ldn = EV_IN; J.col0 = 512; J.ncols = 512; J.drow0 = 512; J.mode = 1; J.sbo = SBO_EVIN; break;
        case 2: J.W = a.in[6]; J.W8 = (signed char*)(ws + W_EVIN); J.ldn = EV_IN; J.col0 = 1024; J.ncols = 512; J.drow0 = 640; J.mode = 1; J.sbo = SBO_EVIN; break;
        case 3: J.W = a.in[6]; J.W8 = (signed char*)(ws + W_EVIN); J.ldn = EV_IN; J.col0 = 1536; J.ncols = 2048; J.drow0 = 1536; J.sbo = SBO_EVIN; break;
        case 4: J.W = a.in[22]; J.W8 = (signed char*)(ws + W_FFGU); J.ldn = 2 * DFF; J.col0 = 0; J.ncols = DFF; J.drow0 = 0; J.mode = 1; J.sbo = SBO_FFGU; break;
        case 5: J.W = a.in[22]; J.W8 = (signed char*)(ws + W_FFGU); J.ldn = 2 * DFF; J.col0 = DFF; J.ncols = DFF; J.drow0 = 128; J.mode = 1; J.sbo = SBO_FFGU; break;
        case 6: J.W = a.in[13]; J.W8 = (signed char*)(ws + W_ODIN); J.ldn = OD_N; J.col0 = 0; J.ncols = OD_N; J.drow0 = 0; J.sbo = SBO_ODIN; break;
        case 7: J.W = a.in[28]; J.W8 = (signed char*)(ws + W_PGATE); J.ldn = D; J.col0 = 0; J.ncols = D; J.drow0 = 0; J.sbo = SBO_PGATE; J.nbatch = 2; J.rows_pb = D; J.sstride = (size_t)D * D; break;
        case 8: J.W = a.in[25]; J.W8 = (signed char*)(ws + W_MGU); J.ldn = 2 * DFE; J.col0 = 0; J.ncols = DFE; J.drow0 = 0; J.mode = 1; J.sbo = SBO_MOE; J.nbatch = NE; J.rows_pb = 2 * DFE; J.sstride = (size_t)D * 2 * DFE; break;
        default: J.W = a.in[25]; J.W8 = (signed char*)(ws + W_MGU); J.ldn = 2 * DFE; J.col0 = DFE; J.ncols = DFE; J.drow0 = 128; J.mode = 1; J.sbo = SBO_MOE; J.nbatch = NE; J.rows_pb = 2 * DFE; J.sstride = (size_t)D * 2 * DFE; break;
    }
    return J;
}
DI int q_drow(const QJob& J, int j0) { return J.drow0 + (J.mode ? ((j0 >> 7) * 256 + (j0 & 127)) : j0); }
DI void absmax_jobs(const Frame& F, const Args& a, int jlo, int jhi, int worker, int nworkers) {
    unsigned* cmax = (unsigned*)(F.ws + WS_CTL) + CW_CMAX;
    const int gw = worker * 8 + F.wave, NGW = nworkers * 8, lane = F.lane;
    for (int j = jlo; j < jhi; ++j) {
        const QJob J = get_qjob(a, j);
        const int nblk = J.ncols / 256, per = (J.K / 64) * nblk, nitems = J.nbatch * per;
        for (int it = gw; it < nitems; it += NGW) {
            const int bi = it / per, r = it - bi * per, kb = r / nblk, nb = r - kb * nblk;
            if (J.fp8 && (kb % 14) != 0) continue;
            const float* p = J.W + (size_t)bi * J.sstride + (size_t)(kb * 64) * J.ldn + J.col0 + nb * 256 + 4 * lane;
            f32x4 m = (f32x4){0.f, 0.f, 0.f, 0.f};
#pragma unroll 1
            for (int i0 = 0; i0 < 64; i0 += 16) {
                f32x4 tv[16];
#pragma unroll
                for (int i = 0; i < 16; ++i) tv[i] = __builtin_nontemporal_load((const f32x4*)(p + (size_t)(i0 + i) * J.ldn));
#pragma unroll
                for (int i = 0; i < 16; ++i) { m[0] = fmaxf(m[0], fabsf(tv[i][0])); m[1] = fmaxf(m[1], fabsf(tv[i][1])); m[2] = fmaxf(m[2], fabsf(tv[i][2])); m[3] = fmaxf(m[3], fabsf(tv[i][3])); }
            }
            unsigned* cp = cmax + J.sbo + bi * J.rows_pb + q_drow(J, nb * 256 + 4 * lane);
#pragma unroll
            for (int e = 0; e < 4; ++e) __hip_atomic_fetch_max(cp + e, __float_as_uint(m[e]), __ATOMIC_RELAXED, __HIP_MEMORY_SCOPE_AGENT);
        }
    }
}
DI void quant_jobs(const Frame& F, const Args& a, int jlo, int jhi, int worker, int nworkers) {
    const unsigned* cmax = (const unsigned*)(F.ws + WS_CTL) + CW_CMAX; float* SB = (float*)(F.ws + WS_SB);
    LAS float* scr = (LAS float*)(F.lds + F.wave * 17408);
    const int gw = worker * 8 + F.wave, NGW = nworkers * 8, lane = F.lane;
    for (int j = jlo; j < jhi; ++j) {
        const QJob J = get_qjob(a, j);
        const int nblk = J.ncols / 32, per = (J.K / 128) * nblk, nitems = J.nbatch * per;
        const float qmax = J.fp8 ? 448.f : 127.f;
        for (int it = gw; it < nitems; it += NGW) {
            const int bi = it / per, r = it - bi * per, kb = r / nblk, nb = r - kb * nblk, k0 = kb * 128, j0 = nb * 32;
            const int srow = J.sbo + bi * J.rows_pb + q_drow(J, j0);
            float cm = __uint_as_float(__hip_atomic_load(cmax + srow + (lane & 31), __ATOMIC_RELAXED, __HIP_MEMORY_SCOPE_AGENT));
            if (J.fp8) cm *= 4.f;
            const float inv = cm > 0.f ? qmax / cm : 0.f;
            const char* pb = (const char*)(J.W + (size_t)bi * J.sstride + (size_t)k0 * J.ldn + J.col0 + j0);
            const unsigned lo = (unsigned)((lane >> 5) * J.ldn + (lane & 31)) * 4u;
            {
                float tv[64];
#pragma unroll
                for (int i = 0; i < 64; ++i) tv[i] = __builtin_nontemporal_load((const float*)(pb + (lo + (unsigned)(2 * i * J.ldn) * 4u)));
#pragma unroll
                for (int i = 0; i < 64; ++i) scr[(2 * i + (lane >> 5)) * 33 + (lane & 31)] = tv[i] * inv;
            }
            asm volatile("s_waitcnt lgkmcnt(0)" ::: "memory");
            const int drow = bi * J.rows_pb + q_drow(J, j0);
            const int c = lane & 7;
#pragma unroll
            for (int jj = 0; jj < 4; ++jj) { const int n = (lane >> 3) + 8 * jj; const LAS float* sp = scr + (16 * c) * 33 + n;
                u32x4 o;
#pragma unroll
                for (int q = 0; q < 4; ++q) { float f0 = sp[(4 * q) * 33], f1 = sp[(4 * q + 1) * 33], f2 = sp[(4 * q + 2) * 33], f3 = sp[(4 * q + 3) * 33];
                    if (J.fp8) { int pk = 0; f0 = __builtin_amdgcn_fmed3f(f0, -448.f, 448.f); f1 = __builtin_amdgcn_fmed3f(f1, -448.f, 448.f); f2 = __builtin_amdgcn_fmed3f(f2, -448.f, 448.f); f3 = __builtin_amdgcn_fmed3f(f3, -448.f, 448.f);
                        pk = __builtin_amdgcn_cvt_pk_fp8_f32(f0, f1, pk, false); pk = __builtin_amdgcn_cvt_pk_fp8_f32(f2, f3, pk, true); o[q] = (unsigned)pk; }
                    else { const int b0 = __float2int_rn(f0), b1 = __float2int_rn(f1), b2 = __float2int_rn(f2), b3 = __float2int_rn(f3);
                        o[q] = (unsigned)(b0 & 0xff) | ((unsigned)(b1 & 0xff) << 8) | ((unsigned)(b2 & 0xff) << 16) | ((unsigned)(b3 & 0xff) << 24); } }
                *(u32x4*)(J.W8 + (size_t)(drow + n) * J.K + k0 + 16 * c) = o; }
            if (k0 == 0 && lane < 32) SB[srow + lane] = cm / qmax;
            asm volatile("s_waitcnt lgkmcnt(0)" ::: "memory");
        }
    }
}

DI void quant_k1024(const Frame& F, const Args& a, int jlo, int jhi, int worker, int nworkers) {
    float* SB = (float*)(F.ws + WS_SB);
    LAS float* scr = (LAS float*)(F.lds + F.wave * 17408);
    LAS float* cmx = (LAS float*)(F.lds + 8 * 17408);
    const int lane = F.lane, q = F.wave; int rot = 0;
#pragma unroll
    for (int j = jlo; j < jhi; ++j) {
        const QJob J = get_qjob(a, j);
        const int nblk = J.ncols / 32, nitems = J.nbatch * nblk;
        const int w0 = (worker + nworkers - (rot % nworkers)) % nworkers; rot += nitems;
        for (int it = w0; it < nitems; it += nworkers) {
            const int bi = it / nblk, nb = it - bi * nblk, j0 = nb * 32;
            const char* pb = (const char*)(J.W + (size_t)bi * J.sstride + (size_t)(128 * q) * J.ldn + J.col0 + j0);
            const unsigned lo = (unsigned)((lane >> 5) * J.ldn + (lane & 31)) * 4u;
            float v[64]; float m = 0.f;
#pragma unroll
            for (int i = 0; i < 64; ++i) v[i] = __builtin_nontemporal_load((const float*)(pb + (lo + (unsigned)(2 * i * J.ldn) * 4u)));
#pragma unroll
            for (int i = 0; i < 64; ++i) m = fmaxf(m, fabsf(v[i]));
            m = fmaxf(m, __shfl_xor(m, 32));
            if (lane < 32) cmx[q * 32 + lane] = m;
            LDS_BAR();
            float cm = cmx[lane & 31];
#pragma unroll
            for (int t = 1; t < 8; ++t) cm = fmaxf(cm, cmx[t * 32 + (lane & 31)]);
            const float inv = cm > 0.f ? 127.f / cm : 0.f;
            const int srow = J.sbo + bi * J.rows_pb + q_drow(J, j0), drow = bi * J.rows_pb + q_drow(J, j0);
#pragma unroll
            for (int i = 0; i < 64; ++i) scr[(2 * i + (lane >> 5)) * 33 + (lane & 31)] = v[i] * inv;
            asm volatile("s_waitcnt lgkmcnt(0)" ::: "memory");
            const int c = lane & 7, k0 = 128 * q;
#pragma unroll
            for (int jj = 0; jj < 4; ++jj) { const int n = (lane >> 3) + 8 * jj; const LAS float* sp = scr + (16 * c) * 33 + n;
                u32x4 o;
#pragma unroll
                for (int t = 0; t < 4; ++t) { const int b0 = __float2int_rn(sp[(4 * t) * 33]), b1 = __float2int_rn(sp[(4 * t + 1) * 33]), b2 = __float2int_rn(sp[(4 * t + 2) * 33]), b3 = __float2int_rn(sp[(4 * t + 3) * 33]);
                    o[t] = (unsigned)(b0 & 0xff) | ((unsigned)(b1 & 0xff) << 8) | ((unsigned)(b2 & 0xff) << 16) | ((unsigned)(b3 & 0xff) << 24); }
                *(u32x4*)(J.W8 + (size_t)(drow + n) * D + k0 + 16 * c) = o; }
            if (q == 0 && lane < 32) SB[srow + lane] = cm * (1.f / 127.f);
            LDS_BAR();
        }
    }
}

DI void load_row(const float* p, int lane, f32x4 (&v)[4]) {
    const f32x4* xr = (const f32x4*)p + lane;
#pragma unroll
    for (int j = 0; j < 4; ++j) v[j] = __builtin_nontemporal_load(xr + 64 * j);
}
DI float sumsq16(const f32x4 (&v)[4]) { float s = 0.f;
#pragma unroll
    for (int j = 0; j < 4; ++j) s += (v[j].x * v[j].x + v[j].y * v[j].y) + (v[j].z * v[j].z + v[j].w * v[j].w);
    return s; }
DI void store_bf16_row(bf16* orow, int lane, const f32x4 (&v)[4]) {
    u32x2* o8 = (u32x2*)orow + lane;
#pragma unroll
    for (int j = 0; j < 4; ++j) { u32x2 w; w.x = pk2(v[j].x, v[j].y); w.y = pk2(v[j].z, v[j].w); o8[64 * j] = w; }
}
DI float quant_row_store(signed char* drow, int lane, const f32x4 (&v)[4]) {
    float am = 0.f;
#pragma unroll
    for (int j = 0; j < 4; ++j) am = fmaxf(fmaxf(am, fmaxf(fabsf(v[j].x), fabsf(v[j].y))), fmaxf(fabsf(v[j].z), fabsf(v[j].w)));
    am = wave_max(am);
    const float qinv = am > 0.f ? 127.f / am : 0.f;
    unsigned* o4 = (unsigned*)drow + lane;
#pragma unroll
    for (int j = 0; j < 4; ++j) { const int b0 = __float2int_rn(v[j].x * qinv), b1 = __float2int_rn(v[j].y * qinv), b2 = __float2int_rn(v[j].z * qinv), b3 = __float2int_rn(v[j].w * qinv);
        o4[64 * j] = (unsigned)(b0 & 0xff) | ((unsigned)(b1 & 0xff) << 8) | ((unsigned)(b2 & 0xff) << 16) | ((unsigned)(b3 & 0xff) << 24); }
    return am * (1.f / 127.f);
}
DI void load_rowB(const bf16* p, int lane, u32x4 (&r)[2]) { const u32x4* xr = (const u32x4*)p + lane; r[0] = __builtin_nontemporal_load(xr); r[1] = __builtin_nontemporal_load(xr + 64); }
DI void load_gB(const float* g, int lane, f32x4 (&v)[4]) {
#pragma unroll
    for (int i = 0; i < 4; ++i) v[i] = *(const f32x4*)(g + 512 * (i >> 1) + 8 * lane + 4 * (i & 1));
}
DI void unpackB(const u32x4 (&r)[2], f32x4 (&v)[4]) {
#pragma unroll
    for (int j = 0; j < 2; ++j) { v[2 * j].x = bflo(r[j].x); v[2 * j].y = bfhi(r[j].x); v[2 * j].z = bflo(r[j].y); v[2 * j].w = bfhi(r[j].y);
        v[2 * j + 1].x = bflo(r[j].z); v[2 * j + 1].y = bfhi(r[j].z); v[2 * j + 1].z = bflo(r[j].w); v[2 * j + 1].w = bfhi(r[j].w); }
}
DI void addB(const u32x4 (&r)[2], f32x4 (&v)[4]) {
#pragma unroll
    for (int j = 0; j < 2; ++j) { v[2 * j].x += bflo(r[j].x); v[2 * j].y += bfhi(r[j].x); v[2 * j].z += bflo(r[j].y); v[2 * j].w += bfhi(r[j].y);
        v[2 * j + 1].x += bflo(r[j].z); v[2 * j + 1].y += bfhi(r[j].z); v[2 * j + 1].z += bflo(r[j].w); v[2 * j + 1].w += bfhi(r[j].w); }
}
DI void store_rowB(bf16* orow, int lane, const f32x4 (&v)[4]) { u32x4* o = (u32x4*)orow + lane; __builtin_nontemporal_store(pg8::pack8(v[0], v[1]), o); __builtin_nontemporal_store(pg8::pack8(v[2], v[3]), o + 64); }
DI unsigned q4(const f32x4& v, float qinv) { const int b0 = __float2int_rn(v.x * qinv), b1 = __float2int_rn(v.y * qinv), b2 = __float2int_rn(v.z * qinv), b3 = __float2int_rn(v.w * qinv);
    return (unsigned)(b0 & 0xff) | ((unsigned)(b1 & 0xff) << 8) | ((unsigned)(b2 & 0xff) << 16) | ((unsigned)(b3 & 0xff) << 24); }
DI float row_absmax(const f32x4 (&v)[4]) { float am = 0.f;
#pragma unroll
    for (int j = 0; j < 4; ++j) am = fmaxf(fmaxf(am, fmaxf(fabsf(v[j].x), fabsf(v[j].y))), fmaxf(fabsf(v[j].z), fabsf(v[j].w)));
    return wave_max(am); }
DI void store_q8B(signed char* drow, int lane, const f32x4 (&v)[4], float qinv) { u32x2* o8 = (u32x2*)drow + lane;
#pragma unroll
    for (int j = 0; j < 2; ++j) { u32x2 w; w.x = q4(v[2 * j], qinv); w.y = q4(v[2 * j + 1], qinv); o8[64 * j] = w; } }
DI float quant_row_storeB(signed char* drow, int lane, const f32x4 (&v)[4]) {
    const float am = row_absmax(v); const float qinv = am > 0.f ? 127.f / am : 0.f;
    store_q8B(drow, lane, v, qinv);
    return am * (1.f / 127.f);
}
DI void norm_plain(const Frame& F, const bf16* src, const float* g, signed char* dst, float* SA) {
    f32x4 gv[4]; load_gB(g, F.lane, gv);
    const int gw = F.vcu * 8 + F.wave, NGW = F.G * 8;
    u32x4 nr[2], n2[2]; load_rowB(src + (size_t)gw * D, F.lane, nr); load_rowB(src + (size_t)(gw + NGW) * D, F.lane, n2);
    for (int m = gw; m < T; m += NGW) {
        f32x4 v[4]; unpackB(nr, v);
        nr[0] = n2[0]; nr[1] = n2[1];
        if (m + 2 * NGW < T) load_rowB(src + (size_t)(m + 2 * NGW) * D, F.lane, n2);
        const float ssl = sumsq16(v);
#pragma unroll
        for (int j = 0; j < 4; ++j) v[j] = v[j] * gv[j];
        const float ssum = wave_sum(ssl), am = row_absmax(v);
        const float rstd = rsqrtf(ssum * (1.f / D) + EPS);
        store_q8B(dst + (size_t)m * D, F.lane, v, am > 0.f ? 127.f / am : 0.f);
        if (F.lane == 0) SA[m] = am * rstd * (1.f / 127.f);
    }
}
DI void norm_mix0(const Frame& F, const Args& a) {
    const float* x = a.in[0]; const float* g = a.in[2]; const float* win = a.in[6];
    signed char* dst = (signed char*)(F.ws + WS_HN); float* SA = (float*)(F.ws + WS_SA); float* GA = (float*)(F.ws + WS_GA); float* BT = (float*)(F.ws + WS_BETA);
    f32x4 gv[4]; load_row(g, F.lane, gv);
    float w8[16][8];
#pragma unroll
    for (int j = 0; j < 4; ++j)
#pragma unroll
        for (int e = 0; e < 4; ++e) { const int k = 256 * j + 4 * F.lane + e; const f32x4 lo = *(const f32x4*)(win + (size_t)k * EV_IN + EV_N), hi = *(const f32x4*)(win + (size_t)k * EV_IN + EV_N + 4);
#pragma unroll
            for (int c = 0; c < 4; ++c) { w8[4 * j + e][c] = lo[c]; w8[4 * j + e][4 + c] = hi[c]; } }
    const int h4 = F.lane & 3;
    const float negA = -__expf(a.in[9][h4]), dtb = a.in[10][h4];
    const int gw = F.vcu * 8 + F.wave, NGW = F.G * 8;
    f32x4 nv[4]; load_row(x + (size_t)gw * D, F.lane, nv);
    for (int m = gw; m < T; m += NGW) {
        f32x4 v[4];
#pragma unroll
        for (int j = 0; j < 4; ++j) v[j] = nv[j];
        if (m + NGW < T) load_row(x + (size_t)(m + NGW) * D, F.lane, nv);
        const float rstd = rsqrtf(wave_sum(sumsq16(v)) * (1.f / D) + EPS);
#pragma unroll
        for (int j = 0; j < 4; ++j) v[j] = v[j] * rstd * gv[j];
        { const float sc = quant_row_store(dst + (size_t)m * D, F.lane, v); if (F.lane == 0) SA[m] = sc; }
        float dsum[8];
#pragma unroll
        for (int c = 0; c < 8; ++c) { float s = 0.f;
#pragma unroll
            for (int j = 0; j < 4; ++j)
#pragma unroll
                for (int e = 0; e < 4; ++e) s += v[j][e] * w8[4 * j + e][c];
            dsum[c] = s; }
        wave_sum8(dsum, F.lane);
        float af = dsum[0], bfv = dsum[4];
        if (h4 == 1) { af = dsum[1]; bfv = dsum[5]; } else if (h4 == 2) { af = dsum[2]; bfv = dsum[6]; } else if (h4 == 3) { af = dsum[3]; bfv = dsum[7]; }
        const float z = af + dtb; const float sp = (z > 20.f) ? z : log1pf(__expf(z));
        if (F.lane < 4) { GA[(size_t)m * 4 + h4] = negA * sp; BT[(size_t)m * 4 + h4] = sigmoid_f(bfv); }
    }
}
DI void convert_p(const Frame& F, const float* p, bf16* dst) {
    const size_t n8 = (size_t)T * 256 / 8;
    for (size_t i = (size_t)F.vcu * 512 + F.tid; i < n8; i += (size_t)F.G * 512) {
        const f32x4 a = *(const f32x4*)(p + i * 8), b = *(const f32x4*)(p + i * 8 + 4);
        *(u32x4*)(dst + i * 8) = pg8::pack8(a, b);
    }
}
DI void norm_router(const Frame& F, const Args& a) {
    const bf16* h = (const bf16*)(F.ws + WS_XB); const float* g = a.in[3] + D; const float* wr_ = a.in[24];
    signed char* dst = (signed char*)(F.ws + WS_HN); int* row_ts = (int*)(F.ws + WS_ROWTS); float* row_gate = (float*)(F.ws + WS_ROWGATE); float* row_sa = (float*)(F.ws + WS_ROWSA); unsigned* ctl = (unsigned*)(F.ws + WS_CTL);
    f32x4 gv[4]; load_gB(g, F.lane, gv);
    float w8[16][8];
#pragma unroll
    for (int j = 0; j < 4; ++j)
#pragma unroll
        for (int e = 0; e < 4; ++e) { const int k = 512 * (j >> 1) + 8 * F.lane + 4 * (j & 1) + e; const f32x4 lo = *(const f32x4*)(wr_ + (size_t)k * 8), hi = *(const f32x4*)(wr_ + (size_t)k * 8 + 4);
#pragma unroll
            for (int c = 0; c < 4; ++c) { w8[4 * j + e][c] = lo[c]; w8[4 * j + e][4 + c] = hi[c]; } }
    const int gw = F.vcu * 8 + F.wave, NGW = F.G * 8;
    if (gw == 0) { unsigned* z = (unsigned*)(dst + (size_t)T * D) + F.lane;
#pragma unroll
        for (int j = 0; j < 4; ++j) z[64 * j] = 0u; }
    for (int grp = gw; grp < T / 32; grp += NGW) {
        int e0 = 0, e1 = 1; float g0 = 0.f, g1 = 0.f, sav = 0.f;
        u32x4 nr[2], n2[2]; load_rowB(h + (size_t)(grp * 32) * D, F.lane, nr); load_rowB(h + (size_t)(grp * 32 + 1) * D, F.lane, n2);
        for (int rr = 0; rr < 32; ++rr) {
            const int m = grp * 32 + rr;
            f32x4 v[4]; unpackB(nr, v);
            nr[0] = n2[0]; nr[1] = n2[1];
            if (rr + 2 < 32) load_rowB(h + (size_t)(m + 2) * D, F.lane, n2);
            const float rstd = rsqrtf(wave_sum(sumsq16(v)) * (1.f / D) + EPS);
#pragma unroll
            for (int j = 0; j < 4; ++j) v[j] = v[j] * rstd * gv[j];
            const float am = row_absmax(v);
            const float qinv = am > 0.f ? 127.f / am : 0.f;
            store_q8B(dst + (size_t)m * D, F.lane, v, qinv);
            float lg[8];
#pragma unroll
            for (int c = 0; c < 8; ++c) { float s = 0.f;
#pragma unroll
                for (int j = 0; j < 4; ++j)
#pragma unroll
                    for (int e = 0; e < 4; ++e) s += v[j][e] * w8[4 * j + e][c];
                lg[c] = s; }
            wave_sum8(lg, F.lane);
            int b0 = 0; float v0 = lg[0];
#pragma unroll
            for (int c = 1; c < 8; ++c) if (lg[c] > v0) { v0 = lg[c]; b0 = c; }
            int b1 = -1; float v1 = -INFINITY;
#pragma unroll
            for (int c = 0; c < 8; ++c) if (c != b0 && lg[c] > v1) { v1 = lg[c]; b1 = c; }
            const float ga = 1.f / (1.f + __expf(v1 - v0));
            if (F.lane == rr) { e0 = b0; e1 = b1; g0 = ga; g1 = 1.f - ga; sav = am * (1.f / 127.f); }
        }
        const bool act = F.lane < 32;
#pragma unroll
        for (int e = 0; e < 8; ++e) {
            const unsigned long long m0 = __ballot(act && e0 == e), m1 = __ballot(act && e1 == e);
            const int n0 = __popcll(m0), n1 = __popcll(m1);
            if (n0 + n1 == 0) continue;
            unsigned base = 0;
            if (F.lane == 0) base = __hip_atomic_fetch_add(ctl + CW_CNT + 64 * e, (unsigned)(n0 + n1), __ATOMIC_RELAXED, __HIP_MEMORY_SCOPE_AGENT);
            base = (unsigned)__builtin_amdgcn_readfirstlane((int)base);
            const unsigned long long below = (1ull << F.lane) - 1ull;
            const int tok = grp * 32 + F.lane;
            if (act && e0 == e) { const unsigned off = base + (unsigned)__popcll(m0 & below); row_ts[(size_t)e * CAP + off] = tok * 2; row_gate[(size_t)e * CAP + off] = g0; row_sa[(size_t)e * CAP + off] = sav; }
            if (act && e1 == e) { const unsigned off = base + (unsigned)n0 + (unsigned)__popcll(m1 & below); row_ts[(size_t)e * CAP + off] = tok * 2 + 1; row_gate[(size_t)e * CAP + off] = g1; row_sa[(size_t)e * CAP + off] = sav; }
        }
    }
}
DI void combine_norm(const Frame& F, const Args& a) {
    bf16* h = (bf16*)(F.ws + WS_XB); const float* g = a.in[4] + D; const bf16* ym = (const bf16*)a.out; signed char* dst = (signed char*)(F.ws + WS_HN); float* SA = (float*)(F.ws + WS_SA);
    f32x4 gv[4]; load_gB(g, F.lane, gv);
    const int gw = F.vcu * 8 + F.wave, NGW = F.G * 8;
    u32x4 nh[2], np[2], nq[2];
    load_rowB(h + (size_t)gw * D, F.lane, nh); load_rowB(ym + (size_t)gw * 2 * D, F.lane, np); load_rowB(ym + (size_t)gw * 2 * D + D, F.lane, nq);
    for (int m = gw; m < T; m += NGW) {
        f32x4 v[4]; unpackB(nh, v); addB(np, v); addB(nq, v);
        if (m + NGW < T) { const int mn = m + NGW; load_rowB(h + (size_t)mn * D, F.lane, nh); load_rowB(ym + (size_t)mn * 2 * D, F.lane, np); load_rowB(ym + (size_t)mn * 2 * D + D, F.lane, nq); }
        store_rowB(h + (size_t)m * D, F.lane, v);
        const float ssl = sumsq16(v);
#pragma unroll
        for (int j = 0; j < 4; ++j) v[j] = v[j] * gv[j];
        const float ssum = wave_sum(ssl), am = row_absmax(v);
        const float rstd = rsqrtf(ssum * (1.f / D) + EPS);
        store_q8B(dst + (size_t)m * D, F.lane, v, am > 0.f ? 127.f / am : 0.f);
        if (F.lane == 0) SA[m] = am * rstd * (1.f / 127.f);
    }
}
DI void final_norm(const Frame& F, const Args& a) {
    const bf16* h = (const bf16*)(F.ws + WS_XB); float* o = a.out; const float* g = a.in[5];
    f32x4 gv[4]; load_gB(g, F.lane, gv);
    const int gw = F.vcu * 8 + F.wave, NGW = F.G * 8;
    u32x4 nr[2], n2[2]; load_rowB(h + (size_t)gw * D, F.lane, nr); load_rowB(h + (size_t)(gw + NGW) * D, F.lane, n2);
    for (int m = gw; m < T; m += NGW) {
        f32x4 v[4]; unpackB(nr, v);
        nr[0] = n2[0]; nr[1] = n2[1];
        if (m + 2 * NGW < T) load_rowB(h + (size_t)(m + 2 * NGW) * D, F.lane, n2);
        const float rstd = rsqrtf(wave_sum(sumsq16(v)) * (1.f / D) + EPS);
        float* orow = o + (size_t)m * D + 8 * F.lane;
#pragma unroll
        for (int i = 0; i < 4; ++i) __builtin_nontemporal_store(v[i] * rstd * gv[i], (f32x4*)(orow + 512 * (i >> 1) + 4 * (i & 1)));
    }
}

DI void mixer_a(const Frame& F, const Args& a, int worker, int nworkers) {
    const bf16* U = (const bf16*)(F.ws + WS_U0); bf16* Y = (bf16*)(F.ws + WS_Y); const float* cw = a.in[7];
    const int c8 = (F.tid & 63) * 8;
    float w0[8], w1[8], w2[8];
#pragma unroll
    for (int e = 0; e < 8; ++e) { w0[e] = cw[c8 + e]; w1[e] = cw[512 + c8 + e]; w2[e] = cw[1024 + c8 + e]; }
    const int rstride = 8 * nworkers;
    for (int run = worker * 8 + (F.tid >> 6); run < T / 8; run += rstride) {
        const int r0 = run * 8; const bool first = (r0 & (SEQ - 1)) == 0;
        const bf16* up = U + (size_t)r0 * EVU + c8;
        u32x4 z[10], bg[8];
        z[0] = (u32x4){0u, 0u, 0u, 0u}; z[1] = z[0];
        if (!first) { z[0] = __builtin_nontemporal_load((const u32x4*)(up - 2 * (size_t)EVU + 512)); z[1] = __builtin_nontemporal_load((const u32x4*)(up - (size_t)EVU + 512)); }
#pragma unroll
        for (int i = 0; i < 8; ++i) { z[2 + i] = __builtin_nontemporal_load((const u32x4*)(up + (size_t)i * EVU + 512)); bg[i] = __builtin_nontemporal_load((const u32x4*)(up + (size_t)i * EVU)); }
#pragma unroll
        for (int i = 0; i < 8; ++i) {
            float o[8];
#pragma unroll
            for (int p = 0; p < 4; ++p) {
                const float a0 = w0[2 * p] * bflo(z[i][p]) + w1[2 * p] * bflo(z[i + 1][p]) + w2[2 * p] * bflo(z[i + 2][p]);
                const float a1 = w0[2 * p + 1] * bfhi(z[i][p]) + w1[2 * p + 1] * bfhi(z[i + 1][p]) + w2[2 * p + 1] * bfhi(z[i + 2][p]);
                o[2 * p] = bflo(bg[i][p]) * a0; o[2 * p + 1] = bfhi(bg[i][p]) * a1;
            }
            u32x4 wv; wv.x = pk2(o[0], o[1]); wv.y = pk2(o[2], o[3]); wv.z = pk2(o[4], o[5]); wv.w = pk2(o[6], o[7]);
            *(u32x4*)(Y + (size_t)(r0 + i) * D + c8) = wv;
        }
    }
}

constexpr int GA_GCS = 0, GA_BTS = 256, GA_KN = 1024, GA_KB = GA_KN + 17408, GA_QN = GA_KB + 17408, GA_VBT = GA_QN + 17408, GA_KGT = GA_VBT + 18432,
              GA_AM = GA_KGT + 18432, GA_TB = GA_AM + 17408, GA_QKS = GA_TB + 9216, GA_CW = GA_QKS + 9216, GA_END = GA_CW + 6144;
static_assert(GA_END <= 155648, "gdn-a lds");
template <int I0, int I1> DI void subst_rows(const LAS float* Ab, float (&Tr)[32], int col) {
    typedef float f32x3_t __attribute__((ext_vector_type(3)));
    f32x4 av[I1 - I0][8]; float at[I1 - I0][3];
#pragma unroll
    for (int i = I0; i < I1; ++i) {
#pragma unroll
        for (int v = 0; v < i / 4; ++v) av[i - I0][v] = *(const LAS f32x4*)(Ab + i * 68 + 4 * v);
        const LAS float* tp = Ab + i * 68 + 4 * (i / 4);
        if ((i & 3) == 1) at[i - I0][0] = tp[0];
        else if ((i & 3) == 2) { const f32x2_t t = *(const LAS f32x2_t*)tp; at[i - I0][0] = t.x; at[i - I0][1] = t.y; }
        else if ((i & 3) == 3) { const f32x3_t t = *(const LAS f32x3_t*)tp; at[i - I0][0] = t.x; at[i - I0][1] = t.y; at[i - I0][2] = t.z; }
    }
    asm volatile("s_waitcnt lgkmcnt(0)" ::: "memory");
#pragma unroll
    for (int i = I0; i < I1; ++i) {
        float acc = (i == col) ? 1.f : 0.f;
#pragma unroll
        for (int j = 0; j < i; ++j) { const float aij = (j < 4 * (i / 4)) ? av[i - I0][j >> 2][j & 3] : at[i - I0][j & 3]; acc = __builtin_fmaf(-aij, Tr[j], acc); }
        Tr[i] = acc;
    }
    asm volatile("" ::: "memory");
}
DI void gdn_a(const Frame& F, const Args& a) {
    LAS unsigned char* L = F.lds;
    LAS float* gcs = (LAS float*)(L + GA_GCS); LAS float* bts = (LAS float*)(L + GA_BTS);
    LAS float* Am = (LAS float*)(L + GA_AM);
    const bf16* U = (const bf16*)(F.ws + WS_U0); const float* GA = (const float*)(F.ws + WS_GA); const float* BT = (const float*)(F.ws + WS_BETA);
    float* EG = (float*)(F.ws + WS_EG); const float* cw = a.in[8];
    const int lane = F.lane, w = F.wave, r = lane & 31, hh = lane >> 5;
    for (int item = F.vcu; item < 4096; item += F.G) {
        const int bh = item >> 5, n = item & 31, b = bh >> 2, h = bh & 3, t0 = b * SEQ + n * 64;
        unsigned char* Gp = F.ws + WS_G + (size_t)item * G_ITEM;
        if (w == 0) {
            float gc = GA[(size_t)(t0 + lane) * 4 + h];
#pragma unroll
            for (int o = 1; o < 64; o <<= 1) { const float up = __shfl_up(gc, o); if (lane >= o) gc += up; }
            gcs[lane] = gc; bts[lane] = BT[(size_t)(t0 + lane) * 4 + h];
            if (lane == 63) EG[item] = __expf(gc);
        }
        for (int i = F.tid; i < 1536; i += 512) { const int part = i >> 9, rem = i & 511, j = rem >> 7, c = rem & 127; *(LAS float*)(L + GA_CW + i * 4) = cw[j * 1536 + part * 512 + h * 128 + c]; }
        const int g2 = (F.tid >> 4) * 2, c8 = (F.tid & 15) * 8;
        u32x4 xr[3][5];
        {
            const bf16* ub = U + (size_t)t0 * EVU + 1024 + h * 128 + c8;
#pragma unroll
            for (int q = 0; q < 5; ++q) {
                const bool ok = (q >= 3) || (n * 64 + g2 - 3 + q >= 0);
                const bf16* rp = ub + (ptrdiff_t)(ok ? g2 - 3 + q : 0) * EVU;
#pragma unroll
                for (int part = 0; part < 3; ++part) { const u32x4 ld = *(const u32x4*)(rp + part * 512); xr[part][q] = ok ? ld : (u32x4){0u, 0u, 0u, 0u}; }
            }
        }
        WG_BAR();
        const float glast = gcs[63];
#pragma unroll
        for (int part = 0; part < 3; ++part) {
            float tp[2][8];
#pragma unroll
            for (int tk = 0; tk < 2; ++tk) {
                const int tok = g2 + tk;
                float acc[8];
#pragma unroll
                for (int e = 0; e < 8; ++e) acc[e] = 0.f;
#pragma unroll
                for (int j = 0; j < 4; ++j) {
                    const u32x4 xv = xr[part][tk + j];
                    const f32x4 w0 = *(const LAS f32x4*)(L + GA_CW + ((part * 4 + j) * 128 + c8) * 4), w1 = *(const LAS f32x4*)(L + GA_CW + ((part * 4 + j) * 128 + c8 + 4) * 4);
                    acc[0] += w0[0] * bflo(xv[0]); acc[1] += w0[1] * bfhi(xv[0]); acc[2] += w0[2] * bflo(xv[1]); acc[3] += w0[3] * bfhi(xv[1]);
                    acc[4] += w1[0] * bflo(xv[2]); acc[5] += w1[1] * bfhi(xv[2]); acc[6] += w1[2] * bflo(xv[3]); acc[7] += w1[3] * bfhi(xv[3]);
                }
                float ss = 0.f;
#pragma unroll
                for (int e = 0; e < 8; ++e) { acc[e] = silu_f(acc[e]); ss += acc[e] * acc[e]; }
                ss = row16_sum(ss);
                const float beta = bts[tok], gc = gcs[tok];
                if (part == 0) {
                    const float sc = rsqrtf(ss + EPS) * 0.08838834764831845f, eg = __expf(gc);
                    u32x4 o; o.x = pk2(acc[0] * sc, acc[1] * sc); o.y = pk2(acc[2] * sc, acc[3] * sc); o.z = pk2(acc[4] * sc, acc[5] * sc); o.w = pk2(acc[6] * sc, acc[7] * sc);
                    *(LAS u32x4*)(L + GA_QN + tok * 272 + c8 * 2) = o;
                    const float s2 = sc * eg;
                    u32x4 g; g.x = pk2(acc[0] * s2, acc[1] * s2); g.y = pk2(acc[2] * s2, acc[3] * s2); g.z = pk2(acc[4] * s2, acc[5] * s2); g.w = pk2(acc[6] * s2, acc[7] * s2);
                    *(u32x4*)(Gp + G_QG + tok * 256 + c8 * 2) = g;
                } else if (part == 1) {
                    const float sc = rsqrtf(ss + EPS), sb = sc * beta, sg = sb * __expf(gc), sd = sc * __expf(glast - gc);
                    u32x4 o; o.x = pk2(acc[0] * sc, acc[1] * sc); o.y = pk2(acc[2] * sc, acc[3] * sc); o.z = pk2(acc[4] * sc, acc[5] * sc); o.w = pk2(acc[6] * sc, acc[7] * sc);
                    *(LAS u32x4*)(L + GA_KN + tok * 272 + c8 * 2) = o;
                    u32x4 p; p.x = pk2(acc[0] * sb, acc[1] * sb); p.y = pk2(acc[2] * sb, acc[3] * sb); p.z = pk2(acc[4] * sb, acc[5] * sb); p.w = pk2(acc[6] * sb, acc[7] * sb);
                    *(LAS u32x4*)(L + GA_KB + tok * 272 + c8 * 2) = p;
                    u32x4 d; d.x = pk2(acc[0] * sd, acc[1] * sd); d.y = pk2(acc[2] * sd, acc[3] * sd); d.z = pk2(acc[4] * sd, acc[5] * sd); d.w = pk2(acc[6] * sd, acc[7] * sd);
                    *(u32x4*)(Gp + G_KD + tok * 256 + c8 * 2) = d;
#pragma unroll
                    for (int e = 0; e < 8; ++e) tp[tk][e] = acc[e] * sg;
                } else {
#pragma unroll
                    for (int e = 0; e < 8; ++e) tp[tk][e] = acc[e] * beta;
                }
            }
            if (part == 1) {
#pragma unroll
                for (int e = 0; e < 8; ++e) *(LAS unsigned*)(L + GA_KGT + (c8 + e) * 144 + g2 * 2) = pk2(tp[0][e], tp[1][e]);
            } else if (part == 2) {
#pragma unroll
                for (int e = 0; e < 8; ++e) *(LAS unsigned*)(L + GA_VBT + (c8 + e) * 144 + g2 * 2) = pk2(tp[0][e], tp[1][e]);
            }
        }
        WG_BAR();
        {
            const int mat = w >> 2, ti = (w >> 1) & 1, tj = w & 1;
            f32x16 x = zero16();
            if (ti >= tj) {
                const LAS unsigned char* ap = L + (mat ? GA_QN : GA_KB) + (32 * ti + r) * 272 + hh * 16;
                const LAS unsigned char* bp = L + GA_KN + (32 * tj + r) * 272 + hh * 16;
#pragma unroll
                for (int s = 0; s < 8; ++s) x = MFMA32(*(const LAS bf16x8*)(ap + 32 * s), *(const LAS bf16x8*)(bp + 32 * s), x);
            }
            const int j = 32 * tj + r; const float gj = gcs[j];
            if (mat == 0) {
#pragma unroll
                for (int reg = 0; reg < 16; ++reg) { const int i = 32 * ti + crow(reg, hh); const float dec = __expf(gcs[i] - gj); Am[i * 68 + j] = (i > j) ? x[reg] * dec : 0.f; }
            } else {
#pragma unroll
                for (int reg = 0; reg < 16; ++reg) { const int i = 32 * ti + crow(reg, hh); const float dec = __expf(gcs[i] - gj);
                    *(LAS bf16*)(L + GA_QKS + i * 144 + j * 2) = (bf16)(pk2((i >= j) ? x[reg] * dec : 0.f, 0.f) & 0xffffu); }
            }
        }
        WG_BAR();
        if (w == 0) {
            const int blk = hh, col = r;
            float Tr[32];
            const LAS float* Ab = Am + (blk * 32) * 68 + blk * 32;
            subst_rows<0, 8>(Ab, Tr, col); subst_rows<8, 12>(Ab, Tr, col); subst_rows<12, 16>(Ab, Tr, col);
            subst_rows<16, 18>(Ab, Tr, col); subst_rows<18, 20>(Ab, Tr, col); subst_rows<20, 22>(Ab, Tr, col); subst_rows<22, 24>(Ab, Tr, col);
            subst_rows<24, 26>(Ab, Tr, col); subst_rows<26, 28>(Ab, Tr, col); subst_rows<28, 30>(Ab, Tr, col); subst_rows<30, 32>(Ab, Tr, col);
#pragma unroll
            for (int i = 0; i < 32; ++i) *(LAS bf16*)(L + GA_TB + (blk * 32 + i) * 144 + (blk * 32 + col) * 2) = (bf16)(pk2(Tr[i], 0.f) & 0xffffu);
            f32x16 P = zero16();
#pragma unroll
            for (int s = 0; s < 2; ++s) {
                const LAS float* arow = Am + (32 + r) * 68 + 16 * s + 8 * hh;
                const f32x4 a0 = *(const LAS f32x4*)arow, a1 = *(const LAS f32x4*)(arow + 4);
                const bf16x8 af = __builtin_bit_cast(bf16x8, pg8::pack8(a0, a1));
                float tv[8];
#pragma unroll
                for (int jj = 0; jj < 8; ++jj) { const float lo = Tr[16 * s + jj]; const float hi = __shfl(Tr[16 * s + 8 + jj], r); tv[jj] = hh ? hi : lo; }
                u32x4 tb; tb.x = pk2(tv[0], tv[1]); tb.y = pk2(tv[2], tv[3]); tb.z = pk2(tv[4], tv[5]); tb.w = pk2(tv[6], tv[7]);
                P = MFMA32(af, __builtin_bit_cast(bf16x8, tb), P);
            }
            f32x16 R = zero16();
#pragma unroll
            for (int s = 0; s < 2; ++s) {
                const LAS unsigned char* tp = L + GA_TB + (32 + r) * 144 + (32 + 16 * s + 4 * hh) * 2;
                const s16x4 lo = *(const LAS s16x4*)tp, hi = *(const LAS s16x4*)(tp + 16);
                R = MFMA32(cat8(lo, hi), pack_step(P, s), R);
            }
#pragma unroll
            for (int reg = 0; reg < 16; ++reg) *(LAS bf16*)(L + GA_TB + (32 + crow(reg, hh)) * 144 + r * 2) = (bf16)(pk2(-R[reg], 0.f) & 0xffffu);
        } else {
            for (int p = F.tid - 64; p < 512; p += 448) { const int row = p >> 3, c = p & 7; *(u32x4*)(Gp + G_QK + row * 128 + c * 16) = *(const LAS u32x4*)(L + GA_QKS + row * 144 + c * 16); }
            if (w == 1) {
#pragma unroll
                for (int i = 0; i < 16; ++i) *(LAS bf16*)(L + GA_TB + (2 * i + hh) * 144 + (32 + r) * 2) = (bf16)0; }
        }
        WG_BAR();
        if (w < 4) {
#pragma unroll
            for (int q = 0; q < 2; ++q) {
                const int idx = w * 2 + q, ib = idx >> 2, db = idx & 3;
                f32x16 x = zero16();
                const LAS unsigned char* ap = L + GA_TB + (32 * ib + r) * 144 + hh * 16;
                const LAS unsigned char* bp = L + GA_VBT + (32 * db + r) * 144 + hh * 16;
#pragma unroll
                for (int s = 0; s < 4; ++s) if (ib || s < 2) x = MFMA32(*(const LAS bf16x8*)(ap + 32 * s), *(const LAS bf16x8*)(bp + 32 * s), x);
#pragma unroll
                for (int g = 0; g < 4; ++g) { u32x2 o; o.x = pk2(x[4 * g], x[4 * g + 1]); o.y = pk2(x[4 * g + 2], x[4 * g + 3]);
                    *(u32x2*)(Gp + G_UT + ((32 * db + r) * 64 + 32 * ib + 8 * g + 4 * hh) * 2) = o; }
            }
        } else {
#pragma unroll
            for (int q = 0; q < 2; ++q) {
                const int idx = (w - 4) * 2 + q, dkb = idx >> 1, ib = idx & 1;
                f32x16 x = zero16();
                const LAS unsigned char* ap = L + GA_KGT + (32 * dkb + r) * 144 + hh * 16;
                const LAS unsigned char* bp = L + GA_TB + (32 * ib + r) * 144 + hh * 16;
#pragma unroll
                for (int s = 0; s < 4; ++s) if (ib || s < 2) x = MFMA32(*(const LAS bf16x8*)(ap + 32 * s), *(const LAS bf16x8*)(bp + 32 * s), x);
#pragma unroll
                for (int g = 0; g < 4; ++g) { u32x2 o; o.x = pk2(x[4 * g], x[4 * g + 1]); o.y = pk2(x[4 * g + 2], x[4 * g + 3]);
                    *(u32x2*)(Gp + G_W + ((32 * ib + r) * 128 + 32 * dkb + 8 * g + 4 * hh) * 2) = o; }
            }
        }
        WG_BAR();
    }
}

constexpr int GB_ST = 0, GB_W = 34816, GB_QG = GB_W + 17408, GB_KD = GB_QG + 17408, GB_QK = GB_KD + 20480, GB_O = GB_QK + 9216, GB_END = GB_O + 33792;
static_assert(GB_END <= 140000, "gdn-b lds");
DI void gdn_b(const Frame& F, const Args& a, int worker, int nworkers) {
    LAS unsigned char* L = F.lds;
    const bf16* U = (const bf16*)(F.ws + WS_U0); bf16* Y = (bf16*)(F.ws + WS_Y); const float* EG = (const float*)(F.ws + WS_EG); const float* gn = a.in[11];
    const int lane = F.lane, w = F.wave, r = lane & 31, hh = lane >> 5, dvb = w & 3, hf = w >> 2;
    const int q4 = (lane & 15) >> 2, p4 = lane & 3, g1 = (lane >> 4) & 1;
    f32x4 gnv[4];
#pragma unroll
    for (int i = 0; i < 4; ++i) gnv[i] = *(const f32x4*)(gn + (F.tid & 7) * 16 + 4 * i);
    const unsigned src_t = (unsigned)F.tid * 16u;
    const unsigned dst_w = (unsigned)((F.tid >> 4) * 272 + (F.tid & 15) * 16);
    const unsigned dst_k = (unsigned)((F.tid >> 4) * 320 + (F.tid & 15) * 16);
    const unsigned dst_q = (unsigned)((F.tid >> 3) * 144 + (F.tid & 7) * 16);
    const unsigned ut_t = (unsigned)(((32 * dvb + r) * 64 + 4 * hh) * 2);
    for (int bh = worker; bh < 128; bh += nworkers) {
        const int b = bh >> 2, h = bh & 3;
        f32x16 Sacc[2] = {zero16(), zero16()};
        for (int p = F.tid; p < 34816 / 16; p += 512) *(LAS u32x4*)(L + GB_ST + p * 16) = (u32x4){0u, 0u, 0u, 0u};
        u32x4 nop[7]; u32x2 nui[2][4]; float neg; u32x4 nog[2];
#define GB_PREFETCH(nn) do { const int _item = bh * 32 + (nn); const unsigned char* _Gp = F.ws + WS_G + (size_t)_item * G_ITEM; \
            unsigned _so = src_t, _uo = ut_t; asm volatile("" : "+v"(_so), "+v"(_uo)); \
            _Pragma("unroll") for (int k = 0; k < 7; ++k) { const unsigned char* _bk = _Gp + (8192 * k + (k >= 2 ? 16384 : 0)); nop[k] = *(const u32x4*)(_bk + _so); } \
            _Pragma("unroll") for (int tb = 0; tb < 2; ++tb) _Pragma("unroll") for (int g = 0; g < 4; ++g) { const unsigned char* _bu = _Gp + G_UT + (64 * tb + 16 * g); nui[tb][g] = *(const u32x2*)(_bu + _uo); } \
            neg = EG[_item]; \
            const unsigned char* _og = (const unsigned char*)(U + (size_t)(b * SEQ + (nn) * 64) * EVU + 2560 + h * 128); \
            unsigned _lo = (unsigned)((F.tid >> 3) * EVU + (F.tid & 7) * 16) * 2u; asm volatile("" : "+v"(_lo)); \
            nog[0] = *(const u32x4*)(_og + _lo); nog[1] = *(const u32x4*)(_og + 16 + _lo); } while (0)
        GB_PREFETCH(0);
        for (int n = 0; n < 32; ++n) {
            const int t0 = b * SEQ + n * 64;
            *(LAS u32x4*)(L + GB_W + dst_w) = nop[0]; *(LAS u32x4*)(L + GB_W + dst_w + 32 * 272) = nop[1];
            *(LAS u32x4*)(L + GB_QG + dst_w) = nop[2]; *(LAS u32x4*)(L + GB_QG + dst_w + 32 * 272) = nop[3];
            *(LAS u32x4*)(L + GB_KD + dst_k) = nop[4]; *(LAS u32x4*)(L + GB_KD + dst_k + 32 * 320) = nop[5];
            *(LAS u32x4*)(L + GB_QK + dst_q) = nop[6];
            u32x2 ui[2][4]; u32x4 og[2];
#pragma unroll
            for (int tb = 0; tb < 2; ++tb)
#pragma unroll
                for (int g = 0; g < 4; ++g) ui[tb][g] = nui[tb][g];
            og[0] = nog[0]; og[1] = nog[1];
            const float eg = neg;
            LDS_BAR();
            if (n + 1 < 32) GB_PREFETCH(n + 1);
            f32x16 x0 = zero16(), x1 = zero16(), o = zero16();
            {
                const LAS unsigned char* sp = L + GB_ST + (32 * dvb + r) * 272 + hh * 16;
                const LAS unsigned char* wp = L + GB_W + r * 272 + hh * 16;
                const LAS unsigned char* qp = L + GB_QG + (32 * hf + r) * 272 + hh * 16;
#pragma unroll
                for (int s = 0; s < 8; ++s) {
                    const bf16x8 sf = *(const LAS bf16x8*)(sp + 32 * s);
                    x0 = MFMA32(*(const LAS bf16x8*)(wp + 32 * s), sf, x0);
                    x1 = MFMA32(*(const LAS bf16x8*)(wp + 32 * 272 + 32 * s), sf, x1);
                    o = MFMA32(*(const LAS bf16x8*)(qp + 32 * s), sf, o);
                }
            }
            bf16x8 pv[2][2];
#pragma unroll
            for (int g = 0; g < 4; ++g) {
                x0[4 * g] = bflo(ui[0][g].x) - x0[4 * g]; x0[4 * g + 1] = bfhi(ui[0][g].x) - x0[4 * g + 1]; x0[4 * g + 2] = bflo(ui[0][g].y) - x0[4 * g + 2]; x0[4 * g + 3] = bfhi(ui[0][g].y) - x0[4 * g + 3];
                x1[4 * g] = bflo(ui[1][g].x) - x1[4 * g]; x1[4 * g + 1] = bfhi(ui[1][g].x) - x1[4 * g + 1]; x1[4 * g + 2] = bflo(ui[1][g].y) - x1[4 * g + 2]; x1[4 * g + 3] = bfhi(ui[1][g].y) - x1[4 * g + 3];
            }
            pv[0][0] = pack_step(x0, 0); pv[0][1] = pack_step(x0, 1); pv[1][0] = pack_step(x1, 0); pv[1][1] = pack_step(x1, 1);
#pragma unroll
            for (int tb = 0; tb < 2; ++tb) {
                if (tb <= hf) {
#pragma unroll
                    for (int s = 0; s < 2; ++s) {
                        const LAS unsigned char* kp = L + GB_QK + (32 * hf + r) * 144 + (32 * tb + 16 * s + 4 * hh) * 2;
                        o = MFMA32(cat8(*(const LAS s16x4*)kp, *(const LAS s16x4*)(kp + 16)), pv[tb][s], o);
                    }
                }
            }
            {
                LAS float* Ol = (LAS float*)(L + GB_O) + (32 * hf + 4 * hh) * 132 + 32 * dvb + r;
#pragma unroll
                for (int reg = 0; reg < 16; ++reg) Ol[((reg & 3) + 8 * (reg >> 2)) * 132] = o[reg];
            }
#pragma unroll
            for (int d2 = 0; d2 < 2; ++d2) {
                const int db = 2 * hf + d2;
                f32x16 x = Sacc[d2] * eg;
                const LAS unsigned char* kb = L + GB_KD + (4 * hh + q4) * 320 + (32 * db + 16 * g1 + 4 * p4) * 2;
#pragma unroll
                for (int tb = 0; tb < 2; ++tb)
#pragma unroll
                    for (int s = 0; s < 2; ++s) {
                        const LAS unsigned char* kp = kb + (32 * tb + 16 * s) * 320;
                        x = MFMA32(cat8(vtr(kp), vtr(kp + 8 * 320)), pv[tb][s], x);
                    }
                Sacc[d2] = x;
            }
            LDS_BAR();
#pragma unroll
            for (int d2 = 0; d2 < 2; ++d2) {
                const int db = 2 * hf + d2;
#pragma unroll
                for (int g = 0; g < 4; ++g) { u32x2 ov; ov.x = pk2(Sacc[d2][4 * g], Sacc[d2][4 * g + 1]); ov.y = pk2(Sacc[d2][4 * g + 2], Sacc[d2][4 * g + 3]);
                    *(LAS u32x2*)(L + GB_ST + (32 * dvb + r) * 272 + (32 * db + 8 * g + 4 * hh) * 2) = ov; }
            }
            {
                const int row = F.tid >> 3, cg = (F.tid & 7) * 16;
                const LAS float* Ol = (const LAS float*)(L + GB_O) + row * 132 + cg;
                f32x4 ov[4]; float ss = 0.f;
#pragma unroll
                for (int i = 0; i < 4; ++i) { ov[i] = *(const LAS f32x4*)(Ol + 4 * i); ss += (ov[i].x * ov[i].x + ov[i].y * ov[i].y) + (ov[i].z * ov[i].z + ov[i].w * ov[i].w); }
                ss += dppf(ss, 0); ss += dppf(ss, 1); ss += dppf(ss, 2);
                const float rstd = rsqrtf(ss * (1.f / 128.f) + EPS);
                bf16* yp = Y + (size_t)(t0 + row) * D + 512 + h * 128 + cg;
#pragma unroll
                for (int hv = 0; hv < 2; ++hv) {
                    const u32x4 gq = og[hv]; const f32x4 a0 = ov[2 * hv] * rstd * gnv[2 * hv], a1 = ov[2 * hv + 1] * rstd * gnv[2 * hv + 1];
                    u32x4 o4; o4.x = pk2(a0.x * silu_f(bflo(gq.x)), a0.y * silu_f(bfhi(gq.x))); o4.y = pk2(a0.z * silu_f(bflo(gq.y)), a0.w * silu_f(bfhi(gq.y)));
                    o4.z = pk2(a1.x * silu_f(bflo(gq.z)), a1.y * silu_f(bfhi(gq.z))); o4.w = pk2(a1.z * silu_f(bflo(gq.w)), a1.w * silu_f(bfhi(gq.w)));
                    *(u32x4*)(yp + 8 * hv) = o4;
                }
            }
        }
        WG_BAR();
    }
#undef GB_PREFETCH
}

constexpr int AT_STAGE = 38912, AT_K = 0, AT_V = 18432, AT_NST = 4, AT_BIAS = LDS_MISC + 1024;
DI void attn_dma_offs(int w, int lane, int h, unsigned (&go)[5]) {
#pragma unroll
    for (int k = 0; k < 5; ++k) {
        int ii = w + 8 * k; if (ii >= 38) ii -= 2; unsigned o;
        if (ii < 18) { const int i = ii * 64 + lane, m = i / 576, rem = i - m * 576, rr = rem / 9, c0 = rem - rr * 9, c = c0 > 7 ? 7 : c0; o = (unsigned)(rr * OD_N + 512 + h * 128 + m * 64 + c * 8) * 2u; }
        else { const int i = (ii - 18) * 64 + lane, rr = i / 20, c0 = i - rr * 20, c = c0 > 15 ? 15 : c0; o = (unsigned)(rr * OD_N + 1024 + h * 128 + c * 8) * 2u; }
        go[k] = o;
    }
}
DI void glds16(const void* gsrc, unsigned lds_dst) { unsigned keep;
    asm volatile("s_mov_b32 %0, m0\n\ts_mov_b32 m0, %2\n\ts_nop 0\n\tglobal_load_lds_dwordx4 %1, off\n\ts_mov_b32 m0, %0" : "=&s"(keep) : "v"(gsrc), "s"(lds_dst) : "memory"); }
DI void attn_dma(const bf16* U1, int trow, LAS unsigned char* stage, int w, const unsigned (&go)[5]) {
    const char* g = (const char*)(U1 + (size_t)trow * OD_N);
    const unsigned sbase = (unsigned)(uintptr_t)stage;
#pragma unroll
    for (int k = 0; k < 5; ++k) {
        int ii = w + 8 * k; if (ii >= 38) ii -= 2;
        const unsigned dst = sbase + ((ii < 18) ? (unsigned)(AT_K + ii * 1024) : (unsigned)(AT_V + (ii - 18) * 1024));
        glds16(g + go[k], (unsigned)__builtin_amdgcn_readfirstlane((int)dst));
    }
}
DI void attn_phase(const Frame& F, const Args& a) {
    LAS unsigned char* L = F.lds;
    const bf16* U1 = (const bf16*)(F.ws + WS_U); bf16* Y = (bf16*)(F.ws + WS_Y);
    const float* lamp = a.in[14]; const float* dng = a.in[15]; const float* relb = a.in[21];
    const int lane = F.lane, w = F.wave, r = lane & 31, hh = lane >> 5, mp = w >> 2, qs = w & 3;
    const int q4 = (lane & 15) >> 2, p4 = lane & 3, g1 = (lane >> 4) & 1;
    const float lam = __expf(wave_sum(lamp[lane] * lamp[64 + lane])) - __expf(wave_sum(lamp[128 + lane] * lamp[192 + lane])) + LAMBDA_INIT;
    const float c1 = 0.125f * LOG2E;
    LAS float* btab = (LAS float*)(L + AT_BIAS);
    LAS float* exch = (LAS float*)L;
    for (int item = F.vcu; item < 256; item += F.G) {
        const int bh = item >> 1, par = item & 1, b = bh >> 2, h = bh & 3, trow0 = b * SEQ;
        WG_BAR();
        if (F.tid < 128) { const int n = F.tid; int bucket = n;
            if (n >= 16) { const int lg = 16 + (int)(__logf((float)n / 16.f) / 2.0794415416798357f * 16.f); bucket = lg < 31 ? lg : 31; }
            btab[n] = relb[bucket * 4 + h] * LOG2E; }
        const float bias_far = relb[31 * 4 + h] * LOG2E;
        unsigned go[5]; attn_dma_offs(w, lane, h, go);
        for (int ui = 0; ui < 8; ++ui) {
            const int qblk = 2 * ui + ((ui ^ par) & 1);
            const int q0 = qblk * 128 + qs * 32, qpos = q0 + r, ntiles = 2 * (qblk + 1);
            bf16x8 qf[4];
            { const bf16* qp = U1 + (size_t)(trow0 + qpos) * OD_N + h * 128 + mp * 64 + 8 * hh;
#pragma unroll
              for (int s = 0; s < 4; ++s) qf[s] = *(const bf16x8*)(qp + 16 * s); }
            asm volatile("s_waitcnt vmcnt(0)" ::: "memory");
            f32x16 O[4] = {zero16(), zero16(), zero16(), zero16()};
            float mrun = -INFINITY, lrun = 0.f;
            attn_dma(U1, trow0, L, w, go);
            attn_dma(U1, trow0 + 64, L + AT_STAGE, w, go);
            bf16x8 pf[2][2]; bool pend = false;
            const LAS unsigned char* vlane = L + AT_V + (4 * hh + q4) * 320 + (16 * g1 + 4 * p4) * 2;
#define ATT_PV(stage_) do { const LAS unsigned char* vb_ = vlane + (stage_) * AT_STAGE; \
                _Pragma("unroll") for (int db = 0; db < 4; ++db) _Pragma("unroll") for (int kh = 0; kh < 2; ++kh) _Pragma("unroll") for (int s_ = 0; s_ < 2; ++s_) { \
                    const LAS unsigned char* vp = vb_ + (32 * kh + 16 * s_) * 320 + 64 * db; O[db] = MFMA32(cat8(vtr(vp), vtr(vp + 8 * 320)), pf[kh][s_], O[db]); } } while (0)
            for (int kt = 0; kt < ntiles; ++kt) {
                if (kt + 1 < ntiles) asm volatile("s_waitcnt vmcnt(5)" ::: "memory"); else asm volatile("s_waitcnt vmcnt(0)" ::: "memory");
                __builtin_amdgcn_s_barrier(); asm volatile("" ::: "memory");
                if (kt + 2 < ntiles) attn_dma(U1, trow0 + (kt + 2) * 64, L + ((kt + 2) & 3) * AT_STAGE, w, go);
                if (mp == 1 && pend) { ATT_PV((kt - 1) & 3); pend = false; }
                const int key0 = kt * 64;
                if (key0 <= q0 + 31) {
                    const LAS unsigned char* sb = L + (kt & 3) * AT_STAGE;
                    const LAS unsigned char* kb = sb + AT_K + mp * 9216 + r * 144 + hh * 16;
                    f32x16 x0 = zero16(), x1 = zero16();
#pragma unroll
                    for (int s = 0; s < 4; ++s) { x0 = MFMA32(*(const LAS bf16x8*)(kb + 32 * s), qf[s], x0); x1 = MFMA32(*(const LAS bf16x8*)(kb + 32 * 144 + 32 * s), qf[s], x1); }
                    const bool far = q0 - (key0 + 63) >= 128;
                    if (!far) {
#pragma unroll
                        for (int reg = 0; reg < 16; ++reg) {
                            const int d0 = qpos - (key0 + crow(reg, hh)), d1 = d0 - 32;
                            const float b0 = btab[d0 < 0 ? 0 : (d0 > 127 ? 127 : d0)], b1 = btab[d1 < 0 ? 0 : (d1 > 127 ? 127 : d1)];
                            x0[reg] = (d0 >= 0) ? x0[reg] * c1 + b0 : -INFINITY; x1[reg] = (d1 >= 0) ? x1[reg] * c1 + b1 : -INFINITY;
                        }
                    }
                    float mx = x0[0];
#pragma unroll
                    for (int reg = 1; reg < 16; ++reg) mx = fmaxf(mx, x0[reg]);
#pragma unroll
                    for (int reg = 0; reg < 16; ++reg) mx = fmaxf(mx, x1[reg]);
                    if (far) mx = mx * c1 + bias_far;
                    mx = fmaxf(mx, __shfl_xor(mx, 32));
                    if (__any(mx - mrun > 6.f)) {
                        const float mnew = fmaxf(mrun, mx), alpha = __builtin_amdgcn_exp2f(mrun - mnew); mrun = mnew;
                        lrun *= alpha;
#pragma unroll
                        for (int db = 0; db < 4; ++db) O[db] = O[db] * alpha;
                    }
                    float rs = 0.f;
                    if (far) { const float off = bias_far - mrun;
#pragma unroll
                        for (int reg = 0; reg < 16; ++reg) { x0[reg] = __builtin_amdgcn_exp2f(x0[reg] * c1 + off); x1[reg] = __builtin_amdgcn_exp2f(x1[reg] * c1 + off); rs += x0[reg] + x1[reg]; }
                    } else {
#pragma unroll
                        for (int reg = 0; reg < 16; ++reg) { x0[reg] = __builtin_amdgcn_exp2f(x0[reg] - mrun); x1[reg] = __builtin_amdgcn_exp2f(x1[reg] - mrun); rs += x0[reg] + x1[reg]; }
                    }
                    lrun += rs;
                    pf[0][0] = pack_step(x0, 0); pf[0][1] = pack_step(x0, 1); pf[1][0] = pack_step(x1, 0); pf[1][1] = pack_step(x1, 1);
                    if (mp == 0) ATT_PV(kt & 3); else pend = true;
                }
            }
            if (mp == 1 && pend) ATT_PV((ntiles - 1) & 3);
#undef ATT_PV
            const float ltot = lrun + __shfl_xor(lrun, 32);
            const float inv = 1.f / ltot;
            LDS_BAR();
            if (mp == 1) {
                const float sc = inv * lam;
#pragma unroll
                for (int db = 0; db < 4; ++db)
#pragma unroll
                    for (int reg = 0; reg < 16; ++reg) exch[(qs * 64 + db * 16 + reg) * 64 + lane] = O[db][reg] * sc;
            }
            LDS_BAR();
            if (mp == 0) {
                float ss = 0.f;
#pragma unroll
                for (int db = 0; db < 4; ++db)
#pragma unroll
                    for (int reg = 0; reg < 16; ++reg) { const float o = O[db][reg] * inv - exch[(qs * 64 + db * 16 + reg) * 64 + lane]; O[db][reg] = o; ss += o * o; }
                ss += __shfl_xor(ss, 32);
                const float rstd = rsqrtf(ss * (1.f / 128.f) + EPS) * (1.f - LAMBDA_INIT);
                bf16* yp = Y + (size_t)(trow0 + qpos) * D + h * 128;
#pragma unroll
                for (int db = 0; db < 4; ++db)
#pragma unroll
                    for (int g = 0; g < 4; ++g) { const int d = 32 * db + 8 * g + 4 * hh; const f32x4 gv = *(const f32x4*)(dng + d);
                        u32x2 o; o.x = pk2(O[db][4 * g] * rstd * gv[0], O[db][4 * g + 1] * rstd * gv[1]); o.y = pk2(O[db][4 * g + 2] * rstd * gv[2], O[db][4 * g + 3] * rstd * gv[3]);
                        *(u32x2*)(yp + d) = o; }
            }
            LDS_BAR();
        }
    }
}

constexpr int CF_GLU = 0, CF_RED = 96256, CF_STAT = CF_RED + 16384, CF_END = CF_STAT + 512;
DI void conformer_phase(const Frame& F, const Args& a) {
    LAS unsigned char* L = F.lds;
    const bf16* U1 = (const bf16*)(F.ws + WS_U); bf16* Y = (bf16*)(F.ws + WS_Y);
    const float* cw = a.in[16]; const float* cb = a.in[17]; const float* lg = a.in[18]; const float* lb = a.in[19];
    const int c = F.tid;
    float wv[31];
#pragma unroll
    for (int j = 0; j < 31; ++j) wv[j] = cw[j * 512 + c];
    const float bias = cb[c], lng = lg[c], lnb = lb[c];
    LAS float* red = (LAS float*)(L + CF_RED); LAS float* stat = (LAS float*)(L + CF_STAT);
    const int tpw = (T / 64 + F.G - 1) / F.G;
    for (int kt = 0; kt < tpw; ++kt) {
        const int tile = F.vcu * tpw + kt; if (tile >= T / 64) break;
        const int t0 = tile * 64, s0 = t0 & (SEQ - 1);
        const bool reuse = (kt > 0) && (s0 != 0);
        WG_BAR();
        if (reuse) {
            u32x4 cp[4];
#pragma unroll
            for (int j = 0; j < 4; ++j) { const int idx = F.tid + 512 * j; if (idx < 1920) cp[j] = *(const LAS u32x4*)(L + CF_GLU + 64 * 1024 + idx * 16); }
#pragma unroll
            for (int j = 0; j < 4; ++j) { const int idx = F.tid + 512 * j; if (idx < 1920) *(LAS u32x4*)(L + CF_GLU + idx * 16) = cp[j]; }
            LDS_BAR();
        }
        const int it0 = reuse ? 30 * 64 : 0, nb4 = reuse ? 3 : 4;
#pragma unroll 1
        for (int b4 = 0; b4 < nb4; ++b4) {
            u32x4 ga[3], gb[3];
#pragma unroll
            for (int k = 0; k < 3; ++k) {
                const int it = it0 + F.tid + 512 * (3 * b4 + k), row = it >> 6, c8 = (it & 63) * 8;
                ga[k] = (u32x4){0u, 0u, 0u, 0u}; gb[k] = ga[k];
                if (it < 94 * 64 && s0 + row - 30 >= 0) { const bf16* up = U1 + (size_t)(t0 + row - 30) * OD_N + 1536 + c8; ga[k] = *(const u32x4*)up; gb[k] = *(const u32x4*)(up + 512); }
            }
#pragma unroll
            for (int k = 0; k < 3; ++k) {
                const int it = it0 + F.tid + 512 * (3 * b4 + k), row = it >> 6, c8 = (it & 63) * 8;
                u32x4 o;
#pragma unroll
                for (int q = 0; q < 4; ++q) o[q] = pk2(bflo(ga[k][q]) * sigmoid_f(bflo(gb[k][q])), bfhi(ga[k][q]) * sigmoid_f(bfhi(gb[k][q])));
                if (it < 94 * 64) *(LAS u32x4*)(L + CF_GLU + row * 1024 + c8 * 2) = o;
            }
            asm volatile("" ::: "memory");
        }
        WG_BAR();
        float out[64];
        float xs[94];
#pragma unroll
        for (int q = 0; q < 46; ++q) xs[q] = bf2f(*(const LAS bf16*)(L + CF_GLU + q * 1024 + c * 2));
#pragma unroll
        for (int hb = 0; hb < 4; ++hb) {
#pragma unroll
            for (int t2 = 0; t2 < 16; ++t2) {
                float acc = bias;
#pragma unroll
                for (int j = 0; j < 31; ++j) acc = __builtin_fmaf(wv[j], xs[16 * hb + t2 + j], acc);
                out[16 * hb + t2] = acc;
            }
            asm volatile("" ::: "memory");
            if (hb < 3) {
#pragma unroll
                for (int q = 0; q < 16; ++q) xs[46 + 16 * hb + q] = bf2f(*(const LAS bf16*)(L + CF_GLU + (46 + 16 * hb + q) * 1024 + c * 2));
            }
        }
        {
            const int part = F.wave * 4 + (F.lane >> 4), tk = (F.lane & 1) * 4 + (F.lane & 2) * 4 + (F.lane & 4) * 4 + (F.lane & 8) * 4;
            float p1[4];
            { float q[64];
#pragma unroll
              for (int tt = 0; tt < 64; ++tt) q[tt] = out[tt];
              transpose_sum_row(q, F.lane);
#pragma unroll
              for (int t = 0; t < 4; ++t) p1[t] = q[t]; }
            __builtin_amdgcn_sched_barrier(0);
            { float q[64];
#pragma unroll
              for (int tt = 0; tt < 64; ++tt) q[tt] = out[tt] * out[tt];
              transpose_sum_row(q, F.lane);
#pragma unroll
              for (int t = 0; t < 4; ++t) *(LAS f32x2_t*)(red + (part * 64 + tk + t) * 2) = (f32x2_t){p1[t], q[t]}; }
        }
        WG_BAR();
        if (F.tid < 64) { float s1 = 0.f, s2 = 0.f;
#pragma unroll
            for (int q = 0; q < 32; ++q) { const f32x2_t pr = *(const LAS f32x2_t*)(red + (q * 64 + F.tid) * 2); s1 += pr.x; s2 += pr.y; }
            const float mean = s1 * (1.f / 512.f); const float var = fmaxf(s2 * (1.f / 512.f) - mean * mean, 0.f);
            stat[F.tid * 2] = mean; stat[F.tid * 2 + 1] = rsqrtf(var + EPS); }
        WG_BAR();
#pragma unroll
        for (int tt = 0; tt < 64; ++tt) {
            const float v = (out[tt] - stat[tt * 2]) * stat[tt * 2 + 1] * lng + lnb;
            Y[(size_t)(t0 + tt) * D + 512 + c] = (bf16)(pk2(silu_f(v), 0.f) & 0xffffu);
        }
    }
}

DI void stagger_us(int us) { const unsigned long long t0 = __builtin_amdgcn_s_memrealtime(); while (__builtin_amdgcn_s_memrealtime() - t0 < (unsigned long long)us * 100ull) __builtin_amdgcn_s_sleep(32); }
constexpr int NPH = 26;
__global__ void __launch_bounds__(512, 2) fwd_kernel(Args args) {
    extern __shared__ __attribute__((aligned(16))) unsigned char lds_raw[];
    Frame F;
    F.lds = (LAS unsigned char*)lds_raw; F.ws = args.ws;
    F.wave = __builtin_amdgcn_readfirstlane((int)threadIdx.x >> 6); F.tid = threadIdx.x; F.lane = F.tid & 63;
    F.G = gridDim.x; { const int bx = blockIdx.x; F.vcu = (F.G % 8 == 0) ? (bx % 8) * (F.G / 8) + bx / 8 : bx; }
    volatile LAS unsigned* MISC = (volatile LAS unsigned*)(F.lds + LDS_MISC);
    if (F.tid < 64) MISC[F.tid] = 0u;
    __syncthreads();
    unsigned* ctl = (unsigned*)(F.ws + WS_CTL);
    const bool multi = (args.ph_hi - args.ph_lo) > 1;
    XcdBarrier bar; bar.bar = ctl + CW_BAR; bar.x = 0; bar.st = MISC + 8; bar.wave = F.wave;
    if (multi) bar = xcd_barrier_post(ctl + CW_BAR, MISC + 8, F.wave);
    const int lo = args.ph_lo, hi = args.ph_hi;
#define IN(k) (lo <= (k) && (k) < hi)
#define SEAM(k) do { if (IN(k) && IN((k) + 1)) xcd_barrier(bar); } while (0)
    unsigned char* ws = F.ws;
    bf16* HN = (bf16*)(ws + WS_HN); signed char* HN8 = (signed char*)(ws + WS_HN); bf16* UB = (bf16*)(ws + WS_U); bf16* UB0 = (bf16*)(ws + WS_U0); bf16* YB = (bf16*)(ws + WS_Y); bf16* XB = (bf16*)(ws + WS_XB); float* SAp = (float*)(ws + WS_SA); const float* SBp = (const float*)(ws + WS_SB);
    const int bx = (int)blockIdx.x;

    if (IN(0)) { quant_k1024(phase_frame(F), args, 0, 4, F.vcu, F.G); absmax_jobs(phase_frame(F), args, 10, N_QJOBS, F.vcu, F.G); convert_weights(phase_frame(F), args); norm_mix0(phase_frame(F), args); } SEAM(0);
    if (IN(1)) { pg8::SchedDense S; S.init(HN, ws + W_EVIN, T, EV_N, D / 2, F.G, bx); pg8::EpiEvInI8 E{UB0, SAp, SBp + SBO_EVIN}; pg8::gemm_phase(F.lds, S, E, F.wave); } SEAM(1);
    if (IN(2)) { gdn_a(phase_frame(F), args); } SEAM(2);
    if (IN(3)) { if ((bx & 1) == 0) { gdn_b(phase_frame(F), args, bx >> 1, (F.G + 1) >> 1); quant_k1024(phase_frame(F), args, 4, 8, bx >> 1, (F.G + 1) >> 1); }     else { mixer_a(phase_frame(F), args, bx >> 1, F.G >> 1); quant_k1024(phase_frame(F), args, 8, 10, bx >> 1, F.G >> 1); quant_jobs(phase_frame(F), args, 10, N_QJOBS, bx >> 1, F.G >> 1); } } SEAM(3);
    if (IN(4)) { pg8::SchedDense S; S.init(YB, ws + W_EVOUT, T, D, D, F.G, bx); pg8::EpiResid E{args.in[0], XB}; pg8::gemm_phase(F.lds, S, E, F.wave); } SEAM(4);
    if (IN(5)) { norm_plain(phase_frame(F), XB, args.in[3], HN8, SAp); } SEAM(5);
    if (IN(6)) { pg8::SchedDense S; S.init(HN, ws + W_FFGU, T, 2 * DFF, D / 2, F.G, bx); pg8::EpiSwiGLUI8 E{UB, DFF, SAp, SBp + SBO_FFGU}; pg8::gemm_phase(F.lds, S, E, F.wave); } SEAM(6);
    if (IN(7)) { pg8::SchedDense S; S.init(UB, ws + W_FFD, T, D, DFF, F.G, bx); pg8::EpiResidB E{XB}; pg8::gemm_phase(F.lds, S, E, F.wave); } SEAM(7);
    if (IN(8)) { norm_plain(phase_frame(F), XB, args.in[4], HN8, SAp); convert_p(phase_frame(F), args.in[1], (bf16*)(ws + WS_GX)); convert_p(phase_frame(F), args.in[1] + (size_t)T * 256, (bf16*)(ws + WS_PB2)); } SEAM(8);
    if (IN(9)) { pg8::SchedDense S; S.init(ws + WS_GX, ws + W_PPROJ, T, D, 256, F.G, bx); pg8::EpiStoreBf16 E{UB, D}; pg8::gemm_phase(F.lds, S, E, F.wave); }
    if (IN(10)) { pg8::SchedDense S; S.init(HN, ws + W_PGATE, T, D, D / 2, F.G, bx); pg8::EpiPleGateI8 E{XB, UB, SAp, SBp + SBO_PGATE}; pg8::gemm_phase(F.lds, S, E, F.wave); } SEAM(10);
    if (IN(11)) { norm_plain(phase_frame(F), XB, args.in[2] + D, HN8, SAp); } SEAM(11);
    if (IN(12)) { pg8::SchedDense S; S.init(HN, ws + W_ODIN, T, OD_N, D / 2, F.G, bx); pg8::EpiStoreBf16I8 E{UB, OD_N, SAp, SBp + SBO_ODIN}; pg8::gemm_phase(F.lds, S, E, F.wave); } SEAM(12);
    if (IN(13)) { attn_phase(phase_frame(F), args); conformer_phase(phase_frame(F), args); } SEAM(13);
    if (IN(14)) { pg8::SchedDense S; S.init(YB, ws + W_ODOUT, T, D, D, F.G, bx); pg8::EpiResidB E{XB}; pg8::gemm_phase(F.lds, S, E, F.wave); } SEAM(14);
    if (IN(15)) { norm_router(phase_frame(F), args); } SEAM(15);
#define MOE_PART(part, phg, phd) \
    if (IN(phg) || IN(phd)) { \
        LAS int* tab = (LAS int*)(F.lds + LDS_MISC + 256); \
        if (is_thread0(F.wave)) { int pb = 0; for (int e = 0; e < 8; ++e) { const int c = (int)__hip_atomic_load(ctl + CW_CNT + 64 * e, __ATOMIC_RELAXED, __HIP_MEMORY_SCOPE_AGENT); tab[e] = c; tab[8 + e] = pb; pb += (c + 255) >> 8; } tab[16] = pb; } \
        __syncthreads(); \
        const int nbt = tab[16]; int nMp = nbt - (part) * MOE_NBP; nMp = nMp < 0 ? 0 : (nMp > MOE_NBP ? MOE_NBP : nMp); \
        if (IN(phg)) { pg8::SchedMoeGU S; S.A = (const char*)HN; S.Bt = (const char*)(ws + W_MGU); S.K = D / 2; S.nM = nMp; S.nN = 2 * DFE / 256; S.G = F.G; S.c = bx; S.blk0 = (part) * MOE_NBP; S.bstride = (size_t)2 * DFE * D; \
            S.row_ts = (const int*)(ws + WS_ROWTS); S.tab = tab; S.gather = true; pg8::EpiSwiGLUI8F8 E{(bf16*)(ws + WS_ACT8), DFE, (const float*)(ws + WS_ROWSA), (const float*)(ws + WS_SB)}; pg8::gemm_phase(F.lds, S, E, F.wave); \
              \
            { const int remg = (nMp * (2 * DFE / 256)) % F.G; if (remg != 0 && bx >= remg) { pg8::SchedDense S2; S2.init(ws + WS_PB2, ws + W_PPROJ + (size_t)D * 256 * 2, T, D, 256, F.G - remg, bx - remg, 0, 1); pg8::EpiStoreBf16 E2{YB, D}; pg8::gemm_phase(F.lds, S2, E2, F.wave); } } } \
        SEAM(phg); \
        if (IN(phd)) { pg8::SchedMoeDown S; S.A = (const char*)(ws + WS_ACT8); S.Bt = (const char*)(ws + W_MD); S.K = DFE / 2; S.nM = nMp; S.nN = D / 256; S.G = F.G; S.c = bx; S.blk0 = (part) * MOE_NBP; S.bstride = (size_t)D * DFE; \
            S.row_ts = (const int*)(ws + WS_ROWTS); S.tab = tab; S.gather = false; pg8::EpiMoeDown E{(bf16*)args.out, (const int*)(ws + WS_ROWTS), (const float*)(ws + WS_ROWGATE), (const float*)(ws + WS_SB) + SBO_MD}; pg8::gemm_phase(F.lds, S, E, F.wave); \
              \
            { const int rem = (nMp * (D / 256)) % F.G, remg = (nMp * (2 * DFE / 256)) % F.G, done = remg ? F.G - remg : 0;     \
              if (rem == 0 || bx >= rem) { pg8::SchedDense S2; S2.init(ws + WS_PB2, ws + W_PPROJ + (size_t)D * 256 * 2, T, D, 256, rem ? F.G - rem : F.G, rem ? bx - rem : bx, done); pg8::EpiStoreBf16 E2{YB, D}; pg8::gemm_phase(F.lds, S2, E2, F.wave); } } } \
        SEAM(phd); \
    }
    MOE_PART(0, 16, 17)
    if (IN(22)) { combine_norm(phase_frame(F), args); } SEAM(22);
    const bool fuse_final = (F.G == 256);
    if (IN(24)) { pg8::SchedDense S; S.init(HN, ws + W_PGATE + (size_t)D * D, T, D, D / 2, F.G, bx);
        if (fuse_final) { pg8::EpiPleGateFinal E{ws, args.in[5], args.out, F.lds}; pg8::gemm_phase(F.lds, S, E, F.wave); }
        else { pg8::EpiPleGateI8 E{XB, YB, SAp, SBp + SBO_PGATE + D}; pg8::gemm_phase(F.lds, S, E, F.wave); } }
    if (!fuse_final) { SEAM(24); if (IN(25)) final_norm(phase_frame(F), args); }

#undef IN
#undef SEAM
}

#ifndef MK_MULTI_LAUNCH
#define MK_MULTI_LAUNCH 0
#endif
extern "C" void kernel_launch(void* const* d_in, const int* in_sizes, int n_in, void* d_out, int out_size, void* d_ws, size_t ws_size, hipStream_t stream) {
    static int grid = 0;
    if (grid == 0) {
        if (n_in != 29 || out_size != T * D || ws_size < WS_END) { fprintf(stderr, "kernel_launch: unexpected shapes (n_in %d out %d ws %zu)\n", n_in, out_size, ws_size); grid = -1; return; }
        int dev = 0, cus = 0, per_cu = 0;
        if (hipGetDevice(&dev) != hipSuccess || hipDeviceGetAttribute(&cus, hipDeviceAttributeMultiprocessorCount, dev) != hipSuccess) { grid = -1; return; }
        if (hipFuncSetAttribute((const void*)fwd_kernel, hipFuncAttributeMaxDynamicSharedMemorySize, LDS_BYTES) != hipSuccess) { fprintf(stderr, "kernel_launch: LDS attribute failed\n"); grid = -1; return; }
        if (hipOccupancyMaxActiveBlocksPerMultiprocessor(&per_cu, (const void*)fwd_kernel, 512, LDS_BYTES) != hipSuccess || per_cu < 1) { fprintf(stderr, "kernel_launch: occupancy query says %d\n", per_cu); }
        (void)hipGetLastError();
        grid = cus;
    }
    if (grid < 0) return;
    (void)hipMemsetAsync((char*)d_ws + WS_CTL, 0, CTL_BYTES, stream);
    Args a{};
    for (int i = 0; i < 29; ++i) a.in[i] = (const float*)d_in[i];
    a.out = (float*)d_out; a.ws = (unsigned char*)d_ws;
#if MK_MULTI_LAUNCH
    for (int ph = 0; ph < NPH; ++ph) { a.ph_lo = ph; a.ph_hi = ph + 1; hipLaunchKernelGGL(fwd_kernel, dim3(grid), dim3(512), LDS_BYTES, stream, a); }
#else
    a.ph_lo = 0; a.ph_hi = NPH;
    hipLaunchKernelGGL(fwd_kernel, dim3(grid), dim3(512), LDS_BYTES, stream, a);
#endif
}
```
